# Optimizing an MI355X kernel written in HIP

```python
import jax
import jax.numpy as jnp
from jax import lax
import numpy as np

D_MODEL = 2048
BATCH = 1
SEQ = 16384
DEPTH = 1
DEC_BATCH = 32
DEC_SEQ = 4
PAST_LEN = 16384
PAGE_SIZE = 128

HEAD_DIM = 128
ATT_GROUPS = ((128, 1), (512, 4), (2048, 16))
H_G = 4
N_ATT_HEADS = H_G * len(ATT_GROUPS)
ATT_W = N_ATT_HEADS * HEAD_DIM
ATT_OUT = H_G * HEAD_DIM
ROT_DIM = HEAD_DIM // 4
ROPE_THETA = 500000.0
Q_BLOCK = 128

HG_HEADS = 8
HG_DK = 128
HG_DV = 128
HG_WK = HG_HEADS * HG_DK
HG_WV = HG_HEADS * HG_DV
HG_CHUNK = 64

D_FF = 5632
CONV_W = 3

N_MOD = 6
EPS = 1e-6

IN_SIZES = (ATT_W, ATT_W, ATT_W, HG_WK, HG_WK, HG_WV, HG_WV, D_MODEL, D_MODEL)
IN_TOTAL = sum(IN_SIZES)
IN_SPLITS = tuple(int(s) for s in np.cumsum(IN_SIZES)[:-1])

kernel_name = 'hybrid_dilated_attn_hgrn2_convffn_step'


def rms_norm(x, w):
    xf = x.astype(jnp.float32)
    y = xf * lax.rsqrt(jnp.mean(xf * xf, axis=-1, keepdims=True) + EPS)
    return (y * w.astype(jnp.float32)).astype(x.dtype)


def partial_rope(x, pos):
    half = ROT_DIM // 2
    inv_freq = ROPE_THETA ** (-jnp.arange(half, dtype=jnp.float32) * 2.0 / ROT_DIM)
    ang = pos.astype(jnp.float32)[:, None] * inv_freq[None, :]
    cos = jnp.cos(ang)[None, :, None, :]
    sin = jnp.sin(ang)[None, :, None, :]
    xr = x[..., :ROT_DIM].astype(jnp.float32)
    x1, x2 = xr[..., :half], xr[..., half:]
    rot = jnp.concatenate([x1 * cos - x2 * sin, x2 * cos + x1 * sin], axis=-1).astype(x.dtype)
    return jnp.concatenate([rot, x[..., ROT_DIM:]], axis=-1)


def dilated_attention(q_groups, ctx_groups, prefix_lens, start):
    B, T = q_groups[0].shape[:2]
    qb = min(Q_BLOCK, T)
    n_blk = -(-T // qb)
    pad = n_blk * qb - T
    qs = [jnp.pad(q, ((0, 0), (0, pad), (0, 0), (0, 0))) for q in q_groups]
    scale = HEAD_DIM ** -0.5

    def block(n):
        t = n * qb + jnp.arange(qb, dtype=jnp.int32)
        lses, outs = [], []
        for (win, dil), q, ctx, P in zip(ATT_GROUPS, qs, ctx_groups, prefix_lens):
            j = jnp.arange(win // dil + 1, dtype=jnp.int32)
            row = P + t[:, None] - dil * j[None, :]
            valid = (row >= 0) & (row + (start - P) >= 0)
            kv = jnp.take(ctx, jnp.clip(row, 0, ctx.shape[1] - 1), axis=1).astype(jnp.float32)
            qblk = lax.dynamic_slice_in_dim(q, n * qb, qb, axis=1).astype(jnp.float32)
            s = jnp.einsum('bqhd,bqkhd->bhqk', qblk, kv[:, :, :, 0]) * scale
            s = jnp.where(valid[None, None], s, -jnp.inf)
            m = jnp.max(s, axis=-1)
            p = jnp.exp(s - m[..., None])
            l = jnp.sum(p, axis=-1)
            o = jnp.einsum('bhqk,bqkhd->bqhd', p, kv[:, :, :, 1]) / jnp.transpose(l, (0, 2, 1))[..., None]
            lses.append(m + jnp.log(l))
            outs.append(o)
        wts = jax.nn.softmax(jnp.stack(lses), axis=0)
        wts = jnp.transpose(wts, (0, 1, 3, 2))[..., None]
        return jnp.sum(wts * jnp.stack(outs), axis=0).astype(q_groups[0].dtype)

    out = lax.map(block, jnp.arange(n_blk, dtype=jnp.int32))
    return jnp.moveaxis(out, 0, 1).reshape(B, n_blk * qb, H_G, HEAD_DIM)[:, :T]


def hgrn2_recurrence(q, k, v, logf, s0):
    B, T, H, DK = q.shape
    DV = v.shape[-1]
    C = min(HG_CHUNK, T)
    n = -(-T // C)
    pad = n * C - T

    def chunks(a):
        a = jnp.pad(a, ((0, 0), (0, pad), (0, 0), (0, 0)))
        return jnp.moveaxis(a.reshape(B, n, C, H, a.shape[-1]), 1, 0)

    causal = jnp.tril(jnp.ones((C, C), dtype=bool))

    def step(S, inp):
        qc, kc, vc, gc = inp
        b = jnp.cumsum(gc, axis=1)
        diff = b[:, :, None] - b[:, None]
        decay = jnp.exp(jnp.where(causal[None, :, :, None, None], diff, -jnp.inf))
        att = jnp.einsum('bthd,btshd,bshd->bhts', qc, decay, kc)
        o = (jnp.einsum('bhts,bshv->bthv', att, vc)
             + jnp.einsum('bthd,bhdv->bthv', qc * jnp.exp(b), S))
        b_last = b[:, -1]
        S = (jnp.exp(b_last)[..., None] * S
             + jnp.einsum('bshd,bshv->bhdv', kc * jnp.exp(b_last[:, None] - b), vc))
        return S, o

    S, o = lax.scan(step, s0, (chunks(q), chunks(k), chunks(v), chunks(logf)))
    o = jnp.moveaxis(o, 0, 1).reshape(B, n * C, H, DV)[:, :T]
    return o, S


def conv_ffn(h, buf, w_a, w_b, conv_w, conv_b, w_down):
    T = h.shape[1]
    a = h @ w_a
    ctx = jnp.concatenate([buf.astype(a.dtype), a], axis=1)
    u = conv_b + sum(ctx[:, i:i + T] * conv_w[i] for i in range(CONV_W))
    y = jax.nn.silu(u) * (h @ w_b)
    return y @ w_down, ctx[:, T:]


def decoder_layer(x, c, start, kv_prefixes, hg_s0, conv_buf, lower_bound,
                  w_ada, b_ada, norm1_w, w_in, hg_norm_w, w_pa, w_pb, w_o,
                  norm2_w, w_ffn_a, w_ffn_b, conv_w, conv_b, w_ffn_down):
    B, T, _ = x.shape
    mod = jax.nn.silu(c) @ w_ada + b_ada
    sh1, sc1, g1, sh2, sc2, g2 = jnp.split(mod[:, None, :], N_MOD, axis=-1)

    h = rms_norm(x, norm1_w) * (1 + sc1) + sh1
    z = h @ w_in
    qa, ka, va, qh, fh, ih, gh, ga, gb = jnp.split(z, IN_SPLITS, axis=-1)

    pos = start + jnp.arange(T, dtype=jnp.int32)
    qa = partial_rope(qa.reshape(B, T, N_ATT_HEADS, HEAD_DIM), pos)
    ka = partial_rope(ka.reshape(B, T, N_ATT_HEADS, HEAD_DIM), pos)
    kv = jnp.stack([ka, va.reshape(B, T, N_ATT_HEADS, HEAD_DIM)], axis=2)
    q_groups, ctxs, prefix_lens, new_kv = [], [], [], []
    for g, (win, dil) in enumerate(ATT_GROUPS):
        hs = slice(g * H_G, (g + 1) * H_G)
        kv_g = kv[:, :, :, hs]
        prefix = kv_prefixes[g]
        if prefix is None:
            ctx, P, keep = kv_g, 0, min(win, T)
        else:
            ctx = jnp.concatenate([prefix.astype(kv_g.dtype), kv_g], axis=1)
            P = prefix.shape[1]
            keep = P
        q_groups.append(qa[:, :, hs])
        ctxs.append(ctx)
        prefix_lens.append(P)
        new_kv.append(ctx[:, ctx.shape[1] - keep:])
    o_att = dilated_attention(q_groups, ctxs, prefix_lens, start).reshape(B, T, ATT_OUT)

    qf = jax.nn.silu(qh.astype(jnp.float32)).reshape(B, T, HG_HEADS, HG_DK)
    fg = lower_bound + (1.0 - lower_bound) * jax.nn.sigmoid(fh.astype(jnp.float32))
    kf = (1.0 - fg).reshape(B, T, HG_HEADS, HG_DK)
    logf = jnp.log(fg).reshape(B, T, HG_HEADS, HG_DK)
    vf = ih.astype(jnp.float32).reshape(B, T, HG_HEADS, HG_DV)
    o_hg, s_new = hgrn2_recurrence(qf, kf, vf, logf, hg_s0.astype(jnp.float32))
    o_hg = rms_norm(o_hg, hg_norm_w) * jax.nn.silu(gh.astype(jnp.float32).reshape(B, T, HG_HEADS, HG_DV))
    o_hg = o_hg.reshape(B, T, HG_WV).astype(x.dtype)

    y_mix = jax.nn.sigmoid(ga) * (o_att @ w_pa) + jax.nn.sigmoid(gb) * (o_hg @ w_pb)
    x = x + g1 * (y_mix @ w_o)

    h2 = rms_norm(x, norm2_w) * (1 + sc2) + sh2
    f, new_buf = conv_ffn(h2, conv_buf, w_ffn_a, w_ffn_b, conv_w, conv_b, w_ffn_down)
    x = x + g2 * f
    return x, (new_kv[0], new_kv[1], new_kv[2], s_new, new_buf)


def setup_inputs(seed: int = 0) -> dict:
    key = jax.random.key(seed)
    keys = jax.random.split(key, 32)

    def nrm(i, shape, scale=1.0):
        return jax.random.normal(keys[i], shape, jnp.float32) * scale

    d = D_MODEL
    l0 = min(ATT_GROUPS[0][0], PAST_LEN)
    l1 = min(ATT_GROUPS[1][0], PAST_LEN)
    l2 = min(ATT_GROUPS[2][0], PAST_LEN)
    return {
        'x_prompt': nrm(0, (BATCH, SEQ, d)),
        'x_sample': nrm(1, (DEC_BATCH, DEC_SEQ, d)),
        'cache_kv_w128': nrm(2, (DEPTH, DEC_BATCH, l0, 2, H_G, HEAD_DIM)),
        'cache_kv_w512': nrm(3, (DEPTH, DEC_BATCH, l1, 2, H_G, HEAD_DIM)),
        'cache_kv_w2048': nrm(4, (DEPTH, DEC_BATCH, l2, 2, H_G, HEAD_DIM)),
        'state_hgrn': nrm(5, (DEPTH, DEC_BATCH, HG_HEADS, HG_DK, HG_DV), 0.5),
        'state_conv': nrm(6, (DEPTH, DEC_BATCH, CONV_W - 1, D_FF)),
        'c_prompt': nrm(7, (BATCH, d)),
        'c_sample': nrm(8, (DEC_BATCH, d)),
        'w_ada': nrm(9, (DEPTH, d, N_MOD * d), 0.5 * d ** -0.5),
        'b_ada': nrm(10, (DEPTH, N_MOD * d), 0.02),
        'norm1_w': 1.0 + nrm(11, (DEPTH, d), 0.02),
        'w_in': nrm(12, (DEPTH, d, IN_TOTAL), d ** -0.5),
        'hg_lb': nrm(13, (DEPTH + 1, HG_WK), 0.1),
        'hg_norm_w': 1.0 + nrm(14, (DEPTH, HG_DV), 0.02),
        'w_pa': nrm(15, (DEPTH, ATT_OUT, d), ATT_OUT ** -0.5),
        'w_pb': nrm(16, (DEPTH, HG_WV, d), HG_WV ** -0.5),
        'w_o': nrm(17, (DEPTH, d, d), d ** -0.5),
        'norm2_w': 1.0 + nrm(18, (DEPTH, d), 0.02),
        'w_ffn_a': nrm(19, (DEPTH, d, D_FF), d ** -0.5),
        'w_ffn_b': nrm(20, (DEPTH, d, D_FF), d ** -0.5),
        'conv_w': nrm(21, (DEPTH, CONV_W, D_FF), CONV_W ** -0.5),
        'conv_b': nrm(22, (DEPTH, D_FF), 0.02),
        'w_ffn_down': nrm(23, (DEPTH, D_FF, d), D_FF ** -0.5),
        'norm_f_w': 1.0 + nrm(24, (d,), 0.02),
    }


def reference(x_prompt, x_sample, cache_kv_w128, cache_kv_w512, cache_kv_w2048, state_hgrn, state_conv,
              c_prompt, c_sample, w_ada, b_ada, norm1_w, w_in, hg_lb, hg_norm_w, w_pa, w_pb, w_o,
              norm2_w, w_ffn_a, w_ffn_b, conv_w, conv_b, w_ffn_down, norm_f_w):
    lower = jnp.cumsum(jax.nn.softmax(hg_lb.astype(jnp.float32), axis=0), axis=0)
    xp, xs = x_prompt, x_sample
    states_p, states_s = [], []
    for l in range(DEPTH):
        lw = (lower[l], w_ada[l], b_ada[l], norm1_w[l], w_in[l], hg_norm_w[l], w_pa[l], w_pb[l], w_o[l],
              norm2_w[l], w_ffn_a[l], w_ffn_b[l], conv_w[l], conv_b[l], w_ffn_down[l])
        hg0 = jnp.zeros((xp.shape[0], HG_HEADS, HG_DK, HG_DV), jnp.float32)
        conv0 = jnp.zeros((xp.shape[0], CONV_W - 1, D_FF), xp.dtype)
        xp, st_p = decoder_layer(xp, c_prompt, 0, (None, None, None), hg0, conv0, *lw)
        xs, st_s = decoder_layer(xs, c_sample, PAST_LEN,
                                 (cache_kv_w128[l], cache_kv_w512[l], cache_kv_w2048[l]),
                                 state_hgrn[l], state_conv[l], *lw)
        states_p.append(st_p)
        states_s.append(st_s)
    y_prompt = rms_norm(xp, norm_f_w)
    y_sample = rms_norm(xs, norm_f_w)

    def stack(states, i):
        return jnp.stack([s[i] for s in states])

    return (y_prompt, y_sample,
            stack(states_p, 0), stack(states_p, 1), stack(states_p, 2), stack(states_p, 3), stack(states_p, 4),
            stack(states_s, 0), stack(states_s, 1), stack(states_s, 2), stack(states_s, 3), stack(states_s, 4))
```

```cpp
#include <hip/hip_runtime.h>
#include <hip/hip_cooperative_groups.h>
#include <cstdio>
namespace cg = cooperative_groups;
namespace pg8 {
#define PG8_LAS __attribute__((address_space(3)))
typedef unsigned short bf16_t;
typedef short bf16x8 __attribute__((ext_vector_type(8)));
typedef float f32x4 __attribute__((ext_vector_type(4)));
typedef unsigned u32x4 __attribute__((ext_vector_type(4)));
constexpr int BM = 256, BK = 64, HALF = 128, HTB = HALF * BK * 2  , STAGE_BYTES = 8 * HTB, NXCD = 8, WGM = 8;

__host__ __device__ __forceinline__ int lds_byte(int r, int c) { const int st = (r >> 4) * 2 + (c >> 5), rr = r & 15, cc = c & 31, ob = rr * 64 + cc * 2; return st * 1024 + (ob ^ (((ob >> 9) & 1) << 5)); }
__host__ __device__ __forceinline__ void stage_rc(int b, int& R, int& C) { const int st = b / 1024, sb = b % 1024, swz = sb ^ (((sb >> 9) & 1) << 5); R = (st >> 1) * 16 + swz / 64; C = (st & 1) * 32 + (swz % 64) / 2; }
__host__ __device__ __forceinline__ int perm32(int rho) { const int n = rho >> 4, i = rho & 15; return 8 * (i >> 2) + 4 * n + (i & 3); }

struct Unit { int pm, pn; };
struct Gemm { const bf16_t* A; const bf16_t* Bt; int M, N, K; };

struct StaticOrder {
    int nM, nN, nwg, G, c;
    __host__ __device__ void init(int M, int N, int G_, int c_) { nM = M / BM; nN = N / BM; nwg = nM * nN; G = G_; c = c_; }
    __host__ __device__ bool next(int i, Unit& u) const {
        const long L = (long)i * G + c; if (L >= nwg) return false;
        int wgid = (int)L; { const int q = nwg / NXCD, r = nwg % NXCD, xcd = wgid % NXCD, off = wgid / NXCD; wgid = (xcd < r ? xcd * (q + 1) : r * (q + 1) + (xcd - r) * q) + off; }
        const int nig = WGM * nN, gid = wgid / nig, fm = gid * WGM, gsz = (nM - fm) < WGM ? (nM - fm) : WGM;
        u.pm = fm + ((wgid % nig) % gsz); u.pn = (wgid % nig) / gsz; return true;
    }
    __device__ __forceinline__ void a_ready(const Unit&) const {}
    __device__ __forceinline__ void done(const Unit&) const {}
};
template <class Epi, class Sched, bool STAMP = false>
__device__ __forceinline__ void gemm_phase(PG8_LAS unsigned char* lds, const Gemm g, const Sched& S, const Epi& E, unsigned long long* stamps) {
    const int tid = threadIdx.x, wid = __builtin_amdgcn_readfirstlane(tid >> 6), lane = tid & 63, wr = wid >> 2, wc = wid & 3, fr = lane & 15, fq = lane >> 4;
    const int K = g.K, nt = K / BK;
    int ts_lo = 0, ts_hi = 0, nts = 0; const unsigned long long rt_entry = STAMP ? (unsigned long long)wall_clock64() : 0ull;
#define PG8_STAMP() do { if (STAMP && wid == 0 && nts < 64) { const unsigned long long _c = (unsigned long long)clock64(); \
        ts_lo = (lane == nts) ? (int)(unsigned)_c : ts_lo; ts_hi = (lane == nts) ? (int)(unsigned)(_c >> 32) : ts_hi; ++nts; } } while (0)
    PG8_STAMP();
    unsigned voffA[2], voffB[2];
#pragma unroll
    for (int i = 0; i < 2; ++i) { int R, C; stage_rc(tid * 16 + i * 8192, R, C); const int Rb = Epi::PERM ? ((R & ~31) + perm32(R & 31)) : R;
        voffA[i] = (unsigned)(R * K + C) * 2u; voffB[i] = (unsigned)(Rb * K + C) * 2u; }
    const size_t kstep = (size_t)(BK * 2);
    const size_t hstep = (size_t)HALF * K * 2;
    const size_t tstep = 2 * hstep;
    const unsigned ldsw = (unsigned)wid * 1024u;
    const int aoff = lds_byte(wr * 64 + fr, fq * 8), boff = lds_byte(wc * 32 + fr, fq * 8);
#define PG8_SA(b, h) (((b) * 2 + (h)) * HTB)
#define PG8_SB(b, h) ((4 + (b) * 2 + (h)) * HTB)
#define PG8_STAGE(bufoff, gbase, voff) do { _Pragma("unroll") for (int _i = 0; _i < 2; ++_i) \
        __builtin_amdgcn_global_load_lds((const unsigned*)((const char*)(gbase) + (voff)[_i]), (PG8_LAS unsigned*)(lds + (bufoff) + ldsw + _i * 8192), 16, 0, 0); } while (0)
#define PG8_LDA(dst, b, h) do { _Pragma("unroll") for (int m = 0; m < 4; ++m) _Pragma("unroll") for (int k = 0; k < 2; ++k) dst[m][k] = *(const PG8_LAS bf16x8*)(lds + PG8_SA(b, h) + aoff + m * 2048 + k * 1024); } while (0)
#define PG8_LDB(dst, b, h) do { _Pragma("unroll") for (int n = 0; n < 2; ++n) _Pragma("unroll") for (int k = 0; k < 2; ++k) dst[n][k] = *(const PG8_LAS bf16x8*)(lds + PG8_SB(b, h) + boff + n * 2048 + k * 1024); } while (0)
#define PG8_MMA(ai, bj, At, Bt) do { __builtin_amdgcn_s_setprio(1); _Pragma("unroll") for (int m = 0; m < 4; ++m) _Pragma("unroll") for (int n = 0; n < 2; ++n) _Pragma("unroll") for (int k = 0; k < 2; ++k) \
        acc[ai][bj][m][n] = __builtin_amdgcn_mfma_f32_16x16x32_bf16(Bt[n][k], At[m][k], acc[ai][bj][m][n], 0, 0, 0); __builtin_amdgcn_s_setprio(0); } while (0)
#define PG8_WAIT_V(n) asm volatile("s_waitcnt vmcnt(" #n ")" ::: "memory")
#define PG8_WAIT_L(n) asm volatile("s_waitcnt lgkmcnt(" #n ")" ::: "memory")
#define PG8_BAR __builtin_amdgcn_s_barrier()
#define PG8_SCHED __builtin_amdgcn_sched_barrier(0)
    Unit cur, nxt; int ui = 0;
    if (!S.next(0, cur)) return;
    f32x4 acc[2][2][4][2];
#pragma unroll
    for (int a = 0; a < 2; ++a)
#pragma unroll
        for (int b = 0; b < 2; ++b)
#pragma unroll
            for (int m = 0; m < 4; ++m)
#pragma unroll
                for (int n = 0; n < 2; ++n) acc[a][b][m][n] = (f32x4){0.f, 0.f, 0.f, 0.f};
    bf16x8 At[4][2], B0[2][2], B1[2][2];
    const char* cA = (const char*)g.A + (size_t)cur.pm * tstep; const char* cB = (const char*)g.Bt + (size_t)cur.pn * tstep;
    S.a_ready(cur);
    PG8_STAGE(PG8_SB(0, 0), cB, voffB); PG8_STAGE(PG8_SA(0, 0), cA, voffA); PG8_STAGE(PG8_SB(0, 1), cB + hstep, voffB); PG8_STAGE(PG8_SA(0, 1), cA + hstep, voffA);
    if (wr == 1) PG8_BAR;
    PG8_WAIT_V(4); PG8_BAR;
    PG8_STAGE(PG8_SB(1, 0), cB + kstep, voffB); PG8_STAGE(PG8_SA(1, 0), cA + kstep, voffA); PG8_STAGE(PG8_SB(1, 1), cB + hstep + kstep, voffB);
    PG8_WAIT_V(6); PG8_BAR;
    PG8_STAMP();
    for (;;) {
        const bool has_next = S.next(ui + 1, nxt);
        const char* nA = has_next ? (const char*)g.A + (size_t)nxt.pm * tstep : cA; const char* nB = has_next ? (const char*)g.Bt + (size_t)nxt.pn * tstep : cB;
        for (int t = 0; t < nt; t += 2) {
            const bool last = (t == nt - 2);
            const char* a1 = cA + (size_t)(t + 1) * kstep;
            const char* a2 = last ? nA : cA + (size_t)(t + 2) * kstep; const char* b2 = last ? nB : cB + (size_t)(t + 2) * kstep;
            const char* a3 = a2 + kstep; const char* b3 = b2 + kstep;
            if (last && has_next) S.a_ready(nxt);
            PG8_LDB(B0, 0, 0); PG8_SCHED; PG8_LDA(At, 0, 0); PG8_STAGE(PG8_SA(1, 1), a1 + hstep, voffA);
            PG8_WAIT_L(8); PG8_BAR; PG8_WAIT_L(0); PG8_MMA(0, 0, At, B0); PG8_BAR; PG8_SCHED;
            PG8_LDB(B1, 0, 1); PG8_STAGE(PG8_SB(0, 0), b2, voffB);
            PG8_BAR; PG8_WAIT_L(0); PG8_MMA(0, 1, At, B1); PG8_BAR;
            PG8_LDA(At, 0, 1); PG8_STAGE(PG8_SA(0, 0), a2, voffA);
            PG8_BAR; PG8_WAIT_L(0); PG8_MMA(1, 0, At, B0); PG8_BAR; PG8_SCHED;
            PG8_STAGE(PG8_SB(0, 1), b2 + hstep, voffB);
            PG8_WAIT_V(6); PG8_BAR; PG8_MMA(1, 1, At, B1); PG8_BAR;
            PG8_LDB(B0, 1, 0); PG8_SCHED; PG8_LDA(At, 1, 0); PG8_STAGE(PG8_SA(0, 1), a2 + hstep, voffA);
            PG8_WAIT_L(8); PG8_BAR; PG8_WAIT_L(0); PG8_MMA(0, 0, At, B0); PG8_BAR; PG8_SCHED;
            PG8_LDB(B1, 1, 1); PG8_STAGE(PG8_SB(1, 0), b3, voffB);
            PG8_BAR; PG8_WAIT_L(0); PG8_MMA(0, 1, At, B1); PG8_BAR;
            PG8_LDA(At, 1, 1); PG8_STAGE(PG8_SA(1, 0), a3, voffA);
            PG8_BAR; PG8_WAIT_L(0); PG8_MMA(1, 0, At, B0); PG8_BAR; PG8_SCHED;
            PG8_STAGE(PG8_SB(1, 1), b3 + hstep, voffB);
            PG8_WAIT_V(6); PG8_BAR; PG8_MMA(1, 1, At, B1); PG8_BAR;
        }
        PG8_STAMP();
        if constexpr (!Epi::AFTER_DRAIN) { E(acc, cur, wr, wc, fr, fq); S.done(cur); }
        PG8_STAMP();
        if (!has_next) break;
#pragma unroll
        for (int a = 0; a < 2; ++a)
#pragma unroll
            for (int b = 0; b < 2; ++b)
#pragma unroll
                for (int m = 0; m < 4; ++m)
#pragma unroll
                    for (int n = 0; n < 2; ++n) acc[a][b][m][n] = (f32x4){0.f, 0.f, 0.f, 0.f};
        cur = nxt; cA = nA; cB = nB; ++ui;
    }
    PG8_WAIT_V(0);
    if (wr == 0) PG8_BAR;
    PG8_BAR;
    if constexpr (Epi::AFTER_DRAIN) { E.fused(acc, cur, wr, wc, fr, fq, lds, wid, lane); S.done(cur); }
    PG8_STAMP();
    if (STAMP && wid == 0) { stamps[lane] = lane < nts ? (((unsigned long long)(unsigned)ts_hi << 32) | (unsigned)ts_lo) : 0ull;
        if (lane == 62) stamps[62] = rt_entry; if (lane == 63) stamps[63] = (unsigned long long)wall_clock64(); }
#undef PG8_STAMP
#undef PG8_SA
#undef PG8_SB
#undef PG8_STAGE
#undef PG8_LDA
#undef PG8_LDB
#undef PG8_MMA
#undef PG8_WAIT_V
#undef PG8_WAIT_L
#undef PG8_BAR
#undef PG8_SCHED
}
}

using pg8::bf16_t; using pg8::bf16x8; using pg8::f32x4; using pg8::Unit;
#define LAS __attribute__((address_space(3)))
#define DI __device__ __forceinline__
typedef float f32x16 __attribute__((ext_vector_type(16)));
typedef float f32x2 __attribute__((ext_vector_type(2)));
typedef unsigned u32x4 __attribute__((ext_vector_type(4)));
typedef unsigned u32x2 __attribute__((ext_vector_type(2)));

constexpr int D = 2048, TP = 16384, NS = 128, MR = TP + NS, MP = 16640;
constexpr int NZ = 12800, DFF = 5632, NAB = 2 * DFF;
constexpr int ZQ = 0, ZK = 1536, ZV = 3072, ZQH = 4608, ZFH = 5632, ZIH = 6656, ZGH = 7680, ZGA = 8704, ZGB = 10752;
constexpr int NMODROW = 33, NMOD = 6 * D;
constexpr float EPS = 1e-6f;
constexpr float ATT_SCALE = 0.08838834764831845f;
constexpr size_t OFF_Y = 0;
constexpr size_t OFF_KVP0 = (size_t)MR * D;
constexpr size_t OFF_KVP1 = OFF_KVP0 + 128 * 1024;
constexpr size_t OFF_KVP2 = OFF_KVP1 + 512 * 1024;
constexpr size_t OFF_HGP = OFF_KVP2 + 2048 * 1024;
constexpr size_t OFF_CVP = OFF_HGP + 8 * 128 * 128;
constexpr size_t OFF_KVS0 = OFF_CVP + 2 * DFF;
constexpr size_t OFF_KVS1 = OFF_KVS0 + (size_t)32 * 128 * 1024;
constexpr size_t OFF_KVS2 = OFF_KVS1 + (size_t)32 * 512 * 1024;
constexpr size_t OFF_HGS = OFF_KVS2 + (size_t)32 * 2048 * 1024;
constexpr size_t OFF_CVS = OFF_HGS + (size_t)32 * 8 * 128 * 128;
constexpr size_t OUT_TOTAL = OFF_CVS + (size_t)32 * 2 * DFF;
static_assert(OUT_TOTAL == 129346560, "output size");
constexpr size_t WS_WIN = 1u << 20;
constexpr size_t WS_WPA = WS_WIN + (size_t)NZ * D * 2;
constexpr size_t WS_WPB = WS_WPA + (size_t)2048 * 512 * 2;
constexpr size_t WS_WO = WS_WPB + (size_t)2048 * 1024 * 2;
constexpr size_t WS_WAB = WS_WO + (size_t)2048 * 2048 * 2;
constexpr size_t WS_WDN = WS_WAB + (size_t)NAB * D * 2;
constexpr size_t WS_MOD = WS_WDN + (size_t)D * DFF * 2;
constexpr size_t WS_ROPE = WS_MOD + (size_t)NMODROW * NMOD * 4;
constexpr size_t WS_Z = WS_ROPE + (size_t)MP * 32 * 4;
constexpr size_t WS_AB = WS_Z;
constexpr size_t WS_H = WS_Z + (size_t)MP * NZ * 2;
constexpr size_t WS_OG = WS_H + (size_t)MP * D * 2;
constexpr size_t WS_LSE = WS_OG + (size_t)3 * MP * 512 * 2;
constexpr size_t WS_OATT = WS_LSE + (size_t)3 * MP * 4 * 4;
constexpr size_t WS_OHG = WS_OATT + (size_t)MP * 512 * 2;
constexpr size_t WS_YMIX = WS_OHG + (size_t)MP * 1024 * 2;
constexpr size_t WS_BLK_END = WS_YMIX + (size_t)MP * D * 2;
constexpr size_t WS_G = WS_H;
static_assert(WS_G + (size_t)MP * DFF * 2 <= WS_BLK_END, "g overlay");
static_assert((size_t)MP * NAB * 2 <= (size_t)MP * NZ * 2, "ab overlay");
constexpr size_t WS_HS = WS_BLK_END;
constexpr size_t WS_HD = WS_HS + (size_t)256 * 8 * 128 * 128 * 4;
constexpr size_t WS_TMP = WS_HS;
constexpr size_t WS_END = WS_TMP + (size_t)MP * D * 4 + (2u << 20);
static_assert(WS_HD + (size_t)256 * 8 * 128 * 4 <= WS_END, "hd");
static_assert(WS_WIN % 256 == 0 && WS_MOD % 256 == 0 && WS_ROPE % 256 == 0 && WS_Z % 256 == 0 && WS_H % 256 == 0 && WS_OG % 256 == 0 && WS_LSE % 256 == 0 && WS_OATT % 256 == 0 && WS_OHG % 256 == 0 && WS_YMIX % 256 == 0 && WS_HS % 256 == 0 && WS_HD % 256 == 0, "align");
constexpr int LDS_BYTES = 131072;
constexpr int NPH = 13;

struct Params { const float* in[25]; float* out; unsigned char* ws; int ph_lo, ph_hi; };

DI float bf2f(unsigned b) { return __uint_as_float(b << 16); }
DI float bflo(unsigned w) { return __uint_as_float(w << 16); }
DI float bfhi(unsigned w) { return __uint_as_float(w & 0xffff0000u); }
DI unsigned pk2(float lo, float hi) { unsigned r; asm("v_cvt_pk_bf16_f32 %0, %1, %2" : "=v"(r) : "v"(lo), "v"(hi)); return r; }
DI float sigm(float x) { return 1.f / (1.f + __expf(-x)); }
DI float silu(float x) { return x / (1.f + __expf(-x)); }
DI float wave_sum(float v) {
#pragma unroll
    for (int o = 32; o >= 1; o >>= 1) v += __shfl_xor(v, o);
    return v;
}
DI float wave_max(float v) {
#pragma unroll
    for (int o = 32; o >= 1; o >>= 1) v = fmaxf(v, __shfl_xor(v, o));
    return v;
}
DI void lds_fence() { asm volatile("s_waitcnt lgkmcnt(0)" ::: "memory"); __builtin_amdgcn_wave_barrier(); }
DI bf16x8 gat8(const LAS bf16_t* p, int stride) {
    bf16x8 r;
#pragma unroll
    for (int j = 0; j < 8; ++j) r[j] = (short)p[j * stride];
    return r;
}
DI bf16x8 ld8(const LAS bf16_t* p) { return *(const LAS bf16x8*)p; }
DI f32x4 mfma16(bf16x8 a, bf16x8 b, f32x4 c) { return __builtin_amdgcn_mfma_f32_16x16x32_bf16(a, b, c, 0, 0, 0); }
DI f32x16 mfma32(bf16x8 a, bf16x8 b, f32x16 c) { return __builtin_amdgcn_mfma_f32_32x32x16_bf16(a, b, c, 0, 0, 0); }
DI void unpack8(u32x4 w, float (&f)[8]) { f[0] = bflo(w.x); f[1] = bfhi(w.x); f[2] = bflo(w.y); f[3] = bfhi(w.y); f[4] = bflo(w.z); f[5] = bfhi(w.z); f[6] = bflo(w.w); f[7] = bfhi(w.w); }
DI int crow_of(int r) { return r < TP ? 0 : 1 + ((r - TP) >> 2); }

struct EpiZ {
    static constexpr bool PERM = true, AFTER_DRAIN = false;
    bf16_t* Z; const float* rope; float* out;
    DI void operator()(const f32x4 (&acc)[2][2][4][2], const Unit& u, int wr, int wc, int fr, int fq) const {
        const int kind = u.pn < 6 ? 0 : (u.pn < 12 ? 1 : (u.pn < 18 ? 2 : 3));
        const bool do_rope = (kind <= 1) && (wc == 0);
        const int pnn = (kind == 1) ? u.pn - 6 : u.pn - 12;
        const int g = pnn >> 1, W = 128 << (2 * g);
        const size_t offp = g == 0 ? OFF_KVP0 : (g == 1 ? OFF_KVP1 : OFF_KVP2), offs = g == 0 ? OFF_KVS0 : (g == 1 ? OFF_KVS1 : OFF_KVS2);
        const float sg = (fq < 2) ? -1.f : 1.f;
#pragma unroll
        for (int ai = 0; ai < 2; ++ai)
#pragma unroll
            for (int m = 0; m < 4; ++m) {
                const int r = u.pm * 256 + ai * 128 + wr * 64 + m * 16 + fr;
                f32x4 cs0 = {0.f, 0.f, 0.f, 0.f}, cs1 = cs0, sn0 = cs0, sn1 = cs0;
                if (do_rope) { const float* rp = rope + (size_t)r * 32 + 8 * (fq & 1); cs0 = *(const f32x4*)rp; cs1 = *(const f32x4*)(rp + 4); sn0 = *(const f32x4*)(rp + 16); sn1 = *(const f32x4*)(rp + 20); }
#pragma unroll
                for (int bj = 0; bj < 2; ++bj) {
                    f32x4 v0 = acc[ai][bj][m][0], v1 = acc[ai][bj][m][1];
                    if (do_rope) {
                        f32x4 p0, p1;
#pragma unroll
                        for (int j = 0; j < 4; ++j) { p0[j] = __shfl_xor(v0[j], 32); p1[j] = __shfl_xor(v1[j], 32); }
                        v0 = v0 * cs0 + sg * (p0 * sn0); v1 = v1 * cs1 + sg * (p1 * sn1);
                    }
                    const int c = u.pn * 256 + bj * 128 + wc * 32 + 8 * fq;
                    u32x4 w; w.x = pk2(v0[0], v0[1]); w.y = pk2(v0[2], v0[3]); w.z = pk2(v1[0], v1[1]); w.w = pk2(v1[2], v1[3]);
                    *(u32x4*)(Z + (size_t)r * NZ + c) = w;
                    if (kind == 1 || kind == 2) {
                        const int hh = 2 * (pnn & 1) + bj, dd = wc * 32 + 8 * fq, kv = kind - 1;
                        float* dst = nullptr;
                        if (r < TP) { if (r >= TP - W) dst = out + offp + ((size_t)(r - (TP - W)) * 2 + kv) * 512 + hh * 128 + dd; }
                        else if (r < MR) { const int b = (r - TP) >> 2, t = (r - TP) & 3; dst = out + offs + ((size_t)(b * W + W - 4 + t) * 2 + kv) * 512 + hh * 128 + dd; }
                        if (dst) { *(f32x4*)dst = v0; *(f32x4*)(dst + 4) = v1; }
                    }
                }
            }
    }
};
struct EpiMix1 {
    static constexpr bool PERM = false, AFTER_DRAIN = false;
    const bf16_t* Z; float* TMP;
    DI void operator()(const f32x4 (&acc)[2][2][4][2], const Unit& u, int wr, int wc, int fr, int fq) const {
#pragma unroll
        for (int ai = 0; ai < 2; ++ai)
#pragma unroll
            for (int m = 0; m < 4; ++m) {
                const int r = u.pm * 256 + ai * 128 + wr * 64 + m * 16 + fr;
#pragma unroll
                for (int bj = 0; bj < 2; ++bj)
#pragma unroll
                    for (int n = 0; n < 2; ++n) {
                        const int c = u.pn * 256 + bj * 128 + wc * 32 + 16 * n + 4 * fq;
                        const u32x2 gw = *(const u32x2*)(Z + (size_t)r * NZ + ZGA + c);
                        f32x4 v = acc[ai][bj][m][n];
                        v[0] *= sigm(bflo(gw.x)); v[1] *= sigm(bfhi(gw.x)); v[2] *= sigm(bflo(gw.y)); v[3] *= sigm(bfhi(gw.y));
                        *(f32x4*)(TMP + (size_t)r * D + c) = v;
                    }
            }
    }
};
struct EpiMix2 {
    static constexpr bool PERM = false, AFTER_DRAIN = false;
    const bf16_t* Z; const float* TMP; bf16_t* Y;
    DI void operator()(const f32x4 (&acc)[2][2][4][2], const Unit& u, int wr, int wc, int fr, int fq) const {
#pragma unroll
        for (int ai = 0; ai < 2; ++ai)
#pragma unroll
            for (int m = 0; m < 4; ++m) {
                const int r = u.pm * 256 + ai * 128 + wr * 64 + m * 16 + fr;
#pragma unroll
                for (int bj = 0; bj < 2; ++bj)
#pragma unroll
                    for (int n = 0; n < 2; ++n) {
                        const int c = u.pn * 256 + bj * 128 + wc * 32 + 16 * n + 4 * fq;
                        const u32x2 gw = *(const u32x2*)(Z + (size_t)r * NZ + ZGB + c);
                        const f32x4 t = *(const f32x4*)(TMP + (size_t)r * D + c);
                        f32x4 v = acc[ai][bj][m][n];
                        v[0] = t[0] + v[0] * sigm(bflo(gw.x)); v[1] = t[1] + v[1] * sigm(bfhi(gw.x)); v[2] = t[2] + v[2] * sigm(bflo(gw.y)); v[3] = t[3] + v[3] * sigm(bfhi(gw.y));
                        u32x2 w; w.x = pk2(v[0], v[1]); w.y = pk2(v[2], v[3]);
                        *(u32x2*)(Y + (size_t)r * D + c) = w;
                    }
            }
    }
};
struct EpiWO {
    static constexpr bool PERM = false, AFTER_DRAIN = false;
    const float* xp; const float* xs; const float* mod; float* out;
    DI void operator()(const f32x4 (&acc)[2][2][4][2], const Unit& u, int wr, int wc, int fr, int fq) const {
#pragma unroll
        for (int ai = 0; ai < 2; ++ai)
#pragma unroll
            for (int m = 0; m < 4; ++m) {
                const int r = u.pm * 256 + ai * 128 + wr * 64 + m * 16 + fr;
                if (r < MR) {
                    const float* xr = r < TP ? xp + (size_t)r * D : xs + (size_t)(r - TP) * D;
                    const float* g1 = mod + (size_t)crow_of(r) * NMOD + 2 * D;
#pragma unroll
                    for (int bj = 0; bj < 2; ++bj)
#pragma unroll
                        for (int n = 0; n < 2; ++n) {
                            const int c = u.pn * 256 + bj * 128 + wc * 32 + 16 * n + 4 * fq;
                            const f32x4 xv = *(const f32x4*)(xr + c), gv = *(const f32x4*)(g1 + c);
                            *(f32x4*)(out + (size_t)r * D + c) = xv + gv * acc[ai][bj][m][n];
                        }
                }
            }
    }
};
struct EpiDown {
    static constexpr bool PERM = false, AFTER_DRAIN = false;
    const float* mod; float* out;
    DI void operator()(const f32x4 (&acc)[2][2][4][2], const Unit& u, int wr, int wc, int fr, int fq) const {
#pragma unroll
        for (int ai = 0; ai < 2; ++ai)
#pragma unroll
            for (int m = 0; m < 4; ++m) {
                const int r = u.pm * 256 + ai * 128 + wr * 64 + m * 16 + fr;
                if (r < MR) {
                    const float* g2 = mod + (size_t)crow_of(r) * NMOD + 5 * D;
#pragma unroll
                    for (int bj = 0; bj < 2; ++bj)
#pragma unroll
                        for (int n = 0; n < 2; ++n) {
                            const int c = u.pn * 256 + bj * 128 + wc * 32 + 16 * n + 4 * fq;
                            float* o = out + (size_t)r * D + c;
                            const f32x4 xv = *(const f32x4*)o, gv = *(const f32x4*)(g2 + c);
                            *(f32x4*)o = xv + gv * acc[ai][bj][m][n];
                        }
                }
            }
    }
};
struct EpiUp {
    static constexpr bool PERM = true, AFTER_DRAIN = false;
    bf16_t* AB; float* out;
    DI void operator()(const f32x4 (&acc)[2][2][4][2], const Unit& u, int wr, int wc, int fr, int fq) const {
#pragma unroll
        for (int ai = 0; ai < 2; ++ai)
#pragma unroll
            for (int m = 0; m < 4; ++m) {
                const int r = u.pm * 256 + ai * 128 + wr * 64 + m * 16 + fr;
#pragma unroll
                for (int bj = 0; bj < 2; ++bj) {
                    const f32x4 v0 = acc[ai][bj][m][0], v1 = acc[ai][bj][m][1];
                    const int c = u.pn * 256 + bj * 128 + wc * 32 + 8 * fq;
                    u32x4 w; w.x = pk2(v0[0], v0[1]); w.y = pk2(v0[2], v0[3]); w.z = pk2(v1[0], v1[1]); w.w = pk2(v1[2], v1[3]);
                    *(u32x4*)(AB + (size_t)r * NAB + c) = w;
                    if (u.pn < 22) {
                        float* dst = nullptr;
                        if (r == TP - 2 || r == TP - 1) dst = out + OFF_CVP + (size_t)(r - (TP - 2)) * DFF + c;
                        else if (r >= TP && r < MR && ((r - TP) & 3) >= 2) dst = out + OFF_CVS + (size_t)(((r - TP) >> 2) * 2 + ((r - TP) & 3) - 2) * DFF + c;
                        if (dst) { *(f32x4*)dst = v0; *(f32x4*)(dst + 4) = v1; }
                    }
                }
            }
    }
};

DI void ph_mod(const Params& p, LAS unsigned char* L, float* mod) {
    LAS float* sS = (LAS float*)L;
    LAS float* sRed = (LAS float*)L;
    const int tid = threadIdx.x, cgp = tid % 12, ksub = tid / 12;
    const float* cpr = p.in[7]; const float* csm = p.in[8]; const float* wada = p.in[9]; const float* bada = p.in[10];
    for (int nb = blockIdx.x; nb < 256; nb += gridDim.x) {
        const int n0 = nb * 48;
        float acc[33][4];
#pragma unroll
        for (int r = 0; r < 33; ++r) { acc[r][0] = 0.f; acc[r][1] = 0.f; acc[r][2] = 0.f; acc[r][3] = 0.f; }
        for (int kc = 0; kc < 4; ++kc) {
            for (int idx = tid; idx < 33 * 512; idx += 512) {
                const int r = idx >> 9, kk = idx & 511;
                const float c = r == 0 ? cpr[kc * 512 + kk] : csm[(r - 1) * D + kc * 512 + kk];
                sS[kk * 36 + r] = silu(c);
            }
            __syncthreads();
            if (ksub < 42) {
                for (int kk = ksub; kk < 512; kk += 42) {
                    const f32x4 w = *(const f32x4*)(wada + (size_t)(kc * 512 + kk) * NMOD + n0 + 4 * cgp);
                    const LAS float* sp = sS + kk * 36;
#pragma unroll
                    for (int r = 0; r < 33; ++r) { const float s = sp[r]; acc[r][0] += s * w[0]; acc[r][1] += s * w[1]; acc[r][2] += s * w[2]; acc[r][3] += s * w[3]; }
                }
            }
            __syncthreads();
        }
#pragma unroll
        for (int r0 = 0; r0 < 33; r0 += 11) {
            if (ksub < 42) {
#pragma unroll
                for (int i = 0; i < 11; ++i)
#pragma unroll
                    for (int j = 0; j < 4; ++j) sRed[ksub * 528 + i * 48 + 4 * cgp + j] = acc[r0 + i][j];
            }
            __syncthreads();
            for (int o = tid; o < 528; o += 512) {
                float s = 0.f;
                for (int k2 = 0; k2 < 42; ++k2) s += sRed[k2 * 528 + o];
                const int i = o / 48, c = o % 48;
                mod[(size_t)(r0 + i) * NMOD + n0 + c] = s + bada[n0 + c];
            }
            __syncthreads();
        }
    }
}
DI void transpose_item(const float* W, int K, int N, bf16_t* WT, int row_off, LAS float* scr, int item, int lane) {
    const int nblk = N / 32, kb = item / nblk, nb = item % nblk, k0 = 64 * kb, n0 = 32 * nb;
#pragma unroll 8
    for (int i = 0; i < 32; ++i) { const int kk = 2 * i + (lane >> 5); scr[kk * 33 + (lane & 31)] = W[(size_t)(k0 + kk) * N + n0 + (lane & 31)]; }
    lds_fence();
    const int c = lane & 7;
#pragma unroll
    for (int j = 0; j < 4; ++j) { const int n = (lane >> 3) + 8 * j; const LAS float* s = scr + (8 * c) * 33 + n;
        u32x4 o; o.x = pk2(s[0 * 33], s[1 * 33]); o.y = pk2(s[2 * 33], s[3 * 33]); o.z = pk2(s[4 * 33], s[5 * 33]); o.w = pk2(s[6 * 33], s[7 * 33]);
        *(u32x4*)(WT + (size_t)(row_off + n0 + n) * K + k0 + 8 * c) = o; }
    lds_fence();
}
DI void ph_prologue(const Params& p, LAS unsigned char* L) {
    unsigned char* ws = p.ws;
    const int tid = threadIdx.x, lane = tid & 63, wave = tid >> 6;
    const int gw = blockIdx.x * 8 + wave, NGW = gridDim.x * 8;
    const size_t gtid = (size_t)blockIdx.x * 512 + tid, gstride = (size_t)gridDim.x * 512;
    ph_mod(p, L, (float*)(ws + WS_MOD));
    LAS float* scr = (LAS float*)(L + wave * 8448);
    constexpr int I_IN = 32 * 400, I_PA = 8 * 64, I_PB = 16 * 64, I_O = 32 * 64, I_A = 32 * 176, I_DN = 88 * 64;
    constexpr int NITEMS = I_IN + I_PA + I_PB + I_O + 2 * I_A + I_DN;
    for (int it = gw; it < NITEMS; it += NGW) {
        int r = it;
        if (r < I_IN) { transpose_item(p.in[12], D, NZ, (bf16_t*)(ws + WS_WIN), 0, scr, r, lane); continue; } r -= I_IN;
        if (r < I_PA) { transpose_item(p.in[15], 512, D, (bf16_t*)(ws + WS_WPA), 0, scr, r, lane); continue; } r -= I_PA;
        if (r < I_PB) { transpose_item(p.in[16], 1024, D, (bf16_t*)(ws + WS_WPB), 0, scr, r, lane); continue; } r -= I_PB;
        if (r < I_O) { transpose_item(p.in[17], D, D, (bf16_t*)(ws + WS_WO), 0, scr, r, lane); continue; } r -= I_O;
        if (r < I_A) { transpose_item(p.in[19], D, DFF, (bf16_t*)(ws + WS_WAB), 0, scr, r, lane); continue; } r -= I_A;
        if (r < I_A) { transpose_item(p.in[20], D, DFF, (bf16_t*)(ws + WS_WAB), DFF, scr, r, lane); continue; } r -= I_A;
        transpose_item(p.in[23], DFF, D, (bf16_t*)(ws + WS_WDN), 0, scr, r, lane);
    }
    {
        float* rope = (float*)(ws + WS_ROPE);
        for (size_t idx = gtid; idx < (size_t)MR * 16; idx += gstride) {
            const int m = (int)(idx >> 4), i = (int)(idx & 15);
            const int pos = m < TP ? m : TP + ((m - TP) & 3);
            const float invf = (float)exp2(-(double)i * (18.931568569324174 / 16.0));
            const float ang = (float)pos * invf;
            const double x = (double)ang, n = rint(x * 0.15915494309189535);
            double rr = fma(-n, 6.283185307179586, x); rr = fma(-n, 2.4492935982947064e-16, rr);
            rope[(size_t)m * 32 + i] = cosf((float)rr); rope[(size_t)m * 32 + 16 + i] = sinf((float)rr);
        }
    }
#pragma unroll
    for (int g = 0; g < 3; ++g) {
        const int W = 128 << (2 * g);
        const f32x4* src = (const f32x4*)p.in[2 + g];
        f32x4* dst = (f32x4*)(p.out + (g == 0 ? OFF_KVS0 : (g == 1 ? OFF_KVS1 : OFF_KVS2)));
        const size_t per = (size_t)(W - 4) * 256, tot = 32 * per;
        for (size_t idx = gtid; idx < tot; idx += gstride) { const size_t b = idx / per, rem = idx - b * per; dst[b * (size_t)W * 256 + rem] = src[b * (size_t)W * 256 + 1024 + rem]; }
    }
}
DI void ph_hnorm(const Params& p, const float* xbase, bool from_out, const float* nw, int sh_idx, bf16_t* H) {
    const int lane = threadIdx.x & 63, wave = threadIdx.x >> 6;
    const float* mod = (const float*)(p.ws + WS_MOD);
    for (int m = blockIdx.x * 8 + wave; m < MR; m += gridDim.x * 8) {
        const float* xr = from_out ? xbase + (size_t)m * D : (m < TP ? p.in[0] + (size_t)m * D : p.in[1] + (size_t)(m - TP) * D);
        const float* md = mod + (size_t)crow_of(m) * NMOD + sh_idx * D;
        f32x4 v[8]; float ss = 0.f;
#pragma unroll
        for (int j = 0; j < 8; ++j) { v[j] = *(const f32x4*)(xr + 4 * lane + 256 * j); ss += v[j][0] * v[j][0] + v[j][1] * v[j][1] + v[j][2] * v[j][2] + v[j][3] * v[j][3]; }
        const float rstd = rsqrtf(wave_sum(ss) * (1.f / D) + EPS);
#pragma unroll
        for (int j = 0; j < 8; ++j) {
            const int c = 4 * lane + 256 * j;
            const f32x4 w = *(const f32x4*)(nw + c), shv = *(const f32x4*)(md + c), scv = *(const f32x4*)(md + D + c);
            const f32x4 o = (v[j] * rstd) * w * (1.f + scv) + shv;
            u32x2 q; q.x = pk2(o[0], o[1]); q.y = pk2(o[2], o[3]);
            *(u32x2*)(H + (size_t)m * D + c) = q;
        }
    }
}
DI void ph_final_norm(const Params& p) {
    const int lane = threadIdx.x & 63, wave = threadIdx.x >> 6;
    const float* nw = p.in[24];
    for (int m = blockIdx.x * 8 + wave; m < MR; m += gridDim.x * 8) {
        float* xr = p.out + (size_t)m * D;
        f32x4 v[8]; float ss = 0.f;
#pragma unroll
        for (int j = 0; j < 8; ++j) { v[j] = *(const f32x4*)(xr + 4 * lane + 256 * j); ss += v[j][0] * v[j][0] + v[j][1] * v[j][1] + v[j][2] * v[j][2] + v[j][3] * v[j][3]; }
        const float rstd = rsqrtf(wave_sum(ss) * (1.f / D) + EPS);
#pragma unroll
        for (int j = 0; j < 8; ++j) { const int c = 4 * lane + 256 * j; const f32x4 w = *(const f32x4*)(nw + c); *(f32x4*)(xr + c) = (v[j] * rstd) * w; }
    }
}

DI void attn_prompt_item(const bf16_t* Z, bf16_t* OG, float* LSE, LAS bf16_t* Vl, int item, int lane) {
    const int g = item >> 11, rem = item & 2047, hh = rem >> 9, bidx = rem & 511;
    const int dsh = 2 * g, nsh = 9 - dsh;
    const int res = bidx >> nsh, blk = bidx & ((1 << nsh) - 1);
    const int s0 = blk * 32, head = g * 4 + hh;
    const int qi = lane & 31, h = lane >> 5;
    const int tq = res + ((s0 + qi) << dsh);
    bf16x8 Qf[8];
    { const bf16_t* qp = Z + (size_t)tq * NZ + ZQ + head * 128 + 8 * h;
#pragma unroll
      for (int ks = 0; ks < 8; ++ks) Qf[ks] = *(const bf16x8*)(qp + 16 * ks); }
    float mrun = -INFINITY, lrun = 0.f;
    f32x16 O[4];
#pragma unroll
    for (int dt = 0; dt < 4; ++dt)
#pragma unroll
        for (int i = 0; i < 16; ++i) O[dt][i] = 0.f;
    const int sq = s0 + qi;
    for (int kt = 4; kt >= 0; --kt) {
        const int kb = s0 - 128 + 32 * kt;
        int skl = kb + qi; skl = skl < 0 ? 0 : skl;
        const bf16_t* kp = Z + (size_t)(res + (skl << dsh)) * NZ + ZK + head * 128 + 8 * h;
        f32x16 S;
#pragma unroll
        for (int i = 0; i < 16; ++i) S[i] = 0.f;
#pragma unroll
        for (int ks = 0; ks < 8; ++ks) { const bf16x8 A = *(const bf16x8*)(kp + 16 * ks); S = mfma32(A, Qf[ks], S); }
#pragma unroll
        for (int i = 0; i < 8; ++i) {
            const int row = 4 * i + (lane >> 4), ch = lane & 15;
            int sv = kb + row; sv = sv < 0 ? 0 : sv;
            const u32x4 v = *(const u32x4*)(Z + (size_t)(res + (sv << dsh)) * NZ + ZV + head * 128 + 8 * ch);
            *(LAS u32x4*)(Vl + row * 136 + 8 * ch) = v;
        }
        float tmax = -INFINITY;
#pragma unroll
        for (int i = 0; i < 16; ++i) {
            const int sk = kb + (i & 3) + 8 * (i >> 2) + 4 * h;
            const bool valid = (sk >= 0) && (sk <= sq) && (sk >= sq - 128);
            S[i] = valid ? S[i] * ATT_SCALE : -INFINITY;
            tmax = fmaxf(tmax, S[i]);
        }
        tmax = fmaxf(tmax, __shfl_xor(tmax, 32));
        const float mn = fmaxf(mrun, tmax), alpha = __expf(mrun - mn);
        float ps = 0.f;
#pragma unroll
        for (int i = 0; i < 16; ++i) { S[i] = __expf(S[i] - mn); ps += S[i]; }
        ps += __shfl_xor(ps, 32);
        lrun = lrun * alpha + ps; mrun = mn;
#pragma unroll
        for (int dt = 0; dt < 4; ++dt) O[dt] = O[dt] * alpha;
        bf16x8 Pf[2];
#pragma unroll
        for (int s2 = 0; s2 < 2; ++s2) {
            u32x4 w; w.x = pk2(S[8 * s2 + 0], S[8 * s2 + 1]); w.y = pk2(S[8 * s2 + 2], S[8 * s2 + 3]); w.z = pk2(S[8 * s2 + 4], S[8 * s2 + 5]); w.w = pk2(S[8 * s2 + 6], S[8 * s2 + 7]);
            Pf[s2] = __builtin_bit_cast(bf16x8, w);
        }
        lds_fence();
#pragma unroll
        for (int dt = 0; dt < 4; ++dt)
#pragma unroll
            for (int s2 = 0; s2 < 2; ++s2) {
                bf16x8 A;
#pragma unroll
                for (int j = 0; j < 8; ++j) A[j] = (short)Vl[(16 * s2 + 8 * (j >> 2) + 4 * h + (j & 3)) * 136 + 32 * dt + qi];
                O[dt] = mfma32(A, Pf[s2], O[dt]);
            }
        lds_fence();
    }
    const float inv = 1.f / lrun;
    bf16_t* op = OG + ((size_t)g * MP + tq) * 512 + hh * 128 + 4 * h;
#pragma unroll
    for (int dt = 0; dt < 4; ++dt)
#pragma unroll
        for (int rq = 0; rq < 4; ++rq) {
            u32x2 w; w.x = pk2(O[dt][4 * rq] * inv, O[dt][4 * rq + 1] * inv); w.y = pk2(O[dt][4 * rq + 2] * inv, O[dt][4 * rq + 3] * inv);
            *(u32x2*)(op + 32 * dt + 8 * rq) = w;
        }
    if (h == 0) LSE[((size_t)g * MP + tq) * 4 + hh] = mrun + __logf(lrun);
}
DI void attn_sample_item(const Params& p, const bf16_t* Z, bf16_t* OG, float* LSE, int item, int lane) {
    const int b = item / 48, r48 = item % 48, t = r48 / 12, head = r48 % 12, g = head >> 2, hh = head & 3;
    const int dsh = 2 * g, W = 128 << dsh;
    const float* cache = p.in[2 + g];
    const float* newkv = p.out + (g == 0 ? OFF_KVS0 : (g == 1 ? OFF_KVS1 : OFF_KVS2));
    const int m = TP + b * 4 + t;
    const unsigned qq = *(const unsigned*)(Z + (size_t)m * NZ + ZQ + head * 128 + 2 * lane);
    const float q0 = bflo(qq), q1 = bfhi(qq);
    float sc0 = -INFINITY, sc1 = -INFINITY, sc2 = -INFINITY;
    for (int j = 0; j <= 128; ++j) {
        const int rr = W + t - (j << dsh);
        const float* base = (rr >= W) ? newkv + ((size_t)(b * W + rr - 4) * 2) * 512 : cache + ((size_t)(b * W + rr) * 2) * 512;
        const f32x2 kk = *(const f32x2*)(base + hh * 128 + 2 * lane);
        const float s = wave_sum(q0 * kk.x + q1 * kk.y) * ATT_SCALE;
        if ((j & 63) == lane) { if (j < 64) sc0 = s; else if (j < 128) sc1 = s; else sc2 = s; }
    }
    const float mx = wave_max(fmaxf(sc0, fmaxf(sc1, sc2)));
    const float p0 = __expf(sc0 - mx), p1 = __expf(sc1 - mx), p2 = __expf(sc2 - mx);
    const float l = wave_sum(p0 + p1 + p2);
    float o0 = 0.f, o1 = 0.f;
    for (int j = 0; j <= 128; ++j) {
        const int rr = W + t - (j << dsh);
        const float* base = (rr >= W) ? newkv + ((size_t)(b * W + rr - 4) * 2) * 512 : cache + ((size_t)(b * W + rr) * 2) * 512;
        const f32x2 vv = *(const f32x2*)(base + 512 + hh * 128 + 2 * lane);
        const float pj = __shfl(j < 64 ? p0 : (j < 128 ? p1 : p2), j & 63);
        o0 += pj * vv.x; o1 += pj * vv.y;
    }
    const float inv = 1.f / l;
    *(unsigned*)(OG + ((size_t)g * MP + m) * 512 + hh * 128 + 2 * lane) = pk2(o0 * inv, o1 * inv);
    if (lane == 0) LSE[((size_t)g * MP + m) * 4 + hh] = mx + __logf(l);
}

DI float hg_gates(const Params& p, const bf16_t* Z, int n, int h, LAS float* tot, float (&kk)[16], float (&bb)[16]) {
    const int tid = threadIdx.x, dk = tid & 127, part = tid >> 7;
    const float* lbp = p.in[13];
    const float lb = 1.f / (1.f + __expf(lbp[1024 + h * 128 + dk] - lbp[h * 128 + dk]));
    float cum = 0.f;
#pragma unroll
    for (int i = 0; i < 16; ++i) {
        const int t = 64 * n + 16 * part + i;
        const float fh = bf2f(Z[(size_t)t * NZ + ZFH + h * 128 + dk]);
        const float f = lb + (1.f - lb) * sigm(fh);
        kk[i] = 1.f - f; cum += __logf(f); bb[i] = cum;
    }
    tot[part * 128 + dk] = cum;
    __syncthreads();
    float off = 0.f, bl = 0.f;
#pragma unroll
    for (int q = 0; q < 4; ++q) { const float tv = tot[q * 128 + dk]; bl += tv; off += (q < part) ? tv : 0.f; }
#pragma unroll
    for (int i = 0; i < 16; ++i) bb[i] += off;
    return bl;
}
DI void hg_load_v(const bf16_t* Z, int n, int h, LAS bf16_t* Vs) {
    const int tid = threadIdx.x;
#pragma unroll
    for (int i = 0; i < 2; ++i) { const int e = tid + 512 * i, s = e >> 4, ch = e & 15;
        *(LAS u32x4*)(Vs + s * 136 + 8 * ch) = *(const u32x4*)(Z + (size_t)(64 * n + s) * NZ + ZIH + h * 128 + 8 * ch); }
}
DI void hg_passA_item(const Params& p, const bf16_t* Z, float* HS, float* HD, LAS unsigned char* L, int item) {
    const int n = item >> 3, h = item & 7;
    const int tid = threadIdx.x, lane = tid & 63, wave = tid >> 6, dk = tid & 127, part = tid >> 7;
    LAS bf16_t* Kh = (LAS bf16_t*)L;
    LAS bf16_t* Vs = (LAS bf16_t*)(L + 17408);
    LAS float* tot = (LAS float*)(L + 34816);
    float kk[16], bb[16];
    const float bl = hg_gates(p, Z, n, h, tot, kk, bb);
#pragma unroll
    for (int i = 0; i < 16; ++i) Kh[(16 * part + i) * 136 + dk] = (bf16_t)(pk2(kk[i] * __expf(bl - bb[i]), 0.f) & 0xffffu);
    if (part == 0) HD[(size_t)(n * 8 + h) * 128 + dk] = __expf(bl);
    hg_load_v(Z, n, h, Vs);
    __syncthreads();
    f32x4 acc[8];
#pragma unroll
    for (int nt = 0; nt < 8; ++nt) acc[nt] = (f32x4){0.f, 0.f, 0.f, 0.f};
#pragma unroll
    for (int ks = 0; ks < 2; ++ks) {
        const bf16x8 A = gat8(Kh + (32 * ks + 8 * (lane >> 4)) * 136 + 16 * wave + (lane & 15), 136);
#pragma unroll
        for (int nt = 0; nt < 8; ++nt) { const bf16x8 B = gat8(Vs + (32 * ks + 8 * (lane >> 4)) * 136 + 16 * nt + (lane & 15), 136); acc[nt] = mfma16(A, B, acc[nt]); }
    }
    float* up = HS + ((size_t)(n * 8 + h) * 128) * 128;
#pragma unroll
    for (int nt = 0; nt < 8; ++nt)
#pragma unroll
        for (int r = 0; r < 4; ++r) up[(size_t)(16 * wave + 4 * (lane >> 4) + r) * 128 + 16 * nt + (lane & 15)] = acc[nt][r];
    __syncthreads();
}
DI void hg_scan(const Params& p, float* HS, const float* HD) {
    for (int e = blockIdx.x * 512 + threadIdx.x; e < 131072; e += gridDim.x * 512) {
        float S = 0.f;
        for (int n0 = 0; n0 < 256; n0 += 16) {
            float U[16], Dd[16];
#pragma unroll
            for (int j = 0; j < 16; ++j) { U[j] = HS[(size_t)(n0 + j) * 131072 + e]; Dd[j] = HD[(n0 + j) * 1024 + (e >> 7)]; }
#pragma unroll
            for (int j = 0; j < 16; ++j) { HS[(size_t)(n0 + j) * 131072 + e] = S; S = Dd[j] * S + U[j]; }
        }
        p.out[OFF_HGP + e] = S;
    }
}
DI void hg_passC_item(const Params& p, const bf16_t* Z, const float* HS, bf16_t* OHG, LAS unsigned char* L, int item) {
    const int n = item >> 3, h = item & 7;
    const int tid = threadIdx.x, lane = tid & 63, wave = tid >> 6, dk = tid & 127, part = tid >> 7;
    LAS bf16_t* Qs = (LAS bf16_t*)L;
    LAS bf16_t* Ks = (LAS bf16_t*)(L + 17408);
    LAS bf16_t* Vs = (LAS bf16_t*)(L + 34816);
    LAS bf16_t* Ss = (LAS bf16_t*)(L + 52224);
    LAS bf16_t* As = (LAS bf16_t*)(L + 87040);
    LAS float* tot = (LAS float*)(L + 96256);
    LAS float* red = (LAS float*)(L + 98304);
    float kk[16], bb[16];
    (void)hg_gates(p, Z, n, h, tot, kk, bb);
#pragma unroll
    for (int i = 0; i < 16; ++i) {
        const int s = 16 * part + i;
        const float qh = bf2f(Z[(size_t)(64 * n + s) * NZ + ZQH + h * 128 + dk]);
        Qs[s * 136 + dk] = (bf16_t)(pk2(silu(qh) * __expf(bb[i]), 0.f) & 0xffffu);
        Ks[s * 136 + dk] = (bf16_t)(pk2(kk[i] * __expf(-bb[i]), 0.f) & 0xffffu);
    }
    hg_load_v(Z, n, h, Vs);
    { const float* sp = HS + ((size_t)(n * 8 + h) * 128) * 128;
#pragma unroll
      for (int i = 0; i < 8; ++i) { const int e = tid + 512 * i, r = e >> 5, c4 = e & 31; const f32x4 v = *(const f32x4*)(sp + r * 128 + 4 * c4);
          u32x2 w; w.x = pk2(v[0], v[1]); w.y = pk2(v[2], v[3]); *(LAS u32x2*)(Ss + r * 136 + 4 * c4) = w; } }
    __syncthreads();
    const int mt = wave >> 1, wh = wave & 1, lr = lane & 15, lq = lane >> 4;
    {
        f32x4 a2[2] = {{0.f, 0.f, 0.f, 0.f}, {0.f, 0.f, 0.f, 0.f}};
#pragma unroll
        for (int ks = 0; ks < 4; ++ks) {
            const bf16x8 A = ld8(Qs + (16 * mt + lr) * 136 + 32 * ks + 8 * lq);
#pragma unroll
            for (int j = 0; j < 2; ++j) { const bf16x8 B = ld8(Ks + (16 * (2 * wh + j) + lr) * 136 + 32 * ks + 8 * lq); a2[j] = mfma16(A, B, a2[j]); }
        }
#pragma unroll
        for (int j = 0; j < 2; ++j)
#pragma unroll
            for (int r = 0; r < 4; ++r) { const int t = 16 * mt + 4 * lq + r, s = 16 * (2 * wh + j) + lr; As[t * 72 + s] = (bf16_t)(pk2(s <= t ? a2[j][r] : 0.f, 0.f) & 0xffffu); }
    }
    __syncthreads();
    f32x4 acc[4];
#pragma unroll
    for (int j = 0; j < 4; ++j) acc[j] = (f32x4){0.f, 0.f, 0.f, 0.f};
#pragma unroll
    for (int ks = 0; ks < 2; ++ks) {
        const bf16x8 A = ld8(As + (16 * mt + lr) * 72 + 32 * ks + 8 * lq);
#pragma unroll
        for (int j = 0; j < 4; ++j) { const bf16x8 B = gat8(Vs + (32 * ks + 8 * lq) * 136 + 16 * (4 * wh + j) + lr, 136); acc[j] = mfma16(A, B, acc[j]); }
    }
#pragma unroll
    for (int ks = 0; ks < 4; ++ks) {
        const bf16x8 A = ld8(Qs + (16 * mt + lr) * 136 + 32 * ks + 8 * lq);
#pragma unroll
        for (int j = 0; j < 4; ++j) { const bf16x8 B = gat8(Ss + (32 * ks + 8 * lq) * 136 + 16 * (4 * wh + j) + lr, 136); acc[j] = mfma16(A, B, acc[j]); }
    }
#pragma unroll
    for (int r = 0; r < 4; ++r) {
        float ss = 0.f;
#pragma unroll
        for (int j = 0; j < 4; ++j) ss += acc[j][r] * acc[j][r];
        ss += __shfl_xor(ss, 1); ss += __shfl_xor(ss, 2); ss += __shfl_xor(ss, 4); ss += __shfl_xor(ss, 8);
        if (lr == 0) red[(16 * mt + 4 * lq + r) * 2 + wh] = ss;
    }
    __syncthreads();
    const float* hgw = p.in[14];
#pragma unroll
    for (int r = 0; r < 4; ++r) {
        const int tl = 16 * mt + 4 * lq + r, t = 64 * n + tl;
        const float rstd = rsqrtf((red[tl * 2] + red[tl * 2 + 1]) * (1.f / 128.f) + EPS);
#pragma unroll
        for (int j = 0; j < 4; ++j) {
            const int dv = 16 * (4 * wh + j) + lr;
            const float gh = bf2f(Z[(size_t)t * NZ + ZGH + h * 128 + dv]);
            OHG[(size_t)t * 1024 + h * 128 + dv] = (bf16_t)(pk2(acc[j][r] * rstd * hgw[dv] * silu(gh), 0.f) & 0xffffu);
        }
    }
    __syncthreads();
}
DI void hg_sample_item(const Params& p, const bf16_t* Z, bf16_t* OHG, LAS unsigned char* L, int item) {
    const int b = item >> 3, h = item & 7;
    const int tid = threadIdx.x, dv = tid & 127, dq = tid >> 7;
    LAS float* fS = (LAS float*)L;
    LAS float* kS = fS + 512;
    LAS float* qS = kS + 512;
    LAS float* red = qS + 512;
    LAS float* rs = red + 2048;
    const float* lbp = p.in[13];
    {
        const int t = tid >> 7, dk = tid & 127, m = TP + b * 4 + t;
        const float lb = 1.f / (1.f + __expf(lbp[1024 + h * 128 + dk] - lbp[h * 128 + dk]));
        const float fh = bf2f(Z[(size_t)m * NZ + ZFH + h * 128 + dk]), qh = bf2f(Z[(size_t)m * NZ + ZQH + h * 128 + dk]);
        const float f = lb + (1.f - lb) * sigm(fh);
        fS[tid] = f; kS[tid] = 1.f - f; qS[tid] = silu(qh);
    }
    float S[32];
    const float* s0 = p.in[5] + ((size_t)(b * 8 + h) * 128) * 128;
#pragma unroll
    for (int i = 0; i < 32; ++i) S[i] = s0[(size_t)(dq * 32 + i) * 128 + dv];
    __syncthreads();
#pragma unroll
    for (int t = 0; t < 4; ++t) {
        const int m = TP + b * 4 + t;
        const float v = bf2f(Z[(size_t)m * NZ + ZIH + h * 128 + dv]);
        float part = 0.f;
#pragma unroll
        for (int i = 0; i < 32; ++i) { const int dk = dq * 32 + i; S[i] = fS[t * 128 + dk] * S[i] + kS[t * 128 + dk] * v; part += S[i] * qS[t * 128 + dk]; }
        red[(t * 4 + dq) * 128 + dv] = part;
    }
    float* so = p.out + OFF_HGS + ((size_t)(b * 8 + h) * 128) * 128;
#pragma unroll
    for (int i = 0; i < 32; ++i) so[(size_t)(dq * 32 + i) * 128 + dv] = S[i];
    __syncthreads();
    {
        const int t = tid >> 7, m = TP + b * 4 + t;
        const float o = red[(t * 4 + 0) * 128 + dv] + red[(t * 4 + 1) * 128 + dv] + red[(t * 4 + 2) * 128 + dv] + red[(t * 4 + 3) * 128 + dv];
        const float ss = wave_sum(o * o);
        if ((tid & 63) == 0) rs[tid >> 6] = ss;
        __syncthreads();
        const float rstd = rsqrtf((rs[2 * t] + rs[2 * t + 1]) * (1.f / 128.f) + EPS);
        const float gh = bf2f(Z[(size_t)m * NZ + ZGH + h * 128 + dv]);
        OHG[(size_t)m * 1024 + h * 128 + dv] = (bf16_t)(pk2(o * rstd * p.in[14][dv] * silu(gh), 0.f) & 0xffffu);
    }
    __syncthreads();
}
DI void ph_merge(const bf16_t* OG, const float* LSE, bf16_t* OATT) {
    for (size_t idx = (size_t)blockIdx.x * 512 + threadIdx.x; idx < (size_t)MR * 64; idx += (size_t)gridDim.x * 512) {
        const int m = (int)(idx >> 6), c8 = (int)(idx & 63), hh = c8 >> 4;
        const float l0 = LSE[((size_t)0 * MP + m) * 4 + hh], l1 = LSE[((size_t)1 * MP + m) * 4 + hh], l2 = LSE[((size_t)2 * MP + m) * 4 + hh];
        const float mx = fmaxf(l0, fmaxf(l1, l2));
        float w0 = __expf(l0 - mx), w1 = __expf(l1 - mx), w2 = __expf(l2 - mx);
        const float inv = 1.f / (w0 + w1 + w2); w0 *= inv; w1 *= inv; w2 *= inv;
        float a[8], b[8], c[8];
        unpack8(*(const u32x4*)(OG + ((size_t)0 * MP + m) * 512 + 8 * c8), a);
        unpack8(*(const u32x4*)(OG + ((size_t)1 * MP + m) * 512 + 8 * c8), b);
        unpack8(*(const u32x4*)(OG + ((size_t)2 * MP + m) * 512 + 8 * c8), c);
        u32x4 o;
        o.x = pk2(w0 * a[0] + w1 * b[0] + w2 * c[0], w0 * a[1] + w1 * b[1] + w2 * c[1]);
        o.y = pk2(w0 * a[2] + w1 * b[2] + w2 * c[2], w0 * a[3] + w1 * b[3] + w2 * c[3]);
        o.z = pk2(w0 * a[4] + w1 * b[4] + w2 * c[4], w0 * a[5] + w1 * b[5] + w2 * c[5]);
        o.w = pk2(w0 * a[6] + w1 * b[6] + w2 * c[6], w0 * a[7] + w1 * b[7] + w2 * c[7]);
        *(u32x4*)(OATT + (size_t)m * 512 + 8 * c8) = o;
    }
}
DI void ph_convact(const Params& p, const bf16_t* AB, bf16_t* G) {
    const float* cw = p.in[21]; const float* cb = p.in[22]; const float* sc = p.in[6];
    for (size_t idx = (size_t)blockIdx.x * 512 + threadIdx.x; idx < (size_t)MR * 704; idx += (size_t)gridDim.x * 512) {
        const int m = (int)(idx / 704), c = (int)(idx % 704) * 8;
        float a2[8], a1[8], a0[8], bl[8];
        unpack8(*(const u32x4*)(AB + (size_t)m * NAB + c), a2);
        unpack8(*(const u32x4*)(AB + (size_t)m * NAB + DFF + c), bl);
        const int t = m < TP ? m : ((m - TP) & 3);
        if (t >= 1) unpack8(*(const u32x4*)(AB + (size_t)(m - 1) * NAB + c), a1);
        else if (m < TP) { for (int j = 0; j < 8; ++j) a1[j] = 0.f; }
        else { const float* s = sc + (size_t)(((m - TP) >> 2) * 2 + 1) * DFF + c; for (int j = 0; j < 8; ++j) a1[j] = s[j]; }
        if (t >= 2) unpack8(*(const u32x4*)(AB + (size_t)(m - 2) * NAB + c), a0);
        else if (m < TP) { for (int j = 0; j < 8; ++j) a0[j] = 0.f; }
        else { const float* s = sc + (size_t)(((m - TP) >> 2) * 2 + t) * DFF + c; for (int j = 0; j < 8; ++j) a0[j] = s[j]; }
        float o[8];
#pragma unroll
        for (int j = 0; j < 8; ++j) { const float u = cb[c + j] + cw[c + j] * a0[j] + cw[DFF + c + j] * a1[j] + cw[2 * DFF + c + j] * a2[j]; o[j] = silu(u) * bl[j]; }
        u32x4 w; w.x = pk2(o[0], o[1]); w.y = pk2(o[2], o[3]); w.z = pk2(o[4], o[5]); w.w = pk2(o[6], o[7]);
        *(u32x4*)(G + (size_t)m * DFF + c) = w;
    }
}

template <class Epi> DI void run_gemm(LAS unsigned char* L, const bf16_t* A, const bf16_t* Bt, int N, int K, const Epi& E) {
    pg8::Gemm g{A, Bt, MP, N, K}; pg8::StaticOrder S; S.init(MP, N, (int)gridDim.x, (int)blockIdx.x);
    pg8::gemm_phase<Epi, pg8::StaticOrder, false>(L, g, S, E, nullptr);
}

__global__ void __launch_bounds__(512, 2) mega(Params p) {
    extern __shared__ __attribute__((aligned(16))) unsigned char lds[];
    LAS unsigned char* L = (LAS unsigned char*)lds;
    cg::grid_group grid = cg::this_grid();
    unsigned char* ws = p.ws;
    const int lo = p.ph_lo, hi = p.ph_hi;
    const int tid = threadIdx.x, lane = tid & 63, wave = tid >> 6;
    bf16_t* Z = (bf16_t*)(ws + WS_Z);
    bf16_t* H = (bf16_t*)(ws + WS_H);
    float* MOD = (float*)(ws + WS_MOD);
#define IN(k) (lo <= (k) && (k) < hi)
#define SEAM(k) do { if (IN(k) && IN((k) + 1)) grid.sync(); } while (0)
    if (IN(0)) ph_prologue(p, L);
    SEAM(0);
    if (IN(1)) ph_hnorm(p, nullptr, false, p.in[11], 0, H);
    SEAM(1);
    if (IN(2)) { EpiZ E{Z, (const float*)(ws + WS_ROPE), p.out}; run_gemm(L, H, (const bf16_t*)(ws + WS_WIN), NZ, D, E); }
    SEAM(2);
    if (IN(3)) {
        for (int it = blockIdx.x; it < 2048; it += gridDim.x) hg_passA_item(p, Z, (float*)(ws + WS_HS), (float*)(ws + WS_HD), L, it);
        const int gw = blockIdx.x * 8 + wave, NGW = gridDim.x * 8;
        LAS bf16_t* Vl = (LAS bf16_t*)(L + wave * 8704);
        for (int base = 0; base < 6144; base += 3 * NGW)
            for (int j = 0; j < 3; ++j) { const int it = base + gw * 3 + j; if (it < 6144) attn_prompt_item(Z, (bf16_t*)(ws + WS_OG), (float*)(ws + WS_LSE), Vl, it, lane); }
        for (int it = gw; it < 1536; it += NGW) attn_sample_item(p, Z, (bf16_t*)(ws + WS_OG), (float*)(ws + WS_LSE), it, lane);
    }
    SEAM(3);
    if (IN(4)) hg_scan(p, (float*)(ws + WS_HS), (const float*)(ws + WS_HD));
    SEAM(4);
    if (IN(5)) {
        for (int it = blockIdx.x; it < 2048; it += gridDim.x) hg_passC_item(p, Z, (const float*)(ws + WS_HS), (bf16_t*)(ws + WS_OHG), L, it);
        for (int it = blockIdx.x; it < 256; it += gridDim.x) hg_sample_item(p, Z, (bf16_t*)(ws + WS_OHG), L, it);
        ph_merge((const bf16_t*)(ws + WS_OG), (const float*)(ws + WS_LSE), (bf16_t*)(ws + WS_OATT));
    }
    SEAM(5);
    if (IN(6)) {
        { EpiMix1 E{Z, (float*)(ws + WS_TMP)}; run_gemm(L, (const bf16_t*)(ws + WS_OATT), (const bf16_t*)(ws + WS_WPA), D, 512, E); }
        { EpiMix2 E{Z, (const float*)(ws + WS_TMP), (bf16_t*)(ws + WS_YMIX)}; run_gemm(L, (const bf16_t*)(ws + WS_OHG), (const bf16_t*)(ws + WS_WPB), D, 1024, E); }
    }
    SEAM(6);
    if (IN(7)) { EpiWO E{p.in[0], p.in[1], MOD, p.out}; run_gemm(L, (const bf16_t*)(ws + WS_YMIX), (const bf16_t*)(ws + WS_WO), D, D, E); }
    SEAM(7);
    if (IN(8)) ph_hnorm(p, p.out, true, p.in[18], 3, H);
    SEAM(8);
    if (IN(9)) { EpiUp E{(bf16_t*)(ws + WS_AB), p.out}; run_gemm(L, H, (const bf16_t*)(ws + WS_WAB), NAB, D, E); }
    SEAM(9);
    if (IN(10)) ph_convact(p, (const bf16_t*)(ws + WS_AB), (bf16_t*)(ws + WS_G));
    SEAM(10);
    if (IN(11)) { EpiDown E{MOD, p.out}; run_gemm(L, (const bf16_t*)(ws + WS_G), (const bf16_t*)(ws + WS_WDN), D, DFF, E); }
    SEAM(11);
    if (IN(12)) ph_final_norm(p);
#undef IN
#undef SEAM
}

#ifndef MK_MULTI
#define MK_MULTI 0
#endif
extern "C" void kernel_launch(void* const* d_in, const int* in_sizes, int n_in, void* d_out, int out_size, void* d_ws, size_t ws_size, hipStream_t stream) {
    static int grid = 0;
    if (grid == 0) {
        if (n_in != 25 || (size_t)out_size != OUT_TOTAL || ws_size < WS_END) { fprintf(stderr, "kernel_launch: unexpected shapes: n_in %d out %d ws %zu (need %zu)\n", n_in, out_size, ws_size, (size_t)WS_END); grid = -1; return; }
        int dev = 0, cus = 0, per_cu = 0;
        hipGetDevice(&dev);
        hipDeviceGetAttribute(&cus, hipDeviceAttributeMultiprocessorCount, dev);
        if (hipFuncSetAttribute((const void*)mega, hipFuncAttributeMaxDynamicSharedMemorySize, LDS_BYTES) != hipSuccess) { fprintf(stderr, "kernel_launch: hipFuncSetAttribute failed\n"); grid = -1; return; }
        if (hipOccupancyMaxActiveBlocksPerMultiprocessor(&per_cu, (const void*)mega, 512, LDS_BYTES) != hipSuccess || per_cu < 1) { fprintf(stderr, "kernel_launch: occupancy query failed (%d)\n", per_cu); (void)hipGetLastError(); per_cu = 1; }
        grid = cus * 1;
        if (grid < 1) grid = -1;
    }
    if (grid < 0) return;
    Params p{};
    for (int i = 0; i < 25; ++i) p.in[i] = (const float*)d_in[i];
    p.out = (float*)d_out; p.ws = (unsigned char*)d_ws;
#if MK_MULTI
    for (int ph = 0; ph < NPH; ++ph) { p.ph_lo = ph; p.ph_hi = ph + 1; hipLaunchKernelGGL(mega, dim3(grid), dim3(512), LDS_BYTES, stream, p); }
#else
    p.ph_lo = 0; p.ph_hi = NPH;
    void* args[] = {&p};
    hipError_t e = hipLaunchCooperativeKernel((const void*)mega, dim3(grid), dim3(512), args, LDS_BYTES, stream);
    if (e != hipSuccess) fprintf(stderr, "cooperative launch failed: %s (grid %d)\n", hipGetErrorString(e), grid);
#endif
}
```

```cpp
#include <hip/hip_runtime.h>
#include <hip/hip_cooperative_groups.h>
#include <cstdio>
namespace cg = cooperative_groups;
namespace pg8 {
#define PG8_LAS __attribute__((address_space(3)))
typedef unsigned short bf16_t;
typedef short bf16x8 __attribute__((ext_vector_type(8)));
typedef float f32x4 __attribute__((ext_vector_type(4)));
typedef unsigned u32x4 __attribute__((ext_vector_type(4)));
constexpr int BM = 256, BK = 64, HALF = 128, HTB = HALF * BK * 2  , STAGE_BYTES = 8 * HTB, NXCD = 8, WGM = 8;

__host__ __device__ __forceinline__ int lds_byte(int r, int c) { const int st = (r >> 4) * 2 + (c >> 5), rr = r & 15, cc = c & 31, ob = rr * 64 + cc * 2; return st * 1024 + (ob ^ (((ob >> 9) & 1) << 5)); }
__host__ __device__ __forceinline__ void stage_rc(int b, int& R, int& C) { const int st = b / 1024, sb = b % 1024, swz = sb ^ (((sb >> 9) & 1) << 5); R = (st >> 1) * 16 + swz / 64; C = (st & 1) * 32 + (swz % 64) / 2; }
__host__ __device__ __forceinline__ int perm32(int rho) { const int n = rho >> 4, i = rho & 15; return 8 * (i >> 2) + 4 * n + (i & 3); }

struct Unit { int pm, pn, kt0, nkt; };
struct Gemm { const bf16_t* A; const bf16_t* Bt; int M, N, K; };

struct StaticOrder {
    int nM, nN, nwg, G, c, nkt;
    __host__ __device__ void init(int M, int N, int K, int G_, int c_) { nM = M / BM; nN = N / BM; nwg = nM * nN; G = G_; c = c_; nkt = K / BK; }
    __host__ __device__ bool next(int i, Unit& u) const {
        const long L = (long)i * G + c; if (L >= nwg) return false;
        int wgid = (int)L; { const int q = nwg / NXCD, r = nwg % NXCD, xcd = wgid % NXCD, off = wgid / NXCD; wgid = (xcd < r ? xcd * (q + 1) : r * (q + 1) + (xcd - r) * q) + off; }
        const int nig = WGM * nN, gid = wgid / nig, fm = gid * WGM, gsz = (nM - fm) < WGM ? (nM - fm) : WGM;
        u.pm = fm + ((wgid % nig) % gsz); u.pn = (wgid % nig) / gsz; u.kt0 = 0; u.nkt = nkt; return true;
    }
    __device__ __forceinline__ void a_ready(const Unit&) const {}
    __device__ __forceinline__ void done(const Unit&) const {}
};
struct SplitOrder {
    int nN, nwg, G, c, nkt, nsp;
    __host__ __device__ void init(int N, int K, int G_, int c_) { nN = N / BM; nwg = 64 * nN; G = G_; c = c_; nkt = K / BK; nsp = nkt / 4; }
    __host__ __device__ bool next(int i, Unit& u) const {
        const long L = (long)i * G + c;
        if (L < nwg) {
            int wgid = (int)L; { const int q = nwg / NXCD, r = nwg % NXCD, xcd = wgid % NXCD, off = wgid / NXCD; wgid = (xcd < r ? xcd * (q + 1) : r * (q + 1) + (xcd - r) * q) + off; }
            const int nig = WGM * nN, gid = wgid / nig, fm = gid * WGM, gsz = (64 - fm) < WGM ? (64 - fm) : WGM;
            u.pm = fm + ((wgid % nig) % gsz); u.pn = (wgid % nig) / gsz; u.kt0 = 0; u.nkt = nkt; return true;
        }
        const long j = L - nwg; if (j >= (long)nN * nsp) return false;
        u.pm = 64; u.pn = (int)(j % nN); u.kt0 = 4 * (int)(j / nN); u.nkt = 4; return true;
    }
    __device__ __forceinline__ void a_ready(const Unit&) const {}
    __device__ __forceinline__ void done(const Unit&) const {}
};
template <class Epi, class Sched, bool STAMP = false>
__device__ __forceinline__ void gemm_phase(PG8_LAS unsigned char* lds, const Gemm g, const Sched& S, const Epi& E, unsigned long long* stamps) {
    const int tid = threadIdx.x, wid = __builtin_amdgcn_readfirstlane(tid >> 6), lane = tid & 63, wr = wid >> 2, wc = wid & 3, fr = lane & 15, fq = lane >> 4;
    const int K = g.K;
    int ts_lo = 0, ts_hi = 0, nts = 0; const unsigned long long rt_entry = STAMP ? (unsigned long long)wall_clock64() : 0ull;
#define PG8_STAMP() do { if (STAMP && wid == 0 && nts < 64) { const unsigned long long _c = (unsigned long long)clock64(); \
        ts_lo = (lane == nts) ? (int)(unsigned)_c : ts_lo; ts_hi = (lane == nts) ? (int)(unsigned)(_c >> 32) : ts_hi; ++nts; } } while (0)
    PG8_STAMP();
    unsigned voffA[2], voffB[2];
#pragma unroll
    for (int i = 0; i < 2; ++i) { int R, C; stage_rc(tid * 16 + i * 8192, R, C); const int Rb = Epi::PERM ? ((R & ~31) + perm32(R & 31)) : R;
        voffA[i] = (unsigned)(R * K + C) * 2u; voffB[i] = (unsigned)(Rb * K + C) * 2u; }
    const size_t kstep = (size_t)(BK * 2);
    const size_t hstep = (size_t)HALF * K * 2;
    const size_t tstep = 2 * hstep;
    const unsigned ldsw = (unsigned)wid * 1024u;
    const int aoff = lds_byte(wr * 64 + fr, fq * 8), boff = lds_byte(wc * 32 + fr, fq * 8);
#define PG8_SA(b, h) (((b) * 2 + (h)) * HTB)
#define PG8_SB(b, h) ((4 + (b) * 2 + (h)) * HTB)
#define PG8_STAGE(bufoff, gbase, voff) do { _Pragma("unroll") for (int _i = 0; _i < 2; ++_i) \
        __builtin_amdgcn_global_load_lds((const unsigned*)((const char*)(gbase) + (voff)[_i]), (PG8_LAS unsigned*)(lds + (bufoff) + ldsw + _i * 8192), 16, 0, 0); } while (0)
#define PG8_LDA(dst, b, h) do { _Pragma("unroll") for (int m = 0; m < 4; ++m) _Pragma("unroll") for (int k = 0; k < 2; ++k) dst[m][k] = *(const PG8_LAS bf16x8*)(lds + PG8_SA(b, h) + aoff + m * 2048 + k * 1024); } while (0)
#define PG8_LDB(dst, b, h) do { _Pragma("unroll") for (int n = 0; n < 2; ++n) _Pragma("unroll") for (int k = 0; k < 2; ++k) dst[n][k] = *(const PG8_LAS bf16x8*)(lds + PG8_SB(b, h) + boff + n * 2048 + k * 1024); } while (0)
#define PG8_MMA(ai, bj, At, Bt) do { __builtin_amdgcn_s_setprio(1); _Pragma("unroll") for (int m = 0; m < 4; ++m) _Pragma("unroll") for (int n = 0; n < 2; ++n) _Pragma("unroll") for (int k = 0; k < 2; ++k) \
        acc[ai][bj][m][n] = __builtin_amdgcn_mfma_f32_16x16x32_bf16(Bt[n][k], At[m][k], acc[ai][bj][m][n], 0, 0, 0); __builtin_amdgcn_s_setprio(0); } while (0)
#define PG8_WAIT_V(n) asm volatile("s_waitcnt vmcnt(" #n ")" ::: "memory")
#define PG8_WAIT_L(n) asm volatile("s_waitcnt lgkmcnt(" #n ")" ::: "memory")
#define PG8_BAR __builtin_amdgcn_s_barrier()
#define PG8_SCHED __builtin_amdgcn_sched_barrier(0)
    Unit cur, nxt; int ui = 0;
    if (!S.next(0, cur)) return;
    f32x4 acc[2][2][4][2];
#pragma unroll
    for (int a = 0; a < 2; ++a)
#pragma unroll
        for (int b = 0; b < 2; ++b)
#pragma unroll
            for (int m = 0; m < 4; ++m)
#pragma unroll
                for (int n = 0; n < 2; ++n) acc[a][b][m][n] = (f32x4){0.f, 0.f, 0.f, 0.f};
    bf16x8 At[4][2], B0[2][2], B1[2][2];
    const char* cA = (const char*)g.A + (size_t)cur.pm * tstep + (size_t)cur.kt0 * kstep; const char* cB = (const char*)g.Bt + (size_t)cur.pn * tstep + (size_t)cur.kt0 * kstep;
    S.a_ready(cur);
    PG8_STAGE(PG8_SB(0, 0), cB, voffB); PG8_STAGE(PG8_SA(0, 0), cA, voffA); PG8_STAGE(PG8_SB(0, 1), cB + hstep, voffB); PG8_STAGE(PG8_SA(0, 1), cA + hstep, voffA);
    if (wr == 1) PG8_BAR;
    PG8_WAIT_V(4); PG8_BAR;
    PG8_STAGE(PG8_SB(1, 0), cB + kstep, voffB); PG8_STAGE(PG8_SA(1, 0), cA + kstep, voffA); PG8_STAGE(PG8_SB(1, 1), cB + hstep + kstep, voffB);
    PG8_WAIT_V(6); PG8_BAR;
    PG8_STAMP();
    for (;;) {
        const bool has_next = S.next(ui + 1, nxt);
        const char* nA = has_next ? (const char*)g.A + (size_t)nxt.pm * tstep + (size_t)nxt.kt0 * kstep : cA; const char* nB = has_next ? (const char*)g.Bt + (size_t)nxt.pn * tstep + (size_t)nxt.kt0 * kstep : cB;
        const int nt = cur.nkt;
        for (int t = 0; t < nt; t += 2) {
            const bool last = (t == nt - 2);
            const char* a1 = cA + (size_t)(t + 1) * kstep;
            const char* a2 = last ? nA : cA + (size_t)(t + 2) * kstep; const char* b2 = last ? nB : cB + (size_t)(t + 2) * kstep;
            const char* a3 = a2 + kstep; const char* b3 = b2 + kstep;
            if (last && has_next) S.a_ready(nxt);
            PG8_LDB(B0, 0, 0); PG8_SCHED; PG8_LDA(At, 0, 0); PG8_STAGE(PG8_SA(1, 1), a1 + hstep, voffA);
            PG8_WAIT_L(8); PG8_BAR; PG8_WAIT_L(0); PG8_MMA(0, 0, At, B0); PG8_BAR; PG8_SCHED;
            PG8_LDB(B1, 0, 1); PG8_STAGE(PG8_SB(0, 0), b2, voffB);
            PG8_BAR; PG8_WAIT_L(0); PG8_MMA(0, 1, At, B1); PG8_BAR;
            PG8_LDA(At, 0, 1); PG8_STAGE(PG8_SA(0, 0), a2, voffA);
            PG8_BAR; PG8_WAIT_L(0); PG8_MMA(1, 0, At, B0); PG8_BAR; PG8_SCHED;
            PG8_STAGE(PG8_SB(0, 1), b2 + hstep, voffB);
            PG8_WAIT_V(6); PG8_BAR; PG8_MMA(1, 1, At, B1); PG8_BAR;
            PG8_LDB(B0, 1, 0); PG8_SCHED; PG8_LDA(At, 1, 0); PG8_STAGE(PG8_SA(0, 1), a2 + hstep, voffA);
            PG8_WAIT_L(8); PG8_BAR; PG8_WAIT_L(0); PG8_MMA(0, 0, At, B0); PG8_BAR; PG8_SCHED;
            PG8_LDB(B1, 1, 1); PG8_STAGE(PG8_SB(1, 0), b3, voffB);
            PG8_BAR; PG8_WAIT_L(0); PG8_MMA(0, 1, At, B1); PG8_BAR;
            PG8_LDA(At, 1, 1); PG8_STAGE(PG8_SA(1, 0), a3, voffA);
            PG8_BAR; PG8_WAIT_L(0); PG8_MMA(1, 0, At, B0); PG8_BAR; PG8_SCHED;
            PG8_STAGE(PG8_SB(1, 1), b3 + hstep, voffB);
            PG8_WAIT_V(6); PG8_BAR; PG8_MMA(1, 1, At, B1); PG8_BAR;
        }
        PG8_STAMP();
        if constexpr (!Epi::AFTER_DRAIN) { E(acc, cur, wr, wc, fr, fq); S.done(cur); }
        PG8_STAMP();
        if (!has_next) break;
#pragma unroll
        for (int a = 0; a < 2; ++a)
#pragma unroll
            for (int b = 0; b < 2; ++b)
#pragma unroll
                for (int m = 0; m < 4; ++m)
#pragma unroll
                    for (int n = 0; n < 2; ++n) acc[a][b][m][n] = (f32x4){0.f, 0.f, 0.f, 0.f};
        cur = nxt; cA = nA; cB = nB; ++ui;
    }
    PG8_WAIT_V(0);
    if (wr == 0) PG8_BAR;
    PG8_BAR;
    if constexpr (Epi::AFTER_DRAIN) { E.fused(acc, cur, wr, wc, fr, fq, lds, wid, lane); S.done(cur); }
    PG8_STAMP();
    if (STAMP && wid == 0) { stamps[lane] = lane < nts ? (((unsigned long long)(unsigned)ts_hi << 32) | (unsigned)ts_lo) : 0ull;
        if (lane == 62) stamps[62] = rt_entry; if (lane == 63) stamps[63] = (unsigned long long)wall_clock64(); }
#undef PG8_STAMP
#undef PG8_SA
#undef PG8_SB
#undef PG8_STAGE
#undef PG8_LDA
#undef PG8_LDB
#undef PG8_MMA
#undef PG8_WAIT_V
#undef PG8_WAIT_L
#undef PG8_BAR
#undef PG8_SCHED
}
}

using pg8::bf16_t; using pg8::bf16x8; using pg8::f32x4; using pg8::Unit;
#define LAS __attribute__((address_space(3)))
#define DI __device__ __forceinline__
typedef float f32x16 __attribute__((ext_vector_type(16)));
typedef float f32x2 __attribute__((ext_vector_type(2)));
typedef unsigned u32x4 __attribute__((ext_vector_type(4)));
typedef unsigned u32x2 __attribute__((ext_vector_type(2)));

constexpr int D = 2048, TP = 16384, NS = 128, MR = TP + NS, MP = 16640;
constexpr int NZ = 12800, DFF = 5632, NAB = 2 * DFF;
constexpr int ZQ = 0, ZK = 1536, ZV = 3072, ZQH = 4608, ZFH = 5632, ZIH = 6656, ZGH = 7680, ZGA = 8704, ZGB = 10752;
constexpr int NMODROW = 33, NMOD = 6 * D;
constexpr float EPS = 1e-6f;
constexpr float ATT_SCALE = 0.08838834764831845f;
constexpr size_t OFF_Y = 0;
constexpr size_t OFF_KVP0 = (size_t)MR * D;
constexpr size_t OFF_KVP1 = OFF_KVP0 + 128 * 1024;
constexpr size_t OFF_KVP2 = OFF_KVP1 + 512 * 1024;
constexpr size_t OFF_HGP = OFF_KVP2 + 2048 * 1024;
constexpr size_t OFF_CVP = OFF_HGP + 8 * 128 * 128;
constexpr size_t OFF_KVS0 = OFF_CVP + 2 * DFF;
constexpr size_t OFF_KVS1 = OFF_KVS0 + (size_t)32 * 128 * 1024;
constexpr size_t OFF_KVS2 = OFF_KVS1 + (size_t)32 * 512 * 1024;
constexpr size_t OFF_HGS = OFF_KVS2 + (size_t)32 * 2048 * 1024;
constexpr size_t OFF_CVS = OFF_HGS + (size_t)32 * 8 * 128 * 128;
constexpr size_t OUT_TOTAL = OFF_CVS + (size_t)32 * 2 * DFF;
static_assert(OUT_TOTAL == 129346560, "output size");
constexpr size_t WS_WIN = 1u << 20;
constexpr size_t WS_WPA = WS_WIN + (size_t)NZ * D * 2;
constexpr size_t WS_WPB = WS_WPA + (size_t)2048 * 512 * 2;
constexpr size_t WS_WO = WS_WPB + (size_t)2048 * 1024 * 2;
constexpr size_t WS_WAB = WS_WO + (size_t)2048 * 2048 * 2;
constexpr size_t WS_WDN = WS_WAB + (size_t)NAB * D * 2;
constexpr size_t WS_MOD = WS_WDN + (size_t)D * DFF * 2;
constexpr size_t WS_ROPE = WS_MOD + (size_t)NMODROW * NMOD * 4;
constexpr size_t WS_Z = WS_ROPE + (size_t)MP * 32 * 4;
constexpr size_t WS_AB = WS_Z;
constexpr size_t WS_H = WS_Z + (size_t)MP * NZ * 2;
constexpr size_t WS_OG = WS_H + (size_t)MP * D * 2;
constexpr size_t WS_LSE = WS_OG + (size_t)3 * MP * 512 * 2;
constexpr size_t WS_OATT = WS_LSE + (size_t)3 * MP * 4 * 4;
constexpr size_t WS_OHG = WS_OATT + (size_t)MP * 512 * 2;
constexpr size_t WS_YMIX = WS_OHG + (size_t)MP * 1024 * 2;
constexpr size_t WS_BLK_END = WS_YMIX + (size_t)MP * D * 2;
constexpr size_t WS_G = WS_OG;
static_assert(WS_G + (size_t)MP * DFF * 2 <= WS_BLK_END + (32u << 20), "g overlay");
static_assert((size_t)MP * NAB * 2 <= (size_t)MP * NZ * 2, "ab overlay");
constexpr size_t WS_HS = WS_BLK_END;
constexpr size_t WS_HD = WS_HS + (size_t)256 * 8 * 128 * 128 * 4;
constexpr size_t WS_TMP = WS_HS;
constexpr size_t WS_ACC_WO = WS_Z;
constexpr size_t WS_ACC_DN = WS_Z;
constexpr size_t WS_ACC_UP = WS_TMP + (64u << 20);
constexpr int NSP_WO = 8, NSP_DN = 22, NSP_UP = 8, NSP_PA = 2, NSP_PB = 4;
constexpr size_t WS_ACC_PA = WS_H, WS_ACC_PB = WS_H + (size_t)NSP_PA * NS * D * 4;
static_assert((size_t)NSP_UP * NS * NAB * 4 + (64u << 20) <= (size_t)MP * D * 4, "up partials");
constexpr size_t WS_END = WS_TMP + (size_t)MP * D * 4 + (1u << 20);
static_assert(WS_HD + (size_t)256 * 8 * 128 * 4 <= WS_END, "hd");
static_assert(WS_WIN % 256 == 0 && WS_MOD % 256 == 0 && WS_ROPE % 256 == 0 && WS_Z % 256 == 0 && WS_H % 256 == 0 && WS_OG % 256 == 0 && WS_LSE % 256 == 0 && WS_OATT % 256 == 0 && WS_OHG % 256 == 0 && WS_YMIX % 256 == 0 && WS_HS % 256 == 0 && WS_HD % 256 == 0, "align");
constexpr int LDS_BYTES = 131072 + 4096 + 256;
constexpr int NPH = 18;

struct Params { const float* in[25]; float* out; unsigned char* ws; int ph_lo, ph_hi; };

DI float bf2f(unsigned b) { return __uint_as_float(b << 16); }
DI float bflo(unsigned w) { return __uint_as_float(w << 16); }
DI float bfhi(unsigned w) { return __uint_as_float(w & 0xffff0000u); }
DI unsigned pk2(float lo, float hi) { unsigned r; asm("v_cvt_pk_bf16_f32 %0, %1, %2" : "=v"(r) : "v"(lo), "v"(hi)); return r; }
DI float sigm(float x) { return 1.f / (1.f + __expf(-x)); }
DI float silu(float x) { return x / (1.f + __expf(-x)); }
DI float wave_sum(float v) {
#pragma unroll
    for (int o = 32; o >= 1; o >>= 1) v += __shfl_xor(v, o);
    return v;
}
DI float wave_max(float v) {
#pragma unroll
    for (int o = 32; o >= 1; o >>= 1) v = fmaxf(v, __shfl_xor(v, o));
    return v;
}
DI void lds_fence() { asm volatile("s_waitcnt lgkmcnt(0)" ::: "memory"); __builtin_amdgcn_wave_barrier(); }
DI bf16x8 gat8(const LAS bf16_t* p, int stride) {
    bf16x8 r;
#pragma unroll
    for (int j = 0; j < 8; ++j) r[j] = (short)p[j * stride];
    return r;
}
DI bf16x8 ld8(const LAS bf16_t* p) { return *(const LAS bf16x8*)p; }
DI f32x4 mfma16(bf16x8 a, bf16x8 b, f32x4 c) { return __builtin_amdgcn_mfma_f32_16x16x32_bf16(a, b, c, 0, 0, 0); }
DI f32x16 mfma32(bf16x8 a, bf16x8 b, f32x16 c) { return __builtin_amdgcn_mfma_f32_32x32x16_bf16(a, b, c, 0, 0, 0); }
DI void unpack8(u32x4 w, float (&f)[8]) { f[0] = bflo(w.x); f[1] = bfhi(w.x); f[2] = bflo(w.y); f[3] = bfhi(w.y); f[4] = bflo(w.z); f[5] = bfhi(w.z); f[6] = bflo(w.w); f[7] = bfhi(w.w); }
DI void atom_add(float* p, float v) { (void)__hip_atomic_fetch_add(p, v, __ATOMIC_RELAXED, __HIP_MEMORY_SCOPE_AGENT); }
DI void ld8f(const float* s, float (&f)[8]) { const f32x4 a = *(const f32x4*)s, b = *(const f32x4*)(s + 4); f[0] = a[0]; f[1] = a[1]; f[2] = a[2]; f[3] = a[3]; f[4] = b[0]; f[5] = b[1]; f[6] = b[2]; f[7] = b[3]; }
DI int crow_of(int r) { return r < TP ? 0 : 1 + ((r - TP) >> 2); }

struct EpiZ {
    static constexpr bool PERM = true, AFTER_DRAIN = false;
    bf16_t* Z; const float* rope; float* out; const float* c0; const float* c1; const float* c2;
    static constexpr int CPY_R0 = 32 * 124, CPY_R1 = 32 * 508, CPY_R2 = 32 * 2044, CPY_ROWS = CPY_R0 + CPY_R1 + CPY_R2, CPY_PER = 28;
    DI void cpy_row(int r, const float*& src, float*& dst) const {
        if (r < CPY_R0) { const int b = r / 124, rr = r - b * 124; src = c0 + ((size_t)(b * 128 + rr + 4)) * 1024; dst = out + OFF_KVS0 + ((size_t)(b * 128 + rr)) * 1024; }
        else if (r < CPY_R0 + CPY_R1) { r -= CPY_R0; const int b = r / 508, rr = r - b * 508; src = c1 + ((size_t)(b * 512 + rr + 4)) * 1024; dst = out + OFF_KVS1 + ((size_t)(b * 512 + rr)) * 1024; }
        else { r -= CPY_R0 + CPY_R1; const int b = r / 2044, rr = r - b * 2044; src = c2 + ((size_t)(b * 2048 + rr + 4)) * 1024; dst = out + OFF_KVS2 + ((size_t)(b * 2048 + rr)) * 1024; }
    }
    DI void operator()(const f32x4 (&acc)[2][2][4][2], const Unit& u, int wr, int wc, int fr, int fq) const {
        {
            int l4 = (wc * 64 + fq * 16 + fr) * 4; asm volatile("" : "+v"(l4));
            const int r0 = (u.pm * 50 + u.pn) * CPY_PER;
#pragma unroll
            for (int h2 = 0; h2 < 2; ++h2) {
                f32x4 v[7];
#pragma unroll
                for (int q = 0; q < 7; ++q) { int r = r0 + (h2 * 7 + q) * 2 + wr; r = r < CPY_ROWS ? r : r - CPY_ROWS; const float* sp; float* dp; cpy_row(r, sp, dp); v[q] = __builtin_nontemporal_load((const f32x4*)(sp + l4)); }
#pragma unroll
                for (int q = 0; q < 7; ++q) { int r = r0 + (h2 * 7 + q) * 2 + wr; r = r < CPY_ROWS ? r : r - CPY_ROWS; const float* sp; float* dp; cpy_row(r, sp, dp); __builtin_nontemporal_store(v[q], (f32x4*)(dp + l4)); }
            }
        }
        const int kind = u.pn < 6 ? 0 : (u.pn < 12 ? 1 : (u.pn < 18 ? 2 : 3));
        const bool do_rope = (kind <= 1) && (wc == 0);
        const int pnn = (kind == 1) ? u.pn - 6 : u.pn - 12;
        const int g = pnn >> 1, W = 128 << (2 * g);
        const size_t offp = g == 0 ? OFF_KVP0 : (g == 1 ? OFF_KVP1 : OFF_KVP2), offs = g == 0 ? OFF_KVS0 : (g == 1 ? OFF_KVS1 : OFF_KVS2);
        const float sg = (fq < 2) ? -1.f : 1.f;
#pragma unroll
        for (int ai = 0; ai < 2; ++ai)
#pragma unroll
            for (int m = 0; m < 4; ++m) {
                const int r = u.pm * 256 + ai * 128 + wr * 64 + m * 16 + fr;
                f32x4 cs0 = {0.f, 0.f, 0.f, 0.f}, cs1 = cs0, sn0 = cs0, sn1 = cs0;
                if (do_rope) { const float* rp = rope + (size_t)r * 32 + 8 * (fq & 1); cs0 = *(const f32x4*)rp; cs1 = *(const f32x4*)(rp + 4); sn0 = *(const f32x4*)(rp + 16); sn1 = *(const f32x4*)(rp + 20); }
#pragma unroll
                for (int bj = 0; bj < 2; ++bj) {
                    f32x4 v0 = acc[ai][bj][m][0], v1 = acc[ai][bj][m][1];
                    if (do_rope) {
                        f32x4 p0, p1;
#pragma unroll
                        for (int j = 0; j < 4; ++j) { p0[j] = __shfl_xor(v0[j], 32); p1[j] = __shfl_xor(v1[j], 32); }
                        v0 = v0 * cs0 + sg * (p0 * sn0); v1 = v1 * cs1 + sg * (p1 * sn1);
                    }
                    const int c = u.pn * 256 + bj * 128 + wc * 32 + 8 * fq;
                    u32x4 w; w.x = pk2(v0[0], v0[1]); w.y = pk2(v0[2], v0[3]); w.z = pk2(v1[0], v1[1]); w.w = pk2(v1[2], v1[3]);
                    *(u32x4*)(Z + (size_t)r * NZ + c) = w;
                    if (kind == 1 || kind == 2) {
                        const int hh = 2 * (pnn & 1) + bj, dd = wc * 32 + 8 * fq, kv = kind - 1;
                        float* dst = nullptr;
                        if (r < TP) { if (r >= TP - W) dst = out + offp + ((size_t)(r - (TP - W)) * 2 + kv) * 512 + hh * 128 + dd; }
                        else if (r < MR) { const int b = (r - TP) >> 2, t = (r - TP) & 3; dst = out + offs + ((size_t)(b * W + W - 4 + t) * 2 + kv) * 512 + hh * 128 + dd; }
                        if (dst) { *(f32x4*)dst = v0; *(f32x4*)(dst + 4) = v1; }
                    }
                }
            }
    }
};
struct EpiMix1 {
    static constexpr bool PERM = false, AFTER_DRAIN = false;
    const bf16_t* Z; float* TMP; float* accs;
    DI void operator()(const f32x4 (&acc)[2][2][4][2], const Unit& u, int wr, int wc, int fr, int fq) const {
        if (u.pm == 64) {
#pragma unroll
            for (int m = 0; m < 4; ++m)
#pragma unroll
                for (int bj = 0; bj < 2; ++bj)
#pragma unroll
                    for (int n = 0; n < 2; ++n) *(f32x4*)(accs + ((size_t)(u.kt0 >> 2) * NS + (wr * 64 + m * 16 + fr)) * D + u.pn * 256 + bj * 128 + wc * 32 + 16 * n + 4 * fq) = acc[0][bj][m][n];
            return;
        }
#pragma unroll
        for (int ai = 0; ai < 2; ++ai)
#pragma unroll
            for (int m = 0; m < 4; ++m) {
                const int r = u.pm * 256 + ai * 128 + wr * 64 + m * 16 + fr;
#pragma unroll
                for (int bj = 0; bj < 2; ++bj)
#pragma unroll
                    for (int n = 0; n < 2; ++n) {
                        const int c = u.pn * 256 + bj * 128 + wc * 32 + 16 * n + 4 * fq;
                        const u32x2 gw = *(const u32x2*)(Z + (size_t)r * NZ + ZGA + c);
                        f32x4 v = acc[ai][bj][m][n];
                        v[0] *= sigm(bflo(gw.x)); v[1] *= sigm(bfhi(gw.x)); v[2] *= sigm(bflo(gw.y)); v[3] *= sigm(bfhi(gw.y));
                        *(f32x4*)(TMP + (size_t)r * D + c) = v;
                    }
            }
    }
};
struct EpiMix2 {
    static constexpr bool PERM = false, AFTER_DRAIN = false;
    const bf16_t* Z; const float* TMP; bf16_t* Y; float* accs;
    DI void operator()(const f32x4 (&acc)[2][2][4][2], const Unit& u, int wr, int wc, int fr, int fq) const {
        if (u.pm == 64) {
#pragma unroll
            for (int m = 0; m < 4; ++m)
#pragma unroll
                for (int bj = 0; bj < 2; ++bj)
#pragma unroll
                    for (int n = 0; n < 2; ++n) *(f32x4*)(accs + ((size_t)(u.kt0 >> 2) * NS + (wr * 64 + m * 16 + fr)) * D + u.pn * 256 + bj * 128 + wc * 32 + 16 * n + 4 * fq) = acc[0][bj][m][n];
            return;
        }
#pragma unroll
        for (int ai = 0; ai < 2; ++ai)
#pragma unroll
            for (int m = 0; m < 4; ++m) {
                const int r = u.pm * 256 + ai * 128 + wr * 64 + m * 16 + fr;
#pragma unroll
                for (int bj = 0; bj < 2; ++bj)
#pragma unroll
                    for (int n = 0; n < 2; ++n) {
                        const int c = u.pn * 256 + bj * 128 + wc * 32 + 16 * n + 4 * fq;
                        const u32x2 gw = *(const u32x2*)(Z + (size_t)r * NZ + ZGB + c);
                        const f32x4 t = *(const f32x4*)(TMP + (size_t)r * D + c);
                        f32x4 v = acc[ai][bj][m][n];
                        v[0] = t[0] + v[0] * sigm(bflo(gw.x)); v[1] = t[1] + v[1] * sigm(bfhi(gw.x)); v[2] = t[2] + v[2] * sigm(bflo(gw.y)); v[3] = t[3] + v[3] * sigm(bfhi(gw.y));
                        u32x2 w; w.x = pk2(v[0], v[1]); w.y = pk2(v[2], v[3]);
                        *(u32x2*)(Y + (size_t)r * D + c) = w;
                    }
            }
    }
};
struct EpiWO {
    static constexpr bool PERM = false, AFTER_DRAIN = false;
    const float* xp; const float* xs; const float* mod; float* out; float* accs;
    DI void operator()(const f32x4 (&acc)[2][2][4][2], const Unit& u, int wr, int wc, int fr, int fq) const {
        if (u.pm == 64) {
#pragma unroll
            for (int m = 0; m < 4; ++m)
#pragma unroll
                for (int bj = 0; bj < 2; ++bj)
#pragma unroll
                    for (int n = 0; n < 2; ++n) {
                        float* d = accs + ((size_t)(u.kt0 >> 2) * NS + (wr * 64 + m * 16 + fr)) * D + u.pn * 256 + bj * 128 + wc * 32 + 16 * n + 4 * fq;
                        *(f32x4*)d = acc[0][bj][m][n];
                    }
            return;
        }
#pragma unroll
        for (int ai = 0; ai < 2; ++ai)
#pragma unroll
            for (int m = 0; m < 4; ++m) {
                const int r = u.pm * 256 + ai * 128 + wr * 64 + m * 16 + fr;
                if (r < MR) {
                    const float* xr = r < TP ? xp + (size_t)r * D : xs + (size_t)(r - TP) * D;
                    const float* g1 = mod + (size_t)crow_of(r) * NMOD + 2 * D;
#pragma unroll
                    for (int bj = 0; bj < 2; ++bj)
#pragma unroll
                        for (int n = 0; n < 2; ++n) {
                            const int c = u.pn * 256 + bj * 128 + wc * 32 + 16 * n + 4 * fq;
                            const f32x4 xv = *(const f32x4*)(xr + c), gv = *(const f32x4*)(g1 + c);
                            *(f32x4*)(out + (size_t)r * D + c) = xv + gv * acc[ai][bj][m][n];
                        }
                }
            }
    }
};
struct EpiDown {
    static constexpr bool PERM = false, AFTER_DRAIN = false;
    const float* mod; float* out; float* accs;
    DI void operator()(const f32x4 (&acc)[2][2][4][2], const Unit& u, int wr, int wc, int fr, int fq) const {
        if (u.pm == 64) {
#pragma unroll
            for (int m = 0; m < 4; ++m)
#pragma unroll
                for (int bj = 0; bj < 2; ++bj)
#pragma unroll
                    for (int n = 0; n < 2; ++n) {
                        float* d = accs + ((size_t)(u.kt0 >> 2) * NS + (wr * 64 + m * 16 + fr)) * D + u.pn * 256 + bj * 128 + wc * 32 + 16 * n + 4 * fq;
                        *(f32x4*)d = acc[0][bj][m][n];
                    }
            return;
        }
#pragma unroll
        for (int ai = 0; ai < 2; ++ai)
#pragma unroll
            for (int m = 0; m < 4; ++m) {
                const int r = u.pm * 256 + ai * 128 + wr * 64 + m * 16 + fr;
                if (r < MR) {
                    const float* g2 = mod + (size_t)crow_of(r) * NMOD + 5 * D;
#pragma unroll
                    for (int bj = 0; bj < 2; ++bj)
#pragma unroll
                        for (int n = 0; n < 2; ++n) {
                            const int c = u.pn * 256 + bj * 128 + wc * 32 + 16 * n + 4 * fq;
                            float* o = out + (size_t)r * D + c;
                            const f32x4 xv = *(const f32x4*)o, gv = *(const f32x4*)(g2 + c);
                            *(f32x4*)o = xv + gv * acc[ai][bj][m][n];
                        }
                }
            }
    }
};
struct EpiUp {
    static constexpr bool PERM = true, AFTER_DRAIN = false;
    bf16_t* AB; bf16_t* G; float* out; float* accs; const float* cw; const float* cb; LAS float* xch;
    DI void operator()(const f32x4 (&acc)[2][2][4][2], const Unit& u, int wr, int wc, int fr, int fq) const {
        int cl = 32 * wc + 8 * fq;
        if (u.pm == 64) {
#pragma unroll
            for (int m = 0; m < 4; ++m)
#pragma unroll
                for (int bj = 0; bj < 2; ++bj)
#pragma unroll
                    for (int n = 0; n < 2; ++n) {
                        float* d = accs + ((size_t)(u.kt0 >> 2) * NS + (wr * 64 + m * 16 + fr)) * NAB + bj * DFF + 128 * u.pn + cl + 4 * n;
                        *(f32x4*)d = acc[0][bj][m][n];
                    }
            return;
        }
        asm volatile("" : "+v"(cl), "+v"(fr), "+v"(fq));
        const int lane = fq * 16 + fr;
        if (fr >= 14) {
#pragma unroll
            for (int ai = 0; ai < 2; ++ai) { LAS float* d = xch + ((2 * ai + wr) * 2 + (fr - 14)) * 128 + cl; *(LAS f32x4*)d = acc[ai][0][3][0]; *(LAS f32x4*)(d + 4) = acc[ai][0][3][1]; }
        }
        asm volatile("s_waitcnt lgkmcnt(0)" ::: "memory"); __builtin_amdgcn_s_barrier(); __builtin_amdgcn_s_barrier(); asm volatile("" ::: "memory");
        const int src1 = (lane & 48) | ((fr + 15) & 15), src2 = (lane & 48) | ((fr + 14) & 15);
#pragma unroll
        for (int n = 0; n < 2; ++n) {
            const int c = 128 * u.pn + cl + 4 * n;
            const f32x4 w0 = *(const f32x4*)(cw + c), w1 = *(const f32x4*)(cw + DFF + c), w2 = *(const f32x4*)(cw + 2 * DFF + c), bb = *(const f32x4*)(cb + c);
#pragma unroll
            for (int ai = 0; ai < 2; ++ai) {
                const int q = 2 * ai + wr;
                f32x4 y1 = {0.f, 0.f, 0.f, 0.f}, z1 = y1;
                if (q > 0) { y1 = *(const LAS f32x4*)(xch + ((q - 1) * 2 + 1) * 128 + cl + 4 * n); z1 = *(const LAS f32x4*)(xch + ((q - 1) * 2 + (fr == 0 ? 0 : 1)) * 128 + cl + 4 * n); }
#pragma unroll
                for (int m = 0; m < 4; ++m) {
                    const f32x4 av = acc[ai][0][m][n], bv = acc[ai][1][m][n];
                    f32x4 o;
#pragma unroll
                    for (int j = 0; j < 4; ++j) {
                        const float y = __shfl(av[j], src1), z = __shfl(av[j], src2);
                        const float a1 = fr >= 1 ? y : y1[j], a0 = fr >= 2 ? z : z1[j];
                        y1[j] = y; z1[j] = z;
                        const float uu = bb[j] + w0[j] * a0 + w1[j] * a1 + w2[j] * av[j];
                        o[j] = silu(uu) * bv[j];
                    }
                    const int rl = 128 * ai + 64 * wr + 16 * m + fr, rg = 256 * u.pm + rl;
                    const bool edge0 = rl < 2, edge1 = rl >= 254;
                    if (!(edge0 && u.pm > 0)) { u32x2 w; w.x = pk2(o[0], o[1]); w.y = pk2(o[2], o[3]); *(u32x2*)(G + (size_t)rg * DFF + c) = w; }
                    if (edge0 || edge1) {
                        u32x2 w; w.x = pk2(av[0], av[1]); w.y = pk2(av[2], av[3]); *(u32x2*)(AB + (size_t)rg * NAB + c) = w;
                        if (edge0) { u32x2 x; x.x = pk2(bv[0], bv[1]); x.y = pk2(bv[2], bv[3]); *(u32x2*)(AB + (size_t)rg * NAB + DFF + c) = x; }
                        if (edge1 && u.pm == 63) *(f32x4*)(out + OFF_CVP + (size_t)(rl - 254) * DFF + c) = av;
                    }
                    asm volatile("" ::: "memory");
                }
            }
        }
    }
};

DI void ph_mod(const Params& p, LAS unsigned char* L, float* mod) {
    LAS float* sS = (LAS float*)L;
    LAS float* sRed = (LAS float*)L;
    const int tid = threadIdx.x, cgp = tid % 24, ksub = tid / 24;
    const float* cpr = p.in[7]; const float* csm = p.in[8]; const float* wada = p.in[9]; const float* bada = p.in[10];
    for (int nb = blockIdx.x; nb < 256; nb += gridDim.x) {
        const int n0 = nb * 48;
        float acc[33][2];
#pragma unroll
        for (int r = 0; r < 33; ++r) { acc[r][0] = 0.f; acc[r][1] = 0.f; }
        for (int kc = 0; kc < 4; ++kc) {
            f32x2 wv[25];
#pragma unroll
            for (int q = 0; q < 25; ++q) { const int kk = ksub + 21 * q; wv[q] = (ksub < 21 && kk < 512) ? *(const f32x2*)(wada + (size_t)(kc * 512 + kk) * NMOD + n0 + 2 * cgp) : (f32x2){0.f, 0.f}; }
            for (int idx = tid; idx < 33 * 512; idx += 512) {
                const int r = idx >> 9, kk = idx & 511;
                const float c = r == 0 ? cpr[kc * 512 + kk] : csm[(r - 1) * D + kc * 512 + kk];
                sS[kk * 36 + r] = silu(c);
            }
            __syncthreads();
#pragma unroll
            for (int q = 0; q < 25; ++q) {
                const int kk = ksub + 21 * q;
                if (ksub < 21 && kk < 512) {
                    const f32x2 w = wv[q];
                    const LAS f32x4* sp = (const LAS f32x4*)(sS + kk * 36);
#pragma unroll
                    for (int r4 = 0; r4 < 9; ++r4) {
                        const f32x4 sv = sp[r4];
#pragma unroll
                        for (int j = 0; j < 4; ++j) { if (4 * r4 + j < 33) { acc[4 * r4 + j][0] += sv[j] * w[0]; acc[4 * r4 + j][1] += sv[j] * w[1]; } }
                    }
                }
            }
            __syncthreads();
        }
#pragma unroll
        for (int r0 = 0; r0 < 33; r0 += 11) {
            if (ksub < 21) {
#pragma unroll
                for (int i = 0; i < 11; ++i) { sRed[ksub * 528 + i * 48 + 2 * cgp] = acc[r0 + i][0]; sRed[ksub * 528 + i * 48 + 2 * cgp + 1] = acc[r0 + i][1]; }
            }
            __syncthreads();
            for (int o = tid; o < 528; o += 512) {
                float sum = 0.f;
                for (int k2 = 0; k2 < 21; ++k2) sum += sRed[k2 * 528 + o];
                const int i = o / 48, c = o % 48;
                mod[(size_t)(r0 + i) * NMOD + n0 + c] = sum + bada[n0 + c];
            }
            __syncthreads();
        }
    }
}
DI void tr_load(const float* W, int N, int r, int lane, f32x4 (&v)[8]) {
    const int nblk = N / 32, kb = r / nblk, nb = r % nblk, k0 = 64 * kb, n0 = 32 * nb;
#pragma unroll
    for (int i = 0; i < 8; ++i) v[i] = *(const f32x4*)(W + (size_t)(k0 + 8 * i + (lane >> 3)) * N + n0 + 4 * (lane & 7));
}
DI void tr_finish(bf16_t* WT, int K, int N, int inter, int r, LAS float* scr, int lane, const f32x4 (&v)[8]) {
    const int nblk = N / 32, kb = r / nblk, nb = r % nblk, k0 = 64 * kb, n0 = 32 * nb;
#pragma unroll
    for (int i = 0; i < 8; ++i) { LAS float* dd = scr + (8 * i + (lane >> 3)) * 33 + 4 * (lane & 7); dd[0] = v[i][0]; dd[1] = v[i][1]; dd[2] = v[i][2]; dd[3] = v[i][3]; }
    lds_fence();
    const int c = lane & 7;
#pragma unroll
    for (int j = 0; j < 4; ++j) { const int n = (lane >> 3) + 8 * j; const LAS float* s = scr + (8 * c) * 33 + n;
        u32x4 o; o.x = pk2(s[0 * 33], s[1 * 33]); o.y = pk2(s[2 * 33], s[3 * 33]); o.z = pk2(s[4 * 33], s[5 * 33]); o.w = pk2(s[6 * 33], s[7 * 33]);
        const int na = n0 + n, drow = inter < 0 ? na : ((na >> 7) << 8) + inter * 128 + (na & 127);
        *(u32x4*)(WT + (size_t)drow * K + k0 + 8 * c) = o; }
    lds_fence();
}
constexpr int TR_I_IN = 32 * 400, TR_I_PA = 8 * 64, TR_I_PB = 16 * 64, TR_I_O = 32 * 64, TR_I_A = 32 * 176, TR_I_DN = 88 * 64;
constexpr int TR_NITEMS = TR_I_IN + TR_I_PA + TR_I_PB + TR_I_O + 2 * TR_I_A + TR_I_DN;
struct TrSrc { const float *w_in, *w_pa, *w_pb, *w_o, *w_a, *w_b, *w_dn; };
DI void tr_decode(const TrSrc& q, unsigned char* ws, int it, const float*& W, bf16_t*& WT, int& K, int& N, int& inter, int& r) {
    r = it; inter = -1;
    if (r < TR_I_IN) { W = q.w_in; WT = (bf16_t*)(ws + WS_WIN); K = D; N = NZ; return; } r -= TR_I_IN;
    if (r < TR_I_PA) { W = q.w_pa; WT = (bf16_t*)(ws + WS_WPA); K = 512; N = D; return; } r -= TR_I_PA;
    if (r < TR_I_PB) { W = q.w_pb; WT = (bf16_t*)(ws + WS_WPB); K = 1024; N = D; return; } r -= TR_I_PB;
    if (r < TR_I_O) { W = q.w_o; WT = (bf16_t*)(ws + WS_WO); K = D; N = D; return; } r -= TR_I_O;
    if (r < TR_I_A) { W = q.w_a; WT = (bf16_t*)(ws + WS_WAB); K = D; N = DFF; inter = 0; return; } r -= TR_I_A;
    if (r < TR_I_A) { W = q.w_b; WT = (bf16_t*)(ws + WS_WAB); K = D; N = DFF; inter = 1; return; } r -= TR_I_A;
    W = q.w_dn; WT = (bf16_t*)(ws + WS_WDN); K = DFF; N = D;
}
DI void ph_prologue(const Params& p, LAS unsigned char* L) {
    unsigned char* ws = p.ws;
    const int tid = threadIdx.x, lane = tid & 63, wave = tid >> 6;
    const int gw = blockIdx.x * 8 + wave, NGW = gridDim.x * 8;
    const size_t gtid = (size_t)blockIdx.x * 512 + tid, gstride = (size_t)gridDim.x * 512;
    ph_mod(p, L, (float*)(ws + WS_MOD));
    LAS float* scr = (LAS float*)(L + wave * 8448);
    const TrSrc tq{p.in[12], p.in[15], p.in[16], p.in[17], p.in[19], p.in[20], p.in[23]};
    for (int it = gw; it < TR_NITEMS; it += 2 * NGW) {
        const float* W0; bf16_t* T0; int K0, N0, i0, r0; tr_decode(tq, ws, it, W0, T0, K0, N0, i0, r0);
        const int it1 = it + NGW; const bool two = it1 < TR_NITEMS;
        const float* W1; bf16_t* T1; int K1, N1, i1, r1; tr_decode(tq, ws, two ? it1 : it, W1, T1, K1, N1, i1, r1);
        f32x4 v0[8], v1[8];
        tr_load(W0, N0, r0, lane, v0); tr_load(W1, N1, r1, lane, v1);
        tr_finish(T0, K0, N0, i0, r0, scr, lane, v0);
        if (two) tr_finish(T1, K1, N1, i1, r1, scr, lane, v1);
    }
    {
        float* rope = (float*)(ws + WS_ROPE);
        for (size_t idx = gtid; idx < (size_t)MR * 16; idx += gstride) {
            const int m = (int)(idx >> 4), i = (int)(idx & 15);
            const int pos = m < TP ? m : TP + ((m - TP) & 3);
            const float invf = (float)exp2(-(double)i * (18.931568569324174 / 16.0));
            const float ang = (float)pos * invf;
            const double x = (double)ang, n = rint(x * 0.15915494309189535);
            double rr = fma(-n, 6.283185307179586, x); rr = fma(-n, 2.4492935982947064e-16, rr);
            rope[(size_t)m * 32 + i] = cosf((float)rr); rope[(size_t)m * 32 + 16 + i] = sinf((float)rr);
        }
    }
}
DI const float* hn_src(const Params& p, const float* xbase, bool from_out, int m) {
    const bool fix = from_out && m >= TP;
    return (from_out && !fix) ? xbase + (size_t)m * D : (m < TP ? p.in[0] + (size_t)m * D : p.in[1] + (size_t)(m - TP) * D);
}
DI void ph_hnorm(const Params& p, float* xbase, bool from_out, const float* nw, int sh_idx, bf16_t* H) {
    const int lane = threadIdx.x & 63, wave = threadIdx.x >> 6, stride = gridDim.x * 8;
    const float* mod = (const float*)(p.ws + WS_MOD);
    int m = blockIdx.x * 8 + wave;
    f32x4 v[8];
    if (m < MR) { const float* xr = hn_src(p, xbase, from_out, m);
#pragma unroll
        for (int j = 0; j < 8; ++j) v[j] = *(const f32x4*)(xr + 4 * lane + 256 * j); }
    while (m < MR) {
        const int mn = m + stride; f32x4 vn[8];
        if (mn < MR) { const float* xr = hn_src(p, xbase, from_out, mn);
#pragma unroll
            for (int j = 0; j < 8; ++j) vn[j] = *(const f32x4*)(xr + 4 * lane + 256 * j); }
        const bool fix = from_out && m >= TP;
        const float* md = mod + (size_t)crow_of(m) * NMOD + sh_idx * D;
        float ss = 0.f;
#pragma unroll
        for (int j = 0; j < 8; ++j) { const int c = 4 * lane + 256 * j;
            if (fix) { f32x4 a = {0.f, 0.f, 0.f, 0.f}; for (int q = 0; q < NSP_WO; ++q) a = a + *(const f32x4*)((const float*)(p.ws + WS_ACC_WO) + ((size_t)q * NS + (m - TP)) * D + c); const f32x4 g = *(const f32x4*)(mod + (size_t)crow_of(m) * NMOD + 2 * D + c); v[j] = v[j] + g * a; *(f32x4*)(xbase + (size_t)m * D + c) = v[j]; }
            ss += v[j][0] * v[j][0] + v[j][1] * v[j][1] + v[j][2] * v[j][2] + v[j][3] * v[j][3]; }
        const float rstd = rsqrtf(wave_sum(ss) * (1.f / D) + EPS);
#pragma unroll
        for (int j = 0; j < 8; ++j) {
            const int c = 4 * lane + 256 * j;
            const f32x4 w = *(const f32x4*)(nw + c), shv = *(const f32x4*)(md + c), scv = *(const f32x4*)(md + D + c);
            const f32x4 o = (v[j] * rstd) * w * (1.f + scv) + shv;
            u32x2 q; q.x = pk2(o[0], o[1]); q.y = pk2(o[2], o[3]);
            *(u32x2*)(H + (size_t)m * D + c) = q;
        }
#pragma unroll
        for (int j = 0; j < 8; ++j) v[j] = vn[j];
        m = mn;
    }
}
DI void ph_final_norm(const Params& p) {
    const int lane = threadIdx.x & 63, wave = threadIdx.x >> 6, stride = gridDim.x * 8;
    const float* nw = p.in[24];
    int m = blockIdx.x * 8 + wave;
    f32x4 v[8];
    if (m < MR) {
#pragma unroll
        for (int j = 0; j < 8; ++j) v[j] = *(const f32x4*)(p.out + (size_t)m * D + 4 * lane + 256 * j); }
    while (m < MR) {
        const int mn = m + stride; f32x4 vn[8];
        if (mn < MR) {
#pragma unroll
            for (int j = 0; j < 8; ++j) vn[j] = *(const f32x4*)(p.out + (size_t)mn * D + 4 * lane + 256 * j); }
        float* xr = p.out + (size_t)m * D;
        float ss = 0.f;
#pragma unroll
        for (int j = 0; j < 8; ++j) { const int c = 4 * lane + 256 * j;
            if (m >= TP) { f32x4 a = {0.f, 0.f, 0.f, 0.f}; for (int q = 0; q < NSP_DN; ++q) a = a + *(const f32x4*)((const float*)(p.ws + WS_ACC_DN) + ((size_t)q * NS + (m - TP)) * D + c); const f32x4 g = *(const f32x4*)((const float*)(p.ws + WS_MOD) + (size_t)crow_of(m) * NMOD + 5 * D + c); v[j] = v[j] + g * a; }
            ss += v[j][0] * v[j][0] + v[j][1] * v[j][1] + v[j][2] * v[j][2] + v[j][3] * v[j][3]; }
        const float rstd = rsqrtf(wave_sum(ss) * (1.f / D) + EPS);
#pragma unroll
        for (int j = 0; j < 8; ++j) { const int c = 4 * lane + 256 * j; const f32x4 w = *(const f32x4*)(nw + c); *(f32x4*)(xr + c) = (v[j] * rstd) * w; }
#pragma unroll
        for (int j = 0; j < 8; ++j) v[j] = vn[j];
        m = mn;
    }
}

DI void attn_prompt_item(const bf16_t* Z, bf16_t* OG, float* LSE, LAS bf16_t* Vl, int item, int lane) {
    const int g = item >> 11, rem = item & 2047, hh = rem >> 9, bidx = rem & 511;
    const int dsh = 2 * g, nsh = 9 - dsh;
    const int res = bidx >> nsh, blk = bidx & ((1 << nsh) - 1);
    const int s0 = blk * 32, head = g * 4 + hh;
    const int qi = lane & 31, h = lane >> 5;
    const int tq = res + ((s0 + qi) << dsh);
    bf16x8 Qf[8];
    { const bf16_t* qp = Z + (size_t)tq * NZ + ZQ + head * 128 + 8 * h;
#pragma unroll
      for (int ks = 0; ks < 8; ++ks) Qf[ks] = *(const bf16x8*)(qp + 16 * ks); }
    float mrun = -INFINITY, lrun = 0.f;
    f32x16 O[4];
#pragma unroll
    for (int dt = 0; dt < 4; ++dt)
#pragma unroll
        for (int i = 0; i < 16; ++i) O[dt][i] = 0.f;
    const int sq = s0 + qi;
    const int vrow = lane >> 4, vch = lane & 15;
    bf16x8 Kc[8]; u32x4 Vr[8];
#define ATT_LOAD_KV(kt_) do { const int kb_ = s0 - 128 + 32 * (kt_); int skl_ = kb_ + qi; skl_ = skl_ < 0 ? 0 : skl_; \
        const bf16_t* kp_ = Z + (size_t)(res + (skl_ << dsh)) * NZ + ZK + head * 128 + 8 * h; \
        _Pragma("unroll") for (int ks = 0; ks < 8; ++ks) Kc[ks] = *(const bf16x8*)(kp_ + 16 * ks); \
        _Pragma("unroll") for (int i = 0; i < 8; ++i) { int sv_ = kb_ + 4 * i + vrow; sv_ = sv_ < 0 ? 0 : sv_; \
            Vr[i] = *(const u32x4*)(Z + (size_t)(res + (sv_ << dsh)) * NZ + ZV + head * 128 + 8 * vch); } } while (0)
    ATT_LOAD_KV(4);
    for (int kt = 4; kt >= 0; --kt) {
        const int kb = s0 - 128 + 32 * kt;
        f32x16 S;
#pragma unroll
        for (int i = 0; i < 16; ++i) S[i] = 0.f;
#pragma unroll
        for (int ks = 0; ks < 8; ++ks) S = mfma32(Kc[ks], Qf[ks], S);
#pragma unroll
        for (int i = 0; i < 8; ++i) *(LAS u32x4*)(Vl + (4 * i + vrow) * 136 + 8 * vch) = Vr[i];
        if (kt > 0) ATT_LOAD_KV(kt - 1);
        float tmax = -INFINITY;
#pragma unroll
        for (int i = 0; i < 16; ++i) {
            const int sk = kb + (i & 3) + 8 * (i >> 2) + 4 * h;
            const bool valid = (sk >= 0) && (sk <= sq) && (sk >= sq - 128);
            S[i] = valid ? S[i] * ATT_SCALE : -INFINITY;
            tmax = fmaxf(tmax, S[i]);
        }
        tmax = fmaxf(tmax, __shfl_xor(tmax, 32));
        const float mn = fmaxf(mrun, tmax), alpha = __expf(mrun - mn);
        float ps = 0.f;
#pragma unroll
        for (int i = 0; i < 16; ++i) { S[i] = __expf(S[i] - mn); ps += S[i]; }
        ps += __shfl_xor(ps, 32);
        lrun = lrun * alpha + ps; mrun = mn;
#pragma unroll
        for (int dt = 0; dt < 4; ++dt) O[dt] = O[dt] * alpha;
        bf16x8 Pf[2];
#pragma unroll
        for (int s2 = 0; s2 < 2; ++s2) {
            u32x4 w; w.x = pk2(S[8 * s2 + 0], S[8 * s2 + 1]); w.y = pk2(S[8 * s2 + 2], S[8 * s2 + 3]); w.z = pk2(S[8 * s2 + 4], S[8 * s2 + 5]); w.w = pk2(S[8 * s2 + 6], S[8 * s2 + 7]);
            Pf[s2] = __builtin_bit_cast(bf16x8, w);
        }
        lds_fence();
#pragma unroll
        for (int dt = 0; dt < 4; ++dt)
#pragma unroll
            for (int s2 = 0; s2 < 2; ++s2) {
                bf16x8 A;
#pragma unroll
                for (int j = 0; j < 8; ++j) A[j] = (short)Vl[(16 * s2 + 8 * (j >> 2) + 4 * h + (j & 3)) * 136 + 32 * dt + qi];
                O[dt] = mfma32(A, Pf[s2], O[dt]);
            }
        lds_fence();
    }
#undef ATT_LOAD_KV
    const float inv = 1.f / lrun;
    bf16_t* op = OG + ((size_t)g * MP + tq) * 512 + hh * 128 + 4 * h;
#pragma unroll
    for (int dt = 0; dt < 4; ++dt)
#pragma unroll
        for (int rq = 0; rq < 4; ++rq) {
            u32x2 w; w.x = pk2(O[dt][4 * rq] * inv, O[dt][4 * rq + 1] * inv); w.y = pk2(O[dt][4 * rq + 2] * inv, O[dt][4 * rq + 3] * inv);
            *(u32x2*)(op + 32 * dt + 8 * rq) = w;
        }
    if (h == 0) LSE[((size_t)g * MP + tq) * 4 + hh] = mrun + __logf(lrun);
}
DI const float* samp_row(const float* cache, const float* newkv, int b, int W, int rr) {
    return (rr >= W) ? newkv + ((size_t)(b * W + rr - 4) * 2) * 512 : cache + ((size_t)(b * W + rr) * 2) * 512;
}
DI void attn_sample_item(const Params& p, const bf16_t* Z, bf16_t* OG, float* LSE, int item, int lane) {
    const int b = item / 48, r48 = item % 48, t = r48 / 12, head = r48 % 12, g = head >> 2, hh = head & 3;
    const int dsh = 2 * g, W = 128 << dsh;
    const float* cache = p.in[2 + g];
    const float* newkv = p.out + (g == 0 ? OFF_KVS0 : (g == 1 ? OFF_KVS1 : OFF_KVS2));
    const int m = TP + b * 4 + t;
    const unsigned qq = *(const unsigned*)(Z + (size_t)m * NZ + ZQ + head * 128 + 2 * lane);
    const float q0 = bflo(qq) * ATT_SCALE, q1 = bfhi(qq) * ATT_SCALE;
    float mrun, lrun, o0, o1;
    {
        const float* rp = samp_row(cache, newkv, b, W, W + t - (128 << dsh)) + hh * 128 + 2 * lane;
        const f32x2 kk = *(const f32x2*)rp, vv = *(const f32x2*)(rp + 512);
        mrun = wave_sum(q0 * kk.x + q1 * kk.y); lrun = 1.f; o0 = vv.x; o1 = vv.y;
    }
    f32x2 kk[16], vv[16];
#pragma unroll
    for (int u = 0; u < 16; ++u) { const float* rp = samp_row(cache, newkv, b, W, W + t - (u << dsh)) + hh * 128 + 2 * lane; kk[u] = *(const f32x2*)rp; vv[u] = *(const f32x2*)(rp + 512); }
    for (int j0 = 0; j0 < 128; j0 += 16) {
        f32x2 kn[16], vn[16];
        if (j0 + 16 < 128) {
#pragma unroll
            for (int u = 0; u < 16; ++u) { const float* rp = samp_row(cache, newkv, b, W, W + t - ((j0 + 16 + u) << dsh)) + hh * 128 + 2 * lane; kn[u] = *(const f32x2*)rp; vn[u] = *(const f32x2*)(rp + 512); }
        }
        float pr[16];
#pragma unroll
        for (int u = 0; u < 16; ++u) pr[u] = q0 * kk[u].x + q1 * kk[u].y;
#pragma unroll
        for (int o = 32; o >= 1; o >>= 1) {
#pragma unroll
            for (int u = 0; u < 16; ++u) pr[u] += __shfl_xor(pr[u], o);
        }
        float bm = pr[0];
#pragma unroll
        for (int u = 1; u < 16; ++u) bm = fmaxf(bm, pr[u]);
        const float mn = fmaxf(mrun, bm), alpha = __expf(mrun - mn);
        lrun *= alpha; o0 *= alpha; o1 *= alpha; mrun = mn;
#pragma unroll
        for (int u = 0; u < 16; ++u) { const float pu = __expf(pr[u] - mn); lrun += pu; o0 += pu * vv[u].x; o1 += pu * vv[u].y; }
#pragma unroll
        for (int u = 0; u < 16; ++u) { kk[u] = kn[u]; vv[u] = vn[u]; }
    }
    const float inv = 1.f / lrun;
    *(unsigned*)(OG + ((size_t)g * MP + m) * 512 + hh * 128 + 2 * lane) = pk2(o0 * inv, o1 * inv);
    if (lane == 0) LSE[((size_t)g * MP + m) * 4 + hh] = mrun + __logf(lrun);
}

DI float hg_gates(const Params& p, const bf16_t (&fhr)[16], int h, LAS float* tot, float (&kk)[16], float (&bb)[16]) {
    const int tid = threadIdx.x, dk = tid & 127, part = tid >> 7;
    const float* lbp = p.in[13];
    const float lb = 1.f / (1.f + __expf(lbp[1024 + h * 128 + dk] - lbp[h * 128 + dk]));
    float cum = 0.f;
#pragma unroll
    for (int i = 0; i < 16; ++i) {
        const float fh = bf2f(fhr[i]);
        const float f = lb + (1.f - lb) * sigm(fh);
        kk[i] = 1.f - f; cum += __logf(f); bb[i] = cum;
    }
    tot[part * 128 + dk] = cum;
    __syncthreads();
    float off = 0.f, bl = 0.f;
#pragma unroll
    for (int q = 0; q < 4; ++q) { const float tv = tot[q * 128 + dk]; bl += tv; off += (q < part) ? tv : 0.f; }
#pragma unroll
    for (int i = 0; i < 16; ++i) bb[i] += off;
    return bl;
}
DI void hg_load_v(const bf16_t* Z, int n, int h, LAS bf16_t* Vs) {
    const int tid = threadIdx.x;
#pragma unroll
    for (int i = 0; i < 2; ++i) { const int e = tid + 512 * i, s = e >> 4, ch = e & 15;
        *(LAS u32x4*)(Vs + s * 136 + 8 * ch) = *(const u32x4*)(Z + (size_t)(64 * n + s) * NZ + ZIH + h * 128 + 8 * ch); }
}
struct HgaRegs { bf16_t fhr[16]; u32x4 vreg[2]; };
DI void hg_passA_load(const bf16_t* Z, int item, HgaRegs& R) {
    const int n = item >> 3, h = item & 7;
    const int tid = threadIdx.x, dk = tid & 127, part = tid >> 7;
#pragma unroll
    for (int i = 0; i < 16; ++i) R.fhr[i] = Z[(size_t)(64 * n + 16 * part + i) * NZ + ZFH + h * 128 + dk];
#pragma unroll
    for (int i = 0; i < 2; ++i) { const int e = tid + 512 * i; R.vreg[i] = *(const u32x4*)(Z + (size_t)(64 * n + (e >> 4)) * NZ + ZIH + h * 128 + 8 * (e & 15)); }
}
DI void hg_passA_item(const Params& p, float* HS, float* HD, LAS unsigned char* L, int item, const HgaRegs& R) {
    const int n = item >> 3, h = item & 7;
    const int tid = threadIdx.x, lane = tid & 63, wave = tid >> 6, dk = tid & 127, part = tid >> 7;
    LAS bf16_t* Kh = (LAS bf16_t*)L;
    LAS bf16_t* Vs = (LAS bf16_t*)(L + 17408);
    LAS float* tot = (LAS float*)(L + 34816);
    float kk[16], bb[16];
    const float bl = hg_gates(p, R.fhr, h, tot, kk, bb);
#pragma unroll
    for (int i = 0; i < 16; ++i) Kh[(16 * part + i) * 136 + dk] = (bf16_t)(pk2(kk[i] * __expf(bl - bb[i]), 0.f) & 0xffffu);
    if (part == 0) HD[(size_t)(n * 8 + h) * 128 + dk] = __expf(bl);
#pragma unroll
    for (int i = 0; i < 2; ++i) { const int e = tid + 512 * i; *(LAS u32x4*)(Vs + (e >> 4) * 136 + 8 * (e & 15)) = R.vreg[i]; }
    __syncthreads();
    f32x4 acc[8];
#pragma unroll
    for (int nt = 0; nt < 8; ++nt) acc[nt] = (f32x4){0.f, 0.f, 0.f, 0.f};
#pragma unroll
    for (int ks = 0; ks < 2; ++ks) {
        const bf16x8 A = gat8(Kh + (32 * ks + 8 * (lane >> 4)) * 136 + 16 * wave + (lane & 15), 136);
#pragma unroll
        for (int nt = 0; nt < 8; ++nt) { const bf16x8 B = gat8(Vs + (32 * ks + 8 * (lane >> 4)) * 136 + 16 * nt + (lane & 15), 136); acc[nt] = mfma16(A, B, acc[nt]); }
    }
    float* up = HS + ((size_t)(n * 8 + h) * 128) * 128;
#pragma unroll
    for (int nt = 0; nt < 8; ++nt)
#pragma unroll
        for (int r = 0; r < 4; ++r) up[(size_t)(16 * wave + 4 * (lane >> 4) + r) * 128 + 16 * nt + (lane & 15)] = acc[nt][r];
    __syncthreads();
}
DI void hg_scan(const Params& p, float* HS, const float* HD) {
    for (int e = blockIdx.x * 512 + threadIdx.x; e < 131072; e += gridDim.x * 512) {
        float S = 0.f;
        for (int n0 = 0; n0 < 256; n0 += 32) {
            float U[32], Dd[32];
#pragma unroll
            for (int j = 0; j < 32; ++j) { U[j] = HS[(size_t)(n0 + j) * 131072 + e]; Dd[j] = HD[(n0 + j) * 1024 + (e >> 7)]; }
#pragma unroll
            for (int j = 0; j < 32; ++j) { HS[(size_t)(n0 + j) * 131072 + e] = S; S = Dd[j] * S + U[j]; }
        }
        p.out[OFF_HGP + e] = S;
    }
}
struct HgcRegs { bf16_t fhr[16], qhr[16]; u32x4 vreg[2]; f32x4 sreg[8]; };
DI void hg_passC_load(const bf16_t* Z, const float* HS, int item, HgcRegs& R) {
    const int n = item >> 3, h = item & 7;
    const int tid = threadIdx.x, dk = tid & 127, part = tid >> 7;
#pragma unroll
    for (int i = 0; i < 16; ++i) { const size_t ro = (size_t)(64 * n + 16 * part + i) * NZ + h * 128 + dk; R.fhr[i] = Z[ro + ZFH]; R.qhr[i] = Z[ro + ZQH]; }
#pragma unroll
    for (int i = 0; i < 2; ++i) { const int e = tid + 512 * i; R.vreg[i] = *(const u32x4*)(Z + (size_t)(64 * n + (e >> 4)) * NZ + ZIH + h * 128 + 8 * (e & 15)); }
    const float* sp = HS + ((size_t)(n * 8 + h) * 128) * 128;
#pragma unroll
    for (int i = 0; i < 8; ++i) { const int e = tid + 512 * i; R.sreg[i] = *(const f32x4*)(sp + (e >> 5) * 128 + 4 * (e & 31)); }
}
DI void hg_passC_item(const Params& p, const bf16_t* Z, bf16_t* OHG, LAS unsigned char* L, int item, const HgcRegs& R) {
    const int n = item >> 3, h = item & 7;
    const int tid = threadIdx.x, lane = tid & 63, wave = tid >> 6, dk = tid & 127, part = tid >> 7;
    LAS bf16_t* Qs = (LAS bf16_t*)L;
    LAS bf16_t* Ks = (LAS bf16_t*)(L + 17408);
    LAS bf16_t* Vs = (LAS bf16_t*)(L + 34816);
    LAS bf16_t* Ss = (LAS bf16_t*)(L + 52224);
    LAS bf16_t* As = (LAS bf16_t*)(L + 87040);
    LAS float* tot = (LAS float*)(L + 96256);
    LAS float* red = (LAS float*)(L + 98304);
    float kk[16], bb[16];
    const int mt = wave >> 1, wh = wave & 1, lr = lane & 15, lq = lane >> 4;
    bf16_t ghr[16];
#pragma unroll
    for (int r = 0; r < 4; ++r)
#pragma unroll
        for (int j = 0; j < 4; ++j) ghr[r * 4 + j] = Z[(size_t)(64 * n + 16 * mt + 4 * lq + r) * NZ + ZGH + h * 128 + 16 * (4 * wh + j) + lr];
    (void)hg_gates(p, R.fhr, h, tot, kk, bb);
#pragma unroll
    for (int i = 0; i < 16; ++i) {
        const int s = 16 * part + i;
        const float qh = bf2f(R.qhr[i]);
        Qs[s * 136 + dk] = (bf16_t)(pk2(silu(qh) * __expf(bb[i]), 0.f) & 0xffffu);
        Ks[s * 136 + dk] = (bf16_t)(pk2(kk[i] * __expf(-bb[i]), 0.f) & 0xffffu);
    }
#pragma unroll
    for (int i = 0; i < 2; ++i) { const int e = tid + 512 * i; *(LAS u32x4*)(Vs + (e >> 4) * 136 + 8 * (e & 15)) = R.vreg[i]; }
#pragma unroll
    for (int i = 0; i < 8; ++i) { const int e = tid + 512 * i; u32x2 w; w.x = pk2(R.sreg[i][0], R.sreg[i][1]); w.y = pk2(R.sreg[i][2], R.sreg[i][3]); *(LAS u32x2*)(Ss + (e >> 5) * 136 + 4 * (e & 31)) = w; }
    __syncthreads();
    {
        f32x4 a2[2] = {{0.f, 0.f, 0.f, 0.f}, {0.f, 0.f, 0.f, 0.f}};
#pragma unroll
        for (int ks = 0; ks < 4; ++ks) {
            const bf16x8 A = ld8(Qs + (16 * mt + lr) * 136 + 32 * ks + 8 * lq);
#pragma unroll
            for (int j = 0; j < 2; ++j) { const bf16x8 B = ld8(Ks + (16 * (2 * wh + j) + lr) * 136 + 32 * ks + 8 * lq); a2[j] = mfma16(A, B, a2[j]); }
        }
#pragma unroll
        for (int j = 0; j < 2; ++j)
#pragma unroll
            for (int r = 0; r < 4; ++r) { const int t = 16 * mt + 4 * lq + r, s = 16 * (2 * wh + j) + lr; As[t * 72 + s] = (bf16_t)(pk2(s <= t ? a2[j][r] : 0.f, 0.f) & 0xffffu); }
    }
    __syncthreads();
    f32x4 acc[4];
#pragma unroll
    for (int j = 0; j < 4; ++j) acc[j] = (f32x4){0.f, 0.f, 0.f, 0.f};
#pragma unroll
    for (int ks = 0; ks < 2; ++ks) {
        const bf16x8 A = ld8(As + (16 * mt + lr) * 72 + 32 * ks + 8 * lq);
#pragma unroll
        for (int j = 0; j < 4; ++j) { const bf16x8 B = gat8(Vs + (32 * ks + 8 * lq) * 136 + 16 * (4 * wh + j) + lr, 136); acc[j] = mfma16(A, B, acc[j]); }
    }
#pragma unroll
    for (int ks = 0; ks < 4; ++ks) {
        const bf16x8 A = ld8(Qs + (16 * mt + lr) * 136 + 32 * ks + 8 * lq);
#pragma unroll
        for (int j = 0; j < 4; ++j) { const bf16x8 B = gat8(Ss + (32 * ks + 8 * lq) * 136 + 16 * (4 * wh + j) + lr, 136); acc[j] = mfma16(A, B, acc[j]); }
    }
#pragma unroll
    for (int r = 0; r < 4; ++r) {
        float ss = 0.f;
#pragma unroll
        for (int j = 0; j < 4; ++j) ss += acc[j][r] * acc[j][r];
        ss += __shfl_xor(ss, 1); ss += __shfl_xor(ss, 2); ss += __shfl_xor(ss, 4); ss += __shfl_xor(ss, 8);
        if (lr == 0) red[(16 * mt + 4 * lq + r) * 2 + wh] = ss;
    }
    __syncthreads();
    const float* hgw = p.in[14];
#pragma unroll
    for (int r = 0; r < 4; ++r) {
        const int tl = 16 * mt + 4 * lq + r, t = 64 * n + tl;
        const float rstd = rsqrtf((red[tl * 2] + red[tl * 2 + 1]) * (1.f / 128.f) + EPS);
#pragma unroll
        for (int j = 0; j < 4; ++j) {
            const int dv = 16 * (4 * wh + j) + lr;
            const float gh = bf2f(ghr[r * 4 + j]);
            OHG[(size_t)t * 1024 + h * 128 + dv] = (bf16_t)(pk2(acc[j][r] * rstd * hgw[dv] * silu(gh), 0.f) & 0xffffu);
        }
    }
    __syncthreads();
}
DI void hg_sample_item(const Params& p, const bf16_t* Z, bf16_t* OHG, LAS unsigned char* L, int item) {
    const int b = item >> 3, h = item & 7;
    const int tid = threadIdx.x, dv = tid & 127, dq = tid >> 7;
    LAS float* fS = (LAS float*)L;
    LAS float* kS = fS + 512;
    LAS float* qS = kS + 512;
    LAS float* red = qS + 512;
    LAS float* rs = red + 2048;
    const float* lbp = p.in[13];
    {
        const int t = tid >> 7, dk = tid & 127, m = TP + b * 4 + t;
        const float lb = 1.f / (1.f + __expf(lbp[1024 + h * 128 + dk] - lbp[h * 128 + dk]));
        const float fh = bf2f(Z[(size_t)m * NZ + ZFH + h * 128 + dk]), qh = bf2f(Z[(size_t)m * NZ + ZQH + h * 128 + dk]);
        const float f = lb + (1.f - lb) * sigm(fh);
        fS[tid] = f; kS[tid] = 1.f - f; qS[tid] = silu(qh);
    }
    float S[32];
    const float* s0 = p.in[5] + ((size_t)(b * 8 + h) * 128) * 128;
#pragma unroll
    for (int i = 0; i < 32; ++i) S[i] = s0[(size_t)(dq * 32 + i) * 128 + dv];
    __syncthreads();
#pragma unroll
    for (int t = 0; t < 4; ++t) {
        const int m = TP + b * 4 + t;
        const float v = bf2f(Z[(size_t)m * NZ + ZIH + h * 128 + dv]);
        float part = 0.f;
#pragma unroll
        for (int i = 0; i < 32; ++i) { const int dk = dq * 32 + i; S[i] = fS[t * 128 + dk] * S[i] + kS[t * 128 + dk] * v; part += S[i] * qS[t * 128 + dk]; }
        red[(t * 4 + dq) * 128 + dv] = part;
    }
    float* so = p.out + OFF_HGS + ((size_t)(b * 8 + h) * 128) * 128;
#pragma unroll
    for (int i = 0; i < 32; ++i) so[(size_t)(dq * 32 + i) * 128 + dv] = S[i];
    __syncthreads();
    {
        const int t = tid >> 7, m = TP + b * 4 + t;
        const float o = red[(t * 4 + 0) * 128 + dv] + red[(t * 4 + 1) * 128 + dv] + red[(t * 4 + 2) * 128 + dv] + red[(t * 4 + 3) * 128 + dv];
        const float ss = wave_sum(o * o);
        if ((tid & 63) == 0) rs[tid >> 6] = ss;
        __syncthreads();
        const float rstd = rsqrtf((rs[2 * t] + rs[2 * t + 1]) * (1.f / 128.f) + EPS);
        const float gh = bf2f(Z[(size_t)m * NZ + ZGH + h * 128 + dv]);
        OHG[(size_t)m * 1024 + h * 128 + dv] = (bf16_t)(pk2(o * rstd * p.in[14][dv] * silu(gh), 0.f) & 0xffffu);
    }
    __syncthreads();
}
DI void ph_merge(const bf16_t* OG, const float* LSE, bf16_t* OATT) {
    for (size_t idx = (size_t)blockIdx.x * 512 + threadIdx.x; idx < (size_t)MR * 64; idx += (size_t)gridDim.x * 512) {
        const int m = (int)(idx >> 6), c8 = (int)(idx & 63), hh = c8 >> 4;
        const float l0 = LSE[((size_t)0 * MP + m) * 4 + hh], l1 = LSE[((size_t)1 * MP + m) * 4 + hh], l2 = LSE[((size_t)2 * MP + m) * 4 + hh];
        const float mx = fmaxf(l0, fmaxf(l1, l2));
        float w0 = __expf(l0 - mx), w1 = __expf(l1 - mx), w2 = __expf(l2 - mx);
        const float inv = 1.f / (w0 + w1 + w2); w0 *= inv; w1 *= inv; w2 *= inv;
        float a[8], b[8], c[8];
        unpack8(*(const u32x4*)(OG + ((size_t)0 * MP + m) * 512 + 8 * c8), a);
        unpack8(*(const u32x4*)(OG + ((size_t)1 * MP + m) * 512 + 8 * c8), b);
        unpack8(*(const u32x4*)(OG + ((size_t)2 * MP + m) * 512 + 8 * c8), c);
        u32x4 o;
        o.x = pk2(w0 * a[0] + w1 * b[0] + w2 * c[0], w0 * a[1] + w1 * b[1] + w2 * c[1]);
        o.y = pk2(w0 * a[2] + w1 * b[2] + w2 * c[2], w0 * a[3] + w1 * b[3] + w2 * c[3]);
        o.z = pk2(w0 * a[4] + w1 * b[4] + w2 * c[4], w0 * a[5] + w1 * b[5] + w2 * c[5]);
        o.w = pk2(w0 * a[6] + w1 * b[6] + w2 * c[6], w0 * a[7] + w1 * b[7] + w2 * c[7]);
        *(u32x4*)(OATT + (size_t)m * 512 + 8 * c8) = o;
    }
}
DI void ld8p(const float* s, float (&f)[8]) {
    f32x4 a = {0.f, 0.f, 0.f, 0.f}, b = a;
#pragma unroll
    for (int q = 0; q < NSP_UP; ++q) { a = a + *(const f32x4*)(s + (size_t)q * NS * NAB); b = b + *(const f32x4*)(s + (size_t)q * NS * NAB + 4); }
    f[0] = a[0]; f[1] = a[1]; f[2] = a[2]; f[3] = a[3]; f[4] = b[0]; f[5] = b[1]; f[6] = b[2]; f[7] = b[3];
}
DI void ph_convact(const Params& p, const bf16_t* AB, bf16_t* G) {
    const float* cw = p.in[21]; const float* cb = p.in[22]; const float* sc = p.in[6];
    const float* ACC = (const float*)(p.ws + WS_ACC_UP);
    for (size_t idx = (size_t)blockIdx.x * 512 + threadIdx.x; idx < (size_t)(126 + NS) * 704; idx += (size_t)gridDim.x * 512) {
        const int ri = (int)(idx / 704), c = (int)(idx % 704) * 8;
        const int m = ri < 126 ? 256 * (1 + (ri >> 1)) + (ri & 1) : TP + (ri - 126);
        float a2[8], a1[8], a0[8], bl[8];
        if (m < TP) {
            unpack8(*(const u32x4*)(AB + (size_t)m * NAB + c), a2);
            unpack8(*(const u32x4*)(AB + (size_t)m * NAB + DFF + c), bl);
            if (m >= 1) unpack8(*(const u32x4*)(AB + (size_t)(m - 1) * NAB + c), a1); else { for (int j = 0; j < 8; ++j) a1[j] = 0.f; }
            if (m >= 2) unpack8(*(const u32x4*)(AB + (size_t)(m - 2) * NAB + c), a0); else { for (int j = 0; j < 8; ++j) a0[j] = 0.f; }
        } else {
            const int ms = m - TP, t = ms & 3, b = ms >> 2;
            ld8p(ACC + (size_t)ms * NAB + c, a2);
            ld8p(ACC + (size_t)ms * NAB + DFF + c, bl);
            if (t >= 1) ld8p(ACC + (size_t)(ms - 1) * NAB + c, a1); else ld8f(sc + (size_t)(b * 2 + 1) * DFF + c, a1);
            if (t >= 2) ld8p(ACC + (size_t)(ms - 2) * NAB + c, a0); else ld8f(sc + (size_t)(b * 2 + t) * DFF + c, a0);
            if (t >= 2) { float* d = p.out + OFF_CVS + (size_t)(b * 2 + t - 2) * DFF + c; *(f32x4*)d = (f32x4){a2[0], a2[1], a2[2], a2[3]}; *(f32x4*)(d + 4) = (f32x4){a2[4], a2[5], a2[6], a2[7]}; }
        }
        float w0[8], w1[8], w2[8], bb[8];
        ld8f(cw + c, w0); ld8f(cw + DFF + c, w1); ld8f(cw + 2 * DFF + c, w2); ld8f(cb + c, bb);
        float o[8];
#pragma unroll
        for (int j = 0; j < 8; ++j) { const float u = bb[j] + w0[j] * a0[j] + w1[j] * a1[j] + w2[j] * a2[j]; o[j] = silu(u) * bl[j]; }
        u32x4 w; w.x = pk2(o[0], o[1]); w.y = pk2(o[2], o[3]); w.z = pk2(o[4], o[5]); w.w = pk2(o[6], o[7]);
        *(u32x4*)(G + (size_t)m * DFF + c) = w;
    }
}

DI void ph_mixfix(const Params& p) {
    const bf16_t* Z = (const bf16_t*)(p.ws + WS_Z); const float* PA = (const float*)(p.ws + WS_ACC_PA); const float* PB = (const float*)(p.ws + WS_ACC_PB); bf16_t* Y = (bf16_t*)(p.ws + WS_YMIX);
    for (int idx = blockIdx.x * 512 + threadIdx.x; idx < NS * (D / 4); idx += gridDim.x * 512) {
        const int r = idx / (D / 4), c = (idx % (D / 4)) * 4;
        f32x4 a = {0.f, 0.f, 0.f, 0.f}, b = a;
#pragma unroll
        for (int q = 0; q < NSP_PA; ++q) a = a + *(const f32x4*)(PA + ((size_t)q * NS + r) * D + c);
#pragma unroll
        for (int q = 0; q < NSP_PB; ++q) b = b + *(const f32x4*)(PB + ((size_t)q * NS + r) * D + c);
        const u32x2 ga = *(const u32x2*)(Z + (size_t)(TP + r) * NZ + ZGA + c), gb = *(const u32x2*)(Z + (size_t)(TP + r) * NZ + ZGB + c);
        const float y0 = sigm(bflo(ga.x)) * a[0] + sigm(bflo(gb.x)) * b[0], y1 = sigm(bfhi(ga.x)) * a[1] + sigm(bfhi(gb.x)) * b[1];
        const float y2 = sigm(bflo(ga.y)) * a[2] + sigm(bflo(gb.y)) * b[2], y3 = sigm(bfhi(ga.y)) * a[3] + sigm(bfhi(gb.y)) * b[3];
        u32x2 w; w.x = pk2(y0, y1); w.y = pk2(y2, y3);
        *(u32x2*)(Y + (size_t)(TP + r) * D + c) = w;
    }
}
#define XB_TMO      128
#define XB_XCNT(j)  (256  + 64 * (j))
#define XB_XSUB(j)  (1280 + 64 * (j))
#define XB_XGEN(j)  (2304 + 64 * (j))
#define XB_TOP      3328
#define XB_TOPGEN   3392
#define XCD_BAR_WORDS 3456
#define XB_SPIN_CAP (1u << 18)

__device__ __forceinline__ unsigned xb_ld(unsigned* p)              { return __hip_atomic_load(p, __ATOMIC_RELAXED, __HIP_MEMORY_SCOPE_AGENT); }
__device__ __forceinline__ unsigned xb_add(unsigned* p, unsigned v) { return __hip_atomic_fetch_add(p, v, __ATOMIC_RELAXED, __HIP_MEMORY_SCOPE_AGENT); }
__device__ __forceinline__ unsigned xb_xcc_id() { return (unsigned)__builtin_amdgcn_s_getreg((3 << 11) | 20) & 0xFu; }
#define XB_SPIN(cond, bar) do { unsigned _sp = 0; while (cond) { __builtin_amdgcn_s_sleep(1); \
    if ((++_sp & 255u) == 0u) { if (xb_ld(&(bar)[XB_TMO])) break; if (_sp > XB_SPIN_CAP) { atomicAdd(&(bar)[XB_TMO], 1u); break; } } } } while (0)

struct XcdBarrier {
    unsigned* bar; unsigned x;
    volatile LAS unsigned* st;
};

__device__ __forceinline__ XcdBarrier xcd_barrier_post(unsigned* bar, volatile LAS unsigned* st) {
    XcdBarrier b; b.bar = bar; b.x = xb_xcc_id(); b.st = st;
    if (threadIdx.x == 0) (void)xb_add(&bar[XB_XCNT(b.x)], 1u);
    return b;
}
__device__ __forceinline__ void xcd_barrier_complete(unsigned* bar, unsigned x, unsigned& nloc, unsigned& nx) {
    const unsigned G = gridDim.x * gridDim.y * gridDim.z;
    unsigned sum, cnt, mine, sp = 0u;
    for (;;) {
        sum = 0u; cnt = 0u; mine = 0u;
#pragma unroll
        for (unsigned j = 0; j < 16; ++j) { const unsigned c = xb_ld(&bar[XB_XCNT(j)]); sum += c; cnt += (c > 0u) ? 1u : 0u; mine = (j == x) ? c : mine; }
        if (sum == G) break;
        __builtin_amdgcn_s_sleep(1);
        if ((++sp & 255u) == 0u) { if (xb_ld(&bar[XB_TMO])) break; if (sp > XB_SPIN_CAP) { atomicAdd(&bar[XB_TMO], 1u); break; } }
    }
    nloc = mine > 0u ? mine : 1u; nx = cnt > 0u ? cnt : 1u;
}

__device__ __forceinline__ void xcd_barrier(const XcdBarrier& b) {
    asm volatile("s_waitcnt vmcnt(0)" ::: "memory");
    __syncthreads();
    if (threadIdx.x == 0) {
        unsigned* bar = b.bar;
        __builtin_amdgcn_s_waitcnt(0);
        unsigned nloc = b.st[0], nx = b.st[1];
        if (nloc == 0u) { xcd_barrier_complete(bar, b.x, nloc, nx); b.st[0] = nloc; b.st[1] = nx; }
        const unsigned old = xb_add(&bar[XB_XSUB(b.x)], 1u);
        const unsigned gen = old / nloc;
        if (old + 1u == (gen + 1u) * nloc) {
            __builtin_amdgcn_fence(__ATOMIC_RELEASE, "agent");
            asm volatile("s_waitcnt vmcnt(0)" ::: "memory");
            const unsigned og = xb_add(&bar[XB_TOP], 1u);
            const unsigned tg = og / nx;
            if (og + 1u == (tg + 1u) * nx) xb_add(&bar[XB_TOPGEN], 1u);
            else XB_SPIN(xb_ld(&bar[XB_TOPGEN]) == tg, bar);
            __builtin_amdgcn_fence(__ATOMIC_ACQUIRE, "agent");
            xb_add(&bar[XB_XGEN(b.x)], 1u);
            asm volatile("s_waitcnt vmcnt(0)" ::: "memory");
        } else {
            XB_SPIN(xb_ld(&bar[XB_XGEN(b.x)]) == gen, bar);
            __builtin_amdgcn_fence(__ATOMIC_ACQUIRE, "agent");
            asm volatile("s_waitcnt vmcnt(0)" ::: "memory");
        }
    }
    __syncthreads();
}

template <class Epi> DI void run_gemm(LAS unsigned char* L, const bf16_t* A, const bf16_t* Bt, int N, int K, const Epi& E) {
    pg8::Gemm g{A, Bt, MP, N, K}; pg8::StaticOrder S; S.init(MP, N, K, (int)gridDim.x, (int)blockIdx.x);
    pg8::gemm_phase<Epi, pg8::StaticOrder, false>(L, g, S, E, nullptr);
}
template <class Epi> DI void run_gemm_split(LAS unsigned char* L, const bf16_t* A, const bf16_t* Bt, int N, int K, const Epi& E) {
    pg8::Gemm g{A, Bt, MP, N, K}; pg8::SplitOrder S; S.init(N, K, (int)gridDim.x, (int)blockIdx.x);
    pg8::gemm_phase<Epi, pg8::SplitOrder, false>(L, g, S, E, nullptr);
}

__global__ void __launch_bounds__(512, 2) mega(Params p) {
    extern __shared__ __attribute__((aligned(16))) unsigned char lds[];
    LAS unsigned char* L = (LAS unsigned char*)lds;
    cg::grid_group grid = cg::this_grid();
    unsigned char* ws = p.ws;
    const int lo = p.ph_lo, hi = p.ph_hi;
    const int tid = threadIdx.x, lane = tid & 63, wave = tid >> 6;
    bf16_t* Z = (bf16_t*)(ws + WS_Z);
    bf16_t* H = (bf16_t*)(ws + WS_H);
    float* MOD = (float*)(ws + WS_MOD);
#define IN(k) (lo <= (k) && (k) < hi)
    XcdBarrier xbar; xbar.bar = (unsigned*)ws; xbar.x = 0; xbar.st = (volatile LAS unsigned*)(L + 131072 + 4096);
    if (hi - lo > 1) {
        if (blockIdx.x == 0) for (int i = threadIdx.x; i < 4096; i += 512) ((unsigned*)ws)[i] = 0u;
        if (threadIdx.x < 2) xbar.st[threadIdx.x] = 0u;
        __threadfence();
        grid.sync();
        xbar = xcd_barrier_post((unsigned*)ws, (volatile LAS unsigned*)(L + 131072 + 4096));
    }
#define SEAM(k) do { if (IN(k) && IN((k) + 1)) xcd_barrier(xbar); } while (0)
#define SOFT(k) do { if (IN(k) && IN((k) + 1)) __syncthreads(); } while (0)
    if (IN(0)) ph_prologue(p, L);
    SEAM(0);
    if (IN(1)) ph_hnorm(p, nullptr, false, p.in[11], 0, H);
    SEAM(1);
    if (IN(2)) { EpiZ E{Z, (const float*)(ws + WS_ROPE), p.out, p.in[2], p.in[3], p.in[4]}; run_gemm(L, H, (const bf16_t*)(ws + WS_WIN), NZ, D, E); }
    SEAM(2);
    if (IN(3)) {
        HgaRegs RA;
        int it = blockIdx.x;
        if (it < 2048) hg_passA_load(Z, it, RA);
        while (it < 2048) {
            const int itn = it + gridDim.x; HgaRegs RB;
            if (itn < 2048) hg_passA_load(Z, itn, RB);
            hg_passA_item(p, (float*)(ws + WS_HS), (float*)(ws + WS_HD), L, it, RA);
            RA = RB; it = itn;
        }
    }
    SOFT(3);
    if (IN(4)) {
        const int gw = blockIdx.x * 8 + wave, NGW = gridDim.x * 8;
        LAS bf16_t* Vl = (LAS bf16_t*)(L + wave * 8704);
        for (int base = 0; base < 6144; base += 3 * NGW)
            for (int j = 0; j < 3; ++j) { const int it = base + gw * 3 + j; if (it < 6144) attn_prompt_item(Z, (bf16_t*)(ws + WS_OG), (float*)(ws + WS_LSE), Vl, it, lane); }
    }
    SOFT(4);
    if (IN(5)) { const int gw = blockIdx.x * 8 + wave, NGW = gridDim.x * 8; for (int it = gw; it < 1536; it += NGW) attn_sample_item(p, Z, (bf16_t*)(ws + WS_OG), (float*)(ws + WS_LSE), it, lane); }
    SEAM(5);
    if (IN(6)) hg_scan(p, (float*)(ws + WS_HS), (const float*)(ws + WS_HD));
    SEAM(6);
    if (IN(7)) {
        HgcRegs RA;
        int it = blockIdx.x;
        if (it < 2048) hg_passC_load(Z, (const float*)(ws + WS_HS), it, RA);
        while (it < 2048) {
            const int itn = it + gridDim.x; HgcRegs RB;
            if (itn < 2048) hg_passC_load(Z, (const float*)(ws + WS_HS), itn, RB);
            hg_passC_item(p, Z, (bf16_t*)(ws + WS_OHG), L, it, RA);
            RA = RB; it = itn;
        }
    }
    SOFT(7);
    if (IN(8)) for (int it = blockIdx.x; it < 256; it += gridDim.x) hg_sample_item(p, Z, (bf16_t*)(ws + WS_OHG), L, it);
    SOFT(8);
    if (IN(9)) ph_merge((const bf16_t*)(ws + WS_OG), (const float*)(ws + WS_LSE), (bf16_t*)(ws + WS_OATT));
    SEAM(9);
    if (IN(10)) {
        { EpiMix1 E{Z, (float*)(ws + WS_TMP), (float*)(ws + WS_ACC_PA)}; run_gemm_split(L, (const bf16_t*)(ws + WS_OATT), (const bf16_t*)(ws + WS_WPA), D, 512, E); }
        { EpiMix2 E{Z, (const float*)(ws + WS_TMP), (bf16_t*)(ws + WS_YMIX), (float*)(ws + WS_ACC_PB)}; run_gemm_split(L, (const bf16_t*)(ws + WS_OHG), (const bf16_t*)(ws + WS_WPB), D, 1024, E); }
    }
    SEAM(10);
    if (IN(11)) ph_mixfix(p);
    SEAM(11);
    if (IN(12)) { EpiWO E{p.in[0], p.in[1], MOD, p.out, (float*)(ws + WS_ACC_WO)}; run_gemm_split(L, (const bf16_t*)(ws + WS_YMIX), (const bf16_t*)(ws + WS_WO), D, D, E); }
    SEAM(12);
    if (IN(13)) ph_hnorm(p, p.out, true, p.in[18], 3, H);
    SEAM(13);
    if (IN(14)) { EpiUp E{(bf16_t*)(ws + WS_AB), (bf16_t*)(ws + WS_G), p.out, (float*)(ws + WS_ACC_UP), p.in[21], p.in[22], (LAS float*)(L + 131072)}; run_gemm_split(L, H, (const bf16_t*)(ws + WS_WAB), NAB, D, E); }
    SEAM(14);
    if (IN(15)) ph_convact(p, (const bf16_t*)(ws + WS_AB), (bf16_t*)(ws + WS_G));
    SEAM(15);
    if (IN(16)) { EpiDown E{MOD, p.out, (float*)(ws + WS_ACC_DN)}; run_gemm_split(L, (const bf16_t*)(ws + WS_G), (const bf16_t*)(ws + WS_WDN), D, DFF, E); }
    SEAM(16);
    if (IN(17)) ph_final_norm(p);
#undef IN
#undef SEAM
#undef SOFT
}

#ifndef MK_MULTI
#define MK_MULTI 0
#endif
extern "C" void kernel_launch(void* const* d_in, const int* in_sizes, int n_in, void* d_out, int out_size, void* d_ws, size_t ws_size, hipStream_t stream) {
    static int grid = 0;
    if (grid == 0) {
        if (n_in != 25 || (size_t)out_size != OUT_TOTAL || ws_size < WS_END) { fprintf(stderr, "kernel_launch: unexpected shapes: n_in %d out %d ws %zu (need %zu)\n", n_in, out_size, ws_size, (size_t)WS_END); grid = -1; return; }
        int dev = 0, cus = 0, per_cu = 0;
        hipGetDevice(&dev);
        hipDeviceGetAttribute(&cus, hipDeviceAttributeMultiprocessorCount, dev);
        if (hipFuncSetAttribute((const void*)mega, hipFuncAttributeMaxDynamicSharedMemorySize, LDS_BYTES) != hipSuccess) { fprintf(stderr, "kernel_launch: hipFuncSetAttribute failed\n"); grid = -1; return; }
        if (hipOccupancyMaxActiveBlocksPerMultiprocessor(&per_cu, (const void*)mega, 512, LDS_BYTES) != hipSuccess || per_cu < 1) { fprintf(stderr, "kernel_launch: occupancy query failed (%d)\n", per_cu); (void)hipGetLastError(); per_cu = 1; }
        grid = cus * 1;
        if (grid < 1) grid = -1;
    }
    if (grid < 0) return;
    Params p{};
    for (int i = 0; i < 25; ++i) p.in[i] = (const float*)d_in[i];
    p.out = (float*)d_out; p.ws = (unsigned char*)d_ws;
#ifndef DUP_MASK
#define DUP_MASK 0
#endif
#if MK_MULTI
    for (int ph = 0; ph < NPH; ++ph) for (int rep = 0; rep < (((DUP_MASK >> ph) & 1) ? 2 : 1); ++rep) { p.ph_lo = ph; p.ph_hi = ph + 1; hipLaunchKernelGGL(mega, dim3(grid), dim3(512), LDS_BYTES, stream, p); }
#else
    p.ph_lo = 0; p.ph_hi = NPH;
    void* args[] = {&p};
    hipError_t e = hipLaunchCooperativeKernel((const void*)mega, dim3(grid), dim3(512), args, LDS_BYTES, stream);
    if (e != hipSuccess) fprintf(stderr, "cooperative launch failed: %s (grid %d)\n", hipGetErrorString(e), grid);
#endif
}
```

```cpp
#include <hip/hip_runtime.h>
#include <hip/hip_cooperative_groups.h>
#include <cstdio>
namespace cg = cooperative_groups;
namespace pg8 {
#define PG8_LAS __attribute__((address_space(3)))
typedef unsigned short bf16_t;
typedef short bf16x8 __attribute__((ext_vector_type(8)));
typedef float f32x4 __attribute__((ext_vector_type(4)));
typedef unsigned u32x4 __attribute__((ext_vector_type(4)));
constexpr int BM = 256, BK = 64, HALF = 128, HTB = HALF * BK * 2  , STAGE_BYTES = 8 * HTB, NXCD = 8, WGM = 8;

__host__ __device__ __forceinline__ int lds_byte(int r, int c) { const int st = (r >> 4) * 2 + (c >> 5), rr = r & 15, cc = c & 31, ob = rr * 64 + cc * 2; return st * 1024 + (ob ^ (((ob >> 9) & 1) << 5)); }
__host__ __device__ __forceinline__ void stage_rc(int b, int& R, int& C) { const int st = b / 1024, sb = b % 1024, swz = sb ^ (((sb >> 9) & 1) << 5); R = (st >> 1) * 16 + swz / 64; C = (st & 1) * 32 + (swz % 64) / 2; }
__host__ __device__ __forceinline__ int perm32(int rho) { const int n = rho >> 4, i = rho & 15; return 8 * (i >> 2) + 4 * n + (i & 3); }

struct Unit { int pm, pn, kt0, nkt; };
struct Gemm { const bf16_t* A; const bf16_t* Bt; int M, N, K; };

struct StaticOrder {
    int nM, nN, nwg, G, c, nkt;
    __host__ __device__ void init(int M, int N, int K, int G_, int c_) { nM = M / BM; nN = N / BM; nwg = nM * nN; G = G_; c = c_; nkt = K / BK; }
    __host__ __device__ bool next(int i, Unit& u) const {
        const long L = (long)i * G + c; if (L >= nwg) return false;
        int wgid = (int)L; { const int q = nwg / NXCD, r = nwg % NXCD, xcd = wgid % NXCD, off = wgid / NXCD; wgid = (xcd < r ? xcd * (q + 1) : r * (q + 1) + (xcd - r) * q) + off; }
        const int nig = WGM * nN, gid = wgid / nig, fm = gid * WGM, gsz = (nM - fm) < WGM ? (nM - fm) : WGM;
        u.pm = fm + ((wgid % nig) % gsz); u.pn = (wgid % nig) / gsz; u.kt0 = 0; u.nkt = nkt; return true;
    }
    __device__ __forceinline__ void a_ready(const Unit&) const {}
    __device__ __forceinline__ void done(const Unit&) const {}
};
struct SplitOrder {
    int nN, nwg, G, c, nkt, nsp;
    __host__ __device__ void init(int N, int K, int G_, int c_) { nN = N / BM; nwg = 64 * nN; G = G_; c = c_; nkt = K / BK; nsp = nkt / 4; }
    __host__ __device__ bool next(int i, Unit& u) const {
        const long L = (long)i * G + c;
        if (L < nwg) {
            int wgid = (int)L; { const int q = nwg / NXCD, r = nwg % NXCD, xcd = wgid % NXCD, off = wgid / NXCD; wgid = (xcd < r ? xcd * (q + 1) : r * (q + 1) + (xcd - r) * q) + off; }
            const int nig = WGM * nN, gid = wgid / nig, fm = gid * WGM, gsz = (64 - fm) < WGM ? (64 - fm) : WGM;
            u.pm = fm + ((wgid % nig) % gsz); u.pn = (wgid % nig) / gsz; u.kt0 = 0; u.nkt = nkt; return true;
        }
        const long j = L - nwg; if (j >= (long)nN * nsp) return false;
        u.pm = 64; u.pn = (int)(j % nN); u.kt0 = 4 * (int)(j / nN); u.nkt = 4; return true;
    }
    __device__ __forceinline__ void a_ready(const Unit&) const {}
    __device__ __forceinline__ void done(const Unit&) const {}
};
template <class Epi, class Sched, bool STAMP = false>
__device__ __forceinline__ void gemm_phase(PG8_LAS unsigned char* lds, const Gemm g, const Sched& S, const Epi& E, unsigned long long* stamps) {
    const int tid = threadIdx.x, wid = __builtin_amdgcn_readfirstlane(tid >> 6), lane = tid & 63, wr = wid >> 2, wc = wid & 3, fr = lane & 15, fq = lane >> 4;
    const int K = g.K;
    int ts_lo = 0, ts_hi = 0, nts = 0; const unsigned long long rt_entry = STAMP ? (unsigned long long)wall_clock64() : 0ull;
#define PG8_STAMP() do { if (STAMP && wid == 0 && nts < 64) { const unsigned long long _c = (unsigned long long)clock64(); \
        ts_lo = (lane == nts) ? (int)(unsigned)_c : ts_lo; ts_hi = (lane == nts) ? (int)(unsigned)(_c >> 32) : ts_hi; ++nts; } } while (0)
    PG8_STAMP();
    unsigned voffA[2], voffB[2];
#pragma unroll
    for (int i = 0; i < 2; ++i) { int R, C; stage_rc(tid * 16 + i * 8192, R, C); const int Rb = Epi::PERM ? ((R & ~31) + perm32(R & 31)) : R;
        voffA[i] = (unsigned)(R * K + C) * 2u; voffB[i] = (unsigned)(Rb * K + C) * 2u; }
    const size_t kstep = (size_t)(BK * 2);
    const size_t hstep = (size_t)HALF * K * 2;
    const size_t tstep = 2 * hstep;
    const unsigned ldsw = (unsigned)wid * 1024u;
    const int aoff = lds_byte(wr * 64 + fr, fq * 8), boff = lds_byte(wc * 32 + fr, fq * 8);
#define PG8_SA(b, h) (((b) * 2 + (h)) * HTB)
#define PG8_SB(b, h) ((4 + (b) * 2 + (h)) * HTB)
#define PG8_STAGE(bufoff, gbase, voff) do { _Pragma("unroll") for (int _i = 0; _i < 2; ++_i) \
        __builtin_amdgcn_global_load_lds((const unsigned*)((const char*)(gbase) + (voff)[_i]), (PG8_LAS unsigned*)(lds + (bufoff) + ldsw + _i * 8192), 16, 0, 0); } while (0)
#define PG8_LDA(dst, b, h) do { _Pragma("unroll") for (int m = 0; m < 4; ++m) _Pragma("unroll") for (int k = 0; k < 2; ++k) dst[m][k] = *(const PG8_LAS bf16x8*)(lds + PG8_SA(b, h) + aoff + m * 2048 + k * 1024); } while (0)
#define PG8_LDB(dst, b, h) do { _Pragma("unroll") for (int n = 0; n < 2; ++n) _Pragma("unroll") for (int k = 0; k < 2; ++k) dst[n][k] = *(const PG8_LAS bf16x8*)(lds + PG8_SB(b, h) + boff + n * 2048 + k * 1024); } while (0)
#define PG8_MMA(ai, bj, At, Bt) do { __builtin_amdgcn_s_setprio(1); _Pragma("unroll") for (int m = 0; m < 4; ++m) _Pragma("unroll") for (int n = 0; n < 2; ++n) _Pragma("unroll") for (int k = 0; k < 2; ++k) \
        acc[ai][bj][m][n] = __builtin_amdgcn_mfma_f32_16x16x32_bf16(Bt[n][k], At[m][k], acc[ai][bj][m][n], 0, 0, 0); __builtin_amdgcn_s_setprio(0); } while (0)
#define PG8_WAIT_V(n) asm volatile("s_waitcnt vmcnt(" #n ")" ::: "memory")
#define PG8_WAIT_L(n) asm volatile("s_waitcnt lgkmcnt(" #n ")" ::: "memory")
#define PG8_BAR __builtin_amdgcn_s_barrier()
#define PG8_SCHED __builtin_amdgcn_sched_barrier(0)
    Unit cur, nxt; int ui = 0;
    if (!S.next(0, cur)) return;
    f32x4 acc[2][2][4][2];
#pragma unroll
    for (int a = 0; a < 2; ++a)
#pragma unroll
        for (int b = 0; b < 2; ++b)
#pragma unroll
            for (int m = 0; m < 4; ++m)
#pragma unroll
                for (int n = 0; n < 2; ++n) acc[a][b][m][n] = (f32x4){0.f, 0.f, 0.f, 0.f};
    bf16x8 At[4][2], B0[2][2], B1[2][2];
    const char* cA = (const char*)g.A + (size_t)cur.pm * tstep + (size_t)cur.kt0 * kstep; const char* cB = (const char*)g.Bt + (size_t)cur.pn * tstep + (size_t)cur.kt0 * kstep;
    S.a_ready(cur);
    PG8_STAGE(PG8_SB(0, 0), cB, voffB); PG8_STAGE(PG8_SA(0, 0), cA, voffA); PG8_STAGE(PG8_SB(0, 1), cB + hstep, voffB); PG8_STAGE(PG8_SA(0, 1), cA + hstep, voffA);
    if (wr == 1) PG8_BAR;
    PG8_WAIT_V(4); PG8_BAR;
    PG8_STAGE(PG8_SB(1, 0), cB + kstep, voffB); PG8_STAGE(PG8_SA(1, 0), cA + kstep, voffA); PG8_STAGE(PG8_SB(1, 1), cB + hstep + kstep, voffB);
    PG8_WAIT_V(6); PG8_BAR;
    PG8_STAMP();
    for (;;) {
        const bool has_next = S.next(ui + 1, nxt);
        const char* nA = has_next ? (const char*)g.A + (size_t)nxt.pm * tstep + (size_t)nxt.kt0 * kstep : cA; const char* nB = has_next ? (const char*)g.Bt + (size_t)nxt.pn * tstep + (size_t)nxt.kt0 * kstep : cB;
        const int nt = cur.nkt;
        for (int t = 0; t < nt; t += 2) {
            const bool last = (t == nt - 2);
            const char* a1 = cA + (size_t)(t + 1) * kstep;
            const char* a2 = last ? nA : cA + (size_t)(t + 2) * kstep; const char* b2 = last ? nB : cB + (size_t)(t + 2) * kstep;
            const char* a3 = a2 + kstep; const char* b3 = b2 + kstep;
            if (last && has_next) S.a_ready(nxt);
            PG8_LDB(B0, 0, 0); PG8_SCHED; PG8_LDA(At, 0, 0); PG8_STAGE(PG8_SA(1, 1), a1 + hstep, voffA);
            PG8_WAIT_L(8); PG8_BAR; PG8_WAIT_L(0); PG8_MMA(0, 0, At, B0); PG8_BAR; PG8_SCHED;
            PG8_LDB(B1, 0, 1); PG8_STAGE(PG8_SB(0, 0), b2, voffB);
            PG8_BAR; PG8_WAIT_L(0); PG8_MMA(0, 1, At, B1); PG8_BAR;
            PG8_LDA(At, 0, 1); PG8_STAGE(PG8_SA(0, 0), a2, voffA);
            PG8_BAR; PG8_WAIT_L(0); PG8_MMA(1, 0, At, B0); PG8_BAR; PG8_SCHED;
            PG8_STAGE(PG8_SB(0, 1), b2 + hstep, voffB);
            PG8_WAIT_V(6); PG8_BAR; PG8_MMA(1, 1, At, B1); PG8_BAR;
            PG8_LDB(B0, 1, 0); PG8_SCHED; PG8_LDA(At, 1, 0); PG8_STAGE(PG8_SA(0, 1), a2 + hstep, voffA);
            PG8_WAIT_L(8); PG8_BAR; PG8_WAIT_L(0); PG8_MMA(0, 0, At, B0); PG8_BAR; PG8_SCHED;
            PG8_LDB(B1, 1, 1); PG8_STAGE(PG8_SB(1, 0), b3, voffB);
            PG8_BAR; PG8_WAIT_L(0); PG8_MMA(0, 1, At, B1); PG8_BAR;
            PG8_LDA(At, 1, 1); PG8_STAGE(PG8_SA(1, 0), a3, voffA);
            PG8_BAR; PG8_WAIT_L(0); PG8_MMA(1, 0, At, B0); PG8_BAR; PG8_SCHED;
            PG8_STAGE(PG8_SB(1, 1), b3 + hstep, voffB);
            PG8_WAIT_V(6); PG8_BAR; PG8_MMA(1, 1, At, B1); PG8_BAR;
        }
        PG8_STAMP();
        if constexpr (!Epi::AFTER_DRAIN) { E(acc, cur, wr, wc, fr, fq); S.done(cur); }
        PG8_STAMP();
        if (!has_next) break;
#pragma unroll
        for (int a = 0; a < 2; ++a)
#pragma unroll
            for (int b = 0; b < 2; ++b)
#pragma unroll
                for (int m = 0; m < 4; ++m)
#pragma unroll
                    for (int n = 0; n < 2; ++n) acc[a][b][m][n] = (f32x4){0.f, 0.f, 0.f, 0.f};
        cur = nxt; cA = nA; cB = nB; ++ui;
    }
    PG8_WAIT_V(0);
    if (wr == 0) PG8_BAR;
    PG8_BAR;
    if constexpr (Epi::AFTER_DRAIN) { E.fused(acc, cur, wr, wc, fr, fq, lds, wid, lane); S.done(cur); }
    PG8_STAMP();
    if (STAMP && wid == 0) { stamps[lane] = lane < nts ? (((unsigned long long)(unsigned)ts_hi << 32) | (unsigned)ts_lo) : 0ull;
        if (lane == 62) stamps[62] = rt_entry; if (lane == 63) stamps[63] = (unsigned long long)wall_clock64(); }
#undef PG8_STAMP
#undef PG8_SA
#undef PG8_SB
#undef PG8_STAGE
#undef PG8_LDA
#undef PG8_LDB
#undef PG8_MMA
#undef PG8_WAIT_V
#undef PG8_WAIT_L
#undef PG8_BAR
#undef PG8_SCHED
}
}

using pg8::bf16_t; using pg8::bf16x8; using pg8::f32x4; using pg8::Unit;
#define LAS __attribute__((address_space(3)))
#define DI __device__ __forceinline__
typedef float f32x16 __attribute__((ext_vector_type(16)));
typedef float f32x2 __attribute__((ext_vector_type(2)));
typedef unsigned u32x4 __attribute__((ext_vector_type(4)));
typedef unsigned u32x2 __attribute__((ext_vector_type(2)));

constexpr int D = 2048, TP = 16384, NS = 128, MR = TP + NS, MP = 16640;
constexpr int NZ = 12800, DFF = 5632, NAB = 2 * DFF;
constexpr int ZQ = 0, ZK = 1536, ZV = 3072, ZQH = 4608, ZFH = 5632, ZIH = 6656, ZGH = 7680, ZGA = 8704, ZGB = 10752;
constexpr int NMODROW = 33, NMOD = 6 * D;
constexpr float EPS = 1e-6f;
constexpr float ATT_SCALE = 0.08838834764831845f;
constexpr size_t OFF_Y = 0;
constexpr size_t OFF_KVP0 = (size_t)MR * D;
constexpr size_t OFF_KVP1 = OFF_KVP0 + 128 * 1024;
constexpr size_t OFF_KVP2 = OFF_KVP1 + 512 * 1024;
constexpr size_t OFF_HGP = OFF_KVP2 + 2048 * 1024;
constexpr size_t OFF_CVP = OFF_HGP + 8 * 128 * 128;
constexpr size_t OFF_KVS0 = OFF_CVP + 2 * DFF;
constexpr size_t OFF_KVS1 = OFF_KVS0 + (size_t)32 * 128 * 1024;
constexpr size_t OFF_KVS2 = OFF_KVS1 + (size_t)32 * 512 * 1024;
constexpr size_t OFF_HGS = OFF_KVS2 + (size_t)32 * 2048 * 1024;
constexpr size_t OFF_CVS = OFF_HGS + (size_t)32 * 8 * 128 * 128;
constexpr size_t OUT_TOTAL = OFF_CVS + (size_t)32 * 2 * DFF;
static_assert(OUT_TOTAL == 129346560, "output size");
constexpr size_t WS_WIN = 1u << 20;
constexpr size_t WS_WPA = WS_WIN + (size_t)NZ * D * 2;
constexpr size_t WS_WPB = WS_WPA + (size_t)2048 * 512 * 2;
constexpr size_t WS_WO = WS_WPB + (size_t)2048 * 1024 * 2;
constexpr size_t WS_WAB = WS_WO + (size_t)2048 * 2048 * 2;
constexpr size_t WS_WDN = WS_WAB + (size_t)NAB * D * 2;
constexpr size_t WS_MOD = WS_WDN + (size_t)D * DFF * 2;
constexpr size_t WS_ROPE = WS_MOD + (size_t)NMODROW * NMOD * 4;
constexpr size_t WS_Z = WS_ROPE + (size_t)MP * 32 * 4;
constexpr size_t WS_AB = WS_Z;
constexpr size_t WS_H = WS_Z + (size_t)MP * NZ * 2;
constexpr size_t WS_OG = WS_H + (size_t)MP * D * 2;
constexpr size_t WS_LSE = WS_OG + (size_t)3 * MP * 512 * 2;
constexpr size_t WS_OATT = WS_LSE + (size_t)3 * MP * 4 * 4;
constexpr size_t WS_OHG = WS_OATT + (size_t)MP * 512 * 2;
constexpr size_t WS_YMIX = WS_OHG + (size_t)MP * 1024 * 2;
constexpr size_t WS_BLK_END = WS_YMIX + (size_t)MP * D * 2;
constexpr size_t WS_G = WS_OG;
static_assert(WS_G + (size_t)MP * DFF * 2 <= WS_BLK_END + (32u << 20), "g overlay");
static_assert((size_t)MP * NAB * 2 <= (size_t)MP * NZ * 2, "ab overlay");
constexpr size_t WS_HS = WS_BLK_END;
constexpr size_t WS_HD = WS_HS + (size_t)256 * 8 * 128 * 128 * 4;
constexpr size_t WS_TMP = WS_HS;
constexpr size_t WS_ACC_WO = WS_Z;
constexpr size_t WS_ACC_DN = WS_Z;
constexpr size_t WS_ACC_UP = WS_TMP + (64u << 20);
constexpr int NSP_WO = 8, NSP_DN = 22, NSP_UP = 8, NSP_PA = 2, NSP_PB = 4;
constexpr size_t WS_ACC_PA = WS_H, WS_ACC_PB = WS_H + (size_t)NSP_PA * NS * D * 4;
static_assert((size_t)NSP_UP * NS * NAB * 4 + (64u << 20) <= (size_t)MP * D * 4, "up partials");
constexpr size_t WS_END = WS_TMP + (size_t)MP * D * 4 + (1u << 20);
static_assert(WS_HD + (size_t)256 * 8 * 128 * 4 <= WS_END, "hd");
static_assert(WS_WIN % 256 == 0 && WS_MOD % 256 == 0 && WS_ROPE % 256 == 0 && WS_Z % 256 == 0 && WS_H % 256 == 0 && WS_OG % 256 == 0 && WS_LSE % 256 == 0 && WS_OATT % 256 == 0 && WS_OHG % 256 == 0 && WS_YMIX % 256 == 0 && WS_HS % 256 == 0 && WS_HD % 256 == 0, "align");
constexpr int LDS_BYTES = 131072 + 4096 + 256;
constexpr int NPH = 18;

struct Params { const float* in[25]; float* out; unsigned char* ws; int ph_lo, ph_hi; };

DI float bf2f(unsigned b) { return __uint_as_float(b << 16); }
DI float bflo(unsigned w) { return __uint_as_float(w << 16); }
DI float bfhi(unsigned w) { return __uint_as_float(w & 0xffff0000u); }
DI unsigned pk2(float lo, float hi) { unsigned r; asm("v_cvt_pk_bf16_f32 %0, %1, %2" : "=v"(r) : "v"(lo), "v"(hi)); return r; }
DI float sigm(float x) { return 1.f / (1.f + __expf(-x)); }
DI float silu(float x) { return x / (1.f + __expf(-x)); }
DI float wave_sum(float v) {
#pragma unroll
    for (int o = 32; o >= 1; o >>= 1) v += __shfl_xor(v, o);
    return v;
}
DI float wave_max(float v) {
#pragma unroll
    for (int o = 32; o >= 1; o >>= 1) v = fmaxf(v, __shfl_xor(v, o));
    return v;
}
DI void lds_fence() { asm volatile("s_waitcnt lgkmcnt(0)" ::: "memory"); __builtin_amdgcn_wave_barrier(); }
DI bf16x8 gat8(const LAS bf16_t* p, int stride) {
    bf16x8 r;
#pragma unroll
    for (int j = 0; j < 8; ++j) r[j] = (short)p[j * stride];
    return r;
}
DI bf16x8 ld8(const LAS bf16_t* p) { return *(const LAS bf16x8*)p; }
DI f32x4 mfma16(bf16x8 a, bf16x8 b, f32x4 c) { return __builtin_amdgcn_mfma_f32_16x16x32_bf16(a, b, c, 0, 0, 0); }
DI f32x16 mfma32(bf16x8 a, bf16x8 b, f32x16 c) { return __builtin_amdgcn_mfma_f32_32x32x16_bf16(a, b, c, 0, 0, 0); }
DI void unpack8(u32x4 w, float (&f)[8]) { f[0] = bflo(w.x); f[1] = bfhi(w.x); f[2] = bflo(w.y); f[3] = bfhi(w.y); f[4] = bflo(w.z); f[5] = bfhi(w.z); f[6] = bflo(w.w); f[7] = bfhi(w.w); }
DI void atom_add(float* p, float v) { (void)__hip_atomic_fetch_add(p, v, __ATOMIC_RELAXED, __HIP_MEMORY_SCOPE_AGENT); }
DI void ld8f(const float* s, float (&f)[8]) { const f32x4 a = *(const f32x4*)s, b = *(const f32x4*)(s + 4); f[0] = a[0]; f[1] = a[1]; f[2] = a[2]; f[3] = a[3]; f[4] = b[0]; f[5] = b[1]; f[6] = b[2]; f[7] = b[3]; }
DI int crow_of(int r) { return r < TP ? 0 : 1 + ((r - TP) >> 2); }

struct EpiZ {
    static constexpr bool PERM = true, AFTER_DRAIN = false;
    bf16_t* Z; const float* rope; float* out; const float* c0; const float* c1; const float* c2;
    static constexpr int CPY_R0 = 32 * 124, CPY_R1 = 32 * 508, CPY_R2 = 32 * 2044, CPY_ROWS = CPY_R0 + CPY_R1 + CPY_R2, CPY_PER = 28;
    DI void cpy_row(int r, const float*& src, float*& dst) const {
        if (r < CPY_R0) { const int b = r / 124, rr = r - b * 124; src = c0 + ((size_t)(b * 128 + rr + 4)) * 1024; dst = out + OFF_KVS0 + ((size_t)(b * 128 + rr)) * 1024; }
        else if (r < CPY_R0 + CPY_R1) { r -= CPY_R0; const int b = r / 508, rr = r - b * 508; src = c1 + ((size_t)(b * 512 + rr + 4)) * 1024; dst = out + OFF_KVS1 + ((size_t)(b * 512 + rr)) * 1024; }
        else { r -= CPY_R0 + CPY_R1; const int b = r / 2044, rr = r - b * 2044; src = c2 + ((size_t)(b * 2048 + rr + 4)) * 1024; dst = out + OFF_KVS2 + ((size_t)(b * 2048 + rr)) * 1024; }
    }
    DI void operator()(const f32x4 (&acc)[2][2][4][2], const Unit& u, int wr, int wc, int fr, int fq) const {
        {
            int l4 = (wc * 64 + fq * 16 + fr) * 4; asm volatile("" : "+v"(l4));
            const int r0 = (u.pm * 50 + u.pn) * CPY_PER;
#pragma unroll
            for (int h2 = 0; h2 < 2; ++h2) {
                f32x4 v[7];
#pragma unroll
                for (int q = 0; q < 7; ++q) { int r = r0 + (h2 * 7 + q) * 2 + wr; r = r < CPY_ROWS ? r : r - CPY_ROWS; const float* sp; float* dp; cpy_row(r, sp, dp); v[q] = __builtin_nontemporal_load((const f32x4*)(sp + l4)); }
#pragma unroll
                for (int q = 0; q < 7; ++q) { int r = r0 + (h2 * 7 + q) * 2 + wr; r = r < CPY_ROWS ? r : r - CPY_ROWS; const float* sp; float* dp; cpy_row(r, sp, dp); __builtin_nontemporal_store(v[q], (f32x4*)(dp + l4)); }
            }
        }
        const int kind = u.pn < 6 ? 0 : (u.pn < 12 ? 1 : (u.pn < 18 ? 2 : 3));
        const bool do_rope = (kind <= 1) && (wc == 0);
        const int pnn = (kind == 1) ? u.pn - 6 : u.pn - 12;
        const int g = pnn >> 1, W = 128 << (2 * g);
        const size_t offp = g == 0 ? OFF_KVP0 : (g == 1 ? OFF_KVP1 : OFF_KVP2), offs = g == 0 ? OFF_KVS0 : (g == 1 ? OFF_KVS1 : OFF_KVS2);
        const float sg = (fq < 2) ? -1.f : 1.f;
#pragma unroll
        for (int ai = 0; ai < 2; ++ai)
#pragma unroll
            for (int m = 0; m < 4; ++m) {
                const int r = u.pm * 256 + ai * 128 + wr * 64 + m * 16 + fr;
                f32x4 cs0 = {0.f, 0.f, 0.f, 0.f}, cs1 = cs0, sn0 = cs0, sn1 = cs0;
                if (do_rope) { const float* rp = rope + (size_t)r * 32 + 8 * (fq & 1); cs0 = *(const f32x4*)rp; cs1 = *(const f32x4*)(rp + 4); sn0 = *(const f32x4*)(rp + 16); sn1 = *(const f32x4*)(rp + 20); }
#pragma unroll
                for (int bj = 0; bj < 2; ++bj) {
                    f32x4 v0 = acc[ai][bj][m][0], v1 = acc[ai][bj][m][1];
                    if (do_rope) {
                        f32x4 p0, p1;
#pragma unroll
                        for (int j = 0; j < 4; ++j) { p0[j] = __shfl_xor(v0[j], 32); p1[j] = __shfl_xor(v1[j], 32); }
                        v0 = v0 * cs0 + sg * (p0 * sn0); v1 = v1 * cs1 + sg * (p1 * sn1);
                    }
                    const int c = u.pn * 256 + bj * 128 + wc * 32 + 8 * fq;
                    u32x4 w; w.x = pk2(v0[0], v0[1]); w.y = pk2(v0[2], v0[3]); w.z = pk2(v1[0], v1[1]); w.w = pk2(v1[2], v1[3]);
                    *(u32x4*)(Z + (size_t)r * NZ + c) = w;
                    if (kind == 1 || kind == 2) {
                        const int hh = 2 * (pnn & 1) + bj, dd = wc * 32 + 8 * fq, kv = kind - 1;
                        float* dst = nullptr;
                        if (r < TP) { if (r >= TP - W) dst = out + offp + ((size_t)(r - (TP - W)) * 2 + kv) * 512 + hh * 128 + dd; }
                        else if (r < MR) { const int b = (r - TP) >> 2, t = (r - TP) & 3; dst = out + offs + ((size_t)(b * W + W - 4 + t) * 2 + kv) * 512 + hh * 128 + dd; }
                        if (dst) { *(f32x4*)dst = v0; *(f32x4*)(dst + 4) = v1; }
                    }
                }
            }
    }
};
struct EpiMix1 {
    static constexpr bool PERM = false, AFTER_DRAIN = false;
    const bf16_t* Z; float* TMP; float* accs;
    DI void operator()(const f32x4 (&acc)[2][2][4][2], const Unit& u, int wr, int wc, int fr, int fq) const {
        if (u.pm == 64) {
#pragma unroll
            for (int m = 0; m < 4; ++m)
#pragma unroll
                for (int bj = 0; bj < 2; ++bj)
#pragma unroll
                    for (int n = 0; n < 2; ++n) *(f32x4*)(accs + ((size_t)(u.kt0 >> 2) * NS + (wr * 64 + m * 16 + fr)) * D + u.pn * 256 + bj * 128 + wc * 32 + 16 * n + 4 * fq) = acc[0][bj][m][n];
            return;
        }
#pragma unroll
        for (int ai = 0; ai < 2; ++ai)
#pragma unroll
            for (int m = 0; m < 4; ++m) {
                const int r = u.pm * 256 + ai * 128 + wr * 64 + m * 16 + fr;
#pragma unroll
                for (int bj = 0; bj < 2; ++bj)
#pragma unroll
                    for (int n = 0; n < 2; ++n) {
                        const int c = u.pn * 256 + bj * 128 + wc * 32 + 16 * n + 4 * fq;
                        const u32x2 gw = *(const u32x2*)(Z + (size_t)r * NZ + ZGA + c);
                        f32x4 v = acc[ai][bj][m][n];
                        v[0] *= sigm(bflo(gw.x)); v[1] *= sigm(bfhi(gw.x)); v[2] *= sigm(bflo(gw.y)); v[3] *= sigm(bfhi(gw.y));
                        *(f32x4*)(TMP + (size_t)r * D + c) = v;
                    }
            }
    }
};
struct EpiMix2 {
    static constexpr bool PERM = false, AFTER_DRAIN = false;
    const bf16_t* Z; const float* TMP; bf16_t* Y; float* accs;
    DI void operator()(const f32x4 (&acc)[2][2][4][2], const Unit& u, int wr, int wc, int fr, int fq) const {
        if (u.pm == 64) {
#pragma unroll
            for (int m = 0; m < 4; ++m)
#pragma unroll
                for (int bj = 0; bj < 2; ++bj)
#pragma unroll
                    for (int n = 0; n < 2; ++n) *(f32x4*)(accs + ((size_t)(u.kt0 >> 2) * NS + (wr * 64 + m * 16 + fr)) * D + u.pn * 256 + bj * 128 + wc * 32 + 16 * n + 4 * fq) = acc[0][bj][m][n];
            return;
        }
#pragma unroll
        for (int ai = 0; ai < 2; ++ai)
#pragma unroll
            for (int m = 0; m < 4; ++m) {
                const int r = u.pm * 256 + ai * 128 + wr * 64 + m * 16 + fr;
#pragma unroll
                for (int bj = 0; bj < 2; ++bj)
#pragma unroll
                    for (int n = 0; n < 2; ++n) {
                        const int c = u.pn * 256 + bj * 128 + wc * 32 + 16 * n + 4 * fq;
                        const u32x2 gw = *(const u32x2*)(Z + (size_t)r * NZ + ZGB + c);
                        const f32x4 t = *(const f32x4*)(TMP + (size_t)r * D + c);
                        f32x4 v = acc[ai][bj][m][n];
                        v[0] = t[0] + v[0] * sigm(bflo(gw.x)); v[1] = t[1] + v[1] * sigm(bfhi(gw.x)); v[2] = t[2] + v[2] * sigm(bflo(gw.y)); v[3] = t[3] + v[3] * sigm(bfhi(gw.y));
                        u32x2 w; w.x = pk2(v[0], v[1]); w.y = pk2(v[2], v[3]);
                        *(u32x2*)(Y + (size_t)r * D + c) = w;
                    }
            }
    }
};
struct EpiWO {
    static constexpr bool PERM = false, AFTER_DRAIN = false;
    const float* xp; const float* xs; const float* mod; float* out; float* accs;
    DI void operator()(const f32x4 (&acc)[2][2][4][2], const Unit& u, int wr, int wc, int fr, int fq) const {
        if (u.pm == 64) {
#pragma unroll
            for (int m = 0; m < 4; ++m)
#pragma unroll
                for (int bj = 0; bj < 2; ++bj)
#pragma unroll
                    for (int n = 0; n < 2; ++n) {
                        float* d = accs + ((size_t)(u.kt0 >> 2) * NS + (wr * 64 + m * 16 + fr)) * D + u.pn * 256 + bj * 128 + wc * 32 + 16 * n + 4 * fq;
                        *(f32x4*)d = acc[0][bj][m][n];
                    }
            return;
        }
#pragma unroll
        for (int ai = 0; ai < 2; ++ai)
#pragma unroll
            for (int m = 0; m < 4; ++m) {
                const int r = u.pm * 256 + ai * 128 + wr * 64 + m * 16 + fr;
                if (r < MR) {
                    const float* xr = r < TP ? xp + (size_t)r * D : xs + (size_t)(r - TP) * D;
                    const float* g1 = mod + (size_t)crow_of(r) * NMOD + 2 * D;
#pragma unroll
                    for (int bj = 0; bj < 2; ++bj)
#pragma unroll
                        for (int n = 0; n < 2; ++n) {
                            const int c = u.pn * 256 + bj * 128 + wc * 32 + 16 * n + 4 * fq;
                            const f32x4 xv = *(const f32x4*)(xr + c), gv = *(const f32x4*)(g1 + c);
                            *(f32x4*)(out + (size_t)r * D + c) = xv + gv * acc[ai][bj][m][n];
                        }
                }
            }
    }
};
struct EpiDown {
    static constexpr bool PERM = false, AFTER_DRAIN = false;
    const float* mod; float* out; float* accs;
    DI void operator()(const f32x4 (&acc)[2][2][4][2], const Unit& u, int wr, int wc, int fr, int fq) const {
        if (u.pm == 64) {
#pragma unroll
            for (int m = 0; m < 4; ++m)
#pragma unroll
                for (int bj = 0; bj < 2; ++bj)
#pragma unroll
                    for (int n = 0; n < 2; ++n) {
                        float* d = accs + ((size_t)(u.kt0 >> 2) * NS + (wr * 64 + m * 16 + fr)) * D + u.pn * 256 + bj * 128 + wc * 32 + 16 * n + 4 * fq;
                        *(f32x4*)d = acc[0][bj][m][n];
                    }
            return;
        }
#pragma unroll
        for (int ai = 0; ai < 2; ++ai)
#pragma unroll
            for (int m = 0; m < 4; ++m) {
                const int r = u.pm * 256 + ai * 128 + wr * 64 + m * 16 + fr;
                if (r < MR) {
                    const float* g2 = mod + (size_t)crow_of(r) * NMOD + 5 * D;
#pragma unroll
                    for (int bj = 0; bj < 2; ++bj)
#pragma unroll
                        for (int n = 0; n < 2; ++n) {
                            const int c = u.pn * 256 + bj * 128 + wc * 32 + 16 * n + 4 * fq;
                            float* o = out + (size_t)r * D + c;
                            const f32x4 xv = *(const f32x4*)o, gv = *(const f32x4*)(g2 + c);
                            *(f32x4*)o = xv + gv * acc[ai][bj][m][n];
                        }
                }
            }
    }
};
struct EpiUp {
    static constexpr bool PERM = true, AFTER_DRAIN = false;
    bf16_t* AB; bf16_t* G; float* out; float* accs; const float* cw; const float* cb; LAS float* xch;
    DI void operator()(const f32x4 (&acc)[2][2][4][2], const Unit& u, int wr, int wc, int fr, int fq) const {
        int cl = 32 * wc + 8 * fq;
        if (u.pm == 64) {
#pragma unroll
            for (int m = 0; m < 4; ++m)
#pragma unroll
                for (int bj = 0; bj < 2; ++bj)
#pragma unroll
                    for (int n = 0; n < 2; ++n) {
                        float* d = accs + ((size_t)(u.kt0 >> 2) * NS + (wr * 64 + m * 16 + fr)) * NAB + bj * DFF + 128 * u.pn + cl + 4 * n;
                        *(f32x4*)d = acc[0][bj][m][n];
                    }
            return;
        }
        asm volatile("" : "+v"(cl), "+v"(fr), "+v"(fq));
        const int lane = fq * 16 + fr;
        if (fr >= 14) {
#pragma unroll
            for (int ai = 0; ai < 2; ++ai) { LAS float* d = xch + ((2 * ai + wr) * 2 + (fr - 14)) * 128 + cl; *(LAS f32x4*)d = acc[ai][0][3][0]; *(LAS f32x4*)(d + 4) = acc[ai][0][3][1]; }
        }
        asm volatile("s_waitcnt lgkmcnt(0)" ::: "memory"); __builtin_amdgcn_s_barrier(); __builtin_amdgcn_s_barrier(); asm volatile("" ::: "memory");
        const int src1 = (lane & 48) | ((fr + 15) & 15), src2 = (lane & 48) | ((fr + 14) & 15);
#pragma unroll
        for (int n = 0; n < 2; ++n) {
            const int c = 128 * u.pn + cl + 4 * n;
            const f32x4 w0 = *(const f32x4*)(cw + c), w1 = *(const f32x4*)(cw + DFF + c), w2 = *(const f32x4*)(cw + 2 * DFF + c), bb = *(const f32x4*)(cb + c);
#pragma unroll
            for (int ai = 0; ai < 2; ++ai) {
                const int q = 2 * ai + wr;
                f32x4 y1 = {0.f, 0.f, 0.f, 0.f}, z1 = y1;
                if (q > 0) { y1 = *(const LAS f32x4*)(xch + ((q - 1) * 2 + 1) * 128 + cl + 4 * n); z1 = *(const LAS f32x4*)(xch + ((q - 1) * 2 + (fr == 0 ? 0 : 1)) * 128 + cl + 4 * n); }
#pragma unroll
                for (int m = 0; m < 4; ++m) {
                    const f32x4 av = acc[ai][0][m][n], bv = acc[ai][1][m][n];
                    f32x4 o;
#pragma unroll
                    for (int j = 0; j < 4; ++j) {
                        const float y = __shfl(av[j], src1), z = __shfl(av[j], src2);
                        const float a1 = fr >= 1 ? y : y1[j], a0 = fr >= 2 ? z : z1[j];
                        y1[j] = y; z1[j] = z;
                        const float uu = bb[j] + w0[j] * a0 + w1[j] * a1 + w2[j] * av[j];
                        o[j] = silu(uu) * bv[j];
                    }
                    const int rl = 128 * ai + 64 * wr + 16 * m + fr, rg = 256 * u.pm + rl;
                    const bool edge0 = rl < 2, edge1 = rl >= 254;
                    if (!(edge0 && u.pm > 0)) { u32x2 w; w.x = pk2(o[0], o[1]); w.y = pk2(o[2], o[3]); *(u32x2*)(G + (size_t)rg * DFF + c) = w; }
                    if (edge0 || edge1) {
                        u32x2 w; w.x = pk2(av[0], av[1]); w.y = pk2(av[2], av[3]); *(u32x2*)(AB + (size_t)rg * NAB + c) = w;
                        if (edge0) { u32x2 x; x.x = pk2(bv[0], bv[1]); x.y = pk2(bv[2], bv[3]); *(u32x2*)(AB + (size_t)rg * NAB + DFF + c) = x; }
                        if (edge1 && u.pm == 63) *(f32x4*)(out + OFF_CVP + (size_t)(rl - 254) * DFF + c) = av;
                    }
                    asm volatile("" ::: "memory");
                }
            }
        }
    }
};

DI void ph_mod(const Params& p, LAS unsigned char* L, float* mod) {
    LAS float* sS = (LAS float*)L;
    LAS float* sRed = (LAS float*)L;
    const int tid = threadIdx.x, cgp = tid % 24, ksub = tid / 24;
    const float* cpr = p.in[7]; const float* csm = p.in[8]; const float* wada = p.in[9]; const float* bada = p.in[10];
    for (int nb = blockIdx.x; nb < 256; nb += gridDim.x) {
        const int n0 = nb * 48;
        float acc[33][2];
#pragma unroll
        for (int r = 0; r < 33; ++r) { acc[r][0] = 0.f; acc[r][1] = 0.f; }
        for (int kc = 0; kc < 4; ++kc) {
            f32x2 wv[25];
#pragma unroll
            for (int q = 0; q < 25; ++q) { const int kk = ksub + 21 * q; wv[q] = (ksub < 21 && kk < 512) ? *(const f32x2*)(wada + (size_t)(kc * 512 + kk) * NMOD + n0 + 2 * cgp) : (f32x2){0.f, 0.f}; }
            for (int idx = tid; idx < 33 * 512; idx += 512) {
                const int r = idx >> 9, kk = idx & 511;
                const float c = r == 0 ? cpr[kc * 512 + kk] : csm[(r - 1) * D + kc * 512 + kk];
                sS[kk * 36 + r] = silu(c);
            }
            __syncthreads();
#pragma unroll
            for (int q = 0; q < 25; ++q) {
                const int kk = ksub + 21 * q;
                if (ksub < 21 && kk < 512) {
                    const f32x2 w = wv[q];
                    const LAS f32x4* sp = (const LAS f32x4*)(sS + kk * 36);
#pragma unroll
                    for (int r4 = 0; r4 < 9; ++r4) {
                        const f32x4 sv = sp[r4];
#pragma unroll
                        for (int j = 0; j < 4; ++j) { if (4 * r4 + j < 33) { acc[4 * r4 + j][0] += sv[j] * w[0]; acc[4 * r4 + j][1] += sv[j] * w[1]; } }
                    }
                }
            }
            __syncthreads();
        }
#pragma unroll
        for (int r0 = 0; r0 < 33; r0 += 11) {
            if (ksub < 21) {
#pragma unroll
                for (int i = 0; i < 11; ++i) { sRed[ksub * 528 + i * 48 + 2 * cgp] = acc[r0 + i][0]; sRed[ksub * 528 + i * 48 + 2 * cgp + 1] = acc[r0 + i][1]; }
            }
            __syncthreads();
            for (int o = tid; o < 528; o += 512) {
                float sum = 0.f;
                for (int k2 = 0; k2 < 21; ++k2) sum += sRed[k2 * 528 + o];
                const int i = o / 48, c = o % 48;
                mod[(size_t)(r0 + i) * NMOD + n0 + c] = sum + bada[n0 + c];
            }
            __syncthreads();
        }
    }
}
DI void tr_load(const float* W, int N, int r, int lane, f32x4 (&v)[8]) {
    const int nblk = N / 32, kb = r / nblk, nb = r % nblk, k0 = 64 * kb, n0 = 32 * nb;
#pragma unroll
    for (int i = 0; i < 8; ++i) v[i] = *(const f32x4*)(W + (size_t)(k0 + 8 * i + (lane >> 3)) * N + n0 + 4 * (lane & 7));
}
DI void tr_finish(bf16_t* WT, int K, int N, int inter, int r, LAS float* scr, int lane, const f32x4 (&v)[8]) {
    const int nblk = N / 32, kb = r / nblk, nb = r % nblk, k0 = 64 * kb, n0 = 32 * nb;
#pragma unroll
    for (int i = 0; i < 8; ++i) { LAS float* dd = scr + (8 * i + (lane >> 3)) * 33 + 4 * (lane & 7); dd[0] = v[i][0]; dd[1] = v[i][1]; dd[2] = v[i][2]; dd[3] = v[i][3]; }
    lds_fence();
    const int c = lane & 7;
#pragma unroll
    for (int j = 0; j < 4; ++j) { const int n = (lane >> 3) + 8 * j; const LAS float* s = scr + (8 * c) * 33 + n;
        u32x4 o; o.x = pk2(s[0 * 33], s[1 * 33]); o.y = pk2(s[2 * 33], s[3 * 33]); o.z = pk2(s[4 * 33], s[5 * 33]); o.w = pk2(s[6 * 33], s[7 * 33]);
        const int na = n0 + n, drow = inter < 0 ? na : ((na >> 7) << 8) + inter * 128 + (na & 127);
        *(u32x4*)(WT + (size_t)drow * K + k0 + 8 * c) = o; }
    lds_fence();
}
constexpr int TR_I_IN = 32 * 400, TR_I_PA = 8 * 64, TR_I_PB = 16 * 64, TR_I_O = 32 * 64, TR_I_A = 32 * 176, TR_I_DN = 88 * 64;
constexpr int TR_NITEMS = TR_I_IN + TR_I_PA + TR_I_PB + TR_I_O + 2 * TR_I_A + TR_I_DN;
struct TrSrc { const float *w_in, *w_pa, *w_pb, *w_o, *w_a, *w_b, *w_dn; };
DI void tr_decode(const TrSrc& q, unsigned char* ws, int it, const float*& W, bf16_t*& WT, int& K, int& N, int& inter, int& r) {
    r = it; inter = -1;
    if (r < TR_I_IN) { W = q.w_in; WT = (bf16_t*)(ws + WS_WIN); K = D; N = NZ; return; } r -= TR_I_IN;
    if (r < TR_I_PA) { W = q.w_pa; WT = (bf16_t*)(ws + WS_WPA); K = 512; N = D; return; } r -= TR_I_PA;
    if (r < TR_I_PB) { W = q.w_pb; WT = (bf16_t*)(ws + WS_WPB); K = 1024; N = D; return; } r -= TR_I_PB;
    if (r < TR_I_O) { W = q.w_o; WT = (bf16_t*)(ws + WS_WO); K = D; N = D; return; } r -= TR_I_O;
    if (r < TR_I_A) { W = q.w_a; WT = (bf16_t*)(ws + WS_WAB); K = D; N = DFF; inter = 0; return; } r -= TR_I_A;
    if (r < TR_I_A) { W = q.w_b; WT = (bf16_t*)(ws + WS_WAB); K = D; N = DFF; inter = 1; return; } r -= TR_I_A;
    W = q.w_dn; WT = (bf16_t*)(ws + WS_WDN); K = DFF; N = D;
}
DI void ph_prologue(const Params& p, LAS unsigned char* L) {
    unsigned char* ws = p.ws;
    const int tid = threadIdx.x, lane = tid & 63, wave = tid >> 6;
    const int gw = blockIdx.x * 8 + wave, NGW = gridDim.x * 8;
    const size_t gtid = (size_t)blockIdx.x * 512 + tid, gstride = (size_t)gridDim.x * 512;
    ph_mod(p, L, (float*)(ws + WS_MOD));
    LAS float* scr = (LAS float*)(L + wave * 8448);
    const TrSrc tq{p.in[12], p.in[15], p.in[16], p.in[17], p.in[19], p.in[20], p.in[23]};
    for (int it = gw; it < TR_NITEMS; it += 2 * NGW) {
        const float* W0; bf16_t* T0; int K0, N0, i0, r0; tr_decode(tq, ws, it, W0, T0, K0, N0, i0, r0);
        const int it1 = it + NGW; const bool two = it1 < TR_NITEMS;
        const float* W1; bf16_t* T1; int K1, N1, i1, r1; tr_decode(tq, ws, two ? it1 : it, W1, T1, K1, N1, i1, r1);
        f32x4 v0[8], v1[8];
        tr_load(W0, N0, r0, lane, v0); tr_load(W1, N1, r1, lane, v1);
        tr_finish(T0, K0, N0, i0, r0, scr, lane, v0);
        if (two) tr_finish(T1, K1, N1, i1, r1, scr, lane, v1);
    }
    {
        float* rope = (float*)(ws + WS_ROPE);
        for (size_t idx = gtid; idx < (size_t)MR * 16; idx += gstride) {
            const int m = (int)(idx >> 4), i = (int)(idx & 15);
            const int pos = m < TP ? m : TP + ((m - TP) & 3);
            const float invf = (float)exp2(-(double)i * (18.931568569324174 / 16.0));
            const float ang = (float)pos * invf;
            const double x = (double)ang, n = rint(x * 0.15915494309189535);
            double rr = fma(-n, 6.283185307179586, x); rr = fma(-n, 2.4492935982947064e-16, rr);
            rope[(size_t)m * 32 + i] = cosf((float)rr); rope[(size_t)m * 32 + 16 + i] = sinf((float)rr);
        }
    }
}
DI const float* hn_src(const Params& p, const float* xbase, bool from_out, int m) {
    const bool fix = from_out && m >= TP;
    return (from_out && !fix) ? xbase + (size_t)m * D : (m < TP ? p.in[0] + (size_t)m * D : p.in[1] + (size_t)(m - TP) * D);
}
DI void ph_hnorm(const Params& p, float* xbase, bool from_out, const float* nw, int sh_idx, bf16_t* H) {
    const int lane = threadIdx.x & 63, wave = threadIdx.x >> 6, stride = gridDim.x * 8;
    const float* mod = (const float*)(p.ws + WS_MOD);
    int m = blockIdx.x * 8 + wave;
    f32x4 v[8];
    if (m < MR) { const float* xr = hn_src(p, xbase, from_out, m);
#pragma unroll
        for (int j = 0; j < 8; ++j) v[j] = *(const f32x4*)(xr + 4 * lane + 256 * j); }
    while (m < MR) {
        const int mn = m + stride; f32x4 vn[8];
        if (mn < MR) { const float* xr = hn_src(p, xbase, from_out, mn);
#pragma unroll
            for (int j = 0; j < 8; ++j) vn[j] = *(const f32x4*)(xr + 4 * lane + 256 * j); }
        const bool fix = from_out && m >= TP;
        const float* md = mod + (size_t)crow_of(m) * NMOD + sh_idx * D;
        float ss = 0.f;
#pragma unroll
        for (int j = 0; j < 8; ++j) { const int c = 4 * lane + 256 * j;
            if (fix) { f32x4 a = {0.f, 0.f, 0.f, 0.f}; for (int q = 0; q < NSP_WO; ++q) a = a + *(const f32x4*)((const float*)(p.ws + WS_ACC_WO) + ((size_t)q * NS + (m - TP)) * D + c); const f32x4 g = *(const f32x4*)(mod + (size_t)crow_of(m) * NMOD + 2 * D + c); v[j] = v[j] + g * a; *(f32x4*)(xbase + (size_t)m * D + c) = v[j]; }
            ss += v[j][0] * v[j][0] + v[j][1] * v[j][1] + v[j][2] * v[j][2] + v[j][3] * v[j][3]; }
        const float rstd = rsqrtf(wave_sum(ss) * (1.f / D) + EPS);
#pragma unroll
        for (int j = 0; j < 8; ++j) {
            const int c = 4 * lane + 256 * j;
            const f32x4 w = *(const f32x4*)(nw + c), shv = *(const f32x4*)(md + c), scv = *(const f32x4*)(md + D + c);
            const f32x4 o = (v[j] * rstd) * w * (1.f + scv) + shv;
            u32x2 q; q.x = pk2(o[0], o[1]); q.y = pk2(o[2], o[3]);
            *(u32x2*)(H + (size_t)m * D + c) = q;
        }
#pragma unroll
        for (int j = 0; j < 8; ++j) v[j] = vn[j];
        m = mn;
    }
}
DI void ph_final_norm(const Params& p) {
    const int lane = threadIdx.x & 63, wave = threadIdx.x >> 6, stride = gridDim.x * 8;
    const float* nw = p.in[24];
    int m = blockIdx.x * 8 + wave;
    f32x4 v[8];
    if (m < MR) {
#pragma unroll
        for (int j = 0; j < 8; ++j) v[j] = *(const f32x4*)(p.out + (size_t)m * D + 4 * lane + 256 * j); }
    while (m < MR) {
        const int mn = m + stride; f32x4 vn[8];
        if (mn < MR) {
#pragma unroll
            for (int j = 0; j < 8; ++j) vn[j] = *(const f32x4*)(p.out + (size_t)mn * D + 4 * lane + 256 * j); }
        float* xr = p.out + (size_t)m * D;
        float ss = 0.f;
#pragma unroll
        for (int j = 0; j < 8; ++j) { const int c = 4 * lane + 256 * j;
            if (m >= TP) { f32x4 a = {0.f, 0.f, 0.f, 0.f}; for (int q = 0; q < NSP_DN; ++q) a = a + *(const f32x4*)((const float*)(p.ws + WS_ACC_DN) + ((size_t)q * NS + (m - TP)) * D + c); const f32x4 g = *(const f32x4*)((const float*)(p.ws + WS_MOD) + (size_t)crow_of(m) * NMOD + 5 * D + c); v[j] = v[j] + g * a; }
            ss += v[j][0] * v[j][0] + v[j][1] * v[j][1] + v[j][2] * v[j][2] + v[j][3] * v[j][3]; }
        const float rstd = rsqrtf(wave_sum(ss) * (1.f / D) + EPS);
#pragma unroll
        for (int j = 0; j < 8; ++j) { const int c = 4 * lane + 256 * j; const f32x4 w = *(const f32x4*)(nw + c); *(f32x4*)(xr + c) = (v[j] * rstd) * w; }
#pragma unroll
        for (int j = 0; j < 8; ++j) v[j] = vn[j];
        m = mn;
    }
}

DI void attn_prompt_item(const bf16_t* Z, bf16_t* OG, float* LSE, LAS bf16_t* Vl, int item, int lane) {
    const int g = item >> 11, rem = item & 2047, hh = rem >> 9, bidx = rem & 511;
    const int dsh = 2 * g, nsh = 9 - dsh;
    const int res = bidx >> nsh, blk = bidx & ((1 << nsh) - 1);
    const int s0 = blk * 32, head = g * 4 + hh;
    const int qi = lane & 31, h = lane >> 5;
    const int tq = res + ((s0 + qi) << dsh);
    bf16x8 Qf[8];
    { const bf16_t* qp = Z + (size_t)tq * NZ + ZQ + head * 128 + 8 * h;
#pragma unroll
      for (int ks = 0; ks < 8; ++ks) Qf[ks] = *(const bf16x8*)(qp + 16 * ks); }
    float mrun = -INFINITY, lrun = 0.f;
    f32x16 O[4];
#pragma unroll
    for (int dt = 0; dt < 4; ++dt)
#pragma unroll
        for (int i = 0; i < 16; ++i) O[dt][i] = 0.f;
    const int sq = s0 + qi;
    const int vrow = lane >> 4, vch = lane & 15;
    bf16x8 Kc[8]; u32x4 Vr[8];
#define ATT_LOAD_KV(kt_) do { const int kb_ = s0 - 128 + 32 * (kt_); int skl_ = kb_ + qi; skl_ = skl_ < 0 ? 0 : skl_; \
        const bf16_t* kp_ = Z + (size_t)(res + (skl_ << dsh)) * NZ + ZK + head * 128 + 8 * h; \
        _Pragma("unroll") for (int ks = 0; ks < 8; ++ks) Kc[ks] = *(const bf16x8*)(kp_ + 16 * ks); \
        _Pragma("unroll") for (int i = 0; i < 8; ++i) { int sv_ = kb_ + 4 * i + vrow; sv_ = sv_ < 0 ? 0 : sv_; \
            Vr[i] = *(const u32x4*)(Z + (size_t)(res + (sv_ << dsh)) * NZ + ZV + head * 128 + 8 * vch); } } while (0)
    ATT_LOAD_KV(4);
    for (int kt = 4; kt >= 0; --kt) {
        const int kb = s0 - 128 + 32 * kt;
        f32x16 S;
#pragma unroll
        for (int i = 0; i < 16; ++i) S[i] = 0.f;
#pragma unroll
        for (int ks = 0; ks < 8; ++ks) S = mfma32(Kc[ks], Qf[ks], S);
#pragma unroll
        for (int i = 0; i < 8; ++i) *(LAS u32x4*)(Vl + (4 * i + vrow) * 136 + 8 * vch) = Vr[i];
        if (kt > 0) ATT_LOAD_KV(kt - 1);
        float tmax = -INFINITY;
#pragma unroll
        for (int i = 0; i < 16; ++i) {
            const int sk = kb + (i & 3) + 8 * (i >> 2) + 4 * h;
            const bool valid = (sk >= 0) && (sk <= sq) && (sk >= sq - 128);
            S[i] = valid ? S[i] * ATT_SCALE : -INFINITY;
            tmax = fmaxf(tmax, S[i]);
        }
        tmax = fmaxf(tmax, __shfl_xor(tmax, 32));
        const float mn = fmaxf(mrun, tmax), alpha = __expf(mrun - mn);
        float ps = 0.f;
#pragma unroll
        for (int i = 0; i < 16; ++i) { S[i] = __expf(S[i] - mn); ps += S[i]; }
        ps += __shfl_xor(ps, 32);
        lrun = lrun * alpha + ps; mrun = mn;
#pragma unroll
        for (int dt = 0; dt < 4; ++dt) O[dt] = O[dt] * alpha;
        bf16x8 Pf[2];
#pragma unroll
        for (int s2 = 0; s2 < 2; ++s2) {
            u32x4 w; w.x = pk2(S[8 * s2 + 0], S[8 * s2 + 1]); w.y = pk2(S[8 * s2 + 2], S[8 * s2 + 3]); w.z = pk2(S[8 * s2 + 4], S[8 * s2 + 5]); w.w = pk2(S[8 * s2 + 6], S[8 * s2 + 7]);
            Pf[s2] = __builtin_bit_cast(bf16x8, w);
        }
        lds_fence();
#pragma unroll
        for (int dt = 0; dt < 4; ++dt)
#pragma unroll
            for (int s2 = 0; s2 < 2; ++s2) {
                bf16x8 A;
#pragma unroll
                for (int j = 0; j < 8; ++j) A[j] = (short)Vl[(16 * s2 + 8 * (j >> 2) + 4 * h + (j & 3)) * 136 + 32 * dt + qi];
                O[dt] = mfma32(A, Pf[s2], O[dt]);
            }
        lds_fence();
    }
#undef ATT_LOAD_KV
    const float inv = 1.f / lrun;
    bf16_t* op = OG + ((size_t)g * MP + tq) * 512 + hh * 128 + 4 * h;
#pragma unroll
    for (int dt = 0; dt < 4; ++dt)
#pragma unroll
        for (int rq = 0; rq < 4; ++rq) {
            u32x2 w; w.x = pk2(O[dt][4 * rq] * inv, O[dt][4 * rq + 1] * inv); w.y = pk2(O[dt][4 * rq + 2] * inv, O[dt][4 * rq + 3] * inv);
            *(u32x2*)(op + 32 * dt + 8 * rq) = w;
        }
    if (h == 0) LSE[((size_t)g * MP + tq) * 4 + hh] = mrun + __logf(lrun);
}
DI const float* samp_row(const float* cache, const float* newkv, int b, int W, int rr) {
    return (rr >= W) ? newkv + ((size_t)(b * W + rr - 4) * 2) * 512 : cache + ((size_t)(b * W + rr) * 2) * 512;
}
DI void attn_sample_item(const Params& p, const bf16_t* Z, bf16_t* OG, float* LSE, int item, int lane) {
    const int b = item / 48, r48 = item % 48, t = r48 / 12, head = r48 % 12, g = head >> 2, hh = head & 3;
    const int dsh = 2 * g, W = 128 << dsh;
    const float* cache = p.in[2 + g];
    const float* newkv = p.out + (g == 0 ? OFF_KVS0 : (g == 1 ? OFF_KVS1 : OFF_KVS2));
    const int m = TP + b * 4 + t;
    const unsigned qq = *(const unsigned*)(Z + (size_t)m * NZ + ZQ + head * 128 + 2 * lane);
    const float q0 = bflo(qq) * ATT_SCALE, q1 = bfhi(qq) * ATT_SCALE;
    float mrun, lrun, o0, o1;
    {
        const float* rp = samp_row(cache, newkv, b, W, W + t - (128 << dsh)) + hh * 128 + 2 * lane;
        const f32x2 kk = *(const f32x2*)rp, vv = *(const f32x2*)(rp + 512);
        mrun = wave_sum(q0 * kk.x + q1 * kk.y); lrun = 1.f; o0 = vv.x; o1 = vv.y;
    }
    f32x2 kk[16], vv[16];
#pragma unroll
    for (int u = 0; u < 16; ++u) { const float* rp = samp_row(cache, newkv, b, W, W + t - (u << dsh)) + hh * 128 + 2 * lane; kk[u] = *(const f32x2*)rp; vv[u] = *(const f32x2*)(rp + 512); }
    for (int j0 = 0; j0 < 128; j0 += 16) {
        f32x2 kn[16], vn[16];
        if (j0 + 16 < 128) {
#pragma unroll
            for (int u = 0; u < 16; ++u) { const float* rp = samp_row(cache, newkv, b, W, W + t - ((j0 + 16 + u) << dsh)) + hh * 128 + 2 * lane; kn[u] = *(const f32x2*)rp; vn[u] = *(const f32x2*)(rp + 512); }
        }
        float pr[16];
#pragma unroll
        for (int u = 0; u < 16; ++u) pr[u] = q0 * kk[u].x + q1 * kk[u].y;
#pragma unroll
        for (int o = 32; o >= 1; o >>= 1) {
#pragma unroll
            for (int u = 0; u < 16; ++u) pr[u] += __shfl_xor(pr[u], o);
        }
        float bm = pr[0];
#pragma unroll
        for (int u = 1; u < 16; ++u) bm = fmaxf(bm, pr[u]);
        const float mn = fmaxf(mrun, bm), alpha = __expf(mrun - mn);
        lrun *= alpha; o0 *= alpha; o1 *= alpha; mrun = mn;
#pragma unroll
        for (int u = 0; u < 16; ++u) { const float pu = __expf(pr[u] - mn); lrun += pu; o0 += pu * vv[u].x; o1 += pu * vv[u].y; }
#pragma unroll
        for (int u = 0; u < 16; ++u) { kk[u] = kn[u]; vv[u] = vn[u]; }
    }
    const float inv = 1.f / lrun;
    *(unsigned*)(OG + ((size_t)g * MP + m) * 512 + hh * 128 + 2 * lane) = pk2(o0 * inv, o1 * inv);
    if (lane == 0) LSE[((size_t)g * MP + m) * 4 + hh] = mrun + __logf(lrun);
}

DI float hg_gates(const Params& p, const bf16_t (&fhr)[16], int h, LAS float* tot, float (&kk)[16], float (&bb)[16]) {
    const int tid = threadIdx.x, dk = tid & 127, part = tid >> 7;
    const float* lbp = p.in[13];
    const float lb = 1.f / (1.f + __expf(lbp[1024 + h * 128 + dk] - lbp[h * 128 + dk]));
    float cum = 0.f;
#pragma unroll
    for (int i = 0; i < 16; ++i) {
        const float fh = bf2f(fhr[i]);
        const float f = lb + (1.f - lb) * sigm(fh);
        kk[i] = 1.f - f; cum += __logf(f); bb[i] = cum;
    }
    tot[part * 128 + dk] = cum;
    __syncthreads();
    float off = 0.f, bl = 0.f;
#pragma unroll
    for (int q = 0; q < 4; ++q) { const float tv = tot[q * 128 + dk]; bl += tv; off += (q < part) ? tv : 0.f; }
#pragma unroll
    for (int i = 0; i < 16; ++i) bb[i] += off;
    return bl;
}
DI void hg_load_v(const bf16_t* Z, int n, int h, LAS bf16_t* Vs) {
    const int tid = threadIdx.x;
#pragma unroll
    for (int i = 0; i < 2; ++i) { const int e = tid + 512 * i, s = e >> 4, ch = e & 15;
        *(LAS u32x4*)(Vs + s * 136 + 8 * ch) = *(const u32x4*)(Z + (size_t)(64 * n + s) * NZ + ZIH + h * 128 + 8 * ch); }
}
struct HgaRegs { bf16_t fhr[16]; u32x4 vreg[2]; };
DI void hg_passA_load(const bf16_t* Z, int item, HgaRegs& R) {
    const int n = item >> 3, h = item & 7;
    const int tid = threadIdx.x, dk = tid & 127, part = tid >> 7;
#pragma unroll
    for (int i = 0; i < 16; ++i) R.fhr[i] = Z[(size_t)(64 * n + 16 * part + i) * NZ + ZFH + h * 128 + dk];
#pragma unroll
    for (int i = 0; i < 2; ++i) { const int e = tid + 512 * i; R.vreg[i] = *(const u32x4*)(Z + (size_t)(64 * n + (e >> 4)) * NZ + ZIH + h * 128 + 8 * (e & 15)); }
}
DI void hg_passA_item(const Params& p, float* HS, float* HD, LAS unsigned char* L, int item, const HgaRegs& R) {
    const int n = item >> 3, h = item & 7;
    const int tid = threadIdx.x, lane = tid & 63, wave = tid >> 6, dk = tid & 127, part = tid >> 7;
    LAS bf16_t* Kh = (LAS bf16_t*)L;
    LAS bf16_t* Vs = (LAS bf16_t*)(L + 17408);
    LAS float* tot = (LAS float*)(L + 34816);
    float kk[16], bb[16];
    const float bl = hg_gates(p, R.fhr, h, tot, kk, bb);
#pragma unroll
    for (int i = 0; i < 16; ++i) Kh[(16 * part + i) * 136 + dk] = (bf16_t)(pk2(kk[i] * __expf(bl - bb[i]), 0.f) & 0xffffu);
    if (part == 0) HD[(size_t)(n * 8 + h) * 128 + dk] = __expf(bl);
#pragma unroll
    for (int i = 0; i < 2; ++i) { const int e = tid + 512 * i; *(LAS u32x4*)(Vs + (e >> 4) * 136 + 8 * (e & 15)) = R.vreg[i]; }
    __syncthreads();
    f32x4 acc[8];
#pragma unroll
    for (int nt = 0; nt < 8; ++nt) acc[nt] = (f32x4){0.f, 0.f, 0.f, 0.f};
#pragma unroll
    for (int ks = 0; ks < 2; ++ks) {
        const bf16x8 A = gat8(Kh + (32 * ks + 8 * (lane >> 4)) * 136 + 16 * wave + (lane & 15), 136);
#pragma unroll
        for (int nt = 0; nt < 8; ++nt) { const bf16x8 B = gat8(Vs + (32 * ks + 8 * (lane >> 4)) * 136 + 16 * nt + (lane & 15), 136); acc[nt] = mfma16(A, B, acc[nt]); }
    }
    float* up = HS + ((size_t)(n * 8 + h) * 128) * 128;
#pragma unroll
    for (int nt = 0; nt < 8; ++nt)
#pragma unroll
        for (int r = 0; r < 4; ++r) up[(size_t)(16 * wave + 4 * (lane >> 4) + r) * 128 + 16 * nt + (lane & 15)] = acc[nt][r];
    __syncthreads();
}
DI void hg_scan(const Params& p, float* HS, const float* HD) {
    for (int e = blockIdx.x * 512 + threadIdx.x; e < 131072; e += gridDim.x * 512) {
        float S = 0.f;
        for (int n0 = 0; n0 < 256; n0 += 32) {
            float U[32], Dd[32];
#pragma unroll
            for (int j = 0; j < 32; ++j) { U[j] = HS[(size_t)(n0 + j) * 131072 + e]; Dd[j] = HD[(n0 + j) * 1024 + (e >> 7)]; }
#pragma unroll
            for (int j = 0; j < 32; ++j) { HS[(size_t)(n0 + j) * 131072 + e] = S; S = Dd[j] * S + U[j]; }
        }
        p.out[OFF_HGP + e] = S;
    }
}
struct HgcRegs { bf16_t fhr[16], qhr[16]; u32x4 vreg[2]; f32x4 sreg[8]; };
DI void hg_passC_load(const bf16_t* Z, const float* HS, int item, HgcRegs& R) {
    const int n = item >> 3, h = item & 7;
    const int tid = threadIdx.x, dk = tid & 127, part = tid >> 7;
#pragma unroll
    for (int i = 0; i < 16; ++i) { const size_t ro = (size_t)(64 * n + 16 * part + i) * NZ + h * 128 + dk; R.fhr[i] = Z[ro + ZFH]; R.qhr[i] = Z[ro + ZQH]; }
#pragma unroll
    for (int i = 0; i < 2; ++i) { const int e = tid + 512 * i; R.vreg[i] = *(const u32x4*)(Z + (size_t)(64 * n + (e >> 4)) * NZ + ZIH + h * 128 + 8 * (e & 15)); }
    const float* sp = HS + ((size_t)(n * 8 + h) * 128) * 128;
#pragma unroll
    for (int i = 0; i < 8; ++i) { const int e = tid + 512 * i; R.sreg[i] = *(const f32x4*)(sp + (e >> 5) * 128 + 4 * (e & 31)); }
}
DI void hg_passC_item(const Params& p, const bf16_t* Z, bf16_t* OHG, LAS unsigned char* L, int item, const HgcRegs& R) {
    const int n = item >> 3, h = item & 7;
    const int tid = threadIdx.x, lane = tid & 63, wave = tid >> 6, dk = tid & 127, part = tid >> 7;
    LAS bf16_t* Qs = (LAS bf16_t*)L;
    LAS bf16_t* Ks = (LAS bf16_t*)(L + 17408);
    LAS bf16_t* Vs = (LAS bf16_t*)(L + 34816);
    LAS bf16_t* Ss = (LAS bf16_t*)(L + 52224);
    LAS bf16_t* As = (LAS bf16_t*)(L + 87040);
    LAS float* tot = (LAS float*)(L + 96256);
    LAS float* red = (LAS float*)(L + 98304);
    float kk[16], bb[16];
    const int mt = wave >> 1, wh = wave & 1, lr = lane & 15, lq = lane >> 4;
    bf16_t ghr[16];
#pragma unroll
    for (int r = 0; r < 4; ++r)
#pragma unroll
        for (int j = 0; j < 4; ++j) ghr[r * 4 + j] = Z[(size_t)(64 * n + 16 * mt + 4 * lq + r) * NZ + ZGH + h * 128 + 16 * (4 * wh + j) + lr];
    (void)hg_gates(p, R.fhr, h, tot, kk, bb);
#pragma unroll
    for (int i = 0; i < 16; ++i) {
        const int s = 16 * part + i;
        const float qh = bf2f(R.qhr[i]);
        Qs[s * 136 + dk] = (bf16_t)(pk2(silu(qh) * __expf(bb[i]), 0.f) & 0xffffu);
        Ks[s * 136 + dk] = (bf16_t)(pk2(kk[i] * __expf(-bb[i]), 0.f) & 0xffffu);
    }
#pragma unroll
    for (int i = 0; i < 2; ++i) { const int e = tid + 512 * i; *(LAS u32x4*)(Vs + (e >> 4) * 136 + 8 * (e & 15)) = R.vreg[i]; }
#pragma unroll
    for (int i = 0; i < 8; ++i) { const int e = tid + 512 * i; u32x2 w; w.x = pk2(R.sreg[i][0], R.sreg[i][1]); w.y = pk2(R.sreg[i][2], R.sreg[i][3]); *(LAS u32x2*)(Ss + (e >> 5) * 136 + 4 * (e & 31)) = w; }
    __syncthreads();
    {
        f32x4 a2[2] = {{0.f, 0.f, 0.f, 0.f}, {0.f, 0.f, 0.f, 0.f}};
#pragma unroll
        for (int ks = 0; ks < 4; ++ks) {
            const bf16x8 A = ld8(Qs + (16 * mt + lr) * 136 + 32 * ks + 8 * lq);
#pragma unroll
            for (int j = 0; j < 2; ++j) { const bf16x8 B = ld8(Ks + (16 * (2 * wh + j) + lr) * 136 + 32 * ks + 8 * lq); a2[j] = mfma16(A, B, a2[j]); }
        }
#pragma unroll
        for (int j = 0; j < 2; ++j)
#pragma unroll
            for (int r = 0; r < 4; ++r) { const int t = 16 * mt + 4 * lq + r, s = 16 * (2 * wh + j) + lr; As[t * 72 + s] = (bf16_t)(pk2(s <= t ? a2[j][r] : 0.f, 0.f) & 0xffffu); }
    }
    __syncthreads();
    f32x4 acc[4];
#pragma unroll
    for (int j = 0; j < 4; ++j) acc[j] = (f32x4){0.f, 0.f, 0.f, 0.f};
#pragma unroll
    for (int ks = 0; ks < 2; ++ks) {
        const bf16x8 A = ld8(As + (16 * mt + lr) * 72 + 32 * ks + 8 * lq);
#pragma unroll
        for (int j = 0; j < 4; ++j) { const bf16x8 B = gat8(Vs + (32 * ks + 8 * lq) * 136 + 16 * (4 * wh + j) + lr, 136); acc[j] = mfma16(A, B, acc[j]); }
    }
#pragma unroll
    for (int ks = 0; ks < 4; ++ks) {
        const bf16x8 A = ld8(Qs + (16 * mt + lr) * 136 + 32 * ks + 8 * lq);
#pragma unroll
        for (int j = 0; j < 4; ++j) { const bf16x8 B = gat8(Ss + (32 * ks + 8 * lq) * 136 + 16 * (4 * wh + j) + lr, 136); acc[j] = mfma16(A, B, acc[j]); }
    }
#pragma unroll
    for (int r = 0; r < 4; ++r) {
        float ss = 0.f;
#pragma unroll
        for (int j = 0; j < 4; ++j) ss += acc[j][r] * acc[j][r];
        ss += __shfl_xor(ss, 1); ss += __shfl_xor(ss, 2); ss += __shfl_xor(ss, 4); ss += __shfl_xor(ss, 8);
        if (lr == 0) red[(16 * mt + 4 * lq + r) * 2 + wh] = ss;
    }
    __syncthreads();
    const float* hgw = p.in[14];
#pragma unroll
    for (int r = 0; r < 4; ++r) {
        const int tl = 16 * mt + 4 * lq + r, t = 64 * n + tl;
        const float rstd = rsqrtf((red[tl * 2] + red[tl * 2 + 1]) * (1.f / 128.f) + EPS);
#pragma unroll
        for (int j = 0; j < 4; ++j) {
            const int dv = 16 * (4 * wh + j) + lr;
            const float gh = bf2f(ghr[r * 4 + j]);
            OHG[(size_t)t * 1024 + h * 128 + dv] = (bf16_t)(pk2(acc[j][r] * rstd * hgw[dv] * silu(gh), 0.f) & 0xffffu);
        }
    }
    __syncthreads();
}
DI void hg_sample_item(const Params& p, const bf16_t* Z, bf16_t* OHG, LAS unsigned char* L, int item) {
    const int b = item >> 3, h = item & 7;
    const int tid = threadIdx.x, dv = tid & 127, dq = tid >> 7;
    LAS float* fS = (LAS float*)L;
    LAS float* kS = fS + 512;
    LAS float* qS = kS + 512;
    LAS float* red = qS + 512;
    LAS float* rs = red + 2048;
    const float* lbp = p.in[13];
    {
        const int t = tid >> 7, dk = tid & 127, m = TP + b * 4 + t;
        const float lb = 1.f / (1.f + __expf(lbp[1024 + h * 128 + dk] - lbp[h * 128 + dk]));
        const float fh = bf2f(Z[(size_t)m * NZ + ZFH + h * 128 + dk]), qh = bf2f(Z[(size_t)m * NZ + ZQH + h * 128 + dk]);
        const float f = lb + (1.f - lb) * sigm(fh);
        fS[tid] = f; kS[tid] = 1.f - f; qS[tid] = silu(qh);
    }
    float S[32];
    const float* s0 = p.in[5] + ((size_t)(b * 8 + h) * 128) * 128;
#pragma unroll
    for (int i = 0; i < 32; ++i) S[i] = s0[(size_t)(dq * 32 + i) * 128 + dv];
    __syncthreads();
#pragma unroll
    for (int t = 0; t < 4; ++t) {
        const int m = TP + b * 4 + t;
        const float v = bf2f(Z[(size_t)m * NZ + ZIH + h * 128 + dv]);
        float part = 0.f;
#pragma unroll
        for (int i = 0; i < 32; ++i) { const int dk = dq * 32 + i; S[i] = fS[t * 128 + dk] * S[i] + kS[t * 128 + dk] * v; part += S[i] * qS[t * 128 + dk]; }
        red[(t * 4 + dq) * 128 + dv] = part;
    }
    float* so = p.out + OFF_HGS + ((size_t)(b * 8 + h) * 128) * 128;
#pragma unroll
    for (int i = 0; i < 32; ++i) so[(size_t)(dq * 32 + i) * 128 + dv] = S[i];
    __syncthreads();
    {
        const int t = tid >> 7, m = TP + b * 4 + t;
        const float o = red[(t * 4 + 0) * 128 + dv] + red[(t * 4 + 1) * 128 + dv] + red[(t * 4 + 2) * 128 + dv] + red[(t * 4 + 3) * 128 + dv];
        const float ss = wave_sum(o * o);
        if ((tid & 63) == 0) rs[tid >> 6] = ss;
        __syncthreads();
        const float rstd = rsqrtf((rs[2 * t] + rs[2 * t + 1]) * (1.f / 128.f) + EPS);
        const float gh = bf2f(Z[(size_t)m * NZ + ZGH + h * 128 + dv]);
        OHG[(size_t)m * 1024 + h * 128 + dv] = (bf16_t)(pk2(o * rstd * p.in[14][dv] * silu(gh), 0.f) & 0xffffu);
    }
    __syncthreads();
}
DI void ph_merge(const bf16_t* OG, const float* LSE, bf16_t* OATT) {
    for (size_t idx = (size_t)blockIdx.x * 512 + threadIdx.x; idx < (size_t)MR * 64; idx += (size_t)gridDim.x * 512) {
        const int m = (int)(idx >> 6), c8 = (int)(idx & 63), hh = c8 >> 4;
        const float l0 = LSE[((size_t)0 * MP + m) * 4 + hh], l1 = LSE[((size_t)1 * MP + m) * 4 + hh], l2 = LSE[((size_t)2 * MP + m) * 4 + hh];
        const float mx = fmaxf(l0, fmaxf(l1, l2));
        float w0 = __expf(l0 - mx), w1 = __expf(l1 - mx), w2 = __expf(l2 - mx);
        const float inv = 1.f / (w0 + w1 + w2); w0 *= inv; w1 *= inv; w2 *= inv;
        float a[8], b[8], c[8];
        unpack8(*(const u32x4*)(OG + ((size_t)0 * MP + m) * 512 + 8 * c8), a);
        unpack8(*(const u32x4*)(OG + ((size_t)1 * MP + m) * 512 + 8 * c8), b);
        unpack8(*(const u32x4*)(OG + ((size_t)2 * MP + m) * 512 + 8 * c8), c);
        u32x4 o;
        o.x = pk2(w0 * a[0] + w1 * b[0] + w2 * c[0], w0 * a[1] + w1 * b[1] + w2 * c[1]);
        o.y = pk2(w0 * a[2] + w1 * b[2] + w2 * c[2], w0 * a[3] + w1 * b[3] + w2 * c[3]);
        o.z = pk2(w0 * a[4] + w1 * b[4] + w2 * c[4], w0 * a[5] + w1 * b[5] + w2 * c[5]);
        o.w = pk2(w0 * a[6] + w1 * b[6] + w2 * c[6], w0 * a[7] + w1 * b[7] + w2 * c[7]);
        *(u32x4*)(OATT + (size_t)m * 512 + 8 * c8) = o;
    }
}
DI void ld8p(const float* s, float (&f)[8]) {
    f32x4 a = {0.f, 0.f, 0.f, 0.f}, b = a;
#pragma unroll
    for (int q = 0; q < NSP_UP; ++q) { a = a + *(const f32x4*)(s + (size_t)q * NS * NAB); b = b + *(const f32x4*)(s + (size_t)q * NS * NAB + 4); }
    f[0] = a[0]; f[1] = a[1]; f[2] = a[2]; f[3] = a[3]; f[4] = b[0]; f[5] = b[1]; f[6] = b[2]; f[7] = b[3];
}
DI void ph_convact(const Params& p, const bf16_t* AB, bf16_t* G) {
    const float* cw = p.in[21]; const float* cb = p.in[22]; const float* sc = p.in[6];
    const float* ACC = (const float*)(p.ws + WS_ACC_UP);
    for (size_t idx = (size_t)blockIdx.x * 512 + threadIdx.x; idx < (size_t)(126 + NS) * 704; idx += (size_t)gridDim.x * 512) {
        const int ri = (int)(idx / 704), c = (int)(idx % 704) * 8;
        const int m = ri < 126 ? 256 * (1 + (ri >> 1)) + (ri & 1) : TP + (ri - 126);
        float a2[8], a1[8], a0[8], bl[8];
        if (m < TP) {
            unpack8(*(const u32x4*)(AB + (size_t)m * NAB + c), a2);
            unpack8(*(const u32x4*)(AB + (size_t)m * NAB + DFF + c), bl);
            if (m >= 1) unpack8(*(const u32x4*)(AB + (size_t)(m - 1) * NAB + c), a1); else { for (int j = 0; j < 8; ++j) a1[j] = 0.f; }
            if (m >= 2) unpack8(*(const u32x4*)(AB + (size_t)(m - 2) * NAB + c), a0); else { for (int j = 0; j < 8; ++j) a0[j] = 0.f; }
        } else {
            const int ms = m - TP, t = ms & 3, b = ms >> 2;
            ld8p(ACC + (size_t)ms * NAB + c, a2);
            ld8p(ACC + (size_t)ms * NAB + DFF + c, bl);
            if (t >= 1) ld8p(ACC + (size_t)(ms - 1) * NAB + c, a1); else ld8f(sc + (size_t)(b * 2 + 1) * DFF + c, a1);
            if (t >= 2) ld8p(ACC + (size_t)(ms - 2) * NAB + c, a0); else ld8f(sc + (size_t)(b * 2 + t) * DFF + c, a0);
            if (t >= 2) { float* d = p.out + OFF_CVS + (size_t)(b * 2 + t - 2) * DFF + c; *(f32x4*)d = (f32x4){a2[0], a2[1], a2[2], a2[3]}; *(f32x4*)(d + 4) = (f32x4){a2[4], a2[5], a2[6], a2[7]}; }
        }
        float w0[8], w1[8], w2[8], bb[8];
        ld8f(cw + c, w0); ld8f(cw + DFF + c, w1); ld8f(cw + 2 * DFF + c, w2); ld8f(cb + c, bb);
        float o[8];
#pragma unroll
        for (int j = 0; j < 8; ++j) { const float u = bb[j] + w0[j] * a0[j] + w1[j] * a1[j] + w2[j] * a2[j]; o[j] = silu(u) * bl[j]; }
        u32x4 w; w.x = pk2(o[0], o[1]); w.y = pk2(o[2], o[3]); w.z = pk2(o[4], o[5]); w.w = pk2(o[6], o[7]);
        *(u32x4*)(G + (size_t)m * DFF + c) = w;
    }
}

DI void ph_mixfix(const Params& p) {
    const bf16_t* Z = (const bf16_t*)(p.ws + WS_Z); const float* PA = (const float*)(p.ws + WS_ACC_PA); const float* PB = (const float*)(p.ws + WS_ACC_PB); bf16_t* Y = (bf16_t*)(p.ws + WS_YMIX);
    for (int idx = blockIdx.x * 512 + threadIdx.x; idx < NS * (D / 4); idx += gridDim.x * 512) {
        const int r = idx / (D / 4), c = (idx % (D / 4)) * 4;
        f32x4 a = {0.f, 0.f, 0.f, 0.f}, b = a;
#pragma unroll
        for (int q = 0; q < NSP_PA; ++q) a = a + *(const f32x4*)(PA + ((size_t)q * NS + r) * D + c);
#pragma unroll
        for (int q = 0; q < NSP_PB; ++q) b = b + *(const f32x4*)(PB + ((size_t)q * NS + r) * D + c);
        const u32x2 ga = *(const u32x2*)(Z + (size_t)(TP + r) * NZ + ZGA + c), gb = *(const u32x2*)(Z + (size_t)(TP + r) * NZ + ZGB + c);
        const float y0 = sigm(bflo(ga.x)) * a[0] + sigm(bflo(gb.x)) * b[0], y1 = sigm(bfhi(ga.x)) * a[1] + sigm(bfhi(gb.x)) * b[1];
        const float y2 = sigm(bflo(ga.y)) * a[2] + sigm(bflo(gb.y)) * b[2], y3 = sigm(bfhi(ga.y)) * a[3] + sigm(bfhi(gb.y)) * b[3];
        u32x2 w; w.x = pk2(y0, y1); w.y = pk2(y2, y3);
        *(u32x2*)(Y + (size_t)(TP + r) * D + c) = w;
    }
}
#define XB_TMO      128
#define XB_XCNT(j)  (256  + 64 * (j))
#define XB_XSUB(j)  (1280 + 64 * (j))
#define XB_XGEN(j)  (2304 + 64 * (j))
#define XB_TOP      3328
#define XB_TOPGEN   3392
#define XCD_BAR_WORDS 3456
#define XB_SPIN_CAP (1u << 18)

__device__ __forceinline__ unsigned xb_ld(unsigned* p)              { return __hip_atomic_load(p, __ATOMIC_RELAXED, __HIP_MEMORY_SCOPE_AGENT); }
__device__ __forceinline__ unsigned xb_add(unsigned* p, unsigned v) { return __hip_atomic_fetch_add(p, v, __ATOMIC_RELAXED, __HIP_MEMORY_SCOPE_AGENT); }
__device__ __forceinline__ unsigned xb_xcc_id() { return (unsigned)__builtin_amdgcn_s_getreg((3 << 11) | 20) & 0xFu; }
#define XB_SPIN(cond, bar) do { unsigned _sp = 0; while (cond) { __builtin_amdgcn_s_sleep(1); \
    if ((++_sp & 255u) == 0u) { if (xb_ld(&(bar)[XB_TMO])) break; if (_sp > XB_SPIN_CAP) { atomicAdd(&(bar)[XB_TMO], 1u); break; } } } } while (0)

struct XcdBarrier {
    unsigned* bar; unsigned x;
    volatile LAS unsigned* st;
};

__device__ __forceinline__ XcdBarrier xcd_barrier_post(unsigned* bar, volatile LAS unsigned* st) {
    XcdBarrier b; b.bar = bar; b.x = xb_xcc_id(); b.st = st;
    if (threadIdx.x == 0) (void)xb_add(&bar[XB_XCNT(b.x)], 1u);
    return b;
}
__device__ __forceinline__ void xcd_barrier_complete(unsigned* bar, unsigned x, unsigned& nloc, unsigned& nx) {
    const unsigned G = gridDim.x * gridDim.y * gridDim.z;
    unsigned sum, cnt, mine, sp = 0u;
    for (;;) {
        sum = 0u; cnt = 0u; mine = 0u;
#pragma unroll
        for (unsigned j = 0; j < 16; ++j) { const unsigned c = xb_ld(&bar[XB_XCNT(j)]); sum += c; cnt += (c > 0u) ? 1u : 0u; mine = (j == x) ? c : mine; }
        if (sum == G) break;
        __builtin_amdgcn_s_sleep(1);
        if ((++sp & 255u) == 0u) { if (xb_ld(&bar[XB_TMO])) break; if (sp > XB_SPIN_CAP) { atomicAdd(&bar[XB_TMO], 1u); break; } }
    }
    nloc = mine > 0u ? mine : 1u; nx = cnt > 0u ? cnt : 1u;
}

__device__ __forceinline__ void xcd_barrier(const XcdBarrier& b) {
    asm volatile("s_waitcnt vmcnt(0)" ::: "memory");
    __syncthreads();
    if (threadIdx.x == 0) {
        unsigned* bar = b.bar;
        __builtin_amdgcn_s_waitcnt(0);
        unsigned nloc = b.st[0], nx = b.st[1];
        if (nloc == 0u) { xcd_barrier_complete(bar, b.x, nloc, nx); b.st[0] = nloc; b.st[1] = nx; }
        const unsigned old = xb_add(&bar[XB_XSUB(b.x)], 1u);
        const unsigned gen = old / nloc;
        if (old + 1u == (gen + 1u) * nloc) {
            __builtin_amdgcn_fence(__ATOMIC_RELEASE, "agent");
            asm volatile("s_waitcnt vmcnt(0)" ::: "memory");
            const unsigned og = xb_add(&bar[XB_TOP], 1u);
            const unsigned tg = og / nx;
            if (og + 1u == (tg + 1u) * nx) xb_add(&bar[XB_TOPGEN], 1u);
            else XB_SPIN(xb_ld(&bar[XB_TOPGEN]) == tg, bar);
            __builtin_amdgcn_fence(__ATOMIC_ACQUIRE, "agent");
            xb_add(&bar[XB_XGEN(b.x)], 1u);
            asm volatile("s_waitcnt vmcnt(0)" ::: "memory");
        } else {
            XB_SPIN(xb_ld(&bar[XB_XGEN(b.x)]) == gen, bar);
            __builtin_amdgcn_fence(__ATOMIC_ACQUIRE, "agent");
            asm volatile("s_waitcnt vmcnt(0)" ::: "memory");
        }
    }
    __syncthreads();
}

template <class Epi> DI void run_gemm(LAS unsigned char* L, const bf16_t* A, const bf16_t* Bt, int N, int K, const Epi& E) {
    pg8::Gemm g{A, Bt, MP, N, K}; pg8::StaticOrder S; S.init(MP, N, K, (int)gridDim.x, (int)blockIdx.x);
    pg8::gemm_phase<Epi, pg8::StaticOrder, false>(L, g, S, E, nullptr);
}
template <class Epi> DI void run_gemm_split(LAS unsigned char* L, const bf16_t* A, const bf16_t* Bt, int N, int K, const Epi& E) {
    pg8::Gemm g{A, Bt, MP, N, K}; pg8::SplitOrder S; S.init(N, K, (int)gridDim.x, (int)blockIdx.x);
    pg8::gemm_phase<Epi, pg8::SplitOrder, false>(L, g, S, E, nullptr);
}

__global__ void __launch_bounds__(512, 2) mega(Params p) {
    extern __shared__ __attribute__((aligned(16))) unsigned char lds[];
    LAS unsigned char* L = (LAS unsigned char*)lds;
    cg::grid_group grid = cg::this_grid();
    unsigned char* ws = p.ws;
    const int lo = p.ph_lo, hi = p.ph_hi;
    const int tid = threadIdx.x, lane = tid & 63, wave = tid >> 6;
    bf16_t* Z = (bf16_t*)(ws + WS_Z);
    bf16_t* H = (bf16_t*)(ws + WS_H);
    float* MOD = (float*)(ws + WS_MOD);
#define IN(k) (lo <= (k) && (k) < hi)
    XcdBarrier xbar; xbar.bar = (unsigned*)ws; xbar.x = 0; xbar.st = (volatile LAS unsigned*)(L + 131072 + 4096);
    if (hi - lo > 1) {
        if (threadIdx.x < 2) xbar.st[threadIdx.x] = 0u;
        __syncthreads();
        xbar = xcd_barrier_post((unsigned*)ws, (volatile LAS unsigned*)(L + 131072 + 4096));
        grid.sync();
    }
#define SEAM(k) do { if (IN(k) && IN((k) + 1)) xcd_barrier(xbar); } while (0)
#define SOFT(k) do { if (IN(k) && IN((k) + 1)) __syncthreads(); } while (0)
    if (IN(0)) ph_prologue(p, L);
    SEAM(0);
    if (IN(1)) ph_hnorm(p, nullptr, false, p.in[11], 0, H);
    SEAM(1);
    if (IN(2)) { EpiZ E{Z, (const float*)(ws + WS_ROPE), p.out, p.in[2], p.in[3], p.in[4]}; run_gemm(L, H, (const bf16_t*)(ws + WS_WIN), NZ, D, E); }
    SEAM(2);
    if (IN(3)) {
        HgaRegs RA;
        int it = blockIdx.x;
        if (it < 2048) hg_passA_load(Z, it, RA);
        while (it < 2048) {
            const int itn = it + gridDim.x; HgaRegs RB;
            if (itn < 2048) hg_passA_load(Z, itn, RB);
            hg_passA_item(p, (float*)(ws + WS_HS), (float*)(ws + WS_HD), L, it, RA);
            RA = RB; it = itn;
        }
    }
    SOFT(3);
    if (IN(4)) {
        const int gw = blockIdx.x * 8 + wave, NGW = gridDim.x * 8;
        LAS bf16_t* Vl = (LAS bf16_t*)(L + wave * 8704);
        for (int base = 0; base < 6144; base += 3 * NGW)
            for (int j = 0; j < 3; ++j) { const int it = base + gw * 3 + j; if (it < 6144) attn_prompt_item(Z, (bf16_t*)(ws + WS_OG), (float*)(ws + WS_LSE), Vl, it, lane); }
    }
    SOFT(4);
    if (IN(5)) { const int gw = blockIdx.x * 8 + wave, NGW = gridDim.x * 8; for (int it = gw; it < 1536; it += NGW) attn_sample_item(p, Z, (bf16_t*)(ws + WS_OG), (float*)(ws + WS_LSE), it, lane); }
    SEAM(5);
    if (IN(6)) hg_scan(p, (float*)(ws + WS_HS), (const float*)(ws + WS_HD));
    SEAM(6);
    if (IN(7)) {
        HgcRegs RA;
        int it = blockIdx.x;
        if (it < 2048) hg_passC_load(Z, (const float*)(ws + WS_HS), it, RA);
        while (it < 2048) {
            const int itn = it + gridDim.x; HgcRegs RB;
            if (itn < 2048) hg_passC_load(Z, (const float*)(ws + WS_HS), itn, RB);
            hg_passC_item(p, Z, (bf16_t*)(ws + WS_OHG), L, it, RA);
            RA = RB; it = itn;
        }
    }
    SOFT(7);
    if (IN(8)) for (int it = blockIdx.x; it < 256; it += gridDim.x) hg_sample_item(p, Z, (bf16_t*)(ws + WS_OHG), L, it);
    SOFT(8);
    if (IN(9)) ph_merge((const bf16_t*)(ws + WS_OG), (const float*)(ws + WS_LSE), (bf16_t*)(ws + WS_OATT));
    SEAM(9);
    if (IN(10)) {
        { EpiMix1 E{Z, (float*)(ws + WS_TMP), (float*)(ws + WS_ACC_PA)}; run_gemm_split(L, (const bf16_t*)(ws + WS_OATT), (const bf16_t*)(ws + WS_WPA), D, 512, E); }
        { EpiMix2 E{Z, (const float*)(ws + WS_TMP), (bf16_t*)(ws + WS_YMIX), (float*)(ws + WS_ACC_PB)}; run_gemm_split(L, (const bf16_t*)(ws + WS_OHG), (const bf16_t*)(ws + WS_WPB), D, 1024, E); }
    }
    SEAM(10);
    if (IN(11)) ph_mixfix(p);
    SEAM(11);
    if (IN(12)) { EpiWO E{p.in[0], p.in[1], MOD, p.out, (float*)(ws + WS_ACC_WO)}; run_gemm_split(L, (const bf16_t*)(ws + WS_YMIX), (const bf16_t*)(ws + WS_WO), D, D, E); }
    SEAM(12);
    if (IN(13)) ph_hnorm(p, p.out, true, p.in[18], 3, H);
    SEAM(13);
    if (IN(14)) { EpiUp E{(bf16_t*)(ws + WS_AB), (bf16_t*)(ws + WS_G), p.out, (float*)(ws + WS_ACC_UP), p.in[21], p.in[22], (LAS float*)(L + 131072)}; run_gemm_split(L, H, (const bf16_t*)(ws + WS_WAB), NAB, D, E); }
    SEAM(14);
    if (IN(15)) ph_convact(p, (const bf16_t*)(ws + WS_AB), (bf16_t*)(ws + WS_G));
    SEAM(15);
    if (IN(16)) { EpiDown E{MOD, p.out, (float*)(ws + WS_ACC_DN)}; run_gemm_split(L, (const bf16_t*)(ws + WS_G), (const bf16_t*)(ws + WS_WDN), D, DFF, E); }
    SEAM(16);
    if (IN(17)) ph_final_norm(p);
#undef IN
#undef SEAM
#undef SOFT
}

#ifndef MK_MULTI
#define MK_MULTI 0
#endif
extern "C" void kernel_launch(void* const* d_in, const int* in_sizes, int n_in, void* d_out, int out_size, void* d_ws, size_t ws_size, hipStream_t stream) {
    static int grid = 0;
    if (grid == 0) {
        if (n_in != 25 || (size_t)out_size != OUT_TOTAL || ws_size < WS_END) { fprintf(stderr, "kernel_launch: unexpected shapes: n_in %d out %d ws %zu (need %zu)\n", n_in, out_size, ws_size, (size_t)WS_END); grid = -1; return; }
        int dev = 0, cus = 0, per_cu = 0;
        hipGetDevice(&dev);
        hipDeviceGetAttribute(&cus, hipDeviceAttributeMultiprocessorCount, dev);
        if (hipFuncSetAttribute((const void*)mega, hipFuncAttributeMaxDynamicSharedMemorySize, LDS_BYTES) != hipSuccess) { fprintf(stderr, "kernel_launch: hipFuncSetAttribute failed\n"); grid = -1; return; }
        if (hipOccupancyMaxActiveBlocksPerMultiprocessor(&per_cu, (const void*)mega, 512, LDS_BYTES) != hipSuccess || per_cu < 1) { fprintf(stderr, "kernel_launch: occupancy query failed (%d)\n", per_cu); (void)hipGetLastError(); per_cu = 1; }
        grid = cus * 1;
        if (grid < 1) grid = -1;
    }
    if (grid < 0) return;
    Params p{};
    for (int i = 0; i < 25; ++i) p.in[i] = (const float*)d_in[i];
    p.out = (float*)d_out; p.ws = (unsigned char*)d_ws;
#ifndef DUP_MASK
#define DUP_MASK 0
#endif
#if MK_MULTI
    for (int ph = 0; ph < NPH; ++ph) for (int rep = 0; rep < (((DUP_MASK >> ph) & 1) ? 2 : 1); ++rep) { p.ph_lo = ph; p.ph_hi = ph + 1; hipLaunchKernelGGL(mega, dim3(grid), dim3(512), LDS_BYTES, stream, p); }
#else
    p.ph_lo = 0; p.ph_hi = NPH;
    if (hipMemsetAsync(d_ws, 0, 16384, stream) != hipSuccess) { fprintf(stderr, "kernel_launch: memset of the barrier words failed\n"); return; }
    void* args[] = {&p};
    hipError_t e = hipLaunchCooperativeKernel((const void*)mega, dim3(grid), dim3(512), args, LDS_BYTES, stream);
    if (e != hipSuccess) fprintf(stderr, "cooperative launch failed: %s (grid %d)\n", hipGetErrorString(e), grid);
#endif
}
```

```cpp
#include <hip/hip_runtime.h>
#include <hip/hip_cooperative_groups.h>
#include <cstdio>
namespace cg = cooperative_groups;
namespace pg8 {
#define PG8_LAS __attribute__((address_space(3)))
typedef unsigned short bf16_t;
typedef short bf16x8 __attribute__((ext_vector_type(8)));
typedef float f32x4 __attribute__((ext_vector_type(4)));
typedef unsigned u32x4 __attribute__((ext_vector_type(4)));
constexpr int BM = 256, BK = 64, HALF = 128, HTB = HALF * BK * 2  , STAGE_BYTES = 8 * HTB, NXCD = 8, WGM = 8;

__host__ __device__ __forceinline__ int lds_byte(int r, int c) { const int st = (r >> 4) * 2 + (c >> 5), rr = r & 15, cc = c & 31, ob = rr * 64 + cc * 2; return st * 1024 + (ob ^ (((ob >> 9) & 1) << 5)); }
__host__ __device__ __forceinline__ void stage_rc(int b, int& R, int& C) { const int st = b / 1024, sb = b % 1024, swz = sb ^ (((sb >> 9) & 1) << 5); R = (st >> 1) * 16 + swz / 64; C = (st & 1) * 32 + (swz % 64) / 2; }
__host__ __device__ __forceinline__ int perm32(int rho) { const int n = rho >> 4, i = rho & 15; return 8 * (i >> 2) + 4 * n + (i & 3); }

struct Unit { int pm, pn, kt0, nkt; };
struct Gemm { const bf16_t* A; const bf16_t* Bt; int M, N, K; };

struct StaticOrder {
    int nM, nN, nwg, G, c, nkt;
    __host__ __device__ void init(int M, int N, int K, int G_, int c_) { nM = M / BM; nN = N / BM; nwg = nM * nN; G = G_; c = c_; nkt = K / BK; }
    __host__ __device__ bool next(int i, Unit& u) const {
        const long L = (long)i * G + c; if (L >= nwg) return false;
        int wgid = (int)L; { const int q = nwg / NXCD, r = nwg % NXCD, xcd = wgid % NXCD, off = wgid / NXCD; wgid = (xcd < r ? xcd * (q + 1) : r * (q + 1) + (xcd - r) * q) + off; }
        const int nig = WGM * nN, gid = wgid / nig, fm = gid * WGM, gsz = (nM - fm) < WGM ? (nM - fm) : WGM;
        u.pm = fm + ((wgid % nig) % gsz); u.pn = (wgid % nig) / gsz; u.kt0 = 0; u.nkt = nkt; return true;
    }
    __device__ __forceinline__ void a_ready(const Unit&) const {}
    __device__ __forceinline__ void done(const Unit&) const {}
};
struct SplitOrder {
    int nN, nwg, G, c, nkt, nsp;
    __host__ __device__ void init(int N, int K, int G_, int c_) { nN = N / BM; nwg = 64 * nN; G = G_; c = c_; nkt = K / BK; nsp = nkt / 4; }
    __host__ __device__ bool next(int i, Unit& u) const {
        const long L = (long)i * G + c;
        if (L < nwg) {
            int wgid = (int)L; { const int q = nwg / NXCD, r = nwg % NXCD, xcd = wgid % NXCD, off = wgid / NXCD; wgid = (xcd < r ? xcd * (q + 1) : r * (q + 1) + (xcd - r) * q) + off; }
            const int nig = WGM * nN, gid = wgid / nig, fm = gid * WGM, gsz = (64 - fm) < WGM ? (64 - fm) : WGM;
            u.pm = fm + ((wgid % nig) % gsz); u.pn = (wgid % nig) / gsz; u.kt0 = 0; u.nkt = nkt; return true;
        }
        const long j = L - nwg; if (j >= (long)nN * nsp) return false;
        u.pm = 64; u.pn = (int)(j % nN); u.kt0 = 4 * (int)(j / nN); u.nkt = 4; return true;
    }
    __device__ __forceinline__ void a_ready(const Unit&) const {}
    __device__ __forceinline__ void done(const Unit&) const {}
};
template <class Epi, class Sched, bool STAMP = false>
__device__ __forceinline__ void gemm_phase(PG8_LAS unsigned char* lds, const Gemm g, const Sched& S, const Epi& E, unsigned long long* stamps) {
    const int tid = threadIdx.x, wid = __builtin_amdgcn_readfirstlane(tid >> 6), lane = tid & 63, wr = wid >> 2, wc = wid & 3, fr = lane & 15, fq = lane >> 4;
    const int K = g.K;
    int ts_lo = 0, ts_hi = 0, nts = 0; const unsigned long long rt_entry = STAMP ? (unsigned long long)wall_clock64() : 0ull;
#define PG8_STAMP() do { if (STAMP && wid == 0 && nts < 64) { const unsigned long long _c = (unsigned long long)clock64(); \
        ts_lo = (lane == nts) ? (int)(unsigned)_c : ts_lo; ts_hi = (lane == nts) ? (int)(unsigned)(_c >> 32) : ts_hi; ++nts; } } while (0)
    PG8_STAMP();
    unsigned voffA[2], voffB[2];
#pragma unroll
    for (int i = 0; i < 2; ++i) { int R, C; stage_rc(tid * 16 + i * 8192, R, C); const int Rb = Epi::PERM ? ((R & ~31) + perm32(R & 31)) : R;
        voffA[i] = (unsigned)(R * K + C) * 2u; voffB[i] = (unsigned)(Rb * K + C) * 2u; }
    const size_t kstep = (size_t)(BK * 2);
    const size_t hstep = (size_t)HALF * K * 2;
    const size_t tstep = 2 * hstep;
    const unsigned ldsw = (unsigned)wid * 1024u;
    const int aoff = lds_byte(wr * 64 + fr, fq * 8), boff = lds_byte(wc * 32 + fr, fq * 8);
#define PG8_SA(b, h) (((b) * 2 + (h)) * HTB)
#define PG8_SB(b, h) ((4 + (b) * 2 + (h)) * HTB)
#define PG8_STAGE(bufoff, gbase, voff) do { _Pragma("unroll") for (int _i = 0; _i < 2; ++_i) \
        __builtin_amdgcn_global_load_lds((const unsigned*)((const char*)(gbase) + (voff)[_i]), (PG8_LAS unsigned*)(lds + (bufoff) + ldsw + _i * 8192), 16, 0, 0); } while (0)
#define PG8_LDA(dst, b, h) do { _Pragma("unroll") for (int m = 0; m < 4; ++m) _Pragma("unroll") for (int k = 0; k < 2; ++k) dst[m][k] = *(const PG8_LAS bf16x8*)(lds + PG8_SA(b, h) + aoff + m * 2048 + k * 1024); } while (0)
#define PG8_LDB(dst, b, h) do { _Pragma("unroll") for (int n = 0; n < 2; ++n) _Pragma("unroll") for (int k = 0; k < 2; ++k) dst[n][k] = *(const PG8_LAS bf16x8*)(lds + PG8_SB(b, h) + boff + n * 2048 + k * 1024); } while (0)
#define PG8_MMA(ai, bj, At, Bt) do { __builtin_amdgcn_s_setprio(1); _Pragma("unroll") for (int m = 0; m < 4; ++m) _Pragma("unroll") for (int n = 0; n < 2; ++n) _Pragma("unroll") for (int k = 0; k < 2; ++k) \
        acc[ai][bj][m][n] = __builtin_amdgcn_mfma_f32_16x16x32_bf16(Bt[n][k], At[m][k], acc[ai][bj][m][n], 0, 0, 0); __builtin_amdgcn_s_setprio(0); } while (0)
#define PG8_WAIT_V(n) asm volatile("s_waitcnt vmcnt(" #n ")" ::: "memory")
#define PG8_WAIT_L(n) asm volatile("s_waitcnt lgkmcnt(" #n ")" ::: "memory")
#define PG8_BAR __builtin_amdgcn_s_barrier()
#define PG8_SCHED __builtin_amdgcn_sched_barrier(0)
    Unit cur, nxt; int ui = 0;
    if (!S.next(0, cur)) return;
    f32x4 acc[2][2][4][2];
#pragma unroll
    for (int a = 0; a < 2; ++a)
#pragma unroll
        for (int b = 0; b < 2; ++b)
#pragma unroll
            for (int m = 0; m < 4; ++m)
#pragma unroll
                for (int n = 0; n < 2; ++n) acc[a][b][m][n] = (f32x4){0.f, 0.f, 0.f, 0.f};
    bf16x8 At[4][2], B0[2][2], B1[2][2];
    const char* cA = (const char*)g.A + (size_t)cur.pm * tstep + (size_t)cur.kt0 * kstep; const char* cB = (const char*)g.Bt + (size_t)cur.pn * tstep + (size_t)cur.kt0 * kstep;
    S.a_ready(cur);
    PG8_STAGE(PG8_SB(0, 0), cB, voffB); PG8_STAGE(PG8_SA(0, 0), cA, voffA); PG8_STAGE(PG8_SB(0, 1), cB + hstep, voffB); PG8_STAGE(PG8_SA(0, 1), cA + hstep, voffA);
    if (wr == 1) PG8_BAR;
    PG8_WAIT_V(4); PG8_BAR;
    PG8_STAGE(PG8_SB(1, 0), cB + kstep, voffB); PG8_STAGE(PG8_SA(1, 0), cA + kstep, voffA); PG8_STAGE(PG8_SB(1, 1), cB + hstep + kstep, voffB);
    PG8_WAIT_V(6); PG8_BAR;
    PG8_STAMP();
    for (;;) {
        const bool has_next = S.next(ui + 1, nxt);
        const char* nA = has_next ? (const char*)g.A + (size_t)nxt.pm * tstep + (size_t)nxt.kt0 * kstep : cA; const char* nB = has_next ? (const char*)g.Bt + (size_t)nxt.pn * tstep + (size_t)nxt.kt0 * kstep : cB;
        const int nt = cur.nkt;
        for (int t = 0; t < nt; t += 2) {
            const bool last = (t == nt - 2);
            const char* a1 = cA + (size_t)(t + 1) * kstep;
            const char* a2 = last ? nA : cA + (size_t)(t + 2) * kstep; const char* b2 = last ? nB : cB + (size_t)(t + 2) * kstep;
            const char* a3 = a2 + kstep; const char* b3 = b2 + kstep;
            if (last && has_next) S.a_ready(nxt);
            PG8_LDB(B0, 0, 0); PG8_SCHED; PG8_LDA(At, 0, 0); PG8_STAGE(PG8_SA(1, 1), a1 + hstep, voffA);
            PG8_WAIT_L(8); PG8_BAR; PG8_WAIT_L(0); PG8_MMA(0, 0, At, B0); PG8_BAR; PG8_SCHED;
            PG8_LDB(B1, 0, 1); PG8_STAGE(PG8_SB(0, 0), b2, voffB);
            PG8_BAR; PG8_WAIT_L(0); PG8_MMA(0, 1, At, B1); PG8_BAR;
            PG8_LDA(At, 0, 1); PG8_STAGE(PG8_SA(0, 0), a2, voffA);
            PG8_BAR; PG8_WAIT_L(0); PG8_MMA(1, 0, At, B0); PG8_BAR; PG8_SCHED;
            PG8_STAGE(PG8_SB(0, 1), b2 + hstep, voffB);
            PG8_WAIT_V(6); PG8_BAR; PG8_MMA(1, 1, At, B1); PG8_BAR;
            PG8_LDB(B0, 1, 0); PG8_SCHED; PG8_LDA(At, 1, 0); PG8_STAGE(PG8_SA(0, 1), a2 + hstep, voffA);
            PG8_WAIT_L(8); PG8_BAR; PG8_WAIT_L(0); PG8_MMA(0, 0, At, B0); PG8_BAR; PG8_SCHED;
            PG8_LDB(B1, 1, 1); PG8_STAGE(PG8_SB(1, 0), b3, voffB);
            PG8_BAR; PG8_WAIT_L(0); PG8_MMA(0, 1, At, B1); PG8_BAR;
            PG8_LDA(At, 1, 1); PG8_STAGE(PG8_SA(1, 0), a3, voffA);
            PG8_BAR; PG8_WAIT_L(0); PG8_MMA(1, 0, At, B0); PG8_BAR; PG8_SCHED;
            PG8_STAGE(PG8_SB(1, 1), b3 + hstep, voffB);
            PG8_WAIT_V(6); PG8_BAR; PG8_MMA(1, 1, At, B1); PG8_BAR;
        }
        PG8_STAMP();
        if constexpr (!Epi::AFTER_DRAIN) { E(acc, cur, wr, wc, fr, fq); S.done(cur); }
        PG8_STAMP();
        if (!has_next) break;
#pragma unroll
        for (int a = 0; a < 2; ++a)
#pragma unroll
            for (int b = 0; b < 2; ++b)
#pragma unroll
                for (int m = 0; m < 4; ++m)
#pragma unroll
                    for (int n = 0; n < 2; ++n) acc[a][b][m][n] = (f32x4){0.f, 0.f, 0.f, 0.f};
        cur = nxt; cA = nA; cB = nB; ++ui;
    }
    PG8_WAIT_V(0);
    if (wr == 0) PG8_BAR;
    PG8_BAR;
    if constexpr (Epi::AFTER_DRAIN) { E.fused(acc, cur, wr, wc, fr, fq, lds, wid, lane); S.done(cur); }
    PG8_STAMP();
    if (STAMP && wid == 0) { stamps[lane] = lane < nts ? (((unsigned long long)(unsigned)ts_hi << 32) | (unsigned)ts_lo) : 0ull;
        if (lane == 62) stamps[62] = rt_entry; if (lane == 63) stamps[63] = (unsigned long long)wall_clock64(); }
#undef PG8_STAMP
#undef PG8_SA
#undef PG8_SB
#undef PG8_STAGE
#undef PG8_LDA
#undef PG8_LDB
#undef PG8_MMA
#undef PG8_WAIT_V
#undef PG8_WAIT_L
#undef PG8_BAR
#undef PG8_SCHED
}
}

using pg8::bf16_t; using pg8::bf16x8; using pg8::f32x4; using pg8::Unit;
#define LAS __attribute__((address_space(3)))
#define DI __device__ __forceinline__
typedef float f32x16 __attribute__((ext_vector_type(16)));
typedef float f32x2 __attribute__((ext_vector_type(2)));
typedef unsigned u32x4 __attribute__((ext_vector_type(4)));
typedef unsigned u32x2 __attribute__((ext_vector_type(2)));

constexpr int D = 2048, TP = 16384, NS = 128, MR = TP + NS, MP = 16640;
constexpr int NZ = 12800, DFF = 5632, NAB = 2 * DFF;
constexpr int ZQ = 0, ZK = 1536, ZV = 3072, ZQH = 4608, ZFH = 5632, ZIH = 6656, ZGH = 7680, ZGA = 8704, ZGB = 10752;
constexpr int NMODROW = 33, NMOD = 6 * D;
constexpr float EPS = 1e-6f;
constexpr float ATT_SCALE = 0.08838834764831845f;
constexpr size_t OFF_Y = 0;
constexpr size_t OFF_KVP0 = (size_t)MR * D;
constexpr size_t OFF_KVP1 = OFF_KVP0 + 128 * 1024;
constexpr size_t OFF_KVP2 = OFF_KVP1 + 512 * 1024;
constexpr size_t OFF_HGP = OFF_KVP2 + 2048 * 1024;
constexpr size_t OFF_CVP = OFF_HGP + 8 * 128 * 128;
constexpr size_t OFF_KVS0 = OFF_CVP + 2 * DFF;
constexpr size_t OFF_KVS1 = OFF_KVS0 + (size_t)32 * 128 * 1024;
constexpr size_t OFF_KVS2 = OFF_KVS1 + (size_t)32 * 512 * 1024;
constexpr size_t OFF_HGS = OFF_KVS2 + (size_t)32 * 2048 * 1024;
constexpr size_t OFF_CVS = OFF_HGS + (size_t)32 * 8 * 128 * 128;
constexpr size_t OUT_TOTAL = OFF_CVS + (size_t)32 * 2 * DFF;
static_assert(OUT_TOTAL == 129346560, "output size");
constexpr size_t WS_WIN = 1u << 20;
constexpr size_t WS_WPA = WS_WIN + (size_t)NZ * D * 2;
constexpr size_t WS_WPB = WS_WPA + (size_t)2048 * 512 * 2;
constexpr size_t WS_WO = WS_WPB + (size_t)2048 * 1024 * 2;
constexpr size_t WS_WAB = WS_WO + (size_t)2048 * 2048 * 2;
constexpr size_t WS_WDN = WS_WAB + (size_t)NAB * D * 2;
constexpr size_t WS_MOD = WS_WDN + (size_t)D * DFF * 2;
constexpr size_t WS_ROPE = WS_MOD + (size_t)NMODROW * NMOD * 4;
constexpr size_t WS_Z = WS_ROPE + (size_t)MP * 32 * 4;
constexpr size_t WS_AB = WS_Z;
constexpr size_t WS_H = WS_Z + (size_t)MP * NZ * 2;
constexpr size_t WS_OG = WS_H + (size_t)MP * D * 2;
constexpr size_t WS_LSE = WS_OG + (size_t)3 * MP * 512 * 2;
constexpr size_t WS_OATT = WS_LSE + (size_t)3 * MP * 4 * 4;
constexpr size_t WS_OHG = WS_OATT + (size_t)MP * 512 * 2;
constexpr size_t WS_YMIX = WS_OHG + (size_t)MP * 1024 * 2;
constexpr size_t WS_BLK_END = WS_YMIX + (size_t)MP * D * 2;
constexpr size_t WS_G = WS_OG;
static_assert(WS_G + (size_t)MP * DFF * 2 <= WS_BLK_END + (32u << 20), "g overlay");
static_assert((size_t)MP * NAB * 2 <= (size_t)MP * NZ * 2, "ab overlay");
constexpr size_t WS_HS = WS_BLK_END;
constexpr size_t WS_HD = WS_HS + (size_t)256 * 8 * 128 * 128 * 4;
constexpr size_t WS_TMP = WS_HS;
constexpr size_t WS_ACC_WO = WS_Z;
constexpr size_t WS_ACC_DN = WS_Z;
constexpr size_t WS_ACC_UP = WS_TMP + (64u << 20);
constexpr int NSP_WO = 8, NSP_DN = 22, NSP_UP = 8, NSP_PA = 2, NSP_PB = 4;
constexpr size_t WS_ACC_PA = WS_H, WS_ACC_PB = WS_H + (size_t)NSP_PA * NS * D * 4;
static_assert((size_t)NSP_UP * NS * NAB * 4 + (64u << 20) <= (size_t)MP * D * 4, "up partials");
constexpr size_t WS_END = WS_TMP + (size_t)MP * D * 4 + (1u << 20);
static_assert(WS_HD + (size_t)256 * 8 * 128 * 4 <= WS_END, "hd");
static_assert(WS_WIN % 256 == 0 && WS_MOD % 256 == 0 && WS_ROPE % 256 == 0 && WS_Z % 256 == 0 && WS_H % 256 == 0 && WS_OG % 256 == 0 && WS_LSE % 256 == 0 && WS_OATT % 256 == 0 && WS_OHG % 256 == 0 && WS_YMIX % 256 == 0 && WS_HS % 256 == 0 && WS_HD % 256 == 0, "align");
constexpr int LDS_BYTES = 131072 + 4096 + 256;
constexpr int NPH = 18;

struct Params { const float* in[25]; float* out; unsigned char* ws; int ph_lo, ph_hi; };

DI float bf2f(unsigned b) { return __uint_as_float(b << 16); }
DI float bflo(unsigned w) { return __uint_as_float(w << 16); }
DI float bfhi(unsigned w) { return __uint_as_float(w & 0xffff0000u); }
DI unsigned pk2(float lo, float hi) { unsigned r; asm("v_cvt_pk_bf16_f32 %0, %1, %2" : "=v"(r) : "v"(lo), "v"(hi)); return r; }
DI float sigm(float x) { return 1.f / (1.f + __expf(-x)); }
DI float silu(float x) { return x / (1.f + __expf(-x)); }
DI float wave_sum(float v) {
#pragma unroll
    for (int o = 32; o >= 1; o >>= 1) v += __shfl_xor(v, o);
    return v;
}
DI float wave_max(float v) {
#pragma unroll
    for (int o = 32; o >= 1; o >>= 1) v = fmaxf(v, __shfl_xor(v, o));
    return v;
}
DI void lds_fence() { asm volatile("s_waitcnt lgkmcnt(0)" ::: "memory"); __builtin_amdgcn_wave_barrier(); }
DI bf16x8 gat8(const LAS bf16_t* p, int stride) {
    bf16x8 r;
#pragma unroll
    for (int j = 0; j < 8; ++j) r[j] = (short)p[j * stride];
    return r;
}
DI bf16x8 ld8(const LAS bf16_t* p) { return *(const LAS bf16x8*)p; }
typedef short s16x4 __attribute__((ext_vector_type(4)));
template <int OFF> DI s16x4 tr_read(unsigned vb) { s16x4 r; asm volatile("ds_read_b64_tr_b16 %0, %1 offset:%2" : "=&v"(r) : "v"(vb), "i"(OFF) : "memory"); return r; }
DI f32x4 mfma16(bf16x8 a, bf16x8 b, f32x4 c) { return __builtin_amdgcn_mfma_f32_16x16x32_bf16(a, b, c, 0, 0, 0); }
DI f32x16 mfma32(bf16x8 a, bf16x8 b, f32x16 c) { return __builtin_amdgcn_mfma_f32_32x32x16_bf16(a, b, c, 0, 0, 0); }
DI void unpack8(u32x4 w, float (&f)[8]) { f[0] = bflo(w.x); f[1] = bfhi(w.x); f[2] = bflo(w.y); f[3] = bfhi(w.y); f[4] = bflo(w.z); f[5] = bfhi(w.z); f[6] = bflo(w.w); f[7] = bfhi(w.w); }
DI void atom_add(float* p, float v) { (void)__hip_atomic_fetch_add(p, v, __ATOMIC_RELAXED, __HIP_MEMORY_SCOPE_AGENT); }
DI void ld8f(const float* s, float (&f)[8]) { const f32x4 a = *(const f32x4*)s, b = *(const f32x4*)(s + 4); f[0] = a[0]; f[1] = a[1]; f[2] = a[2]; f[3] = a[3]; f[4] = b[0]; f[5] = b[1]; f[6] = b[2]; f[7] = b[3]; }
DI int crow_of(int r) { return r < TP ? 0 : 1 + ((r - TP) >> 2); }

struct EpiZ {
    static constexpr bool PERM = true, AFTER_DRAIN = false;
    bf16_t* Z; const float* rope; float* out; const float* c0; const float* c1; const float* c2;
    static constexpr int CPY_R0 = 32 * 124, CPY_R1 = 32 * 508, CPY_R2 = 32 * 2044, CPY_ROWS = CPY_R0 + CPY_R1 + CPY_R2, CPY_PER = 28;
    DI void cpy_row(int r, const float*& src, float*& dst) const {
        if (r < CPY_R0) { const int b = r / 124, rr = r - b * 124; src = c0 + ((size_t)(b * 128 + rr + 4)) * 1024; dst = out + OFF_KVS0 + ((size_t)(b * 128 + rr)) * 1024; }
        else if (r < CPY_R0 + CPY_R1) { r -= CPY_R0; const int b = r / 508, rr = r - b * 508; src = c1 + ((size_t)(b * 512 + rr + 4)) * 1024; dst = out + OFF_KVS1 + ((size_t)(b * 512 + rr)) * 1024; }
        else { r -= CPY_R0 + CPY_R1; const int b = r / 2044, rr = r - b * 2044; src = c2 + ((size_t)(b * 2048 + rr + 4)) * 1024; dst = out + OFF_KVS2 + ((size_t)(b * 2048 + rr)) * 1024; }
    }
    DI void operator()(const f32x4 (&acc)[2][2][4][2], const Unit& u, int wr, int wc, int fr, int fq) const {
        {
            int l4 = (wc * 64 + fq * 16 + fr) * 4; asm volatile("" : "+v"(l4));
            const int r0 = (u.pm * 50 + u.pn) * CPY_PER;
#pragma unroll
            for (int h2 = 0; h2 < 2; ++h2) {
                f32x4 v[7];
#pragma unroll
                for (int q = 0; q < 7; ++q) { int r = r0 + (h2 * 7 + q) * 2 + wr; r = r < CPY_ROWS ? r : r - CPY_ROWS; const float* sp; float* dp; cpy_row(r, sp, dp); v[q] = __builtin_nontemporal_load((const f32x4*)(sp + l4)); }
#pragma unroll
                for (int q = 0; q < 7; ++q) { int r = r0 + (h2 * 7 + q) * 2 + wr; r = r < CPY_ROWS ? r : r - CPY_ROWS; const float* sp; float* dp; cpy_row(r, sp, dp); __builtin_nontemporal_store(v[q], (f32x4*)(dp + l4)); }
            }
        }
        const int kind = u.pn < 6 ? 0 : (u.pn < 12 ? 1 : (u.pn < 18 ? 2 : 3));
        const bool do_rope = (kind <= 1) && (wc == 0);
        const int pnn = (kind == 1) ? u.pn - 6 : u.pn - 12;
        const int g = pnn >> 1, W = 128 << (2 * g);
        const size_t offp = g == 0 ? OFF_KVP0 : (g == 1 ? OFF_KVP1 : OFF_KVP2), offs = g == 0 ? OFF_KVS0 : (g == 1 ? OFF_KVS1 : OFF_KVS2);
        const float sg = (fq < 2) ? -1.f : 1.f;
#pragma unroll
        for (int ai = 0; ai < 2; ++ai)
#pragma unroll
            for (int m = 0; m < 4; ++m) {
                const int r = u.pm * 256 + ai * 128 + wr * 64 + m * 16 + fr;
                f32x4 cs0 = {0.f, 0.f, 0.f, 0.f}, cs1 = cs0, sn0 = cs0, sn1 = cs0;
                if (do_rope) { const float* rp = rope + (size_t)r * 32 + 8 * (fq & 1); cs0 = *(const f32x4*)rp; cs1 = *(const f32x4*)(rp + 4); sn0 = *(const f32x4*)(rp + 16); sn1 = *(const f32x4*)(rp + 20); }
#pragma unroll
                for (int bj = 0; bj < 2; ++bj) {
                    f32x4 v0 = acc[ai][bj][m][0], v1 = acc[ai][bj][m][1];
                    if (do_rope) {
                        f32x4 p0, p1;
#pragma unroll
                        for (int j = 0; j < 4; ++j) { p0[j] = __shfl_xor(v0[j], 32); p1[j] = __shfl_xor(v1[j], 32); }
                        v0 = v0 * cs0 + sg * (p0 * sn0); v1 = v1 * cs1 + sg * (p1 * sn1);
                    }
                    const int c = u.pn * 256 + bj * 128 + wc * 32 + 8 * fq;
                    u32x4 w; w.x = pk2(v0[0], v0[1]); w.y = pk2(v0[2], v0[3]); w.z = pk2(v1[0], v1[1]); w.w = pk2(v1[2], v1[3]);
                    *(u32x4*)(Z + (size_t)r * NZ + c) = w;
                    if (kind == 1 || kind == 2) {
                        const int hh = 2 * (pnn & 1) + bj, dd = wc * 32 + 8 * fq, kv = kind - 1;
                        float* dst = nullptr;
                        if (r < TP) { if (r >= TP - W) dst = out + offp + ((size_t)(r - (TP - W)) * 2 + kv) * 512 + hh * 128 + dd; }
                        else if (r < MR) { const int b = (r - TP) >> 2, t = (r - TP) & 3; dst = out + offs + ((size_t)(b * W + W - 4 + t) * 2 + kv) * 512 + hh * 128 + dd; }
                        if (dst) { *(f32x4*)dst = v0; *(f32x4*)(dst + 4) = v1; }
                    }
                }
            }
    }
};
struct EpiMix1 {
    static constexpr bool PERM = false, AFTER_DRAIN = false;
    const bf16_t* Z; float* TMP; float* accs;
    DI void operator()(const f32x4 (&acc)[2][2][4][2], const Unit& u, int wr, int wc, int fr, int fq) const {
        if (u.pm == 64) {
#pragma unroll
            for (int m = 0; m < 4; ++m)
#pragma unroll
                for (int bj = 0; bj < 2; ++bj)
#pragma unroll
                    for (int n = 0; n < 2; ++n) *(f32x4*)(accs + ((size_t)(u.kt0 >> 2) * NS + (wr * 64 + m * 16 + fr)) * D + u.pn * 256 + bj * 128 + wc * 32 + 16 * n + 4 * fq) = acc[0][bj][m][n];
            return;
        }
#pragma unroll
        for (int ai = 0; ai < 2; ++ai)
#pragma unroll
            for (int m = 0; m < 4; ++m) {
                const int r = u.pm * 256 + ai * 128 + wr * 64 + m * 16 + fr;
#pragma unroll
                for (int bj = 0; bj < 2; ++bj)
#pragma unroll
                    for (int n = 0; n < 2; ++n) {
                        const int c = u.pn * 256 + bj * 128 + wc * 32 + 16 * n + 4 * fq;
                        const u32x2 gw = *(const u32x2*)(Z + (size_t)r * NZ + ZGA + c);
                        f32x4 v = acc[ai][bj][m][n];
                        v[0] *= sigm(bflo(gw.x)); v[1] *= sigm(bfhi(gw.x)); v[2] *= sigm(bflo(gw.y)); v[3] *= sigm(bfhi(gw.y));
                        *(f32x4*)(TMP + (size_t)r * D + c) = v;
                    }
            }
    }
};
struct EpiMix2 {
    static constexpr bool PERM = false, AFTER_DRAIN = false;
    const bf16_t* Z; const float* TMP; bf16_t* Y; float* accs;
    DI void operator()(const f32x4 (&acc)[2][2][4][2], const Unit& u, int wr, int wc, int fr, int fq) const {
        if (u.pm == 64) {
#pragma unroll
            for (int m = 0; m < 4; ++m)
#pragma unroll
                for (int bj = 0; bj < 2; ++bj)
#pragma unroll
                    for (int n = 0; n < 2; ++n) *(f32x4*)(accs + ((size_t)(u.kt0 >> 2) * NS + (wr * 64 + m * 16 + fr)) * D + u.pn * 256 + bj * 128 + wc * 32 + 16 * n + 4 * fq) = acc[0][bj][m][n];
            return;
        }
#pragma unroll
        for (int ai = 0; ai < 2; ++ai)
#pragma unroll
            for (int m = 0; m < 4; ++m) {
                const int r = u.pm * 256 + ai * 128 + wr * 64 + m * 16 + fr;
#pragma unroll
                for (int bj = 0; bj < 2; ++bj)
#pragma unroll
                    for (int n = 0; n < 2; ++n) {
                        const int c = u.pn * 256 + bj * 128 + wc * 32 + 16 * n + 4 * fq;
                        const u32x2 gw = *(const u32x2*)(Z + (size_t)r * NZ + ZGB + c);
                        const f32x4 t = *(const f32x4*)(TMP + (size_t)r * D + c);
                        f32x4 v = acc[ai][bj][m][n];
                        v[0] = t[0] + v[0] * sigm(bflo(gw.x)); v[1] = t[1] + v[1] * sigm(bfhi(gw.x)); v[2] = t[2] + v[2] * sigm(bflo(gw.y)); v[3] = t[3] + v[3] * sigm(bfhi(gw.y));
                        u32x2 w; w.x = pk2(v[0], v[1]); w.y = pk2(v[2], v[3]);
                        *(u32x2*)(Y + (size_t)r * D + c) = w;
                    }
            }
    }
};
struct EpiWO {
    static constexpr bool PERM = false, AFTER_DRAIN = false;
    const float* xp; const float* xs; const float* mod; float* out; float* accs;
    DI void operator()(const f32x4 (&acc)[2][2][4][2], const Unit& u, int wr, int wc, int fr, int fq) const {
        if (u.pm == 64) {
#pragma unroll
            for (int m = 0; m < 4; ++m)
#pragma unroll
                for (int bj = 0; bj < 2; ++bj)
#pragma unroll
                    for (int n = 0; n < 2; ++n) {
                        float* d = accs + ((size_t)(u.kt0 >> 2) * NS + (wr * 64 + m * 16 + fr)) * D + u.pn * 256 + bj * 128 + wc * 32 + 16 * n + 4 * fq;
                        *(f32x4*)d = acc[0][bj][m][n];
                    }
            return;
        }
#pragma unroll
        for (int ai = 0; ai < 2; ++ai)
#pragma unroll
            for (int m = 0; m < 4; ++m) {
                const int r = u.pm * 256 + ai * 128 + wr * 64 + m * 16 + fr;
                if (r < MR) {
                    const float* xr = r < TP ? xp + (size_t)r * D : xs + (size_t)(r - TP) * D;
                    const float* g1 = mod + (size_t)crow_of(r) * NMOD + 2 * D;
#pragma unroll
                    for (int bj = 0; bj < 2; ++bj)
#pragma unroll
                        for (int n = 0; n < 2; ++n) {
                            const int c = u.pn * 256 + bj * 128 + wc * 32 + 16 * n + 4 * fq;
                            const f32x4 xv = *(const f32x4*)(xr + c), gv = *(const f32x4*)(g1 + c);
                            *(f32x4*)(out + (size_t)r * D + c) = xv + gv * acc[ai][bj][m][n];
                        }
                }
            }
    }
};
struct EpiDown {
    static constexpr bool PERM = false, AFTER_DRAIN = false;
    const float* mod; float* out; float* accs;
    DI void operator()(const f32x4 (&acc)[2][2][4][2], const Unit& u, int wr, int wc, int fr, int fq) const {
        if (u.pm == 64) {
#pragma unroll
            for (int m = 0; m < 4; ++m)
#pragma unroll
                for (int bj = 0; bj < 2; ++bj)
#pragma unroll
                    for (int n = 0; n < 2; ++n) {
                        float* d = accs + ((size_t)(u.kt0 >> 2) * NS + (wr * 64 + m * 16 + fr)) * D + u.pn * 256 + bj * 128 + wc * 32 + 16 * n + 4 * fq;
                        *(f32x4*)d = acc[0][bj][m][n];
                    }
            return;
        }
#pragma unroll
        for (int ai = 0; ai < 2; ++ai)
#pragma unroll
            for (int m = 0; m < 4; ++m) {
                const int r = u.pm * 256 + ai * 128 + wr * 64 + m * 16 + fr;
                if (r < MR) {
                    const float* g2 = mod + (size_t)crow_of(r) * NMOD + 5 * D;
#pragma unroll
                    for (int bj = 0; bj < 2; ++bj)
#pragma unroll
                        for (int n = 0; n < 2; ++n) {
                            const int c = u.pn * 256 + bj * 128 + wc * 32 + 16 * n + 4 * fq;
                            float* o = out + (size_t)r * D + c;
                            const f32x4 xv = *(const f32x4*)o, gv = *(const f32x4*)(g2 + c);
                            *(f32x4*)o = xv + gv * acc[ai][bj][m][n];
                        }
                }
            }
    }
};
struct EpiUp {
    static constexpr bool PERM = true, AFTER_DRAIN = false;
    bf16_t* AB; bf16_t* G; float* out; float* accs; const float* cw; const float* cb; LAS float* xch;
    DI void operator()(const f32x4 (&acc)[2][2][4][2], const Unit& u, int wr, int wc, int fr, int fq) const {
        int cl = 32 * wc + 8 * fq;
        if (u.pm == 64) {
#pragma unroll
            for (int m = 0; m < 4; ++m)
#pragma unroll
                for (int bj = 0; bj < 2; ++bj)
#pragma unroll
                    for (int n = 0; n < 2; ++n) {
                        float* d = accs + ((size_t)(u.kt0 >> 2) * NS + (wr * 64 + m * 16 + fr)) * NAB + bj * DFF + 128 * u.pn + cl + 4 * n;
                        *(f32x4*)d = acc[0][bj][m][n];
                    }
            return;
        }
        asm volatile("" : "+v"(cl), "+v"(fr), "+v"(fq));
        const int lane = fq * 16 + fr;
        if (fr >= 14) {
#pragma unroll
            for (int ai = 0; ai < 2; ++ai) { LAS float* d = xch + ((2 * ai + wr) * 2 + (fr - 14)) * 128 + cl; *(LAS f32x4*)d = acc[ai][0][3][0]; *(LAS f32x4*)(d + 4) = acc[ai][0][3][1]; }
        }
        asm volatile("s_waitcnt lgkmcnt(0)" ::: "memory"); __builtin_amdgcn_s_barrier(); __builtin_amdgcn_s_barrier(); asm volatile("" ::: "memory");
        const int src1 = (lane & 48) | ((fr + 15) & 15), src2 = (lane & 48) | ((fr + 14) & 15);
#pragma unroll
        for (int n = 0; n < 2; ++n) {
            const int c = 128 * u.pn + cl + 4 * n;
            const f32x4 w0 = *(const f32x4*)(cw + c), w1 = *(const f32x4*)(cw + DFF + c), w2 = *(const f32x4*)(cw + 2 * DFF + c), bb = *(const f32x4*)(cb + c);
#pragma unroll
            for (int ai = 0; ai < 2; ++ai) {
                const int q = 2 * ai + wr;
                f32x4 y1 = {0.f, 0.f, 0.f, 0.f}, z1 = y1;
                if (q > 0) { y1 = *(const LAS f32x4*)(xch + ((q - 1) * 2 + 1) * 128 + cl + 4 * n); z1 = *(const LAS f32x4*)(xch + ((q - 1) * 2 + (fr == 0 ? 0 : 1)) * 128 + cl + 4 * n); }
#pragma unroll
                for (int m = 0; m < 4; ++m) {
                    const f32x4 av = acc[ai][0][m][n], bv = acc[ai][1][m][n];
                    f32x4 o;
#pragma unroll
                    for (int j = 0; j < 4; ++j) {
                        const float y = __shfl(av[j], src1), z = __shfl(av[j], src2);
                        const float a1 = fr >= 1 ? y : y1[j], a0 = fr >= 2 ? z : z1[j];
                        y1[j] = y; z1[j] = z;
                        const float uu = bb[j] + w0[j] * a0 + w1[j] * a1 + w2[j] * av[j];
                        o[j] = silu(uu) * bv[j];
                    }
                    const int rl = 128 * ai + 64 * wr + 16 * m + fr, rg = 256 * u.pm + rl;
                    const bool edge0 = rl < 2, edge1 = rl >= 254;
                    if (!(edge0 && u.pm > 0)) { u32x2 w; w.x = pk2(o[0], o[1]); w.y = pk2(o[2], o[3]); *(u32x2*)(G + (size_t)rg * DFF + c) = w; }
                    if (edge0 || edge1) {
                        u32x2 w; w.x = pk2(av[0], av[1]); w.y = pk2(av[2], av[3]); *(u32x2*)(AB + (size_t)rg * NAB + c) = w;
                        if (edge0) { u32x2 x; x.x = pk2(bv[0], bv[1]); x.y = pk2(bv[2], bv[3]); *(u32x2*)(AB + (size_t)rg * NAB + DFF + c) = x; }
                        if (edge1 && u.pm == 63) *(f32x4*)(out + OFF_CVP + (size_t)(rl - 254) * DFF + c) = av;
                    }
                    asm volatile("" ::: "memory");
                }
            }
        }
    }
};

DI void ph_mod(const Params& p, LAS unsigned char* L, float* mod) {
    LAS float* sS = (LAS float*)L;
    LAS float* sRed = (LAS float*)L;
    const int tid = threadIdx.x, cgp = tid % 24, ksub = tid / 24;
    const float* cpr = p.in[7]; const float* csm = p.in[8]; const float* wada = p.in[9]; const float* bada = p.in[10];
    for (int nb = blockIdx.x; nb < 256; nb += gridDim.x) {
        const int n0 = nb * 48;
        float acc[33][2];
#pragma unroll
        for (int r = 0; r < 33; ++r) { acc[r][0] = 0.f; acc[r][1] = 0.f; }
        for (int kc = 0; kc < 4; ++kc) {
            f32x2 wv[25];
#pragma unroll
            for (int q = 0; q < 25; ++q) { const int kk = ksub + 21 * q; wv[q] = (ksub < 21 && kk < 512) ? *(const f32x2*)(wada + (size_t)(kc * 512 + kk) * NMOD + n0 + 2 * cgp) : (f32x2){0.f, 0.f}; }
            for (int idx = tid; idx < 33 * 512; idx += 512) {
                const int r = idx >> 9, kk = idx & 511;
                const float c = r == 0 ? cpr[kc * 512 + kk] : csm[(r - 1) * D + kc * 512 + kk];
                sS[kk * 36 + r] = silu(c);
            }
            __syncthreads();
#pragma unroll
            for (int q = 0; q < 25; ++q) {
                const int kk = ksub + 21 * q;
                if (ksub < 21 && kk < 512) {
                    const f32x2 w = wv[q];
                    const LAS f32x4* sp = (const LAS f32x4*)(sS + kk * 36);
#pragma unroll
                    for (int r4 = 0; r4 < 9; ++r4) {
                        const f32x4 sv = sp[r4];
#pragma unroll
                        for (int j = 0; j < 4; ++j) { if (4 * r4 + j < 33) { acc[4 * r4 + j][0] += sv[j] * w[0]; acc[4 * r4 + j][1] += sv[j] * w[1]; } }
                    }
                }
            }
            __syncthreads();
        }
#pragma unroll
        for (int r0 = 0; r0 < 33; r0 += 11) {
            if (ksub < 21) {
#pragma unroll
                for (int i = 0; i < 11; ++i) { sRed[ksub * 528 + i * 48 + 2 * cgp] = acc[r0 + i][0]; sRed[ksub * 528 + i * 48 + 2 * cgp + 1] = acc[r0 + i][1]; }
            }
            __syncthreads();
            for (int o = tid; o < 528; o += 512) {
                float sum = 0.f;
                for (int k2 = 0; k2 < 21; ++k2) sum += sRed[k2 * 528 + o];
                const int i = o / 48, c = o % 48;
                mod[(size_t)(r0 + i) * NMOD + n0 + c] = sum + bada[n0 + c];
            }
            __syncthreads();
        }
    }
}
DI void tr_load(const float* W, int N, int r, int lane, f32x4 (&v)[8]) {
    const int nblk = N / 32, kb = r / nblk, nb = r % nblk, k0 = 64 * kb, n0 = 32 * nb;
#pragma unroll
    for (int i = 0; i < 8; ++i) v[i] = *(const f32x4*)(W + (size_t)(k0 + 8 * i + (lane >> 3)) * N + n0 + 4 * (lane & 7));
}
DI void tr_finish(bf16_t* WT, int K, int N, int inter, int r, LAS float* scr, int lane, const f32x4 (&v)[8]) {
    const int nblk = N / 32, kb = r / nblk, nb = r % nblk, k0 = 64 * kb, n0 = 32 * nb;
#pragma unroll
    for (int i = 0; i < 8; ++i) { LAS float* dd = scr + (8 * i + (lane >> 3)) * 33 + 4 * (lane & 7); dd[0] = v[i][0]; dd[1] = v[i][1]; dd[2] = v[i][2]; dd[3] = v[i][3]; }
    lds_fence();
    const int c = lane & 7;
#pragma unroll
    for (int j = 0; j < 4; ++j) { const int n = (lane >> 3) + 8 * j; const LAS float* s = scr + (8 * c) * 33 + n;
        u32x4 o; o.x = pk2(s[0 * 33], s[1 * 33]); o.y = pk2(s[2 * 33], s[3 * 33]); o.z = pk2(s[4 * 33], s[5 * 33]); o.w = pk2(s[6 * 33], s[7 * 33]);
        const int na = n0 + n, drow = inter < 0 ? na : ((na >> 7) << 8) + inter * 128 + (na & 127);
        *(u32x4*)(WT + (size_t)drow * K + k0 + 8 * c) = o; }
    lds_fence();
}
constexpr int TR_I_IN = 32 * 400, TR_I_PA = 8 * 64, TR_I_PB = 16 * 64, TR_I_O = 32 * 64, TR_I_A = 32 * 176, TR_I_DN = 88 * 64;
constexpr int TR_NITEMS = TR_I_IN + TR_I_PA + TR_I_PB + TR_I_O + 2 * TR_I_A + TR_I_DN;
struct TrSrc { const float *w_in, *w_pa, *w_pb, *w_o, *w_a, *w_b, *w_dn; };
DI void tr_decode(const TrSrc& q, unsigned char* ws, int it, const float*& W, bf16_t*& WT, int& K, int& N, int& inter, int& r) {
    r = it; inter = -1;
    if (r < TR_I_IN) { W = q.w_in; WT = (bf16_t*)(ws + WS_WIN); K = D; N = NZ; return; } r -= TR_I_IN;
    if (r < TR_I_PA) { W = q.w_pa; WT = (bf16_t*)(ws + WS_WPA); K = 512; N = D; return; } r -= TR_I_PA;
    if (r < TR_I_PB) { W = q.w_pb; WT = (bf16_t*)(ws + WS_WPB); K = 1024; N = D; return; } r -= TR_I_PB;
    if (r < TR_I_O) { W = q.w_o; WT = (bf16_t*)(ws + WS_WO); K = D; N = D; return; } r -= TR_I_O;
    if (r < TR_I_A) { W = q.w_a; WT = (bf16_t*)(ws + WS_WAB); K = D; N = DFF; inter = 0; return; } r -= TR_I_A;
    if (r < TR_I_A) { W = q.w_b; WT = (bf16_t*)(ws + WS_WAB); K = D; N = DFF; inter = 1; return; } r -= TR_I_A;
    W = q.w_dn; WT = (bf16_t*)(ws + WS_WDN); K = DFF; N = D;
}
DI void ph_prologue(const Params& p, LAS unsigned char* L) {
    unsigned char* ws = p.ws;
    const int tid = threadIdx.x, lane = tid & 63, wave = tid >> 6;
    const int gw = blockIdx.x * 8 + wave, NGW = gridDim.x * 8;
    const size_t gtid = (size_t)blockIdx.x * 512 + tid, gstride = (size_t)gridDim.x * 512;
    ph_mod(p, L, (float*)(ws + WS_MOD));
    LAS float* scr = (LAS float*)(L + wave * 8448);
    const TrSrc tq{p.in[12], p.in[15], p.in[16], p.in[17], p.in[19], p.in[20], p.in[23]};
    for (int it = gw; it < TR_NITEMS; it += 2 * NGW) {
        const float* W0; bf16_t* T0; int K0, N0, i0, r0; tr_decode(tq, ws, it, W0, T0, K0, N0, i0, r0);
        const int it1 = it + NGW; const bool two = it1 < TR_NITEMS;
        const float* W1; bf16_t* T1; int K1, N1, i1, r1; tr_decode(tq, ws, two ? it1 : it, W1, T1, K1, N1, i1, r1);
        f32x4 v0[8], v1[8];
        tr_load(W0, N0, r0, lane, v0); tr_load(W1, N1, r1, lane, v1);
        tr_finish(T0, K0, N0, i0, r0, scr, lane, v0);
        if (two) tr_finish(T1, K1, N1, i1, r1, scr, lane, v1);
    }
    {
        float* rope = (float*)(ws + WS_ROPE);
        for (size_t idx = gtid; idx < (size_t)MR * 16; idx += gstride) {
            const int m = (int)(idx >> 4), i = (int)(idx & 15);
            const int pos = m < TP ? m : TP + ((m - TP) & 3);
            const float invf = (float)exp2(-(double)i * (18.931568569324174 / 16.0));
            const float ang = (float)pos * invf;
            const double x = (double)ang, n = rint(x * 0.15915494309189535);
            double rr = fma(-n, 6.283185307179586, x); rr = fma(-n, 2.4492935982947064e-16, rr);
            rope[(size_t)m * 32 + i] = cosf((float)rr); rope[(size_t)m * 32 + 16 + i] = sinf((float)rr);
        }
    }
}
DI const float* hn_src(const Params& p, const float* xbase, bool from_out, int m) {
    const bool fix = from_out && m >= TP;
    return (from_out && !fix) ? xbase + (size_t)m * D : (m < TP ? p.in[0] + (size_t)m * D : p.in[1] + (size_t)(m - TP) * D);
}
DI void ph_hnorm(const Params& p, float* xbase, bool from_out, const float* nw, int sh_idx, bf16_t* H) {
    const int lane = threadIdx.x & 63, wave = threadIdx.x >> 6, stride = gridDim.x * 8;
    const float* mod = (const float*)(p.ws + WS_MOD);
    int m = blockIdx.x * 8 + wave;
    f32x4 v[8];
    if (m < MR) { const float* xr = hn_src(p, xbase, from_out, m);
#pragma unroll
        for (int j = 0; j < 8; ++j) v[j] = *(const f32x4*)(xr + 4 * lane + 256 * j); }
    while (m < MR) {
        const int mn = m + stride; f32x4 vn[8];
        if (mn < MR) { const float* xr = hn_src(p, xbase, from_out, mn);
#pragma unroll
            for (int j = 0; j < 8; ++j) vn[j] = *(const f32x4*)(xr + 4 * lane + 256 * j); }
        const bool fix = from_out && m >= TP;
        const float* md = mod + (size_t)crow_of(m) * NMOD + sh_idx * D;
        float ss = 0.f;
#pragma unroll
        for (int j = 0; j < 8; ++j) { const int c = 4 * lane + 256 * j;
            if (fix) { f32x4 a = {0.f, 0.f, 0.f, 0.f}; for (int q = 0; q < NSP_WO; ++q) a = a + *(const f32x4*)((const float*)(p.ws + WS_ACC_WO) + ((size_t)q * NS + (m - TP)) * D + c); const f32x4 g = *(const f32x4*)(mod + (size_t)crow_of(m) * NMOD + 2 * D + c); v[j] = v[j] + g * a; *(f32x4*)(xbase + (size_t)m * D + c) = v[j]; }
            ss += v[j][0] * v[j][0] + v[j][1] * v[j][1] + v[j][2] * v[j][2] + v[j][3] * v[j][3]; }
        const float rstd = rsqrtf(wave_sum(ss) * (1.f / D) + EPS);
#pragma unroll
        for (int j = 0; j < 8; ++j) {
            const int c = 4 * lane + 256 * j;
            const f32x4 w = *(const f32x4*)(nw + c), shv = *(const f32x4*)(md + c), scv = *(const f32x4*)(md + D + c);
            const f32x4 o = (v[j] * rstd) * w * (1.f + scv) + shv;
            u32x2 q; q.x = pk2(o[0], o[1]); q.y = pk2(o[2], o[3]);
            *(u32x2*)(H + (size_t)m * D + c) = q;
        }
#pragma unroll
        for (int j = 0; j < 8; ++j) v[j] = vn[j];
        m = mn;
    }
}
DI void ph_final_norm(const Params& p) {
    const int lane = threadIdx.x & 63, wave = threadIdx.x >> 6, stride = gridDim.x * 8;
    const float* nw = p.in[24];
    int m = blockIdx.x * 8 + wave;
    f32x4 v[8];
    if (m < MR) {
#pragma unroll
        for (int j = 0; j < 8; ++j) v[j] = *(const f32x4*)(p.out + (size_t)m * D + 4 * lane + 256 * j); }
    while (m < MR) {
        const int mn = m + stride; f32x4 vn[8];
        if (mn < MR) {
#pragma unroll
            for (int j = 0; j < 8; ++j) vn[j] = *(const f32x4*)(p.out + (size_t)mn * D + 4 * lane + 256 * j); }
        float* xr = p.out + (size_t)m * D;
        float ss = 0.f;
#pragma unroll
        for (int j = 0; j < 8; ++j) { const int c = 4 * lane + 256 * j;
            if (m >= TP) { f32x4 a = {0.f, 0.f, 0.f, 0.f}; for (int q = 0; q < NSP_DN; ++q) a = a + *(const f32x4*)((const float*)(p.ws + WS_ACC_DN) + ((size_t)q * NS + (m - TP)) * D + c); const f32x4 g = *(const f32x4*)((const float*)(p.ws + WS_MOD) + (size_t)crow_of(m) * NMOD + 5 * D + c); v[j] = v[j] + g * a; }
            ss += v[j][0] * v[j][0] + v[j][1] * v[j][1] + v[j][2] * v[j][2] + v[j][3] * v[j][3]; }
        const float rstd = rsqrtf(wave_sum(ss) * (1.f / D) + EPS);
#pragma unroll
        for (int j = 0; j < 8; ++j) { const int c = 4 * lane + 256 * j; const f32x4 w = *(const f32x4*)(nw + c); *(f32x4*)(xr + c) = (v[j] * rstd) * w; }
#pragma unroll
        for (int j = 0; j < 8; ++j) v[j] = vn[j];
        m = mn;
    }
}

DI void attn_prompt_item(const bf16_t* Z, bf16_t* OG, float* LSE, LAS bf16_t* Vl, int item, int lane) {
    const int g = item >> 11, rem = item & 2047, hh = rem >> 9, bidx = rem & 511;
    const int dsh = 2 * g, nsh = 9 - dsh;
    const int res = bidx >> nsh, blk = bidx & ((1 << nsh) - 1);
    const int s0 = blk * 32, head = g * 4 + hh;
    const int qi = lane & 31, h = lane >> 5;
    const int tq = res + ((s0 + qi) << dsh);
    bf16x8 Qf[8];
    { const bf16_t* qp = Z + (size_t)tq * NZ + ZQ + head * 128 + 8 * h;
#pragma unroll
      for (int ks = 0; ks < 8; ++ks) Qf[ks] = *(const bf16x8*)(qp + 16 * ks); }
    float mrun = -INFINITY, lrun = 0.f;
    f32x16 O[4];
#pragma unroll
    for (int dt = 0; dt < 4; ++dt)
#pragma unroll
        for (int i = 0; i < 16; ++i) O[dt][i] = 0.f;
    const int sq = s0 + qi;
    const int vrow = lane >> 4, vch = lane & 15;
    const unsigned vtr = (unsigned)(unsigned long long)Vl + (unsigned)(((4 * h + ((lane & 15) >> 2)) * 136 + 16 * ((lane >> 4) & 1) + 4 * (lane & 3)) * 2);
    bf16x8 Kc[8]; u32x4 Vr[8];
#define ATT_LOAD_KV(kt_) do { const int kb_ = s0 - 128 + 32 * (kt_); int skl_ = kb_ + qi; skl_ = skl_ < 0 ? 0 : skl_; \
        const bf16_t* kp_ = Z + (size_t)(res + (skl_ << dsh)) * NZ + ZK + head * 128 + 8 * h; \
        _Pragma("unroll") for (int ks = 0; ks < 8; ++ks) Kc[ks] = *(const bf16x8*)(kp_ + 16 * ks); \
        _Pragma("unroll") for (int i = 0; i < 8; ++i) { int sv_ = kb_ + 4 * i + vrow; sv_ = sv_ < 0 ? 0 : sv_; \
            Vr[i] = *(const u32x4*)(Z + (size_t)(res + (sv_ << dsh)) * NZ + ZV + head * 128 + 8 * vch); } } while (0)
    ATT_LOAD_KV(4);
    for (int kt = 4; kt >= 0; --kt) {
        const int kb = s0 - 128 + 32 * kt;
        f32x16 S;
#pragma unroll
        for (int i = 0; i < 16; ++i) S[i] = 0.f;
#pragma unroll
        for (int ks = 0; ks < 8; ++ks) S = mfma32(Kc[ks], Qf[ks], S);
#pragma unroll
        for (int i = 0; i < 8; ++i) *(LAS u32x4*)(Vl + (4 * i + vrow) * 136 + 8 * vch) = Vr[i];
        if (kt > 0) ATT_LOAD_KV(kt - 1);
        float tmax = -INFINITY;
#pragma unroll
        for (int i = 0; i < 16; ++i) {
            const int sk = kb + (i & 3) + 8 * (i >> 2) + 4 * h;
            const bool valid = (sk >= 0) && (sk <= sq) && (sk >= sq - 128);
            S[i] = valid ? S[i] * ATT_SCALE : -INFINITY;
            tmax = fmaxf(tmax, S[i]);
        }
        tmax = fmaxf(tmax, __shfl_xor(tmax, 32));
        const float mn = fmaxf(mrun, tmax), alpha = __expf(mrun - mn);
        float ps = 0.f;
#pragma unroll
        for (int i = 0; i < 16; ++i) { S[i] = __expf(S[i] - mn); ps += S[i]; }
        ps += __shfl_xor(ps, 32);
        lrun = lrun * alpha + ps; mrun = mn;
#pragma unroll
        for (int dt = 0; dt < 4; ++dt) O[dt] = O[dt] * alpha;
        bf16x8 Pf[2];
#pragma unroll
        for (int s2 = 0; s2 < 2; ++s2) {
            u32x4 w; w.x = pk2(S[8 * s2 + 0], S[8 * s2 + 1]); w.y = pk2(S[8 * s2 + 2], S[8 * s2 + 3]); w.z = pk2(S[8 * s2 + 4], S[8 * s2 + 5]); w.w = pk2(S[8 * s2 + 6], S[8 * s2 + 7]);
            Pf[s2] = __builtin_bit_cast(bf16x8, w);
        }
        lds_fence();
        const s16x4 l00 = tr_read<0>(vtr), h00 = tr_read<2176>(vtr);
        const s16x4 l01 = tr_read<4352>(vtr), h01 = tr_read<6528>(vtr);
        const s16x4 l10 = tr_read<64>(vtr), h10 = tr_read<2240>(vtr);
        const s16x4 l11 = tr_read<4416>(vtr), h11 = tr_read<6592>(vtr);
        const s16x4 l20 = tr_read<128>(vtr), h20 = tr_read<2304>(vtr);
        const s16x4 l21 = tr_read<4480>(vtr), h21 = tr_read<6656>(vtr);
        const s16x4 l30 = tr_read<192>(vtr), h30 = tr_read<2368>(vtr);
        const s16x4 l31 = tr_read<4544>(vtr), h31 = tr_read<6720>(vtr);
        asm volatile("s_waitcnt lgkmcnt(0)" ::: "memory"); __builtin_amdgcn_sched_barrier(0);
#define PK8(L_, H_) (bf16x8){L_[0], L_[1], L_[2], L_[3], H_[0], H_[1], H_[2], H_[3]}
        O[0] = mfma32(PK8(l00, h00), Pf[0], O[0]);
        O[0] = mfma32(PK8(l01, h01), Pf[1], O[0]);
        O[1] = mfma32(PK8(l10, h10), Pf[0], O[1]);
        O[1] = mfma32(PK8(l11, h11), Pf[1], O[1]);
        O[2] = mfma32(PK8(l20, h20), Pf[0], O[2]);
        O[2] = mfma32(PK8(l21, h21), Pf[1], O[2]);
        O[3] = mfma32(PK8(l30, h30), Pf[0], O[3]);
        O[3] = mfma32(PK8(l31, h31), Pf[1], O[3]);
#undef PK8
        lds_fence();
    }
#undef ATT_LOAD_KV
    const float inv = 1.f / lrun;
    bf16_t* op = OG + ((size_t)g * MP + tq) * 512 + hh * 128 + 4 * h;
#pragma unroll
    for (int dt = 0; dt < 4; ++dt)
#pragma unroll
        for (int rq = 0; rq < 4; ++rq) {
            u32x2 w; w.x = pk2(O[dt][4 * rq] * inv, O[dt][4 * rq + 1] * inv); w.y = pk2(O[dt][4 * rq + 2] * inv, O[dt][4 * rq + 3] * inv);
            *(u32x2*)(op + 32 * dt + 8 * rq) = w;
        }
    if (h == 0) LSE[((size_t)g * MP + tq) * 4 + hh] = mrun + __logf(lrun);
}
DI const float* samp_row(const float* cache, const float* newkv, int b, int W, int rr) {
    return (rr >= W) ? newkv + ((size_t)(b * W + rr - 4) * 2) * 512 : cache + ((size_t)(b * W + rr) * 2) * 512;
}
DI void attn_sample_item(const Params& p, const bf16_t* Z, bf16_t* OG, float* LSE, int item, int lane) {
    const int b = item / 48, r48 = item % 48, t = r48 / 12, head = r48 % 12, g = head >> 2, hh = head & 3;
    const int dsh = 2 * g, W = 128 << dsh;
    const float* cache = p.in[2 + g];
    const float* newkv = p.out + (g == 0 ? OFF_KVS0 : (g == 1 ? OFF_KVS1 : OFF_KVS2));
    const int m = TP + b * 4 + t;
    const unsigned qq = *(const unsigned*)(Z + (size_t)m * NZ + ZQ + head * 128 + 2 * lane);
    const float q0 = bflo(qq) * ATT_SCALE, q1 = bfhi(qq) * ATT_SCALE;
    float mrun, lrun, o0, o1;
    {
        const float* rp = samp_row(cache, newkv, b, W, W + t - (128 << dsh)) + hh * 128 + 2 * lane;
        const f32x2 kk = *(const f32x2*)rp, vv = *(const f32x2*)(rp + 512);
        mrun = wave_sum(q0 * kk.x + q1 * kk.y); lrun = 1.f; o0 = vv.x; o1 = vv.y;
    }
    f32x2 kk[16], vv[16];
#pragma unroll
    for (int u = 0; u < 16; ++u) { const float* rp = samp_row(cache, newkv, b, W, W + t - (u << dsh)) + hh * 128 + 2 * lane; kk[u] = *(const f32x2*)rp; vv[u] = *(const f32x2*)(rp + 512); }
    for (int j0 = 0; j0 < 128; j0 += 16) {
        f32x2 kn[16], vn[16];
        if (j0 + 16 < 128) {
#pragma unroll
            for (int u = 0; u < 16; ++u) { const float* rp = samp_row(cache, newkv, b, W, W + t - ((j0 + 16 + u) << dsh)) + hh * 128 + 2 * lane; kn[u] = *(const f32x2*)rp; vn[u] = *(const f32x2*)(rp + 512); }
        }
        float pr[16];
#pragma unroll
        for (int u = 0; u < 16; ++u) pr[u] = q0 * kk[u].x + q1 * kk[u].y;
#pragma unroll
        for (int o = 32; o >= 1; o >>= 1) {
#pragma unroll
            for (int u = 0; u < 16; ++u) pr[u] += __shfl_xor(pr[u], o);
        }
        float bm = pr[0];
#pragma unroll
        for (int u = 1; u < 16; ++u) bm = fmaxf(bm, pr[u]);
        const float mn = fmaxf(mrun, bm), alpha = __expf(mrun - mn);
        lrun *= alpha; o0 *= alpha; o1 *= alpha; mrun = mn;
#pragma unroll
        for (int u = 0; u < 16; ++u) { const float pu = __expf(pr[u] - mn); lrun += pu; o0 += pu * vv[u].x; o1 += pu * vv[u].y; }
#pragma unroll
        for (int u = 0; u < 16; ++u) { kk[u] = kn[u]; vv[u] = vn[u]; }
    }
    const float inv = 1.f / lrun;
    *(unsigned*)(OG + ((size_t)g * MP + m) * 512 + hh * 128 + 2 * lane) = pk2(o0 * inv, o1 * inv);
    if (lane == 0) LSE[((size_t)g * MP + m) * 4 + hh] = mrun + __logf(lrun);
}

DI float hg_gates(const Params& p, const bf16_t (&fhr)[16], int h, LAS float* tot, float (&kk)[16], float (&bb)[16]) {
    const int tid = threadIdx.x, dk = tid & 127, part = tid >> 7;
    const float* lbp = p.in[13];
    const float lb = 1.f / (1.f + __expf(lbp[1024 + h * 128 + dk] - lbp[h * 128 + dk]));
    float cum = 0.f;
#pragma unroll
    for (int i = 0; i < 16; ++i) {
        const float fh = bf2f(fhr[i]);
        const float f = lb + (1.f - lb) * sigm(fh);
        kk[i] = 1.f - f; cum += __logf(f); bb[i] = cum;
    }
    tot[part * 128 + dk] = cum;
    __syncthreads();
    float off = 0.f, bl = 0.f;
#pragma unroll
    for (int q = 0; q < 4; ++q) { const float tv = tot[q * 128 + dk]; bl += tv; off += (q < part) ? tv : 0.f; }
#pragma unroll
    for (int i = 0; i < 16; ++i) bb[i] += off;
    return bl;
}
DI void hg_load_v(const bf16_t* Z, int n, int h, LAS bf16_t* Vs) {
    const int tid = threadIdx.x;
#pragma unroll
    for (int i = 0; i < 2; ++i) { const int e = tid + 512 * i, s = e >> 4, ch = e & 15;
        *(LAS u32x4*)(Vs + s * 136 + 8 * ch) = *(const u32x4*)(Z + (size_t)(64 * n + s) * NZ + ZIH + h * 128 + 8 * ch); }
}
struct HgaRegs { bf16_t fhr[16]; u32x4 vreg[2]; };
DI void hg_passA_load(const bf16_t* Z, int item, HgaRegs& R) {
    const int n = item >> 3, h = item & 7;
    const int tid = threadIdx.x, dk = tid & 127, part = tid >> 7;
#pragma unroll
    for (int i = 0; i < 16; ++i) R.fhr[i] = Z[(size_t)(64 * n + 16 * part + i) * NZ + ZFH + h * 128 + dk];
#pragma unroll
    for (int i = 0; i < 2; ++i) { const int e = tid + 512 * i; R.vreg[i] = *(const u32x4*)(Z + (size_t)(64 * n + (e >> 4)) * NZ + ZIH + h * 128 + 8 * (e & 15)); }
}
DI void hg_passA_item(const Params& p, float* HS, float* HD, LAS unsigned char* L, int item, const HgaRegs& R) {
    const int n = item >> 3, h = item & 7;
    const int tid = threadIdx.x, lane = tid & 63, wave = tid >> 6, dk = tid & 127, part = tid >> 7;
    LAS bf16_t* Kh = (LAS bf16_t*)L;
    LAS bf16_t* Vs = (LAS bf16_t*)(L + 17408);
    LAS float* tot = (LAS float*)(L + 34816);
    float kk[16], bb[16];
    const float bl = hg_gates(p, R.fhr, h, tot, kk, bb);
#pragma unroll
    for (int i = 0; i < 16; ++i) Kh[(16 * part + i) * 136 + dk] = (bf16_t)(pk2(kk[i] * __expf(bl - bb[i]), 0.f) & 0xffffu);
    if (part == 0) HD[(size_t)(n * 8 + h) * 128 + dk] = __expf(bl);
#pragma unroll
    for (int i = 0; i < 2; ++i) { const int e = tid + 512 * i; *(LAS u32x4*)(Vs + (e >> 4) * 136 + 8 * (e & 15)) = R.vreg[i]; }
    __syncthreads();
    f32x4 acc[8];
#pragma unroll
    for (int nt = 0; nt < 8; ++nt) acc[nt] = (f32x4){0.f, 0.f, 0.f, 0.f};
#pragma unroll
    for (int ks = 0; ks < 2; ++ks) {
        const bf16x8 A = gat8(Kh + (32 * ks + 8 * (lane >> 4)) * 136 + 16 * wave + (lane & 15), 136);
#pragma unroll
        for (int nt = 0; nt < 8; ++nt) { const bf16x8 B = gat8(Vs + (32 * ks + 8 * (lane >> 4)) * 136 + 16 * nt + (lane & 15), 136); acc[nt] = mfma16(A, B, acc[nt]); }
    }
    float* up = HS + ((size_t)(n * 8 + h) * 128) * 128;
#pragma unroll
    for (int nt = 0; nt < 8; ++nt)
#pragma unroll
        for (int r = 0; r < 4; ++r) up[(size_t)(16 * wave + 4 * (lane >> 4) + r) * 128 + 16 * nt + (lane & 15)] = acc[nt][r];
    __syncthreads();
}
DI void hg_scan(const Params& p, float* HS, const float* HD) {
    for (int e = blockIdx.x * 512 + threadIdx.x; e < 131072; e += gridDim.x * 512) {
        float S = 0.f;
        for (int n0 = 0; n0 < 256; n0 += 32) {
            float U[32], Dd[32];
#pragma unroll
            for (int j = 0; j < 32; ++j) { U[j] = HS[(size_t)(n0 + j) * 131072 + e]; Dd[j] = HD[(n0 + j) * 1024 + (e >> 7)]; }
#pragma unroll
            for (int j = 0; j < 32; ++j) { HS[(size_t)(n0 + j) * 131072 + e] = S; S = Dd[j] * S + U[j]; }
        }
        p.out[OFF_HGP + e] = S;
    }
}
struct HgcRegs { bf16_t fhr[16], qhr[16]; u32x4 vreg[2]; f32x4 sreg[8]; };
DI void hg_passC_load(const bf16_t* Z, const float* HS, int item, HgcRegs& R) {
    const int n = item >> 3, h = item & 7;
    const int tid = threadIdx.x, dk = tid & 127, part = tid >> 7;
#pragma unroll
    for (int i = 0; i < 16; ++i) { const size_t ro = (size_t)(64 * n + 16 * part + i) * NZ + h * 128 + dk; R.fhr[i] = Z[ro + ZFH]; R.qhr[i] = Z[ro + ZQH]; }
#pragma unroll
    for (int i = 0; i < 2; ++i) { const int e = tid + 512 * i; R.vreg[i] = *(const u32x4*)(Z + (size_t)(64 * n + (e >> 4)) * NZ + ZIH + h * 128 + 8 * (e & 15)); }
    const float* sp = HS + ((size_t)(n * 8 + h) * 128) * 128;
#pragma unroll
    for (int i = 0; i < 8; ++i) { const int e = tid + 512 * i; R.sreg[i] = *(const f32x4*)(sp + (e >> 5) * 128 + 4 * (e & 31)); }
}
DI void hg_passC_item(const Params& p, const bf16_t* Z, bf16_t* OHG, LAS unsigned char* L, int item, const HgcRegs& R) {
    const int n = item >> 3, h = item & 7;
    const int tid = threadIdx.x, lane = tid & 63, wave = tid >> 6, dk = tid & 127, part = tid >> 7;
    LAS bf16_t* Qs = (LAS bf16_t*)L;
    LAS bf16_t* Ks = (LAS bf16_t*)(L + 17408);
    LAS bf16_t* Vs = (LAS bf16_t*)(L + 34816);
    LAS bf16_t* Ss = (LAS bf16_t*)(L + 52224);
    LAS bf16_t* As = (LAS bf16_t*)(L + 87040);
    LAS float* tot = (LAS float*)(L + 96256);
    LAS float* red = (LAS float*)(L + 98304);
    float kk[16], bb[16];
    const int mt = wave >> 1, wh = wave & 1, lr = lane & 15, lq = lane >> 4;
    bf16_t ghr[16];
#pragma unroll
    for (int r = 0; r < 4; ++r)
#pragma unroll
        for (int j = 0; j < 4; ++j) ghr[r * 4 + j] = Z[(size_t)(64 * n + 16 * mt + 4 * lq + r) * NZ + ZGH + h * 128 + 16 * (4 * wh + j) + lr];
    (void)hg_gates(p, R.fhr, h, tot, kk, bb);
#pragma unroll
    for (int i = 0; i < 16; ++i) {
        const int s = 16 * part + i;
        const float qh = bf2f(R.qhr[i]);
        Qs[s * 136 + dk] = (bf16_t)(pk2(silu(qh) * __expf(bb[i]), 0.f) & 0xffffu);
        Ks[s * 136 + dk] = (bf16_t)(pk2(kk[i] * __expf(-bb[i]), 0.f) & 0xffffu);
    }
#pragma unroll
    for (int i = 0; i < 2; ++i) { const int e = tid + 512 * i; *(LAS u32x4*)(Vs + (e >> 4) * 136 + 8 * (e & 15)) = R.vreg[i]; }
#pragma unroll
    for (int i = 0; i < 8; ++i) { const int e = tid + 512 * i; u32x2 w; w.x = pk2(R.sreg[i][0], R.sreg[i][1]); w.y = pk2(R.sreg[i][2], R.sreg[i][3]); *(LAS u32x2*)(Ss + (e >> 5) * 136 + 4 * (e & 31)) = w; }
    __syncthreads();
    {
        f32x4 a2[2] = {{0.f, 0.f, 0.f, 0.f}, {0.f, 0.f, 0.f, 0.f}};
#pragma unroll
        for (int ks = 0; ks < 4; ++ks) {
            const bf16x8 A = ld8(Qs + (16 * mt + lr) * 136 + 32 * ks + 8 * lq);
#pragma unroll
            for (int j = 0; j < 2; ++j) { const bf16x8 B = ld8(Ks + (16 * (2 * wh + j) + lr) * 136 + 32 * ks + 8 * lq); a2[j] = mfma16(A, B, a2[j]); }
        }
#pragma unroll
        for (int j = 0; j < 2; ++j)
#pragma unroll
            for (int r = 0; r < 4; ++r) { const int t = 16 * mt + 4 * lq + r, s = 16 * (2 * wh + j) + lr; As[t * 72 + s] = (bf16_t)(pk2(s <= t ? a2[j][r] : 0.f, 0.f) & 0xffffu); }
    }
    __syncthreads();
    f32x4 acc[4];
#pragma unroll
    for (int j = 0; j < 4; ++j) acc[j] = (f32x4){0.f, 0.f, 0.f, 0.f};
#pragma unroll
    for (int ks = 0; ks < 2; ++ks) {
        const bf16x8 A = ld8(As + (16 * mt + lr) * 72 + 32 * ks + 8 * lq);
#pragma unroll
        for (int j = 0; j < 4; ++j) { const bf16x8 B = gat8(Vs + (32 * ks + 8 * lq) * 136 + 16 * (4 * wh + j) + lr, 136); acc[j] = mfma16(A, B, acc[j]); }
    }
#pragma unroll
    for (int ks = 0; ks < 4; ++ks) {
        const bf16x8 A = ld8(Qs + (16 * mt + lr) * 136 + 32 * ks + 8 * lq);
#pragma unroll
        for (int j = 0; j < 4; ++j) { const bf16x8 B = gat8(Ss + (32 * ks + 8 * lq) * 136 + 16 * (4 * wh + j) + lr, 136); acc[j] = mfma16(A, B, acc[j]); }
    }
#pragma unroll
    for (int r = 0; r < 4; ++r) {
        float ss = 0.f;
#pragma unroll
        for (int j = 0; j < 4; ++j) ss += acc[j][r] * acc[j][r];
        ss += __shfl_xor(ss, 1); ss += __shfl_xor(ss, 2); ss += __shfl_xor(ss, 4); ss += __shfl_xor(ss, 8);
        if (lr == 0) red[(16 * mt + 4 * lq + r) * 2 + wh] = ss;
    }
    __syncthreads();
    const float* hgw = p.in[14];
#pragma unroll
    for (int r = 0; r < 4; ++r) {
        const int tl = 16 * mt + 4 * lq + r, t = 64 * n + tl;
        const float rstd = rsqrtf((red[tl * 2] + red[tl * 2 + 1]) * (1.f / 128.f) + EPS);
#pragma unroll
        for (int j = 0; j < 4; ++j) {
            const int dv = 16 * (4 * wh + j) + lr;
            const float gh = bf2f(ghr[r * 4 + j]);
            OHG[(size_t)t * 1024 + h * 128 + dv] = (bf16_t)(pk2(acc[j][r] * rstd * hgw[dv] * silu(gh), 0.f) & 0xffffu);
        }
    }
    __syncthreads();
}
DI void hg_sample_item(const Params& p, const bf16_t* Z, bf16_t* OHG, LAS unsigned char* L, int item) {
    const int b = item >> 3, h = item & 7;
    const int tid = threadIdx.x, dv = tid & 127, dq = tid >> 7;
    LAS float* fS = (LAS float*)L;
    LAS float* kS = fS + 512;
    LAS float* qS = kS + 512;
    LAS float* red = qS + 512;
    LAS float* rs = red + 2048;
    const float* lbp = p.in[13];
    {
        const int t = tid >> 7, dk = tid & 127, m = TP + b * 4 + t;
        const float lb = 1.f / (1.f + __expf(lbp[1024 + h * 128 + dk] - lbp[h * 128 + dk]));
        const float fh = bf2f(Z[(size_t)m * NZ + ZFH + h * 128 + dk]), qh = bf2f(Z[(size_t)m * NZ + ZQH + h * 128 + dk]);
        const float f = lb + (1.f - lb) * sigm(fh);
        fS[tid] = f; kS[tid] = 1.f - f; qS[tid] = silu(qh);
    }
    float S[32];
    const float* s0 = p.in[5] + ((size_t)(b * 8 + h) * 128) * 128;
#pragma unroll
    for (int i = 0; i < 32; ++i) S[i] = s0[(size_t)(dq * 32 + i) * 128 + dv];
    __syncthreads();
#pragma unroll
    for (int t = 0; t < 4; ++t) {
        const int m = TP + b * 4 + t;
        const float v = bf2f(Z[(size_t)m * NZ + ZIH + h * 128 + dv]);
        float part = 0.f;
#pragma unroll
        for (int i = 0; i < 32; ++i) { const int dk = dq * 32 + i; S[i] = fS[t * 128 + dk] * S[i] + kS[t * 128 + dk] * v; part += S[i] * qS[t * 128 + dk]; }
        red[(t * 4 + dq) * 128 + dv] = part;
    }
    float* so = p.out + OFF_HGS + ((size_t)(b * 8 + h) * 128) * 128;
#pragma unroll
    for (int i = 0; i < 32; ++i) so[(size_t)(dq * 32 + i) * 128 + dv] = S[i];
    __syncthreads();
    {
        const int t = tid >> 7, m = TP + b * 4 + t;
        const float o = red[(t * 4 + 0) * 128 + dv] + red[(t * 4 + 1) * 128 + dv] + red[(t * 4 + 2) * 128 + dv] + red[(t * 4 + 3) * 128 + dv];
        const float ss = wave_sum(o * o);
        if ((tid & 63) == 0) rs[tid >> 6] = ss;
        __syncthreads();
        const float rstd = rsqrtf((rs[2 * t] + rs[2 * t + 1]) * (1.f / 128.f) + EPS);
        const float gh = bf2f(Z[(size_t)m * NZ + ZGH + h * 128 + dv]);
        OHG[(size_t)m * 1024 + h * 128 + dv] = (bf16_t)(pk2(o * rstd * p.in[14][dv] * silu(gh), 0.f) & 0xffffu);
    }
    __syncthreads();
}
DI void ph_merge(const bf16_t* OG, const float* LSE, bf16_t* OATT) {
    for (size_t idx = (size_t)blockIdx.x * 512 + threadIdx.x; idx < (size_t)MR * 64; idx += (size_t)gridDim.x * 512) {
        const int m = (int)(idx >> 6), c8 = (int)(idx & 63), hh = c8 >> 4;
        const float l0 = LSE[((size_t)0 * MP + m) * 4 + hh], l1 = LSE[((size_t)1 * MP + m) * 4 + hh], l2 = LSE[((size_t)2 * MP + m) * 4 + hh];
        const float mx = fmaxf(l0, fmaxf(l1, l2));
        float w0 = __expf(l0 - mx), w1 = __expf(l1 - mx), w2 = __expf(l2 - mx);
        const float inv = 1.f / (w0 + w1 + w2); w0 *= inv; w1 *= inv; w2 *= inv;
        float a[8], b[8], c[8];
        unpack8(*(const u32x4*)(OG + ((size_t)0 * MP + m) * 512 + 8 * c8), a);
        unpack8(*(const u32x4*)(OG + ((size_t)1 * MP + m) * 512 + 8 * c8), b);
        unpack8(*(const u32x4*)(OG + ((size_t)2 * MP + m) * 512 + 8 * c8), c);
        u32x4 o;
        o.x = pk2(w0 * a[0] + w1 * b[0] + w2 * c[0], w0 * a[1] + w1 * b[1] + w2 * c[1]);
        o.y = pk2(w0 * a[2] + w1 * b[2] + w2 * c[2], w0 * a[3] + w1 * b[3] + w2 * c[3]);
        o.z = pk2(w0 * a[4] + w1 * b[4] + w2 * c[4], w0 * a[5] + w1 * b[5] + w2 * c[5]);
        o.w = pk2(w0 * a[6] + w1 * b[6] + w2 * c[6], w0 * a[7] + w1 * b[7] + w2 * c[7]);
        *(u32x4*)(OATT + (size_t)m * 512 + 8 * c8) = o;
    }
}
DI void ld8p(const float* s, float (&f)[8]) {
    f32x4 a = {0.f, 0.f, 0.f, 0.f}, b = a;
#pragma unroll
    for (int q = 0; q < NSP_UP; ++q) { a = a + *(const f32x4*)(s + (size_t)q * NS * NAB); b = b + *(const f32x4*)(s + (size_t)q * NS * NAB + 4); }
    f[0] = a[0]; f[1] = a[1]; f[2] = a[2]; f[3] = a[3]; f[4] = b[0]; f[5] = b[1]; f[6] = b[2]; f[7] = b[3];
}
DI void ph_convact(const Params& p, const bf16_t* AB, bf16_t* G) {
    const float* cw = p.in[21]; const float* cb = p.in[22]; const float* sc = p.in[6];
    const float* ACC = (const float*)(p.ws + WS_ACC_UP);
    for (size_t idx = (size_t)blockIdx.x * 512 + threadIdx.x; idx < (size_t)(126 + NS) * 704; idx += (size_t)gridDim.x * 512) {
        const int ri = (int)(idx / 704), c = (int)(idx % 704) * 8;
        const int m = ri < 126 ? 256 * (1 + (ri >> 1)) + (ri & 1) : TP + (ri - 126);
        float a2[8], a1[8], a0[8], bl[8];
        if (m < TP) {
            unpack8(*(const u32x4*)(AB + (size_t)m * NAB + c), a2);
            unpack8(*(const u32x4*)(AB + (size_t)m * NAB + DFF + c), bl);
            if (m >= 1) unpack8(*(const u32x4*)(AB + (size_t)(m - 1) * NAB + c), a1); else { for (int j = 0; j < 8; ++j) a1[j] = 0.f; }
            if (m >= 2) unpack8(*(const u32x4*)(AB + (size_t)(m - 2) * NAB + c), a0); else { for (int j = 0; j < 8; ++j) a0[j] = 0.f; }
        } else {
            const int ms = m - TP, t = ms & 3, b = ms >> 2;
            ld8p(ACC + (size_t)ms * NAB + c, a2);
            ld8p(ACC + (size_t)ms * NAB + DFF + c, bl);
            if (t >= 1) ld8p(ACC + (size_t)(ms - 1) * NAB + c, a1); else ld8f(sc + (size_t)(b * 2 + 1) * DFF + c, a1);
            if (t >= 2) ld8p(ACC + (size_t)(ms - 2) * NAB + c, a0); else ld8f(sc + (size_t)(b * 2 + t) * DFF + c, a0);
            if (t >= 2) { float* d = p.out + OFF_CVS + (size_t)(b * 2 + t - 2) * DFF + c; *(f32x4*)d = (f32x4){a2[0], a2[1], a2[2], a2[3]}; *(f32x4*)(d + 4) = (f32x4){a2[4], a2[5], a2[6], a2[7]}; }
        }
        float w0[8], w1[8], w2[8], bb[8];
        ld8f(cw + c, w0); ld8f(cw + DFF + c, w1); ld8f(cw + 2 * DFF + c, w2); ld8f(cb + c, bb);
        float o[8];
#pragma unroll
        for (int j = 0; j < 8; ++j) { const float u = bb[j] + w0[j] * a0[j] + w1[j] * a1[j] + w2[j] * a2[j]; o[j] = silu(u) * bl[j]; }
        u32x4 w; w.x = pk2(o[0], o[1]); w.y = pk2(o[2], o[3]); w.z = pk2(o[4], o[5]); w.w = pk2(o[6], o[7]);
        *(u32x4*)(G + (size_t)m * DFF + c) = w;
    }
}

DI void ph_mixfix(const Params& p) {
    const bf16_t* Z = (const bf16_t*)(p.ws + WS_Z); const float* PA = (const float*)(p.ws + WS_ACC_PA); const float* PB = (const float*)(p.ws + WS_ACC_PB); bf16_t* Y = (bf16_t*)(p.ws + WS_YMIX);
    for (int idx = blockIdx.x * 512 + threadIdx.x; idx < NS * (D / 4); idx += gridDim.x * 512) {
        const int r = idx / (D / 4), c = (idx % (D / 4)) * 4;
        f32x4 a = {0.f, 0.f, 0.f, 0.f}, b = a;
#pragma unroll
        for (int q = 0; q < NSP_PA; ++q) a = a + *(const f32x4*)(PA + ((size_t)q * NS + r) * D + c);
#pragma unroll
        for (int q = 0; q < NSP_PB; ++q) b = b + *(const f32x4*)(PB + ((size_t)q * NS + r) * D + c);
        const u32x2 ga = *(const u32x2*)(Z + (size_t)(TP + r) * NZ + ZGA + c), gb = *(const u32x2*)(Z + (size_t)(TP + r) * NZ + ZGB + c);
        const float y0 = sigm(bflo(ga.x)) * a[0] + sigm(bflo(gb.x)) * b[0], y1 = sigm(bfhi(ga.x)) * a[1] + sigm(bfhi(gb.x)) * b[1];
        const float y2 = sigm(bflo(ga.y)) * a[2] + sigm(bflo(gb.y)) * b[2], y3 = sigm(bfhi(ga.y)) * a[3] + sigm(bfhi(gb.y)) * b[3];
        u32x2 w; w.x = pk2(y0, y1); w.y = pk2(y2, y3);
        *(u32x2*)(Y + (size_t)(TP + r) * D + c) = w;
    }
}
#define XB_TMO      128
#define XB_XCNT(j)  (256  + 64 * (j))
#define XB_XSUB(j)  (1280 + 64 * (j))
#define XB_XGEN(j)  (2304 + 64 * (j))
#define XB_TOP      3328
#define XB_TOPGEN   3392
#define XCD_BAR_WORDS 3456
#define XB_SPIN_CAP (1u << 18)

__device__ __forceinline__ unsigned xb_ld(unsigned* p)              { return __hip_atomic_load(p, __ATOMIC_RELAXED, __HIP_MEMORY_SCOPE_AGENT); }
__device__ __forceinline__ unsigned xb_add(unsigned* p, unsigned v) { return __hip_atomic_fetch_add(p, v, __ATOMIC_RELAXED, __HIP_MEMORY_SCOPE_AGENT); }
__device__ __forceinline__ unsigned xb_xcc_id() { return (unsigned)__builtin_amdgcn_s_getreg((3 << 11) | 20) & 0xFu; }
#define XB_SPIN(cond, bar) do { unsigned _sp = 0; while (cond) { __builtin_amdgcn_s_sleep(1); \
    if ((++_sp & 255u) == 0u) { if (xb_ld(&(bar)[XB_TMO])) break; if (_sp > XB_SPIN_CAP) { atomicAdd(&(bar)[XB_TMO], 1u); break; } } } } while (0)

struct XcdBarrier {
    unsigned* bar; unsigned x;
    volatile LAS unsigned* st;
};

__device__ __forceinline__ XcdBarrier xcd_barrier_post(unsigned* bar, volatile LAS unsigned* st) {
    XcdBarrier b; b.bar = bar; b.x = xb_xcc_id(); b.st = st;
    if (threadIdx.x == 0) (void)xb_add(&bar[XB_XCNT(b.x)], 1u);
    return b;
}
__device__ __forceinline__ void xcd_barrier_complete(unsigned* bar, unsigned x, unsigned& nloc, unsigned& nx) {
    const unsigned G = gridDim.x * gridDim.y * gridDim.z;
    unsigned sum, cnt, mine, sp = 0u;
    for (;;) {
        sum = 0u; cnt = 0u; mine = 0u;
#pragma unroll
        for (unsigned j = 0; j < 16; ++j) { const unsigned c = xb_ld(&bar[XB_XCNT(j)]); sum += c; cnt += (c > 0u) ? 1u : 0u; mine = (j == x) ? c : mine; }
        if (sum == G) break;
        __builtin_amdgcn_s_sleep(1);
        if ((++sp & 255u) == 0u) { if (xb_ld(&bar[XB_TMO])) break; if (sp > XB_SPIN_CAP) { atomicAdd(&bar[XB_TMO], 1u); break; } }
    }
    nloc = mine > 0u ? mine : 1u; nx = cnt > 0u ? cnt : 1u;
}

__device__ __forceinline__ void xcd_barrier(const XcdBarrier& b) {
    asm volatile("s_waitcnt vmcnt(0)" ::: "memory");
    __syncthreads();
    if (threadIdx.x == 0) {
        unsigned* bar = b.bar;
        __builtin_amdgcn_s_waitcnt(0);
        unsigned nloc = b.st[0], nx = b.st[1];
        if (nloc == 0u) { xcd_barrier_complete(bar, b.x, nloc, nx); b.st[0] = nloc; b.st[1] = nx; }
        const unsigned old = xb_add(&bar[XB_XSUB(b.x)], 1u);
        const unsigned gen = old / nloc;
        if (old + 1u == (gen + 1u) * nloc) {
            __builtin_amdgcn_fence(__ATOMIC_RELEASE, "agent");
            asm volatile("s_waitcnt vmcnt(0)" ::: "memory");
            const unsigned og = xb_add(&bar[XB_TOP], 1u);
            const unsigned tg = og / nx;
            if (og + 1u == (tg + 1u) * nx) xb_add(&bar[XB_TOPGEN], 1u);
            else XB_SPIN(xb_ld(&bar[XB_TOPGEN]) == tg, bar);
            __builtin_amdgcn_fence(__ATOMIC_ACQUIRE, "agent");
            xb_add(&bar[XB_XGEN(b.x)], 1u);
            asm volatile("s_waitcnt vmcnt(0)" ::: "memory");
        } else {
            XB_SPIN(xb_ld(&bar[XB_XGEN(b.x)]) == gen, bar);
            __builtin_amdgcn_fence(__ATOMIC_ACQUIRE, "agent");
            asm volatile("s_waitcnt vmcnt(0)" ::: "memory");
        }
    }
    __syncthreads();
}

template <class Epi> DI void run_gemm(LAS unsigned char* L, const bf16_t* A, const bf16_t* Bt, int N, int K, const Epi& E) {
    pg8::Gemm g{A, Bt, MP, N, K}; pg8::StaticOrder S; S.init(MP, N, K, (int)gridDim.x, (int)blockIdx.x);
    pg8::gemm_phase<Epi, pg8::StaticOrder, false>(L, g, S, E, nullptr);
}
template <class Epi> DI void run_gemm_split(LAS unsigned char* L, const bf16_t* A, const bf16_t* Bt, int N, int K, const Epi& E) {
    pg8::Gemm g{A, Bt, MP, N, K}; pg8::SplitOrder S; S.init(N, K, (int)gridDim.x, (int)blockIdx.x);
    pg8::gemm_phase<Epi, pg8::SplitOrder, false>(L, g, S, E, nullptr);
}

__global__ void __launch_bounds__(512, 2) mega(Params p) {
    extern __shared__ __attribute__((aligned(16))) unsigned char lds[];
    LAS unsigned char* L = (LAS unsigned char*)lds;
    cg::grid_group grid = cg::this_grid();
    unsigned char* ws = p.ws;
    const int lo = p.ph_lo, hi = p.ph_hi;
    const int tid = threadIdx.x, lane = tid & 63, wave = tid >> 6;
    bf16_t* Z = (bf16_t*)(ws + WS_Z);
    bf16_t* H = (bf16_t*)(ws + WS_H);
    float* MOD = (float*)(ws + WS_MOD);
#define IN(k) (lo <= (k) && (k) < hi)
    XcdBarrier xbar; xbar.bar = (unsigned*)ws; xbar.x = 0; xbar.st = (volatile LAS unsigned*)(L + 131072 + 4096);
    if (hi - lo > 1) {
        if (threadIdx.x < 2) xbar.st[threadIdx.x] = 0u;
        __syncthreads();
        xbar = xcd_barrier_post((unsigned*)ws, (volatile LAS unsigned*)(L + 131072 + 4096));
        grid.sync();
    }
#define SEAM(k) do { if (IN(k) && IN((k) + 1)) xcd_barrier(xbar); } while (0)
#define SOFT(k) do { if (IN(k) && IN((k) + 1)) __syncthreads(); } while (0)
    if (IN(0)) ph_prologue(p, L);
    SEAM(0);
    if (IN(1)) ph_hnorm(p, nullptr, false, p.in[11], 0, H);
    SEAM(1);
    if (IN(2)) { EpiZ E{Z, (const float*)(ws + WS_ROPE), p.out, p.in[2], p.in[3], p.in[4]}; run_gemm(L, H, (const bf16_t*)(ws + WS_WIN), NZ, D, E); }
    SEAM(2);
    if (IN(3)) {
        HgaRegs RA;
        int it = blockIdx.x;
        if (it < 2048) hg_passA_load(Z, it, RA);
        while (it < 2048) {
            const int itn = it + gridDim.x; HgaRegs RB;
            if (itn < 2048) hg_passA_load(Z, itn, RB);
            hg_passA_item(p, (float*)(ws + WS_HS), (float*)(ws + WS_HD), L, it, RA);
            RA = RB; it = itn;
        }
    }
    SOFT(3);
    if (IN(4)) {
        const int gw = blockIdx.x * 8 + wave, NGW = gridDim.x * 8;
        LAS bf16_t* Vl = (LAS bf16_t*)(L + wave * 8704);
        for (int base = 0; base < 6144; base += 3 * NGW)
            for (int j = 0; j < 3; ++j) { const int it = base + gw * 3 + j; if (it < 6144) attn_prompt_item(Z, (bf16_t*)(ws + WS_OG), (float*)(ws + WS_LSE), Vl, it, lane); }
    }
    SOFT(4);
    if (IN(5)) { const int gw = blockIdx.x * 8 + wave, NGW = gridDim.x * 8; for (int it = gw; it < 1536; it += NGW) attn_sample_item(p, Z, (bf16_t*)(ws + WS_OG), (float*)(ws + WS_LSE), it, lane); }
    SEAM(5);
    if (IN(6)) hg_scan(p, (float*)(ws + WS_HS), (const float*)(ws + WS_HD));
    SEAM(6);
    if (IN(7)) {
        HgcRegs RA;
        int it = blockIdx.x;
        if (it < 2048) hg_passC_load(Z, (const float*)(ws + WS_HS), it, RA);
        while (it < 2048) {
            const int itn = it + gridDim.x; HgcRegs RB;
            if (itn < 2048) hg_passC_load(Z, (const float*)(ws + WS_HS), itn, RB);
            hg_passC_item(p, Z, (bf16_t*)(ws + WS_OHG), L, it, RA);
            RA = RB; it = itn;
        }
    }
    SOFT(7);
    if (IN(8)) for (int it = blockIdx.x; it < 256; it += gridDim.x) hg_sample_item(p, Z, (bf16_t*)(ws + WS_OHG), L, it);
    SOFT(8);
    if (IN(9)) ph_merge((const bf16_t*)(ws + WS_OG), (const float*)(ws + WS_LSE), (bf16_t*)(ws + WS_OATT));
    SEAM(9);
    if (IN(10)) {
        { EpiMix1 E{Z, (float*)(ws + WS_TMP), (float*)(ws + WS_ACC_PA)}; run_gemm_split(L, (const bf16_t*)(ws + WS_OATT), (const bf16_t*)(ws + WS_WPA), D, 512, E); }
        { EpiMix2 E{Z, (const float*)(ws + WS_TMP), (bf16_t*)(ws + WS_YMIX), (float*)(ws + WS_ACC_PB)}; run_gemm_split(L, (const bf16_t*)(ws + WS_OHG), (const bf16_t*)(ws + WS_WPB), D, 1024, E); }
    }
    SEAM(10);
    if (IN(11)) ph_mixfix(p);
    SEAM(11);
    if (IN(12)) { EpiWO E{p.in[0], p.in[1], MOD, p.out, (float*)(ws + WS_ACC_WO)}; run_gemm_split(L, (const bf16_t*)(ws + WS_YMIX), (const bf16_t*)(ws + WS_WO), D, D, E); }
    SEAM(12);
    if (IN(13)) ph_hnorm(p, p.out, true, p.in[18], 3, H);
    SEAM(13);
    if (IN(14)) { EpiUp E{(bf16_t*)(ws + WS_AB), (bf16_t*)(ws + WS_G), p.out, (float*)(ws + WS_ACC_UP), p.in[21], p.in[22], (LAS float*)(L + 131072)}; run_gemm_split(L, H, (const bf16_t*)(ws + WS_WAB), NAB, D, E); }
    SEAM(14);
    if (IN(15)) ph_convact(p, (const bf16_t*)(ws + WS_AB), (bf16_t*)(ws + WS_G));
    SEAM(15);
    if (IN(16)) { EpiDown E{MOD, p.out, (float*)(ws + WS_ACC_DN)}; run_gemm_split(L, (const bf16_t*)(ws + WS_G), (const bf16_t*)(ws + WS_WDN), D, DFF, E); }
    SEAM(16);
    if (IN(17)) ph_final_norm(p);
#undef IN
#undef SEAM
#undef SOFT
}

#ifndef MK_MULTI
#define MK_MULTI 0
#endif
extern "C" void kernel_launch(void* const* d_in, const int* in_sizes, int n_in, void* d_out, int out_size, void* d_ws, size_t ws_size, hipStream_t stream) {
    static int grid = 0;
    if (grid == 0) {
        if (n_in != 25 || (size_t)out_size != OUT_TOTAL || ws_size < WS_END) { fprintf(stderr, "kernel_launch: unexpected shapes: n_in %d out %d ws %zu (need %zu)\n", n_in, out_size, ws_size, (size_t)WS_END); grid = -1; return; }
        int dev = 0, cus = 0, per_cu = 0;
        hipGetDevice(&dev);
        hipDeviceGetAttribute(&cus, hipDeviceAttributeMultiprocessorCount, dev);
        if (hipFuncSetAttribute((const void*)mega, hipFuncAttributeMaxDynamicSharedMemorySize, LDS_BYTES) != hipSuccess) { fprintf(stderr, "kernel_launch: hipFuncSetAttribute failed\n"); grid = -1; return; }
        if (hipOccupancyMaxActiveBlocksPerMultiprocessor(&per_cu, (const void*)mega, 512, LDS_BYTES) != hipSuccess || per_cu < 1) { fprintf(stderr, "kernel_launch: occupancy query failed (%d)\n", per_cu); (void)hipGetLastError(); per_cu = 1; }
        grid = cus * 1;
        if (grid < 1) grid = -1;
    }
    if (grid < 0) return;
    Params p{};
    for (int i = 0; i < 25; ++i) p.in[i] = (const float*)d_in[i];
    p.out = (float*)d_out; p.ws = (unsigned char*)d_ws;
#ifndef DUP_MASK
#define DUP_MASK 0
#endif
#if MK_MULTI
    for (int ph = 0; ph < NPH; ++ph) for (int rep = 0; rep < (((DUP_MASK >> ph) & 1) ? 2 : 1); ++rep) { p.ph_lo = ph; p.ph_hi = ph + 1; hipLaunchKernelGGL(mega, dim3(grid), dim3(512), LDS_BYTES, stream, p); }
#else
    p.ph_lo = 0; p.ph_hi = NPH;
    if (hipMemsetAsync(d_ws, 0, 16384, stream) != hipSuccess) { fprintf(stderr, "kernel_launch: memset of the barrier words failed\n"); return; }
    void* args[] = {&p};
    hipError_t e = hipLaunchCooperativeKernel((const void*)mega, dim3(grid), dim3(512), args, LDS_BYTES, stream);
    if (e != hipSuccess) fprintf(stderr, "cooperative launch failed: %s (grid %d)\n", hipGetErrorString(e), grid);
#endif
}
```

```cpp
#include <hip/hip_runtime.h>
#include <hip/hip_cooperative_groups.h>
#include <cstdio>
namespace cg = cooperative_groups;
namespace pg8 {
#define PG8_LAS __attribute__((address_space(3)))
typedef unsigned short bf16_t;
typedef short bf16x8 __attribute__((ext_vector_type(8)));
typedef float f32x4 __attribute__((ext_vector_type(4)));
typedef unsigned u32x4 __attribute__((ext_vector_type(4)));
constexpr int BM = 256, BK = 64, HALF = 128, HTB = HALF * BK * 2  , STAGE_BYTES = 8 * HTB, NXCD = 8, WGM = 8;

__host__ __device__ __forceinline__ int lds_byte(int r, int c) { const int st = (r >> 4) * 2 + (c >> 5), rr = r & 15, cc = c & 31, ob = rr * 64 + cc * 2; return st * 1024 + (ob ^ (((ob >> 9) & 1) << 5)); }
__host__ __device__ __forceinline__ void stage_rc(int b, int& R, int& C) { const int st = b / 1024, sb = b % 1024, swz = sb ^ (((sb >> 9) & 1) << 5); R = (st >> 1) * 16 + swz / 64; C = (st & 1) * 32 + (swz % 64) / 2; }
__host__ __device__ __forceinline__ int perm32(int rho) { const int n = rho >> 4, i = rho & 15; return 8 * (i >> 2) + 4 * n + (i & 3); }

struct Unit { int pm, pn, kt0, nkt; };
struct Gemm { const bf16_t* A; const bf16_t* Bt; int M, N, K; };

struct StaticOrder {
    int nM, nN, nwg, G, c, nkt;
    __host__ __device__ void init(int M, int N, int K, int G_, int c_) { nM = M / BM; nN = N / BM; nwg = nM * nN; G = G_; c = c_; nkt = K / BK; }
    __host__ __device__ bool next(int i, Unit& u) const {
        const long L = (long)i * G + c; if (L >= nwg) return false;
        int wgid = (int)L; { const int q = nwg / NXCD, r = nwg % NXCD, xcd = wgid % NXCD, off = wgid / NXCD; wgid = (xcd < r ? xcd * (q + 1) : r * (q + 1) + (xcd - r) * q) + off; }
        const int nig = WGM * nN, gid = wgid / nig, fm = gid * WGM, gsz = (nM - fm) < WGM ? (nM - fm) : WGM;
        u.pm = fm + ((wgid % nig) % gsz); u.pn = (wgid % nig) / gsz; u.kt0 = 0; u.nkt = nkt; return true;
    }
    __device__ __forceinline__ void a_ready(const Unit&) const {}
    __device__ __forceinline__ void done(const Unit&) const {}
};
struct SplitOrder {
    int nN, nwg, G, c, nkt, nsp;
    __host__ __device__ void init(int N, int K, int G_, int c_) { nN = N / BM; nwg = 64 * nN; G = G_; c = c_; nkt = K / BK; nsp = nkt / 4; }
    __host__ __device__ bool next(int i, Unit& u) const {
        const long L = (long)i * G + c;
        if (L < nwg) {
            int wgid = (int)L; { const int q = nwg / NXCD, r = nwg % NXCD, xcd = wgid % NXCD, off = wgid / NXCD; wgid = (xcd < r ? xcd * (q + 1) : r * (q + 1) + (xcd - r) * q) + off; }
            const int nig = WGM * nN, gid = wgid / nig, fm = gid * WGM, gsz = (64 - fm) < WGM ? (64 - fm) : WGM;
            u.pm = fm + ((wgid % nig) % gsz); u.pn = (wgid % nig) / gsz; u.kt0 = 0; u.nkt = nkt; return true;
        }
        const long j = L - nwg; if (j >= (long)nN * nsp) return false;
        u.pm = 64; u.pn = (int)(j % nN); u.kt0 = 4 * (int)(j / nN); u.nkt = 4; return true;
    }
    __device__ __forceinline__ void a_ready(const Unit&) const {}
    __device__ __forceinline__ void done(const Unit&) const {}
};
template <class Epi, class Sched, bool STAMP = false>
__device__ __forceinline__ void gemm_phase(PG8_LAS unsigned char* lds, const Gemm g, const Sched& S, const Epi& E, unsigned long long* stamps) {
    const int tid = threadIdx.x, wid = __builtin_amdgcn_readfirstlane(tid >> 6), lane = tid & 63, wr = wid >> 2, wc = wid & 3, fr = lane & 15, fq = lane >> 4;
    const int K = g.K;
    int ts_lo = 0, ts_hi = 0, nts = 0; const unsigned long long rt_entry = STAMP ? (unsigned long long)wall_clock64() : 0ull;
#define PG8_STAMP() do { if (STAMP && wid == 0 && nts < 64) { const unsigned long long _c = (unsigned long long)clock64(); \
        ts_lo = (lane == nts) ? (int)(unsigned)_c : ts_lo; ts_hi = (lane == nts) ? (int)(unsigned)(_c >> 32) : ts_hi; ++nts; } } while (0)
    PG8_STAMP();
    unsigned voffA[2], voffB[2];
#pragma unroll
    for (int i = 0; i < 2; ++i) { int R, C; stage_rc(tid * 16 + i * 8192, R, C); const int Rb = Epi::PERM ? ((R & ~31) + perm32(R & 31)) : R;
        voffA[i] = (unsigned)(R * K + C) * 2u; voffB[i] = (unsigned)(Rb * K + C) * 2u; }
    const size_t kstep = (size_t)(BK * 2);
    const size_t hstep = (size_t)HALF * K * 2;
    const size_t tstep = 2 * hstep;
    const unsigned ldsw = (unsigned)wid * 1024u;
    const int aoff = lds_byte(wr * 64 + fr, fq * 8), boff = lds_byte(wc * 32 + fr, fq * 8);
#define PG8_SA(b, h) (((b) * 2 + (h)) * HTB)
#define PG8_SB(b, h) ((4 + (b) * 2 + (h)) * HTB)
#define PG8_STAGE(bufoff, gbase, voff) do { _Pragma("unroll") for (int _i = 0; _i < 2; ++_i) \
        __builtin_amdgcn_global_load_lds((const unsigned*)((const char*)(gbase) + (voff)[_i]), (PG8_LAS unsigned*)(lds + (bufoff) + ldsw + _i * 8192), 16, 0, 0); } while (0)
#define PG8_LDA(dst, b, h) do { _Pragma("unroll") for (int m = 0; m < 4; ++m) _Pragma("unroll") for (int k = 0; k < 2; ++k) dst[m][k] = *(const PG8_LAS bf16x8*)(lds + PG8_SA(b, h) + aoff + m * 2048 + k * 1024); } while (0)
#define PG8_LDB(dst, b, h) do { _Pragma("unroll") for (int n = 0; n < 2; ++n) _Pragma("unroll") for (int k = 0; k < 2; ++k) dst[n][k] = *(const PG8_LAS bf16x8*)(lds + PG8_SB(b, h) + boff + n * 2048 + k * 1024); } while (0)
#define PG8_MMA(ai, bj, At, Bt) do { __builtin_amdgcn_s_setprio(1); _Pragma("unroll") for (int m = 0; m < 4; ++m) _Pragma("unroll") for (int n = 0; n < 2; ++n) _Pragma("unroll") for (int k = 0; k < 2; ++k) \
        acc[ai][bj][m][n] = __builtin_amdgcn_mfma_f32_16x16x32_bf16(Bt[n][k], At[m][k], acc[ai][bj][m][n], 0, 0, 0); __builtin_amdgcn_s_setprio(0); } while (0)
#define PG8_WAIT_V(n) asm volatile("s_waitcnt vmcnt(" #n ")" ::: "memory")
#define PG8_WAIT_L(n) asm volatile("s_waitcnt lgkmcnt(" #n ")" ::: "memory")
#define PG8_BAR __builtin_amdgcn_s_barrier()
#define PG8_SCHED __builtin_amdgcn_sched_barrier(0)
    Unit cur, nxt; int ui = 0;
    if (!S.next(0, cur)) return;
    f32x4 acc[2][2][4][2];
#pragma unroll
    for (int a = 0; a < 2; ++a)
#pragma unroll
        for (int b = 0; b < 2; ++b)
#pragma unroll
            for (int m = 0; m < 4; ++m)
#pragma unroll
                for (int n = 0; n < 2; ++n) acc[a][b][m][n] = (f32x4){0.f, 0.f, 0.f, 0.f};
    bf16x8 At[4][2], B0[2][2], B1[2][2];
    const char* cA = (const char*)g.A + (size_t)cur.pm * tstep + (size_t)cur.kt0 * kstep; const char* cB = (const char*)g.Bt + (size_t)cur.pn * tstep + (size_t)cur.kt0 * kstep;
    S.a_ready(cur);
    PG8_STAGE(PG8_SB(0, 0), cB, voffB); PG8_STAGE(PG8_SA(0, 0), cA, voffA); PG8_STAGE(PG8_SB(0, 1), cB + hstep, voffB); PG8_STAGE(PG8_SA(0, 1), cA + hstep, voffA);
    if (wr == 1) PG8_BAR;
    PG8_WAIT_V(4); PG8_BAR;
    PG8_STAGE(PG8_SB(1, 0), cB + kstep, voffB); PG8_STAGE(PG8_SA(1, 0), cA + kstep, voffA); PG8_STAGE(PG8_SB(1, 1), cB + hstep + kstep, voffB);
    PG8_WAIT_V(6); PG8_BAR;
    PG8_STAMP();
    for (;;) {
        const bool has_next = S.next(ui + 1, nxt);
        const char* nA = has_next ? (const char*)g.A + (size_t)nxt.pm * tstep + (size_t)nxt.kt0 * kstep : cA; const char* nB = has_next ? (const char*)g.Bt + (size_t)nxt.pn * tstep + (size_t)nxt.kt0 * kstep : cB;
        const int nt = cur.nkt;
        for (int t = 0; t < nt; t += 2) {
            const bool last = (t == nt - 2);
            const char* a1 = cA + (size_t)(t + 1) * kstep;
            const char* a2 = last ? nA : cA + (size_t)(t + 2) * kstep; const char* b2 = last ? nB : cB + (size_t)(t + 2) * kstep;
            const char* a3 = a2 + kstep; const char* b3 = b2 + kstep;
            if (last && has_next) S.a_ready(nxt);
            PG8_LDB(B0, 0, 0); PG8_SCHED; PG8_LDA(At, 0, 0); PG8_STAGE(PG8_SA(1, 1), a1 + hstep, voffA);
            PG8_WAIT_L(8); PG8_BAR; PG8_WAIT_L(0); PG8_MMA(0, 0, At, B0); PG8_BAR; PG8_SCHED;
            PG8_LDB(B1, 0, 1); PG8_STAGE(PG8_SB(0, 0), b2, voffB);
            PG8_BAR; PG8_WAIT_L(0); PG8_MMA(0, 1, At, B1); PG8_BAR;
            PG8_LDA(At, 0, 1); PG8_STAGE(PG8_SA(0, 0), a2, voffA);
            PG8_BAR; PG8_WAIT_L(0); PG8_MMA(1, 0, At, B0); PG8_BAR; PG8_SCHED;
            PG8_STAGE(PG8_SB(0, 1), b2 + hstep, voffB);
            PG8_WAIT_V(6); PG8_BAR; PG8_MMA(1, 1, At, B1); PG8_BAR;
            PG8_LDB(B0, 1, 0); PG8_SCHED; PG8_LDA(At, 1, 0); PG8_STAGE(PG8_SA(0, 1), a2 + hstep, voffA);
            PG8_WAIT_L(8); PG8_BAR; PG8_WAIT_L(0); PG8_MMA(0, 0, At, B0); PG8_BAR; PG8_SCHED;
            PG8_LDB(B1, 1, 1); PG8_STAGE(PG8_SB(1, 0), b3, voffB);
            PG8_BAR; PG8_WAIT_L(0); PG8_MMA(0, 1, At, B1); PG8_BAR;
            PG8_LDA(At, 1, 1); PG8_STAGE(PG8_SA(1, 0), a3, voffA);
            PG8_BAR; PG8_WAIT_L(0); PG8_MMA(1, 0, At, B0); PG8_BAR; PG8_SCHED;
            PG8_STAGE(PG8_SB(1, 1), b3 + hstep, voffB);
            PG8_WAIT_V(6); PG8_BAR; PG8_MMA(1, 1, At, B1); PG8_BAR;
        }
        PG8_STAMP();
        if constexpr (!Epi::AFTER_DRAIN) { E(acc, cur, wr, wc, fr, fq); S.done(cur); }
        PG8_STAMP();
        if (!has_next) break;
#pragma unroll
        for (int a = 0; a < 2; ++a)
#pragma unroll
            for (int b = 0; b < 2; ++b)
#pragma unroll
                for (int m = 0; m < 4; ++m)
#pragma unroll
                    for (int n = 0; n < 2; ++n) acc[a][b][m][n] = (f32x4){0.f, 0.f, 0.f, 0.f};
        cur = nxt; cA = nA; cB = nB; ++ui;
    }
    PG8_WAIT_V(0);
    if (wr == 0) PG8_BAR;
    PG8_BAR;
    if constexpr (Epi::AFTER_DRAIN) { E.fused(acc, cur, wr, wc, fr, fq, lds, wid, lane); S.done(cur); }
    PG8_STAMP();
    if (STAMP && wid == 0) { stamps[lane] = lane < nts ? (((unsigned long long)(unsigned)ts_hi << 32) | (unsigned)ts_lo) : 0ull;
        if (lane == 62) stamps[62] = rt_entry; if (lane == 63) stamps[63] = (unsigned long long)wall_clock64(); }
#undef PG8_STAMP
#undef PG8_SA
#undef PG8_SB
#undef PG8_STAGE
#undef PG8_LDA
#undef PG8_LDB
#undef PG8_MMA
#undef PG8_WAIT_V
#undef PG8_WAIT_L
#undef PG8_BAR
#undef PG8_SCHED
}
}

using pg8::bf16_t; using pg8::bf16x8; using pg8::f32x4; using pg8::Unit;
#define LAS __attribute__((address_space(3)))
#define DI __device__ __forceinline__
typedef float f32x16 __attribute__((ext_vector_type(16)));
typedef float f32x2 __attribute__((ext_vector_type(2)));
typedef unsigned u32x4 __attribute__((ext_vector_type(4)));
typedef unsigned u32x2 __attribute__((ext_vector_type(2)));

constexpr int D = 2048, TP = 16384, NS = 128, MR = TP + NS, MP = 16640;
constexpr int NZ = 12800, DFF = 5632, NAB = 2 * DFF;
constexpr int ZQ = 0, ZK = 1536, ZV = 3072, ZQH = 4608, ZFH = 5632, ZIH = 6656, ZGH = 7680, ZGA = 8704, ZGB = 10752;
constexpr int NMODROW = 33, NMOD = 6 * D;
constexpr float EPS = 1e-6f;
constexpr float ATT_SCALE = 0.08838834764831845f;
constexpr size_t OFF_Y = 0;
constexpr size_t OFF_KVP0 = (size_t)MR * D;
constexpr size_t OFF_KVP1 = OFF_KVP0 + 128 * 1024;
constexpr size_t OFF_KVP2 = OFF_KVP1 + 512 * 1024;
constexpr size_t OFF_HGP = OFF_KVP2 + 2048 * 1024;
constexpr size_t OFF_CVP = OFF_HGP + 8 * 128 * 128;
constexpr size_t OFF_KVS0 = OFF_CVP + 2 * DFF;
constexpr size_t OFF_KVS1 = OFF_KVS0 + (size_t)32 * 128 * 1024;
constexpr size_t OFF_KVS2 = OFF_KVS1 + (size_t)32 * 512 * 1024;
constexpr size_t OFF_HGS = OFF_KVS2 + (size_t)32 * 2048 * 1024;
constexpr size_t OFF_CVS = OFF_HGS + (size_t)32 * 8 * 128 * 128;
constexpr size_t OUT_TOTAL = OFF_CVS + (size_t)32 * 2 * DFF;
static_assert(OUT_TOTAL == 129346560, "output size");
constexpr size_t WS_WIN = 1u << 20;
constexpr size_t WS_WPA = WS_WIN + (size_t)NZ * D * 2;
constexpr size_t WS_WPB = WS_WPA + (size_t)2048 * 512 * 2;
constexpr size_t WS_WO = WS_WPB + (size_t)2048 * 1024 * 2;
constexpr size_t WS_WAB = WS_WO + (size_t)2048 * 2048 * 2;
constexpr size_t WS_WDN = WS_WAB + (size_t)NAB * D * 2;
constexpr size_t WS_MOD = WS_WDN + (size_t)D * DFF * 2;
constexpr size_t WS_ROPE = WS_MOD + (size_t)NMODROW * NMOD * 4;
constexpr size_t WS_Z = WS_ROPE + (size_t)MP * 32 * 4;
constexpr size_t WS_AB = WS_Z;
constexpr size_t WS_H = WS_Z + (size_t)MP * NZ * 2;
constexpr size_t WS_OG = WS_H + (size_t)MP * D * 2;
constexpr size_t WS_LSE = WS_OG + (size_t)3 * MP * 512 * 2;
constexpr size_t WS_OATT = WS_LSE + (size_t)3 * MP * 4 * 4;
constexpr size_t WS_OHG = WS_OATT + (size_t)MP * 512 * 2;
constexpr size_t WS_YMIX = WS_OHG + (size_t)MP * 1024 * 2;
constexpr size_t WS_BLK_END = WS_YMIX + (size_t)MP * D * 2;
constexpr size_t WS_G = WS_OG;
static_assert(WS_G + (size_t)MP * DFF * 2 <= WS_BLK_END + (32u << 20), "g overlay");
static_assert((size_t)MP * NAB * 2 <= (size_t)MP * NZ * 2, "ab overlay");
constexpr size_t WS_HS = WS_BLK_END;
constexpr size_t WS_HD = WS_HS + (size_t)256 * 8 * 128 * 128 * 4;
constexpr size_t WS_TMP = WS_HS;
constexpr size_t WS_ACC_WO = WS_Z;
constexpr size_t WS_ACC_DN = WS_Z;
constexpr size_t WS_ACC_UP = WS_TMP + (64u << 20);
constexpr int NSP_WO = 8, NSP_DN = 22, NSP_UP = 8, NSP_PA = 2, NSP_PB = 4;
constexpr size_t WS_ACC_PA = WS_H, WS_ACC_PB = WS_H + (size_t)NSP_PA * NS * D * 4;
static_assert((size_t)NSP_UP * NS * NAB * 4 + (64u << 20) <= (size_t)MP * D * 4, "up partials");
constexpr size_t WS_END = WS_TMP + (size_t)MP * D * 4 + (1u << 20);
static_assert(WS_HD + (size_t)256 * 8 * 128 * 4 <= WS_END, "hd");
static_assert(WS_WIN % 256 == 0 && WS_MOD % 256 == 0 && WS_ROPE % 256 == 0 && WS_Z % 256 == 0 && WS_H % 256 == 0 && WS_OG % 256 == 0 && WS_LSE % 256 == 0 && WS_OATT % 256 == 0 && WS_OHG % 256 == 0 && WS_YMIX % 256 == 0 && WS_HS % 256 == 0 && WS_HD % 256 == 0, "align");
constexpr int LDS_BYTES = 131072 + 4096 + 256;
constexpr int NPH = 18;

struct Params { const float* in[25]; float* out; unsigned char* ws; int ph_lo, ph_hi; };

DI float bf2f(unsigned b) { return __uint_as_float(b << 16); }
DI float bflo(unsigned w) { return __uint_as_float(w << 16); }
DI float bfhi(unsigned w) { return __uint_as_float(w & 0xffff0000u); }
DI unsigned pk2(float lo, float hi) { unsigned r; asm("v_cvt_pk_bf16_f32 %0, %1, %2" : "=v"(r) : "v"(lo), "v"(hi)); return r; }
DI float sigm(float x) { return __builtin_amdgcn_rcpf(1.f + __expf(-x)); }
DI float silu(float x) { return x * __builtin_amdgcn_rcpf(1.f + __expf(-x)); }
DI float wave_sum(float v) {
#pragma unroll
    for (int o = 32; o >= 1; o >>= 1) v += __shfl_xor(v, o);
    return v;
}
DI float wave_max(float v) {
#pragma unroll
    for (int o = 32; o >= 1; o >>= 1) v = fmaxf(v, __shfl_xor(v, o));
    return v;
}
DI void lds_fence() { asm volatile("s_waitcnt lgkmcnt(0)" ::: "memory"); __builtin_amdgcn_wave_barrier(); }
DI bf16x8 gat8(const LAS bf16_t* p, int stride) {
    bf16x8 r;
#pragma unroll
    for (int j = 0; j < 8; ++j) r[j] = (short)p[j * stride];
    return r;
}
DI bf16x8 ld8(const LAS bf16_t* p) { return *(const LAS bf16x8*)p; }
typedef short s16x4 __attribute__((ext_vector_type(4)));
template <int OFF> DI s16x4 tr_read(unsigned vb) { s16x4 r; asm volatile("ds_read_b64_tr_b16 %0, %1 offset:%2" : "=&v"(r) : "v"(vb), "i"(OFF) : "memory"); return r; }
DI f32x4 mfma16(bf16x8 a, bf16x8 b, f32x4 c) { return __builtin_amdgcn_mfma_f32_16x16x32_bf16(a, b, c, 0, 0, 0); }
DI f32x16 mfma32(bf16x8 a, bf16x8 b, f32x16 c) { return __builtin_amdgcn_mfma_f32_32x32x16_bf16(a, b, c, 0, 0, 0); }
DI void unpack8(u32x4 w, float (&f)[8]) { f[0] = bflo(w.x); f[1] = bfhi(w.x); f[2] = bflo(w.y); f[3] = bfhi(w.y); f[4] = bflo(w.z); f[5] = bfhi(w.z); f[6] = bflo(w.w); f[7] = bfhi(w.w); }
DI void atom_add(float* p, float v) { (void)__hip_atomic_fetch_add(p, v, __ATOMIC_RELAXED, __HIP_MEMORY_SCOPE_AGENT); }
DI void ld8f(const float* s, float (&f)[8]) { const f32x4 a = *(const f32x4*)s, b = *(const f32x4*)(s + 4); f[0] = a[0]; f[1] = a[1]; f[2] = a[2]; f[3] = a[3]; f[4] = b[0]; f[5] = b[1]; f[6] = b[2]; f[7] = b[3]; }
DI int crow_of(int r) { return r < TP ? 0 : 1 + ((r - TP) >> 2); }

struct EpiZ {
    static constexpr bool PERM = true, AFTER_DRAIN = false;
    bf16_t* Z; const float* rope; float* out; const float* c0; const float* c1; const float* c2;
    static constexpr int CPY_R0 = 32 * 124, CPY_R1 = 32 * 508, CPY_R2 = 32 * 2044, CPY_ROWS = CPY_R0 + CPY_R1 + CPY_R2, CPY_PER = 28;
    DI void cpy_row(int r, const float*& src, float*& dst) const {
        if (r < CPY_R0) { const int b = r / 124, rr = r - b * 124; src = c0 + ((size_t)(b * 128 + rr + 4)) * 1024; dst = out + OFF_KVS0 + ((size_t)(b * 128 + rr)) * 1024; }
        else if (r < CPY_R0 + CPY_R1) { r -= CPY_R0; const int b = r / 508, rr = r - b * 508; src = c1 + ((size_t)(b * 512 + rr + 4)) * 1024; dst = out + OFF_KVS1 + ((size_t)(b * 512 + rr)) * 1024; }
        else { r -= CPY_R0 + CPY_R1; const int b = r / 2044, rr = r - b * 2044; src = c2 + ((size_t)(b * 2048 + rr + 4)) * 1024; dst = out + OFF_KVS2 + ((size_t)(b * 2048 + rr)) * 1024; }
    }
    DI void operator()(const f32x4 (&acc)[2][2][4][2], const Unit& u, int wr, int wc, int fr, int fq) const {
        {
            int l4 = (wc * 64 + fq * 16 + fr) * 4; asm volatile("" : "+v"(l4));
            const int r0 = (u.pm * 50 + u.pn) * CPY_PER;
#pragma unroll
            for (int h2 = 0; h2 < 2; ++h2) {
                f32x4 v[7];
#pragma unroll
                for (int q = 0; q < 7; ++q) { int r = r0 + (h2 * 7 + q) * 2 + wr; r = r < CPY_ROWS ? r : r - CPY_ROWS; const float* sp; float* dp; cpy_row(r, sp, dp); v[q] = __builtin_nontemporal_load((const f32x4*)(sp + l4)); }
#pragma unroll
                for (int q = 0; q < 7; ++q) { int r = r0 + (h2 * 7 + q) * 2 + wr; r = r < CPY_ROWS ? r : r - CPY_ROWS; const float* sp; float* dp; cpy_row(r, sp, dp); __builtin_nontemporal_store(v[q], (f32x4*)(dp + l4)); }
            }
        }
        const int kind = u.pn < 6 ? 0 : (u.pn < 12 ? 1 : (u.pn < 18 ? 2 : 3));
        const bool do_rope = (kind <= 1) && (wc == 0);
        const int pnn = (kind == 1) ? u.pn - 6 : u.pn - 12;
        const int g = pnn >> 1, W = 128 << (2 * g);
        const size_t offp = g == 0 ? OFF_KVP0 : (g == 1 ? OFF_KVP1 : OFF_KVP2), offs = g == 0 ? OFF_KVS0 : (g == 1 ? OFF_KVS1 : OFF_KVS2);
        const float sg = (fq < 2) ? -1.f : 1.f;
#pragma unroll
        for (int ai = 0; ai < 2; ++ai)
#pragma unroll
            for (int m = 0; m < 4; ++m) {
                const int r = u.pm * 256 + ai * 128 + wr * 64 + m * 16 + fr;
                f32x4 cs0 = {0.f, 0.f, 0.f, 0.f}, cs1 = cs0, sn0 = cs0, sn1 = cs0;
                if (do_rope) { const float* rp = rope + (size_t)r * 32 + 8 * (fq & 1); cs0 = *(const f32x4*)rp; cs1 = *(const f32x4*)(rp + 4); sn0 = *(const f32x4*)(rp + 16); sn1 = *(const f32x4*)(rp + 20); }
#pragma unroll
                for (int bj = 0; bj < 2; ++bj) {
                    f32x4 v0 = acc[ai][bj][m][0], v1 = acc[ai][bj][m][1];
                    if (do_rope) {
                        f32x4 p0, p1;
#pragma unroll
                        for (int j = 0; j < 4; ++j) { p0[j] = __shfl_xor(v0[j], 32); p1[j] = __shfl_xor(v1[j], 32); }
                        v0 = v0 * cs0 + sg * (p0 * sn0); v1 = v1 * cs1 + sg * (p1 * sn1);
                    }
                    const int c = u.pn * 256 + bj * 128 + wc * 32 + 8 * fq;
                    u32x4 w; w.x = pk2(v0[0], v0[1]); w.y = pk2(v0[2], v0[3]); w.z = pk2(v1[0], v1[1]); w.w = pk2(v1[2], v1[3]);
                    *(u32x4*)(Z + (size_t)r * NZ + c) = w;
                    if (kind == 1 || kind == 2) {
                        const int hh = 2 * (pnn & 1) + bj, dd = wc * 32 + 8 * fq, kv = kind - 1;
                        float* dst = nullptr;
                        if (r < TP) { if (r >= TP - W) dst = out + offp + ((size_t)(r - (TP - W)) * 2 + kv) * 512 + hh * 128 + dd; }
                        else if (r < MR) { const int b = (r - TP) >> 2, t = (r - TP) & 3; dst = out + offs + ((size_t)(b * W + W - 4 + t) * 2 + kv) * 512 + hh * 128 + dd; }
                        if (dst) { *(f32x4*)dst = v0; *(f32x4*)(dst + 4) = v1; }
                    }
                }
            }
    }
};
struct EpiMix1 {
    static constexpr bool PERM = false, AFTER_DRAIN = false;
    const bf16_t* Z; float* TMP; float* accs;
    DI void operator()(const f32x4 (&acc)[2][2][4][2], const Unit& u, int wr, int wc, int fr, int fq) const {
        if (u.pm == 64) {
#pragma unroll
            for (int m = 0; m < 4; ++m)
#pragma unroll
                for (int bj = 0; bj < 2; ++bj)
#pragma unroll
                    for (int n = 0; n < 2; ++n) *(f32x4*)(accs + ((size_t)(u.kt0 >> 2) * NS + (wr * 64 + m * 16 + fr)) * D + u.pn * 256 + bj * 128 + wc * 32 + 16 * n + 4 * fq) = acc[0][bj][m][n];
            return;
        }
#pragma unroll
        for (int ai = 0; ai < 2; ++ai)
#pragma unroll
            for (int m = 0; m < 4; ++m) {
                const int r = u.pm * 256 + ai * 128 + wr * 64 + m * 16 + fr;
#pragma unroll
                for (int bj = 0; bj < 2; ++bj)
#pragma unroll
                    for (int n = 0; n < 2; ++n) {
                        const int c = u.pn * 256 + bj * 128 + wc * 32 + 16 * n + 4 * fq;
                        const u32x2 gw = *(const u32x2*)(Z + (size_t)r * NZ + ZGA + c);
                        f32x4 v = acc[ai][bj][m][n];
                        v[0] *= sigm(bflo(gw.x)); v[1] *= sigm(bfhi(gw.x)); v[2] *= sigm(bflo(gw.y)); v[3] *= sigm(bfhi(gw.y));
                        *(f32x4*)(TMP + (size_t)r * D + c) = v;
                    }
            }
    }
};
struct EpiMix2 {
    static constexpr bool PERM = false, AFTER_DRAIN = false;
    const bf16_t* Z; const float* TMP; bf16_t* Y; float* accs;
    DI void operator()(const f32x4 (&acc)[2][2][4][2], const Unit& u, int wr, int wc, int fr, int fq) const {
        if (u.pm == 64) {
#pragma unroll
            for (int m = 0; m < 4; ++m)
#pragma unroll
                for (int bj = 0; bj < 2; ++bj)
#pragma unroll
                    for (int n = 0; n < 2; ++n) *(f32x4*)(accs + ((size_t)(u.kt0 >> 2) * NS + (wr * 64 + m * 16 + fr)) * D + u.pn * 256 + bj * 128 + wc * 32 + 16 * n + 4 * fq) = acc[0][bj][m][n];
            return;
        }
#pragma unroll
        for (int ai = 0; ai < 2; ++ai)
#pragma unroll
            for (int m = 0; m < 4; ++m) {
                const int r = u.pm * 256 + ai * 128 + wr * 64 + m * 16 + fr;
#pragma unroll
                for (int bj = 0; bj < 2; ++bj)
#pragma unroll
                    for (int n = 0; n < 2; ++n) {
                        const int c = u.pn * 256 + bj * 128 + wc * 32 + 16 * n + 4 * fq;
                        const u32x2 gw = *(const u32x2*)(Z + (size_t)r * NZ + ZGB + c);
                        const f32x4 t = *(const f32x4*)(TMP + (size_t)r * D + c);
                        f32x4 v = acc[ai][bj][m][n];
                        v[0] = t[0] + v[0] * sigm(bflo(gw.x)); v[1] = t[1] + v[1] * sigm(bfhi(gw.x)); v[2] = t[2] + v[2] * sigm(bflo(gw.y)); v[3] = t[3] + v[3] * sigm(bfhi(gw.y));
                        u32x2 w; w.x = pk2(v[0], v[1]); w.y = pk2(v[2], v[3]);
                        *(u32x2*)(Y + (size_t)r * D + c) = w;
                    }
            }
    }
};
struct EpiWO {
    static constexpr bool PERM = false, AFTER_DRAIN = false;
    const float* xp; const float* xs; const float* mod; float* out; float* accs;
    DI void operator()(const f32x4 (&acc)[2][2][4][2], const Unit& u, int wr, int wc, int fr, int fq) const {
        if (u.pm == 64) {
#pragma unroll
            for (int m = 0; m < 4; ++m)
#pragma unroll
                for (int bj = 0; bj < 2; ++bj)
#pragma unroll
                    for (int n = 0; n < 2; ++n) {
                        float* d = accs + ((size_t)(u.kt0 >> 2) * NS + (wr * 64 + m * 16 + fr)) * D + u.pn * 256 + bj * 128 + wc * 32 + 16 * n + 4 * fq;
                        *(f32x4*)d = acc[0][bj][m][n];
                    }
            return;
        }
#pragma unroll
        for (int ai = 0; ai < 2; ++ai)
#pragma unroll
            for (int m = 0; m < 4; ++m) {
                const int r = u.pm * 256 + ai * 128 + wr * 64 + m * 16 + fr;
                if (r < MR) {
                    const float* xr = r < TP ? xp + (size_t)r * D : xs + (size_t)(r - TP) * D;
                    const float* g1 = mod + (size_t)crow_of(r) * NMOD + 2 * D;
#pragma unroll
                    for (int bj = 0; bj < 2; ++bj)
#pragma unroll
                        for (int n = 0; n < 2; ++n) {
                            const int c = u.pn * 256 + bj * 128 + wc * 32 + 16 * n + 4 * fq;
                            const f32x4 xv = *(const f32x4*)(xr + c), gv = *(const f32x4*)(g1 + c);
                            *(f32x4*)(out + (size_t)r * D + c) = xv + gv * acc[ai][bj][m][n];
                        }
                }
            }
    }
};
struct EpiDown {
    static constexpr bool PERM = false, AFTER_DRAIN = false;
    const float* mod; float* out; float* accs;
    DI void operator()(const f32x4 (&acc)[2][2][4][2], const Unit& u, int wr, int wc, int fr, int fq) const {
        if (u.pm == 64) {
#pragma unroll
            for (int m = 0; m < 4; ++m)
#pragma unroll
                for (int bj = 0; bj < 2; ++bj)
#pragma unroll
                    for (int n = 0; n < 2; ++n) {
                        float* d = accs + ((size_t)(u.kt0 >> 2) * NS + (wr * 64 + m * 16 + fr)) * D + u.pn * 256 + bj * 128 + wc * 32 + 16 * n + 4 * fq;
                        *(f32x4*)d = acc[0][bj][m][n];
                    }
            return;
        }
#pragma unroll
        for (int ai = 0; ai < 2; ++ai)
#pragma unroll
            for (int m = 0; m < 4; ++m) {
                const int r = u.pm * 256 + ai * 128 + wr * 64 + m * 16 + fr;
                if (r < MR) {
                    const float* g2 = mod + (size_t)crow_of(r) * NMOD + 5 * D;
#pragma unroll
                    for (int bj = 0; bj < 2; ++bj)
#pragma unroll
                        for (int n = 0; n < 2; ++n) {
                            const int c = u.pn * 256 + bj * 128 + wc * 32 + 16 * n + 4 * fq;
                            float* o = out + (size_t)r * D + c;
                            const f32x4 xv = *(const f32x4*)o, gv = *(const f32x4*)(g2 + c);
                            *(f32x4*)o = xv + gv * acc[ai][bj][m][n];
                        }
                }
            }
    }
};
struct EpiUp {
    static constexpr bool PERM = true, AFTER_DRAIN = false;
    bf16_t* AB; bf16_t* G; float* out; float* accs; const float* cw; const float* cb; LAS float* xch;
    DI void operator()(const f32x4 (&acc)[2][2][4][2], const Unit& u, int wr, int wc, int fr, int fq) const {
        int cl = 32 * wc + 8 * fq;
        if (u.pm == 64) {
#pragma unroll
            for (int m = 0; m < 4; ++m)
#pragma unroll
                for (int bj = 0; bj < 2; ++bj)
#pragma unroll
                    for (int n = 0; n < 2; ++n) {
                        float* d = accs + ((size_t)(u.kt0 >> 2) * NS + (wr * 64 + m * 16 + fr)) * NAB + bj * DFF + 128 * u.pn + cl + 4 * n;
                        *(f32x4*)d = acc[0][bj][m][n];
                    }
            return;
        }
        asm volatile("" : "+v"(cl), "+v"(fr), "+v"(fq));
        const int lane = fq * 16 + fr;
        if (fr >= 14) {
#pragma unroll
            for (int ai = 0; ai < 2; ++ai) { LAS float* d = xch + ((2 * ai + wr) * 2 + (fr - 14)) * 128 + cl; *(LAS f32x4*)d = acc[ai][0][3][0]; *(LAS f32x4*)(d + 4) = acc[ai][0][3][1]; }
        }
        asm volatile("s_waitcnt lgkmcnt(0)" ::: "memory"); __builtin_amdgcn_s_barrier(); __builtin_amdgcn_s_barrier(); asm volatile("" ::: "memory");
        const int src1 = (lane & 48) | ((fr + 15) & 15), src2 = (lane & 48) | ((fr + 14) & 15);
#pragma unroll
        for (int n = 0; n < 2; ++n) {
            const int c = 128 * u.pn + cl + 4 * n;
            const f32x4 w0 = *(const f32x4*)(cw + c), w1 = *(const f32x4*)(cw + DFF + c), w2 = *(const f32x4*)(cw + 2 * DFF + c), bb = *(const f32x4*)(cb + c);
#pragma unroll
            for (int ai = 0; ai < 2; ++ai) {
                const int q = 2 * ai + wr;
                f32x4 y1 = {0.f, 0.f, 0.f, 0.f}, z1 = y1;
                if (q > 0) { y1 = *(const LAS f32x4*)(xch + ((q - 1) * 2 + 1) * 128 + cl + 4 * n); z1 = *(const LAS f32x4*)(xch + ((q - 1) * 2 + (fr == 0 ? 0 : 1)) * 128 + cl + 4 * n); }
#pragma unroll
                for (int m = 0; m < 4; ++m) {
                    const f32x4 av = acc[ai][0][m][n], bv = acc[ai][1][m][n];
                    f32x4 o;
#pragma unroll
                    for (int j = 0; j < 4; ++j) {
                        const float y = __shfl(av[j], src1), z = __shfl(av[j], src2);
                        const float a1 = fr >= 1 ? y : y1[j], a0 = fr >= 2 ? z : z1[j];
                        y1[j] = y; z1[j] = z;
                        const float uu = bb[j] + w0[j] * a0 + w1[j] * a1 + w2[j] * av[j];
                        o[j] = silu(uu) * bv[j];
                    }
                    const int rl = 128 * ai + 64 * wr + 16 * m + fr, rg = 256 * u.pm + rl;
                    const bool edge0 = rl < 2, edge1 = rl >= 254;
                    if (!(edge0 && u.pm > 0)) { u32x2 w; w.x = pk2(o[0], o[1]); w.y = pk2(o[2], o[3]); *(u32x2*)(G + (size_t)rg * DFF + c) = w; }
                    if (edge0 || edge1) {
                        u32x2 w; w.x = pk2(av[0], av[1]); w.y = pk2(av[2], av[3]); *(u32x2*)(AB + (size_t)rg * NAB + c) = w;
                        if (edge0) { u32x2 x; x.x = pk2(bv[0], bv[1]); x.y = pk2(bv[2], bv[3]); *(u32x2*)(AB + (size_t)rg * NAB + DFF + c) = x; }
                        if (edge1 && u.pm == 63) *(f32x4*)(out + OFF_CVP + (size_t)(rl - 254) * DFF + c) = av;
                    }
                    asm volatile("" ::: "memory");
                }
            }
        }
    }
};

DI void ph_mod(const Params& p, LAS unsigned char* L, float* mod) {
    LAS float* sS = (LAS float*)L;
    LAS float* sRed = (LAS float*)L;
    const int tid = threadIdx.x, cgp = tid % 24, ksub = tid / 24;
    const float* cpr = p.in[7]; const float* csm = p.in[8]; const float* wada = p.in[9]; const float* bada = p.in[10];
    for (int nb = blockIdx.x; nb < 256; nb += gridDim.x) {
        const int n0 = nb * 48;
        float acc[33][2];
#pragma unroll
        for (int r = 0; r < 33; ++r) { acc[r][0] = 0.f; acc[r][1] = 0.f; }
        for (int kc = 0; kc < 4; ++kc) {
            f32x2 wv[25];
#pragma unroll
            for (int q = 0; q < 25; ++q) { const int kk = ksub + 21 * q; wv[q] = (ksub < 21 && kk < 512) ? *(const f32x2*)(wada + (size_t)(kc * 512 + kk) * NMOD + n0 + 2 * cgp) : (f32x2){0.f, 0.f}; }
            for (int idx = tid; idx < 33 * 512; idx += 512) {
                const int r = idx >> 9, kk = idx & 511;
                const float c = r == 0 ? cpr[kc * 512 + kk] : csm[(r - 1) * D + kc * 512 + kk];
                sS[kk * 36 + r] = silu(c);
            }
            __syncthreads();
#pragma unroll
            for (int q = 0; q < 25; ++q) {
                const int kk = ksub + 21 * q;
                if (ksub < 21 && kk < 512) {
                    const f32x2 w = wv[q];
                    const LAS f32x4* sp = (const LAS f32x4*)(sS + kk * 36);
#pragma unroll
                    for (int r4 = 0; r4 < 9; ++r4) {
                        const f32x4 sv = sp[r4];
#pragma unroll
                        for (int j = 0; j < 4; ++j) { if (4 * r4 + j < 33) { acc[4 * r4 + j][0] += sv[j] * w[0]; acc[4 * r4 + j][1] += sv[j] * w[1]; } }
                    }
                }
            }
            __syncthreads();
        }
#pragma unroll
        for (int r0 = 0; r0 < 33; r0 += 11) {
            if (ksub < 21) {
#pragma unroll
                for (int i = 0; i < 11; ++i) { sRed[ksub * 528 + i * 48 + 2 * cgp] = acc[r0 + i][0]; sRed[ksub * 528 + i * 48 + 2 * cgp + 1] = acc[r0 + i][1]; }
            }
            __syncthreads();
            for (int o = tid; o < 528; o += 512) {
                float sum = 0.f;
                for (int k2 = 0; k2 < 21; ++k2) sum += sRed[k2 * 528 + o];
                const int i = o / 48, c = o % 48;
                mod[(size_t)(r0 + i) * NMOD + n0 + c] = sum + bada[n0 + c];
            }
            __syncthreads();
        }
    }
}
DI void tr_load(const float* W, int N, int r, int lane, f32x4 (&v)[8]) {
    const int nblk = N / 32, kb = r / nblk, nb = r % nblk, k0 = 64 * kb, n0 = 32 * nb;
#pragma unroll
    for (int i = 0; i < 8; ++i) v[i] = *(const f32x4*)(W + (size_t)(k0 + 8 * i + (lane >> 3)) * N + n0 + 4 * (lane & 7));
}
DI void tr_finish(bf16_t* WT, int K, int N, int inter, int r, LAS float* scr, int lane, const f32x4 (&v)[8]) {
    const int nblk = N / 32, kb = r / nblk, nb = r % nblk, k0 = 64 * kb, n0 = 32 * nb;
#pragma unroll
    for (int i = 0; i < 8; ++i) { LAS float* dd = scr + (8 * i + (lane >> 3)) * 33 + 4 * (lane & 7); dd[0] = v[i][0]; dd[1] = v[i][1]; dd[2] = v[i][2]; dd[3] = v[i][3]; }
    lds_fence();
    const int c = lane & 7;
#pragma unroll
    for (int j = 0; j < 4; ++j) { const int n = (lane >> 3) + 8 * j; const LAS float* s = scr + (8 * c) * 33 + n;
        u32x4 o; o.x = pk2(s[0 * 33], s[1 * 33]); o.y = pk2(s[2 * 33], s[3 * 33]); o.z = pk2(s[4 * 33], s[5 * 33]); o.w = pk2(s[6 * 33], s[7 * 33]);
        const int na = n0 + n, drow = inter < 0 ? na : ((na >> 7) << 8) + inter * 128 + (na & 127);
        *(u32x4*)(WT + (size_t)drow * K + k0 + 8 * c) = o; }
    lds_fence();
}
constexpr int TR_I_IN = 32 * 400, TR_I_PA = 8 * 64, TR_I_PB = 16 * 64, TR_I_O = 32 * 64, TR_I_A = 32 * 176, TR_I_DN = 88 * 64;
constexpr int TR_NITEMS = TR_I_IN + TR_I_PA + TR_I_PB + TR_I_O + 2 * TR_I_A + TR_I_DN;
struct TrSrc { const float *w_in, *w_pa, *w_pb, *w_o, *w_a, *w_b, *w_dn; };
DI void tr_decode(const TrSrc& q, unsigned char* ws, int it, const float*& W, bf16_t*& WT, int& K, int& N, int& inter, int& r) {
    r = it; inter = -1;
    if (r < TR_I_IN) { W = q.w_in; WT = (bf16_t*)(ws + WS_WIN); K = D; N = NZ; return; } r -= TR_I_IN;
    if (r < TR_I_PA) { W = q.w_pa; WT = (bf16_t*)(ws + WS_WPA); K = 512; N = D; return; } r -= TR_I_PA;
    if (r < TR_I_PB) { W = q.w_pb; WT = (bf16_t*)(ws + WS_WPB); K = 1024; N = D; return; } r -= TR_I_PB;
    if (r < TR_I_O) { W = q.w_o; WT = (bf16_t*)(ws + WS_WO); K = D; N = D; return; } r -= TR_I_O;
    if (r < TR_I_A) { W = q.w_a; WT = (bf16_t*)(ws + WS_WAB); K = D; N = DFF; inter = 0; return; } r -= TR_I_A;
    if (r < TR_I_A) { W = q.w_b; WT = (bf16_t*)(ws + WS_WAB); K = D; N = DFF; inter = 1; return; } r -= TR_I_A;
    W = q.w_dn; WT = (bf16_t*)(ws + WS_WDN); K = DFF; N = D;
}
DI void ph_prologue(const Params& p, LAS unsigned char* L) {
    unsigned char* ws = p.ws;
    const int tid = threadIdx.x, lane = tid & 63, wave = tid >> 6;
    const int gw = blockIdx.x * 8 + wave, NGW = gridDim.x * 8;
    const size_t gtid = (size_t)blockIdx.x * 512 + tid, gstride = (size_t)gridDim.x * 512;
    ph_mod(p, L, (float*)(ws + WS_MOD));
    LAS float* scr = (LAS float*)(L + wave * 8448);
    const TrSrc tq{p.in[12], p.in[15], p.in[16], p.in[17], p.in[19], p.in[20], p.in[23]};
    for (int it = gw; it < TR_NITEMS; it += 2 * NGW) {
        const float* W0; bf16_t* T0; int K0, N0, i0, r0; tr_decode(tq, ws, it, W0, T0, K0, N0, i0, r0);
        const int it1 = it + NGW; const bool two = it1 < TR_NITEMS;
        const float* W1; bf16_t* T1; int K1, N1, i1, r1; tr_decode(tq, ws, two ? it1 : it, W1, T1, K1, N1, i1, r1);
        f32x4 v0[8], v1[8];
        tr_load(W0, N0, r0, lane, v0); tr_load(W1, N1, r1, lane, v1);
        tr_finish(T0, K0, N0, i0, r0, scr, lane, v0);
        if (two) tr_finish(T1, K1, N1, i1, r1, scr, lane, v1);
    }
    {
        float* rope = (float*)(ws + WS_ROPE);
        for (size_t idx = gtid; idx < (size_t)MR * 16; idx += gstride) {
            const int m = (int)(idx >> 4), i = (int)(idx & 15);
            const int pos = m < TP ? m : TP + ((m - TP) & 3);
            const float invf = (float)exp2(-(double)i * (18.931568569324174 / 16.0));
            const float ang = (float)pos * invf;
            const double x = (double)ang, n = rint(x * 0.15915494309189535);
            double rr = fma(-n, 6.283185307179586, x); rr = fma(-n, 2.4492935982947064e-16, rr);
            rope[(size_t)m * 32 + i] = cosf((float)rr); rope[(size_t)m * 32 + 16 + i] = sinf((float)rr);
        }
    }
}
DI const float* hn_src(const Params& p, const float* xbase, bool from_out, int m) {
    const bool fix = from_out && m >= TP;
    return (from_out && !fix) ? xbase + (size_t)m * D : (m < TP ? p.in[0] + (size_t)m * D : p.in[1] + (size_t)(m - TP) * D);
}
DI void ph_hnorm(const Params& p, float* xbase, bool from_out, const float* nw, int sh_idx, bf16_t* H) {
    const int lane = threadIdx.x & 63, wave = threadIdx.x >> 6, stride = gridDim.x * 8;
    const float* mod = (const float*)(p.ws + WS_MOD);
    int m = blockIdx.x * 8 + wave;
    f32x4 v[8];
    if (m < MR) { const float* xr = hn_src(p, xbase, from_out, m);
#pragma unroll
        for (int j = 0; j < 8; ++j) v[j] = *(const f32x4*)(xr + 4 * lane + 256 * j); }
    while (m < MR) {
        const int mn = m + stride; f32x4 vn[8];
        if (mn < MR) { const float* xr = hn_src(p, xbase, from_out, mn);
#pragma unroll
            for (int j = 0; j < 8; ++j) vn[j] = *(const f32x4*)(xr + 4 * lane + 256 * j); }
        const bool fix = from_out && m >= TP;
        const float* md = mod + (size_t)crow_of(m) * NMOD + sh_idx * D;
        float ss = 0.f;
#pragma unroll
        for (int j = 0; j < 8; ++j) { const int c = 4 * lane + 256 * j;
            if (fix) { f32x4 a = {0.f, 0.f, 0.f, 0.f}; for (int q = 0; q < NSP_WO; ++q) a = a + *(const f32x4*)((const float*)(p.ws + WS_ACC_WO) + ((size_t)q * NS + (m - TP)) * D + c); const f32x4 g = *(const f32x4*)(mod + (size_t)crow_of(m) * NMOD + 2 * D + c); v[j] = v[j] + g * a; *(f32x4*)(xbase + (size_t)m * D + c) = v[j]; }
            ss += v[j][0] * v[j][0] + v[j][1] * v[j][1] + v[j][2] * v[j][2] + v[j][3] * v[j][3]; }
        const float rstd = rsqrtf(wave_sum(ss) * (1.f / D) + EPS);
#pragma unroll
        for (int j = 0; j < 8; ++j) {
            const int c = 4 * lane + 256 * j;
            const f32x4 w = *(const f32x4*)(nw + c), shv = *(const f32x4*)(md + c), scv = *(const f32x4*)(md + D + c);
            const f32x4 o = (v[j] * rstd) * w * (1.f + scv) + shv;
            u32x2 q; q.x = pk2(o[0], o[1]); q.y = pk2(o[2], o[3]);
            *(u32x2*)(H + (size_t)m * D + c) = q;
        }
#pragma unroll
        for (int j = 0; j < 8; ++j) v[j] = vn[j];
        m = mn;
    }
}
DI void ph_final_norm(const Params& p) {
    const int lane = threadIdx.x & 63, wave = threadIdx.x >> 6, stride = gridDim.x * 8;
    const float* nw = p.in[24];
    int m = blockIdx.x * 8 + wave;
    f32x4 v[8];
    if (m < MR) {
#pragma unroll
        for (int j = 0; j < 8; ++j) v[j] = *(const f32x4*)(p.out + (size_t)m * D + 4 * lane + 256 * j); }
    while (m < MR) {
        const int mn = m + stride; f32x4 vn[8];
        if (mn < MR) {
#pragma unroll
            for (int j = 0; j < 8; ++j) vn[j] = *(const f32x4*)(p.out + (size_t)mn * D + 4 * lane + 256 * j); }
        float* xr = p.out + (size_t)m * D;
        float ss = 0.f;
#pragma unroll
        for (int j = 0; j < 8; ++j) { const int c = 4 * lane + 256 * j;
            if (m >= TP) { f32x4 a = {0.f, 0.f, 0.f, 0.f}; for (int q = 0; q < NSP_DN; ++q) a = a + *(const f32x4*)((const float*)(p.ws + WS_ACC_DN) + ((size_t)q * NS + (m - TP)) * D + c); const f32x4 g = *(const f32x4*)((const float*)(p.ws + WS_MOD) + (size_t)crow_of(m) * NMOD + 5 * D + c); v[j] = v[j] + g * a; }
            ss += v[j][0] * v[j][0] + v[j][1] * v[j][1] + v[j][2] * v[j][2] + v[j][3] * v[j][3]; }
        const float rstd = rsqrtf(wave_sum(ss) * (1.f / D) + EPS);
#pragma unroll
        for (int j = 0; j < 8; ++j) { const int c = 4 * lane + 256 * j; const f32x4 w = *(const f32x4*)(nw + c); *(f32x4*)(xr + c) = (v[j] * rstd) * w; }
#pragma unroll
        for (int j = 0; j < 8; ++j) v[j] = vn[j];
        m = mn;
    }
}

DI void attn_prompt_item(const bf16_t* Z, bf16_t* OG, float* LSE, LAS bf16_t* Vl, int item, int lane) {
    const int g = item >> 11, rem = item & 2047, hh = rem >> 9, bidx = rem & 511;
    const int dsh = 2 * g, nsh = 9 - dsh;
    const int res = bidx >> nsh, blk = bidx & ((1 << nsh) - 1);
    const int s0 = blk * 32, head = g * 4 + hh;
    const int qi = lane & 31, h = lane >> 5;
    const int tq = res + ((s0 + qi) << dsh);
    bf16x8 Qf[8];
    { const bf16_t* qp = Z + (size_t)tq * NZ + ZQ + head * 128 + 8 * h;
#pragma unroll
      for (int ks = 0; ks < 8; ++ks) Qf[ks] = *(const bf16x8*)(qp + 16 * ks); }
    float mrun = -INFINITY, lrun = 0.f;
    f32x16 O[4];
#pragma unroll
    for (int dt = 0; dt < 4; ++dt)
#pragma unroll
        for (int i = 0; i < 16; ++i) O[dt][i] = 0.f;
    const int sq = s0 + qi;
    const int vrow = lane >> 4, vch = lane & 15;
    const unsigned vtr = (unsigned)(unsigned long long)Vl + (unsigned)(((4 * h + ((lane & 15) >> 2)) * 136 + 16 * ((lane >> 4) & 1) + 4 * (lane & 3)) * 2);
    bf16x8 Kc[8]; u32x4 Vr[8];
#define ATT_LOAD_KV(kt_) do { const int kb_ = s0 - 128 + 32 * (kt_); int skl_ = kb_ + qi; skl_ = skl_ < 0 ? 0 : skl_; \
        const bf16_t* kp_ = Z + (size_t)(res + (skl_ << dsh)) * NZ + ZK + head * 128 + 8 * h; \
        _Pragma("unroll") for (int ks = 0; ks < 8; ++ks) Kc[ks] = *(const bf16x8*)(kp_ + 16 * ks); \
        _Pragma("unroll") for (int i = 0; i < 8; ++i) { int sv_ = kb_ + 4 * i + vrow; sv_ = sv_ < 0 ? 0 : sv_; \
            Vr[i] = *(const u32x4*)(Z + (size_t)(res + (sv_ << dsh)) * NZ + ZV + head * 128 + 8 * vch); } } while (0)
    ATT_LOAD_KV(4);
    for (int kt = 4; kt >= 0; --kt) {
        const int kb = s0 - 128 + 32 * kt;
        f32x16 S;
#pragma unroll
        for (int i = 0; i < 16; ++i) S[i] = 0.f;
#pragma unroll
        for (int ks = 0; ks < 8; ++ks) S = mfma32(Kc[ks], Qf[ks], S);
#pragma unroll
        for (int i = 0; i < 8; ++i) *(LAS u32x4*)(Vl + (4 * i + vrow) * 136 + 8 * vch) = Vr[i];
        if (kt > 0) ATT_LOAD_KV(kt - 1);
        float tmax = -INFINITY;
#pragma unroll
        for (int i = 0; i < 16; ++i) {
            const int sk = kb + (i & 3) + 8 * (i >> 2) + 4 * h;
            const bool valid = (sk >= 0) && (sk <= sq) && (sk >= sq - 128);
            S[i] = valid ? S[i] * ATT_SCALE : -INFINITY;
            tmax = fmaxf(tmax, S[i]);
        }
        tmax = fmaxf(tmax, __shfl_xor(tmax, 32));
        const float mn = fmaxf(mrun, tmax), alpha = __expf(mrun - mn);
        float ps = 0.f;
#pragma unroll
        for (int i = 0; i < 16; ++i) { S[i] = __expf(S[i] - mn); ps += S[i]; }
        ps += __shfl_xor(ps, 32);
        lrun = lrun * alpha + ps; mrun = mn;
#pragma unroll
        for (int dt = 0; dt < 4; ++dt) O[dt] = O[dt] * alpha;
        bf16x8 Pf[2];
#pragma unroll
        for (int s2 = 0; s2 < 2; ++s2) {
            u32x4 w; w.x = pk2(S[8 * s2 + 0], S[8 * s2 + 1]); w.y = pk2(S[8 * s2 + 2], S[8 * s2 + 3]); w.z = pk2(S[8 * s2 + 4], S[8 * s2 + 5]); w.w = pk2(S[8 * s2 + 6], S[8 * s2 + 7]);
            Pf[s2] = __builtin_bit_cast(bf16x8, w);
        }
        lds_fence();
        const s16x4 l00 = tr_read<0>(vtr), h00 = tr_read<2176>(vtr);
        const s16x4 l01 = tr_read<4352>(vtr), h01 = tr_read<6528>(vtr);
        const s16x4 l10 = tr_read<64>(vtr), h10 = tr_read<2240>(vtr);
        const s16x4 l11 = tr_read<4416>(vtr), h11 = tr_read<6592>(vtr);
        const s16x4 l20 = tr_read<128>(vtr), h20 = tr_read<2304>(vtr);
        const s16x4 l21 = tr_read<4480>(vtr), h21 = tr_read<6656>(vtr);
        const s16x4 l30 = tr_read<192>(vtr), h30 = tr_read<2368>(vtr);
        const s16x4 l31 = tr_read<4544>(vtr), h31 = tr_read<6720>(vtr);
        asm volatile("s_waitcnt lgkmcnt(0)" ::: "memory"); __builtin_amdgcn_sched_barrier(0);
#define PK8(L_, H_) (bf16x8){L_[0], L_[1], L_[2], L_[3], H_[0], H_[1], H_[2], H_[3]}
        O[0] = mfma32(PK8(l00, h00), Pf[0], O[0]);
        O[0] = mfma32(PK8(l01, h01), Pf[1], O[0]);
        O[1] = mfma32(PK8(l10, h10), Pf[0], O[1]);
        O[1] = mfma32(PK8(l11, h11), Pf[1], O[1]);
        O[2] = mfma32(PK8(l20, h20), Pf[0], O[2]);
        O[2] = mfma32(PK8(l21, h21), Pf[1], O[2]);
        O[3] = mfma32(PK8(l30, h30), Pf[0], O[3]);
        O[3] = mfma32(PK8(l31, h31), Pf[1], O[3]);
#undef PK8
        lds_fence();
    }
#undef ATT_LOAD_KV
    const float inv = 1.f / lrun;
    bf16_t* op = OG + ((size_t)g * MP + tq) * 512 + hh * 128 + 4 * h;
#pragma unroll
    for (int dt = 0; dt < 4; ++dt)
#pragma unroll
        for (int rq = 0; rq < 4; ++rq) {
            u32x2 w; w.x = pk2(O[dt][4 * rq] * inv, O[dt][4 * rq + 1] * inv); w.y = pk2(O[dt][4 * rq + 2] * inv, O[dt][4 * rq + 3] * inv);
            *(u32x2*)(op + 32 * dt + 8 * rq) = w;
        }
    if (h == 0) LSE[((size_t)g * MP + tq) * 4 + hh] = mrun + __logf(lrun);
}
DI const float* samp_row(const float* cache, const float* newkv, int b, int W, int rr) {
    return (rr >= W) ? newkv + ((size_t)(b * W + rr - 4) * 2) * 512 : cache + ((size_t)(b * W + rr) * 2) * 512;
}
DI void attn_sample_item(const Params& p, const bf16_t* Z, bf16_t* OG, float* LSE, int item, int lane) {
    const int b = item / 48, r48 = item % 48, t = r48 / 12, head = r48 % 12, g = head >> 2, hh = head & 3;
    const int dsh = 2 * g, W = 128 << dsh;
    const float* cache = p.in[2 + g];
    const float* newkv = p.out + (g == 0 ? OFF_KVS0 : (g == 1 ? OFF_KVS1 : OFF_KVS2));
    const int m = TP + b * 4 + t;
    const unsigned qq = *(const unsigned*)(Z + (size_t)m * NZ + ZQ + head * 128 + 2 * lane);
    const float q0 = bflo(qq) * ATT_SCALE, q1 = bfhi(qq) * ATT_SCALE;
    float mrun, lrun, o0, o1;
    {
        const float* rp = samp_row(cache, newkv, b, W, W + t - (128 << dsh)) + hh * 128 + 2 * lane;
        const f32x2 kk = *(const f32x2*)rp, vv = *(const f32x2*)(rp + 512);
        mrun = wave_sum(q0 * kk.x + q1 * kk.y); lrun = 1.f; o0 = vv.x; o1 = vv.y;
    }
    f32x2 kk[16], vv[16];
#pragma unroll
    for (int u = 0; u < 16; ++u) { const float* rp = samp_row(cache, newkv, b, W, W + t - (u << dsh)) + hh * 128 + 2 * lane; kk[u] = *(const f32x2*)rp; vv[u] = *(const f32x2*)(rp + 512); }
    for (int j0 = 0; j0 < 128; j0 += 16) {
        f32x2 kn[16], vn[16];
        if (j0 + 16 < 128) {
#pragma unroll
            for (int u = 0; u < 16; ++u) { const float* rp = samp_row(cache, newkv, b, W, W + t - ((j0 + 16 + u) << dsh)) + hh * 128 + 2 * lane; kn[u] = *(const f32x2*)rp; vn[u] = *(const f32x2*)(rp + 512); }
        }
        float pr[16];
#pragma unroll
        for (int u = 0; u < 16; ++u) pr[u] = q0 * kk[u].x + q1 * kk[u].y;
#pragma unroll
        for (int o = 32; o >= 1; o >>= 1) {
#pragma unroll
            for (int u = 0; u < 16; ++u) pr[u] += __shfl_xor(pr[u], o);
        }
        float bm = pr[0];
#pragma unroll
        for (int u = 1; u < 16; ++u) bm = fmaxf(bm, pr[u]);
        const float mn = fmaxf(mrun, bm), alpha = __expf(mrun - mn);
        lrun *= alpha; o0 *= alpha; o1 *= alpha; mrun = mn;
#pragma unroll
        for (int u = 0; u < 16; ++u) { const float pu = __expf(pr[u] - mn); lrun += pu; o0 += pu * vv[u].x; o1 += pu * vv[u].y; }
#pragma unroll
        for (int u = 0; u < 16; ++u) { kk[u] = kn[u]; vv[u] = vn[u]; }
    }
    const float inv = 1.f / lrun;
    *(unsigned*)(OG + ((size_t)g * MP + m) * 512 + hh * 128 + 2 * lane) = pk2(o0 * inv, o1 * inv);
    if (lane == 0) LSE[((size_t)g * MP + m) * 4 + hh] = mrun + __logf(lrun);
}

DI float hg_gates(const Params& p, const bf16_t (&fhr)[16], int h, LAS float* tot, float (&kk)[16], float (&bb)[16]) {
    const int tid = threadIdx.x, dk = tid & 127, part = tid >> 7;
    const float* lbp = p.in[13];
    const float lb = 1.f / (1.f + __expf(lbp[1024 + h * 128 + dk] - lbp[h * 128 + dk]));
    float cum = 0.f;
#pragma unroll
    for (int i = 0; i < 16; ++i) {
        const float fh = bf2f(fhr[i]);
        const float f = lb + (1.f - lb) * sigm(fh);
        kk[i] = 1.f - f; cum += __logf(f); bb[i] = cum;
    }
    tot[part * 128 + dk] = cum;
    __syncthreads();
    float off = 0.f, bl = 0.f;
#pragma unroll
    for (int q = 0; q < 4; ++q) { const float tv = tot[q * 128 + dk]; bl += tv; off += (q < part) ? tv : 0.f; }
#pragma unroll
    for (int i = 0; i < 16; ++i) bb[i] += off;
    return bl;
}
DI void hg_load_v(const bf16_t* Z, int n, int h, LAS bf16_t* Vs) {
    const int tid = threadIdx.x;
#pragma unroll
    for (int i = 0; i < 2; ++i) { const int e = tid + 512 * i, s = e >> 4, ch = e & 15;
        *(LAS u32x4*)(Vs + s * 136 + 8 * ch) = *(const u32x4*)(Z + (size_t)(64 * n + s) * NZ + ZIH + h * 128 + 8 * ch); }
}
struct HgaRegs { bf16_t fhr[16]; u32x4 vreg[2]; };
DI void hg_passA_load(const bf16_t* Z, int item, HgaRegs& R) {
    const int n = item >> 3, h = item & 7;
    const int tid = threadIdx.x, dk = tid & 127, part = tid >> 7;
#pragma unroll
    for (int i = 0; i < 16; ++i) R.fhr[i] = Z[(size_t)(64 * n + 16 * part + i) * NZ + ZFH + h * 128 + dk];
#pragma unroll
    for (int i = 0; i < 2; ++i) { const int e = tid + 512 * i; R.vreg[i] = *(const u32x4*)(Z + (size_t)(64 * n + (e >> 4)) * NZ + ZIH + h * 128 + 8 * (e & 15)); }
}
DI void hg_passA_item(const Params& p, float* HS, float* HD, LAS unsigned char* L, int item, const HgaRegs& R) {
    const int n = item >> 3, h = item & 7;
    const int tid = threadIdx.x, lane = tid & 63, wave = tid >> 6, dk = tid & 127, part = tid >> 7;
    LAS bf16_t* Kh = (LAS bf16_t*)L;
    LAS bf16_t* Vs = (LAS bf16_t*)(L + 17408);
    LAS float* tot = (LAS float*)(L + 34816);
    float kk[16], bb[16];
    const float bl = hg_gates(p, R.fhr, h, tot, kk, bb);
#pragma unroll
    for (int i = 0; i < 16; ++i) Kh[(16 * part + i) * 136 + dk] = (bf16_t)(pk2(kk[i] * __expf(bl - bb[i]), 0.f) & 0xffffu);
    if (part == 0) HD[(size_t)(n * 8 + h) * 128 + dk] = __expf(bl);
#pragma unroll
    for (int i = 0; i < 2; ++i) { const int e = tid + 512 * i; *(LAS u32x4*)(Vs + (e >> 4) * 136 + 8 * (e & 15)) = R.vreg[i]; }
    __syncthreads();
    f32x4 acc[8];
#pragma unroll
    for (int nt = 0; nt < 8; ++nt) acc[nt] = (f32x4){0.f, 0.f, 0.f, 0.f};
#pragma unroll
    for (int ks = 0; ks < 2; ++ks) {
        const bf16x8 A = gat8(Kh + (32 * ks + 8 * (lane >> 4)) * 136 + 16 * wave + (lane & 15), 136);
#pragma unroll
        for (int nt = 0; nt < 8; ++nt) { const bf16x8 B = gat8(Vs + (32 * ks + 8 * (lane >> 4)) * 136 + 16 * nt + (lane & 15), 136); acc[nt] = mfma16(A, B, acc[nt]); }
    }
    float* up = HS + ((size_t)(n * 8 + h) * 128) * 128;
#pragma unroll
    for (int nt = 0; nt < 8; ++nt)
#pragma unroll
        for (int r = 0; r < 4; ++r) up[(size_t)(16 * wave + 4 * (lane >> 4) + r) * 128 + 16 * nt + (lane & 15)] = acc[nt][r];
    __syncthreads();
}
DI void hg_scan(const Params& p, float* HS, const float* HD) {
    for (int e = blockIdx.x * 512 + threadIdx.x; e < 131072; e += gridDim.x * 512) {
        float S = 0.f;
        for (int n0 = 0; n0 < 256; n0 += 32) {
            float U[32], Dd[32];
#pragma unroll
            for (int j = 0; j < 32; ++j) { U[j] = HS[(size_t)(n0 + j) * 131072 + e]; Dd[j] = HD[(n0 + j) * 1024 + (e >> 7)]; }
#pragma unroll
            for (int j = 0; j < 32; ++j) { HS[(size_t)(n0 + j) * 131072 + e] = S; S = Dd[j] * S + U[j]; }
        }
        p.out[OFF_HGP + e] = S;
    }
}
struct HgcRegs { bf16_t fhr[16], qhr[16]; u32x4 vreg[2]; f32x4 sreg[8]; };
DI void hg_passC_load(const bf16_t* Z, const float* HS, int item, HgcRegs& R) {
    const int n = item >> 3, h = item & 7;
    const int tid = threadIdx.x, dk = tid & 127, part = tid >> 7;
#pragma unroll
    for (int i = 0; i < 16; ++i) { const size_t ro = (size_t)(64 * n + 16 * part + i) * NZ + h * 128 + dk; R.fhr[i] = Z[ro + ZFH]; R.qhr[i] = Z[ro + ZQH]; }
#pragma unroll
    for (int i = 0; i < 2; ++i) { const int e = tid + 512 * i; R.vreg[i] = *(const u32x4*)(Z + (size_t)(64 * n + (e >> 4)) * NZ + ZIH + h * 128 + 8 * (e & 15)); }
    const float* sp = HS + ((size_t)(n * 8 + h) * 128) * 128;
#pragma unroll
    for (int i = 0; i < 8; ++i) { const int e = tid + 512 * i; R.sreg[i] = *(const f32x4*)(sp + (e >> 5) * 128 + 4 * (e & 31)); }
}
DI void hg_passC_item(const Params& p, const bf16_t* Z, bf16_t* OHG, LAS unsigned char* L, int item, const HgcRegs& R) {
    const int n = item >> 3, h = item & 7;
    const int tid = threadIdx.x, lane = tid & 63, wave = tid >> 6, dk = tid & 127, part = tid >> 7;
    LAS bf16_t* Qs = (LAS bf16_t*)L;
    LAS bf16_t* Ks = (LAS bf16_t*)(L + 17408);
    LAS bf16_t* Vs = (LAS bf16_t*)(L + 34816);
    LAS bf16_t* Ss = (LAS bf16_t*)(L + 52224);
    LAS bf16_t* As = (LAS bf16_t*)(L + 87040);
    LAS float* tot = (LAS float*)(L + 96256);
    LAS float* red = (LAS float*)(L + 98304);
    float kk[16], bb[16];
    const int mt = wave >> 1, wh = wave & 1, lr = lane & 15, lq = lane >> 4;
    bf16_t ghr[16];
#pragma unroll
    for (int r = 0; r < 4; ++r)
#pragma unroll
        for (int j = 0; j < 4; ++j) ghr[r * 4 + j] = Z[(size_t)(64 * n + 16 * mt + 4 * lq + r) * NZ + ZGH + h * 128 + 16 * (4 * wh + j) + lr];
    (void)hg_gates(p, R.fhr, h, tot, kk, bb);
#pragma unroll
    for (int i = 0; i < 16; ++i) {
        const int s = 16 * part + i;
        const float qh = bf2f(R.qhr[i]);
        Qs[s * 136 + dk] = (bf16_t)(pk2(silu(qh) * __expf(bb[i]), 0.f) & 0xffffu);
        Ks[s * 136 + dk] = (bf16_t)(pk2(kk[i] * __expf(-bb[i]), 0.f) & 0xffffu);
    }
#pragma unroll
    for (int i = 0; i < 2; ++i) { const int e = tid + 512 * i; *(LAS u32x4*)(Vs + (e >> 4) * 136 + 8 * (e & 15)) = R.vreg[i]; }
#pragma unroll
    for (int i = 0; i < 8; ++i) { const int e = tid + 512 * i; u32x2 w; w.x = pk2(R.sreg[i][0], R.sreg[i][1]); w.y = pk2(R.sreg[i][2], R.sreg[i][3]); *(LAS u32x2*)(Ss + (e >> 5) * 136 + 4 * (e & 31)) = w; }
    __syncthreads();
    {
        f32x4 a2[2] = {{0.f, 0.f, 0.f, 0.f}, {0.f, 0.f, 0.f, 0.f}};
#pragma unroll
        for (int ks = 0; ks < 4; ++ks) {
            const bf16x8 A = ld8(Qs + (16 * mt + lr) * 136 + 32 * ks + 8 * lq);
#pragma unroll
            for (int j = 0; j < 2; ++j) { const bf16x8 B = ld8(Ks + (16 * (2 * wh + j) + lr) * 136 + 32 * ks + 8 * lq); a2[j] = mfma16(A, B, a2[j]); }
        }
#pragma unroll
        for (int j = 0; j < 2; ++j)
#pragma unroll
            for (int r = 0; r < 4; ++r) { const int t = 16 * mt + 4 * lq + r, s = 16 * (2 * wh + j) + lr; As[t * 72 + s] = (bf16_t)(pk2(s <= t ? a2[j][r] : 0.f, 0.f) & 0xffffu); }
    }
    __syncthreads();
    f32x4 acc[4];
#pragma unroll
    for (int j = 0; j < 4; ++j) acc[j] = (f32x4){0.f, 0.f, 0.f, 0.f};
#pragma unroll
    for (int ks = 0; ks < 2; ++ks) {
        const bf16x8 A = ld8(As + (16 * mt + lr) * 72 + 32 * ks + 8 * lq);
#pragma unroll
        for (int j = 0; j < 4; ++j) { const bf16x8 B = gat8(Vs + (32 * ks + 8 * lq) * 136 + 16 * (4 * wh + j) + lr, 136); acc[j] = mfma16(A, B, acc[j]); }
    }
#pragma unroll
    for (int ks = 0; ks < 4; ++ks) {
        const bf16x8 A = ld8(Qs + (16 * mt + lr) * 136 + 32 * ks + 8 * lq);
#pragma unroll
        for (int j = 0; j < 4; ++j) { const bf16x8 B = gat8(Ss + (32 * ks + 8 * lq) * 136 + 16 * (4 * wh + j) + lr, 136); acc[j] = mfma16(A, B, acc[j]); }
    }
#pragma unroll
    for (int r = 0; r < 4; ++r) {
        float ss = 0.f;
#pragma unroll
        for (int j = 0; j < 4; ++j) ss += acc[j][r] * acc[j][r];
        ss += __shfl_xor(ss, 1); ss += __shfl_xor(ss, 2); ss += __shfl_xor(ss, 4); ss += __shfl_xor(ss, 8);
        if (lr == 0) red[(16 * mt + 4 * lq + r) * 2 + wh] = ss;
    }
    __syncthreads();
    const float* hgw = p.in[14];
#pragma unroll
    for (int r = 0; r < 4; ++r) {
        const int tl = 16 * mt + 4 * lq + r, t = 64 * n + tl;
        const float rstd = rsqrtf((red[tl * 2] + red[tl * 2 + 1]) * (1.f / 128.f) + EPS);
#pragma unroll
        for (int j = 0; j < 4; ++j) {
            const int dv = 16 * (4 * wh + j) + lr;
            const float gh = bf2f(ghr[r * 4 + j]);
            OHG[(size_t)t * 1024 + h * 128 + dv] = (bf16_t)(pk2(acc[j][r] * rstd * hgw[dv] * silu(gh), 0.f) & 0xffffu);
        }
    }
    __syncthreads();
}
DI void hg_sample_item(const Params& p, const bf16_t* Z, bf16_t* OHG, LAS unsigned char* L, int item) {
    const int b = item >> 3, h = item & 7;
    const int tid = threadIdx.x, dv = tid & 127, dq = tid >> 7;
    LAS float* fS = (LAS float*)L;
    LAS float* kS = fS + 512;
    LAS float* qS = kS + 512;
    LAS float* red = qS + 512;
    LAS float* rs = red + 2048;
    const float* lbp = p.in[13];
    {
        const int t = tid >> 7, dk = tid & 127, m = TP + b * 4 + t;
        const float lb = 1.f / (1.f + __expf(lbp[1024 + h * 128 + dk] - lbp[h * 128 + dk]));
        const float fh = bf2f(Z[(size_t)m * NZ + ZFH + h * 128 + dk]), qh = bf2f(Z[(size_t)m * NZ + ZQH + h * 128 + dk]);
        const float f = lb + (1.f - lb) * sigm(fh);
        fS[tid] = f; kS[tid] = 1.f - f; qS[tid] = silu(qh);
    }
    float S[32];
    const float* s0 = p.in[5] + ((size_t)(b * 8 + h) * 128) * 128;
#pragma unroll
    for (int i = 0; i < 32; ++i) S[i] = s0[(size_t)(dq * 32 + i) * 128 + dv];
    __syncthreads();
#pragma unroll
    for (int t = 0; t < 4; ++t) {
        const int m = TP + b * 4 + t;
        const float v = bf2f(Z[(size_t)m * NZ + ZIH + h * 128 + dv]);
        float part = 0.f;
#pragma unroll
        for (int i = 0; i < 32; ++i) { const int dk = dq * 32 + i; S[i] = fS[t * 128 + dk] * S[i] + kS[t * 128 + dk] * v; part += S[i] * qS[t * 128 + dk]; }
        red[(t * 4 + dq) * 128 + dv] = part;
    }
    float* so = p.out + OFF_HGS + ((size_t)(b * 8 + h) * 128) * 128;
#pragma unroll
    for (int i = 0; i < 32; ++i) so[(size_t)(dq * 32 + i) * 128 + dv] = S[i];
    __syncthreads();
    {
        const int t = tid >> 7, m = TP + b * 4 + t;
        const float o = red[(t * 4 + 0) * 128 + dv] + red[(t * 4 + 1) * 128 + dv] + red[(t * 4 + 2) * 128 + dv] + red[(t * 4 + 3) * 128 + dv];
        const float ss = wave_sum(o * o);
        if ((tid & 63) == 0) rs[tid >> 6] = ss;
        __syncthreads();
        const float rstd = rsqrtf((rs[2 * t] + rs[2 * t + 1]) * (1.f / 128.f) + EPS);
        const float gh = bf2f(Z[(size_t)m * NZ + ZGH + h * 128 + dv]);
        OHG[(size_t)m * 1024 + h * 128 + dv] = (bf16_t)(pk2(o * rstd * p.in[14][dv] * silu(gh), 0.f) & 0xffffu);
    }
    __syncthreads();
}
DI void ph_merge(const bf16_t* OG, const float* LSE, bf16_t* OATT) {
    for (size_t idx = (size_t)blockIdx.x * 512 + threadIdx.x; idx < (size_t)MR * 64; idx += (size_t)gridDim.x * 512) {
        const int m = (int)(idx >> 6), c8 = (int)(idx & 63), hh = c8 >> 4;
        const float l0 = LSE[((size_t)0 * MP + m) * 4 + hh], l1 = LSE[((size_t)1 * MP + m) * 4 + hh], l2 = LSE[((size_t)2 * MP + m) * 4 + hh];
        const float mx = fmaxf(l0, fmaxf(l1, l2));
        float w0 = __expf(l0 - mx), w1 = __expf(l1 - mx), w2 = __expf(l2 - mx);
        const float inv = 1.f / (w0 + w1 + w2); w0 *= inv; w1 *= inv; w2 *= inv;
        float a[8], b[8], c[8];
        unpack8(*(const u32x4*)(OG + ((size_t)0 * MP + m) * 512 + 8 * c8), a);
        unpack8(*(const u32x4*)(OG + ((size_t)1 * MP + m) * 512 + 8 * c8), b);
        unpack8(*(const u32x4*)(OG + ((size_t)2 * MP + m) * 512 + 8 * c8), c);
        u32x4 o;
        o.x = pk2(w0 * a[0] + w1 * b[0] + w2 * c[0], w0 * a[1] + w1 * b[1] + w2 * c[1]);
        o.y = pk2(w0 * a[2] + w1 * b[2] + w2 * c[2], w0 * a[3] + w1 * b[3] + w2 * c[3]);
        o.z = pk2(w0 * a[4] + w1 * b[4] + w2 * c[4], w0 * a[5] + w1 * b[5] + w2 * c[5]);
        o.w = pk2(w0 * a[6] + w1 * b[6] + w2 * c[6], w0 * a[7] + w1 * b[7] + w2 * c[7]);
        *(u32x4*)(OATT + (size_t)m * 512 + 8 * c8) = o;
    }
}
DI void ld8p(const float* s, float (&f)[8]) {
    f32x4 a = {0.f, 0.f, 0.f, 0.f}, b = a;
#pragma unroll
    for (int q = 0; q < NSP_UP; ++q) { a = a + *(const f32x4*)(s + (size_t)q * NS * NAB); b = b + *(const f32x4*)(s + (size_t)q * NS * NAB + 4); }
    f[0] = a[0]; f[1] = a[1]; f[2] = a[2]; f[3] = a[3]; f[4] = b[0]; f[5] = b[1]; f[6] = b[2]; f[7] = b[3];
}
DI void ph_convact(const Params& p, const bf16_t* AB, bf16_t* G) {
    const float* cw = p.in[21]; const float* cb = p.in[22]; const float* sc = p.in[6];
    const float* ACC = (const float*)(p.ws + WS_ACC_UP);
    for (size_t idx = (size_t)blockIdx.x * 512 + threadIdx.x; idx < (size_t)(126 + NS) * 704; idx += (size_t)gridDim.x * 512) {
        const int ri = (int)(idx / 704), c = (int)(idx % 704) * 8;
        const int m = ri < 126 ? 256 * (1 + (ri >> 1)) + (ri & 1) : TP + (ri - 126);
        float a2[8], a1[8], a0[8], bl[8];
        if (m < TP) {
            unpack8(*(const u32x4*)(AB + (size_t)m * NAB + c), a2);
            unpack8(*(const u32x4*)(AB + (size_t)m * NAB + DFF + c), bl);
            if (m >= 1) unpack8(*(const u32x4*)(AB + (size_t)(m - 1) * NAB + c), a1); else { for (int j = 0; j < 8; ++j) a1[j] = 0.f; }
            if (m >= 2) unpack8(*(const u32x4*)(AB + (size_t)(m - 2) * NAB + c), a0); else { for (int j = 0; j < 8; ++j) a0[j] = 0.f; }
        } else {
            const int ms = m - TP, t = ms & 3, b = ms >> 2;
            ld8p(ACC + (size_t)ms * NAB + c, a2);
            ld8p(ACC + (size_t)ms * NAB + DFF + c, bl);
            if (t >= 1) ld8p(ACC + (size_t)(ms - 1) * NAB + c, a1); else ld8f(sc + (size_t)(b * 2 + 1) * DFF + c, a1);
            if (t >= 2) ld8p(ACC + (size_t)(ms - 2) * NAB + c, a0); else ld8f(sc + (size_t)(b * 2 + t) * DFF + c, a0);
            if (t >= 2) { float* d = p.out + OFF_CVS + (size_t)(b * 2 + t - 2) * DFF + c; *(f32x4*)d = (f32x4){a2[0], a2[1], a2[2], a2[3]}; *(f32x4*)(d + 4) = (f32x4){a2[4], a2[5], a2[6], a2[7]}; }
        }
        float w0[8], w1[8], w2[8], bb[8];
        ld8f(cw + c, w0); ld8f(cw + DFF + c, w1); ld8f(cw + 2 * DFF + c, w2); ld8f(cb + c, bb);
        float o[8];
#pragma unroll
        for (int j = 0; j < 8; ++j) { const float u = bb[j] + w0[j] * a0[j] + w1[j] * a1[j] + w2[j] * a2[j]; o[j] = silu(u) * bl[j]; }
        u32x4 w; w.x = pk2(o[0], o[1]); w.y = pk2(o[2], o[3]); w.z = pk2(o[4], o[5]); w.w = pk2(o[6], o[7]);
        *(u32x4*)(G + (size_t)m * DFF + c) = w;
    }
}

DI void ph_mixfix(const Params& p) {
    const bf16_t* Z = (const bf16_t*)(p.ws + WS_Z); const float* PA = (const float*)(p.ws + WS_ACC_PA); const float* PB = (const float*)(p.ws + WS_ACC_PB); bf16_t* Y = (bf16_t*)(p.ws + WS_YMIX);
    for (int idx = blockIdx.x * 512 + threadIdx.x; idx < NS * (D / 4); idx += gridDim.x * 512) {
        const int r = idx / (D / 4), c = (idx % (D / 4)) * 4;
        f32x4 a = {0.f, 0.f, 0.f, 0.f}, b = a;
#pragma unroll
        for (int q = 0; q < NSP_PA; ++q) a = a + *(const f32x4*)(PA + ((size_t)q * NS + r) * D + c);
#pragma unroll
        for (int q = 0; q < NSP_PB; ++q) b = b + *(const f32x4*)(PB + ((size_t)q * NS + r) * D + c);
        const u32x2 ga = *(const u32x2*)(Z + (size_t)(TP + r) * NZ + ZGA + c), gb = *(const u32x2*)(Z + (size_t)(TP + r) * NZ + ZGB + c);
        const float y0 = sigm(bflo(ga.x)) * a[0] + sigm(bflo(gb.x)) * b[0], y1 = sigm(bfhi(ga.x)) * a[1] + sigm(bfhi(gb.x)) * b[1];
        const float y2 = sigm(bflo(ga.y)) * a[2] + sigm(bflo(gb.y)) * b[2], y3 = sigm(bfhi(ga.y)) * a[3] + sigm(bfhi(gb.y)) * b[3];
        u32x2 w; w.x = pk2(y0, y1); w.y = pk2(y2, y3);
        *(u32x2*)(Y + (size_t)(TP + r) * D + c) = w;
    }
}
#define XB_TMO      128
#define XB_XCNT(j)  (256  + 64 * (j))
#define XB_XSUB(j)  (1280 + 64 * (j))
#define XB_XGEN(j)  (2304 + 64 * (j))
#define XB_TOP      3328
#define XB_TOPGEN   3392
#define XCD_BAR_WORDS 3456
#define XB_SPIN_CAP (1u << 18)

__device__ __forceinline__ unsigned xb_ld(unsigned* p)              { return __hip_atomic_load(p, __ATOMIC_RELAXED, __HIP_MEMORY_SCOPE_AGENT); }
__device__ __forceinline__ unsigned xb_add(unsigned* p, unsigned v) { return __hip_atomic_fetch_add(p, v, __ATOMIC_RELAXED, __HIP_MEMORY_SCOPE_AGENT); }
__device__ __forceinline__ unsigned xb_xcc_id() { return (unsigned)__builtin_amdgcn_s_getreg((3 << 11) | 20) & 0xFu; }
#define XB_SPIN(cond, bar) do { unsigned _sp = 0; while (cond) { __builtin_amdgcn_s_sleep(1); \
    if ((++_sp & 255u) == 0u) { if (xb_ld(&(bar)[XB_TMO])) break; if (_sp > XB_SPIN_CAP) { atomicAdd(&(bar)[XB_TMO], 1u); break; } } } } while (0)

struct XcdBarrier {
    unsigned* bar; unsigned x;
    volatile LAS unsigned* st;
};

__device__ __forceinline__ XcdBarrier xcd_barrier_post(unsigned* bar, volatile LAS unsigned* st) {
    XcdBarrier b; b.bar = bar; b.x = xb_xcc_id(); b.st = st;
    if (threadIdx.x == 0) (void)xb_add(&bar[XB_XCNT(b.x)], 1u);
    return b;
}
__device__ __forceinline__ void xcd_barrier_complete(unsigned* bar, unsigned x, unsigned& nloc, unsigned& nx) {
    const unsigned G = gridDim.x * gridDim.y * gridDim.z;
    unsigned sum, cnt, mine, sp = 0u;
    for (;;) {
        sum = 0u; cnt = 0u; mine = 0u;
#pragma unroll
        for (unsigned j = 0; j < 16; ++j) { const unsigned c = xb_ld(&bar[XB_XCNT(j)]); sum += c; cnt += (c > 0u) ? 1u : 0u; mine = (j == x) ? c : mine; }
        if (sum == G) break;
        __builtin_amdgcn_s_sleep(1);
        if ((++sp & 255u) == 0u) { if (xb_ld(&bar[XB_TMO])) break; if (sp > XB_SPIN_CAP) { atomicAdd(&bar[XB_TMO], 1u); break; } }
    }
    nloc = mine > 0u ? mine : 1u; nx = cnt > 0u ? cnt : 1u;
}

__device__ __forceinline__ void xcd_barrier(const XcdBarrier& b) {
    asm volatile("s_waitcnt vmcnt(0)" ::: "memory");
    __syncthreads();
    if (threadIdx.x == 0) {
        unsigned* bar = b.bar;
        __builtin_amdgcn_s_waitcnt(0);
        unsigned nloc = b.st[0], nx = b.st[1];
        if (nloc == 0u) { xcd_barrier_complete(bar, b.x, nloc, nx); b.st[0] = nloc; b.st[1] = nx; }
        const unsigned old = xb_add(&bar[XB_XSUB(b.x)], 1u);
        const unsigned gen = old / nloc;
        if (old + 1u == (gen + 1u) * nloc) {
            __builtin_amdgcn_fence(__ATOMIC_RELEASE, "agent");
            asm volatile("s_waitcnt vmcnt(0)" ::: "memory");
            const unsigned og = xb_add(&bar[XB_TOP], 1u);
            const unsigned tg = og / nx;
            if (og + 1u == (tg + 1u) * nx) xb_add(&bar[XB_TOPGEN], 1u);
            else XB_SPIN(xb_ld(&bar[XB_TOPGEN]) == tg, bar);
            __builtin_amdgcn_fence(__ATOMIC_ACQUIRE, "agent");
            xb_add(&bar[XB_XGEN(b.x)], 1u);
            asm volatile("s_waitcnt vmcnt(0)" ::: "memory");
        } else {
            XB_SPIN(xb_ld(&bar[XB_XGEN(b.x)]) == gen, bar);
            __builtin_amdgcn_fence(__ATOMIC_ACQUIRE, "agent");
            asm volatile("s_waitcnt vmcnt(0)" ::: "memory");
        }
    }
    __syncthreads();
}

template <class Epi> DI void run_gemm(LAS unsigned char* L, const bf16_t* A, const bf16_t* Bt, int N, int K, const Epi& E) {
    pg8::Gemm g{A, Bt, MP, N, K}; pg8::StaticOrder S; S.init(MP, N, K, (int)gridDim.x, (int)blockIdx.x);
    pg8::gemm_phase<Epi, pg8::StaticOrder, false>(L, g, S, E, nullptr);
}
template <class Epi> DI void run_gemm_split(LAS unsigned char* L, const bf16_t* A, const bf16_t* Bt, int N, int K, const Epi& E) {
    pg8::Gemm g{A, Bt, MP, N, K}; pg8::SplitOrder S; S.init(N, K, (int)gridDim.x, (int)blockIdx.x);
    pg8::gemm_phase<Epi, pg8::SplitOrder, false>(L, g, S, E, nullptr);
}

__global__ void __launch_bounds__(512, 2) mega(Params p) {
    extern __shared__ __attribute__((aligned(16))) unsigned char lds[];
    LAS unsigned char* L = (LAS unsigned char*)lds;
    cg::grid_group grid = cg::this_grid();
    unsigned char* ws = p.ws;
    const int lo = p.ph_lo, hi = p.ph_hi;
    const int tid = threadIdx.x, lane = tid & 63, wave = tid >> 6;
    bf16_t* Z = (bf16_t*)(ws + WS_Z);
    bf16_t* H = (bf16_t*)(ws + WS_H);
    float* MOD = (float*)(ws + WS_MOD);
#define IN(k) (lo <= (k) && (k) < hi)
    XcdBarrier xbar; xbar.bar = (unsigned*)ws; xbar.x = 0; xbar.st = (volatile LAS unsigned*)(L + 131072 + 4096);
    if (hi - lo > 1) {
        if (threadIdx.x < 2) xbar.st[threadIdx.x] = 0u;
        __syncthreads();
        xbar = xcd_barrier_post((unsigned*)ws, (volatile LAS unsigned*)(L + 131072 + 4096));
        grid.sync();
    }
#define SEAM(k) do { if (IN(k) && IN((k) + 1)) xcd_barrier(xbar); } while (0)
#define SOFT(k) do { if (IN(k) && IN((k) + 1)) __syncthreads(); } while (0)
    if (IN(0)) ph_prologue(p, L);
    SEAM(0);
    if (IN(1)) ph_hnorm(p, nullptr, false, p.in[11], 0, H);
    SEAM(1);
    if (IN(2)) { EpiZ E{Z, (const float*)(ws + WS_ROPE), p.out, p.in[2], p.in[3], p.in[4]}; run_gemm(L, H, (const bf16_t*)(ws + WS_WIN), NZ, D, E); }
    SEAM(2);
    if (IN(3)) {
        HgaRegs RA;
        int it = blockIdx.x;
        if (it < 2048) hg_passA_load(Z, it, RA);
        while (it < 2048) {
            const int itn = it + gridDim.x; HgaRegs RB;
            if (itn < 2048) hg_passA_load(Z, itn, RB);
            hg_passA_item(p, (float*)(ws + WS_HS), (float*)(ws + WS_HD), L, it, RA);
            RA = RB; it = itn;
        }
    }
    SOFT(3);
    if (IN(4)) {
        const int gw = blockIdx.x * 8 + wave, NGW = gridDim.x * 8;
        LAS bf16_t* Vl = (LAS bf16_t*)(L + wave * 8704);
        for (int base = 0; base < 6144; base += 3 * NGW)
            for (int j = 0; j < 3; ++j) { const int it = base + gw * 3 + j; if (it < 6144) attn_prompt_item(Z, (bf16_t*)(ws + WS_OG), (float*)(ws + WS_LSE), Vl, it, lane); }
    }
    SOFT(4);
    if (IN(5)) { const int gw = blockIdx.x * 8 + wave, NGW = gridDim.x * 8; for (int it = gw; it < 1536; it += NGW) attn_sample_item(p, Z, (bf16_t*)(ws + WS_OG), (float*)(ws + WS_LSE), it, lane); }
    SEAM(5);
    if (IN(6)) hg_scan(p, (float*)(ws + WS_HS), (const float*)(ws + WS_HD));
    SEAM(6);
    if (IN(7)) {
        HgcRegs RA;
        int it = blockIdx.x;
        if (it < 2048) hg_passC_load(Z, (const float*)(ws + WS_HS), it, RA);
        while (it < 2048) {
            const int itn = it + gridDim.x; HgcRegs RB;
            if (itn < 2048) hg_passC_load(Z, (const float*)(ws + WS_HS), itn, RB);
            hg_passC_item(p, Z, (bf16_t*)(ws + WS_OHG), L, it, RA);
            RA = RB; it = itn;
        }
    }
    SOFT(7);
    if (IN(8)) for (int it = blockIdx.x; it < 256; it += gridDim.x) hg_sample_item(p, Z, (bf16_t*)(ws + WS_OHG), L, it);
    SOFT(8);
    if (IN(9)) ph_merge((const bf16_t*)(ws + WS_OG), (const float*)(ws + WS_LSE), (bf16_t*)(ws + WS_OATT));
    SEAM(9);
    if (IN(10)) {
        { EpiMix1 E{Z, (float*)(ws + WS_TMP), (float*)(ws + WS_ACC_PA)}; run_gemm_split(L, (const bf16_t*)(ws + WS_OATT), (const bf16_t*)(ws + WS_WPA), D, 512, E); }
        { EpiMix2 E{Z, (const float*)(ws + WS_TMP), (bf16_t*)(ws + WS_YMIX), (float*)(ws + WS_ACC_PB)}; run_gemm_split(L, (const bf16_t*)(ws + WS_OHG), (const bf16_t*)(ws + WS_WPB), D, 1024, E); }
    }
    SEAM(10);
    if (IN(11)) ph_mixfix(p);
    SEAM(11);
    if (IN(12)) { EpiWO E{p.in[0], p.in[1], MOD, p.out, (float*)(ws + WS_ACC_WO)}; run_gemm_split(L, (const bf16_t*)(ws + WS_YMIX), (const bf16_t*)(ws + WS_WO), D, D, E); }
    SEAM(12);
    if (IN(13)) ph_hnorm(p, p.out, true, p.in[18], 3, H);
    SEAM(13);
    if (IN(14)) { EpiUp E{(bf16_t*)(ws + WS_AB), (bf16_t*)(ws + WS_G), p.out, (float*)(ws + WS_ACC_UP), p.in[21], p.in[22], (LAS float*)(L + 131072)}; run_gemm_split(L, H, (const bf16_t*)(ws + WS_WAB), NAB, D, E); }
    SEAM(14);
    if (IN(15)) ph_convact(p, (const bf16_t*)(ws + WS_AB), (bf16_t*)(ws + WS_G));
    SEAM(15);
    if (IN(16)) { EpiDown E{MOD, p.out, (float*)(ws + WS_ACC_DN)}; run_gemm_split(L, (const bf16_t*)(ws + WS_G), (const bf16_t*)(ws + WS_WDN), D, DFF, E); }
    SEAM(16);
    if (IN(17)) ph_final_norm(p);
#undef IN
#undef SEAM
#undef SOFT
}

#ifndef MK_MULTI
#define MK_MULTI 0
#endif
extern "C" void kernel_launch(void* const* d_in, const int* in_sizes, int n_in, void* d_out, int out_size, void* d_ws, size_t ws_size, hipStream_t stream) {
    static int grid = 0;
    if (grid == 0) {
        if (n_in != 25 || (size_t)out_size != OUT_TOTAL || ws_size < WS_END) { fprintf(stderr, "kernel_launch: unexpected shapes: n_in %d out %d ws %zu (need %zu)\n", n_in, out_size, ws_size, (size_t)WS_END); grid = -1; return; }
        int dev = 0, cus = 0, per_cu = 0;
        hipGetDevice(&dev);
        hipDeviceGetAttribute(&cus, hipDeviceAttributeMultiprocessorCount, dev);
        if (hipFuncSetAttribute((const void*)mega, hipFuncAttributeMaxDynamicSharedMemorySize, LDS_BYTES) != hipSuccess) { fprintf(stderr, "kernel_launch: hipFuncSetAttribute failed\n"); grid = -1; return; }
        if (hipOccupancyMaxActiveBlocksPerMultiprocessor(&per_cu, (const void*)mega, 512, LDS_BYTES) != hipSuccess || per_cu < 1) { fprintf(stderr, "kernel_launch: occupancy query failed (%d)\n", per_cu); (void)hipGetLastError(); per_cu = 1; }
        grid = cus * 1;
        if (grid < 1) grid = -1;
    }
    if (grid < 0) return;
    Params p{};
    for (int i = 0; i < 25; ++i) p.in[i] = (const float*)d_in[i];
    p.out = (float*)d_out; p.ws = (unsigned char*)d_ws;
#ifndef DUP_MASK
#define DUP_MASK 0
#endif
#if MK_MULTI
    for (int ph = 0; ph < NPH; ++ph) for (int rep = 0; rep < (((DUP_MASK >> ph) & 1) ? 2 : 1); ++rep) { p.ph_lo = ph; p.ph_hi = ph + 1; hipLaunchKernelGGL(mega, dim3(grid), dim3(512), LDS_BYTES, stream, p); }
#else
    p.ph_lo = 0; p.ph_hi = NPH;
    if (hipMemsetAsync(d_ws, 0, 16384, stream) != hipSuccess) { fprintf(stderr, "kernel_launch: memset of the barrier words failed\n"); return; }
    void* args[] = {&p};
    hipError_t e = hipLaunchCooperativeKernel((const void*)mega, dim3(grid), dim3(512), args, LDS_BYTES, stream);
    if (e != hipSuccess) fprintf(stderr, "cooperative launch failed: %s (grid %d)\n", hipGetErrorString(e), grid);
#endif
}
```

```cpp
#include <hip/hip_runtime.h>
#include <hip/hip_cooperative_groups.h>
#include <cstdio>
namespace cg = cooperative_groups;
namespace pg8 {
#define PG8_LAS __attribute__((address_space(3)))
typedef unsigned short bf16_t;
typedef short bf16x8 __attribute__((ext_vector_type(8)));
typedef float f32x4 __attribute__((ext_vector_type(4)));
typedef unsigned u32x4 __attribute__((ext_vector_type(4)));
constexpr int BM = 256, BK = 64, HALF = 128, HTB = HALF * BK * 2  , STAGE_BYTES = 8 * HTB, NXCD = 8, WGM = 8;

__host__ __device__ __forceinline__ int lds_byte(int r, int c) { const int st = (r >> 4) * 2 + (c >> 5), rr = r & 15, cc = c & 31, ob = rr * 64 + cc * 2; return st * 1024 + (ob ^ (((ob >> 9) & 1) << 5)); }
__host__ __device__ __forceinline__ void stage_rc(int b, int& R, int& C) { const int st = b / 1024, sb = b % 1024, swz = sb ^ (((sb >> 9) & 1) << 5); R = (st >> 1) * 16 + swz / 64; C = (st & 1) * 32 + (swz % 64) / 2; }
__host__ __device__ __forceinline__ int perm32(int rho) { const int n = rho >> 4, i = rho & 15; return 8 * (i >> 2) + 4 * n + (i & 3); }

struct Unit { int pm, pn, kt0, nkt; };
struct Gemm { const bf16_t* A; const bf16_t* Bt; int M, N, K; };

struct StaticOrder {
    int nM, nN, nwg, G, c, nkt;
    __host__ __device__ void init(int M, int N, int K, int G_, int c_) { nM = M / BM; nN = N / BM; nwg = nM * nN; G = G_; c = c_; nkt = K / BK; }
    __host__ __device__ bool next(int i, Unit& u) const {
        const long L = (long)i * G + c; if (L >= nwg) return false;
        int wgid = (int)L; { const int q = nwg / NXCD, r = nwg % NXCD, xcd = wgid % NXCD, off = wgid / NXCD; wgid = (xcd < r ? xcd * (q + 1) : r * (q + 1) + (xcd - r) * q) + off; }
        const int nig = WGM * nN, gid = wgid / nig, fm = gid * WGM, gsz = (nM - fm) < WGM ? (nM - fm) : WGM;
        u.pm = fm + ((wgid % nig) % gsz); u.pn = (wgid % nig) / gsz; u.kt0 = 0; u.nkt = nkt; return true;
    }
    __device__ __forceinline__ void a_ready(const Unit&) const {}
    __device__ __forceinline__ void done(const Unit&) const {}
};
struct SplitOrder {
    int nN, nwg, G, c, nkt, nsp;
    __host__ __device__ void init(int N, int K, int G_, int c_) { nN = N / BM; nwg = 64 * nN; G = G_; c = c_; nkt = K / BK; nsp = nkt / 4; }
    __host__ __device__ bool next(int i, Unit& u) const {
        const long L = (long)i * G + c;
        if (L < nwg) {
            int wgid = (int)L; { const int q = nwg / NXCD, r = nwg % NXCD, xcd = wgid % NXCD, off = wgid / NXCD; wgid = (xcd < r ? xcd * (q + 1) : r * (q + 1) + (xcd - r) * q) + off; }
            const int nig = WGM * nN, gid = wgid / nig, fm = gid * WGM, gsz = (64 - fm) < WGM ? (64 - fm) : WGM;
            u.pm = fm + ((wgid % nig) % gsz); u.pn = (wgid % nig) / gsz; u.kt0 = 0; u.nkt = nkt; return true;
        }
        const long j = L - nwg; if (j >= (long)nN * nsp) return false;
        u.pm = 64; u.pn = (int)(j % nN); u.kt0 = 4 * (int)(j / nN); u.nkt = 4; return true;
    }
    __device__ __forceinline__ void a_ready(const Unit&) const {}
    __device__ __forceinline__ void done(const Unit&) const {}
};
template <class Epi, class Sched, bool STAMP = false>
__device__ __forceinline__ void gemm_phase(PG8_LAS unsigned char* lds, const Gemm g, const Sched& S, const Epi& E, unsigned long long* stamps) {
    const int tid = threadIdx.x, wid = __builtin_amdgcn_readfirstlane(tid >> 6), lane = tid & 63, wr = wid >> 2, wc = wid & 3, fr = lane & 15, fq = lane >> 4;
    const int K = g.K;
    int ts_lo = 0, ts_hi = 0, nts = 0; const unsigned long long rt_entry = STAMP ? (unsigned long long)wall_clock64() : 0ull;
#define PG8_STAMP() do { if (STAMP && wid == 0 && nts < 64) { const unsigned long long _c = (unsigned long long)clock64(); \
        ts_lo = (lane == nts) ? (int)(unsigned)_c : ts_lo; ts_hi = (lane == nts) ? (int)(unsigned)(_c >> 32) : ts_hi; ++nts; } } while (0)
    PG8_STAMP();
    unsigned voffA[2], voffB[2];
#pragma unroll
    for (int i = 0; i < 2; ++i) { int R, C; stage_rc(tid * 16 + i * 8192, R, C); const int Rb = Epi::PERM ? ((R & ~31) + perm32(R & 31)) : R;
        voffA[i] = (unsigned)(R * K + C) * 2u; voffB[i] = (unsigned)(Rb * K + C) * 2u; }
    const size_t kstep = (size_t)(BK * 2);
    const size_t hstep = (size_t)HALF * K * 2;
    const size_t tstep = 2 * hstep;
    const unsigned ldsw = (unsigned)wid * 1024u;
    const int aoff = lds_byte(wr * 64 + fr, fq * 8), boff = lds_byte(wc * 32 + fr, fq * 8);
#define PG8_SA(b, h) (((b) * 2 + (h)) * HTB)
#define PG8_SB(b, h) ((4 + (b) * 2 + (h)) * HTB)
#define PG8_STAGE(bufoff, gbase, voff) do { _Pragma("unroll") for (int _i = 0; _i < 2; ++_i) \
        __builtin_amdgcn_global_load_lds((const unsigned*)((const char*)(gbase) + (voff)[_i]), (PG8_LAS unsigned*)(lds + (bufoff) + ldsw + _i * 8192), 16, 0, 0); } while (0)
#define PG8_LDA(dst, b, h) do { _Pragma("unroll") for (int m = 0; m < 4; ++m) _Pragma("unroll") for (int k = 0; k < 2; ++k) dst[m][k] = *(const PG8_LAS bf16x8*)(lds + PG8_SA(b, h) + aoff + m * 2048 + k * 1024); } while (0)
#define PG8_LDB(dst, b, h) do { _Pragma("unroll") for (int n = 0; n < 2; ++n) _Pragma("unroll") for (int k = 0; k < 2; ++k) dst[n][k] = *(const PG8_LAS bf16x8*)(lds + PG8_SB(b, h) + boff + n * 2048 + k * 1024); } while (0)
#define PG8_MMA(ai, bj, At, Bt) do { __builtin_amdgcn_s_setprio(1); _Pragma("unroll") for (int m = 0; m < 4; ++m) _Pragma("unroll") for (int n = 0; n < 2; ++n) _Pragma("unroll") for (int k = 0; k < 2; ++k) \
        acc[ai][bj][m][n] = __builtin_amdgcn_mfma_f32_16x16x32_bf16(Bt[n][k], At[m][k], acc[ai][bj][m][n], 0, 0, 0); __builtin_amdgcn_s_setprio(0); } while (0)
#define PG8_WAIT_V(n) asm volatile("s_waitcnt vmcnt(" #n ")" ::: "memory")
#define PG8_WAIT_L(n) asm volatile("s_waitcnt lgkmcnt(" #n ")" ::: "memory")
#define PG8_BAR __builtin_amdgcn_s_barrier()
#define PG8_SCHED __builtin_amdgcn_sched_barrier(0)
    Unit cur, nxt; int ui = 0;
    if (!S.next(0, cur)) return;
    f32x4 acc[2][2][4][2];
#pragma unroll
    for (int a = 0; a < 2; ++a)
#pragma unroll
        for (int b = 0; b < 2; ++b)
#pragma unroll
            for (int m = 0; m < 4; ++m)
#pragma unroll
                for (int n = 0; n < 2; ++n) acc[a][b][m][n] = (f32x4){0.f, 0.f, 0.f, 0.f};
    bf16x8 At[4][2], B0[2][2], B1[2][2];
    const char* cA = (const char*)g.A + (size_t)cur.pm * tstep + (size_t)cur.kt0 * kstep; const char* cB = (const char*)g.Bt + (size_t)cur.pn * tstep + (size_t)cur.kt0 * kstep;
    S.a_ready(cur);
    PG8_STAGE(PG8_SB(0, 0), cB, voffB); PG8_STAGE(PG8_SA(0, 0), cA, voffA); PG8_STAGE(PG8_SB(0, 1), cB + hstep, voffB); PG8_STAGE(PG8_SA(0, 1), cA + hstep, voffA);
    if (wr == 1) PG8_BAR;
    PG8_WAIT_V(4); PG8_BAR;
    PG8_STAGE(PG8_SB(1, 0), cB + kstep, voffB); PG8_STAGE(PG8_SA(1, 0), cA + kstep, voffA); PG8_STAGE(PG8_SB(1, 1), cB + hstep + kstep, voffB);
    PG8_WAIT_V(6); PG8_BAR;
    PG8_STAMP();
    for (;;) {
        const bool has_next = S.next(ui + 1, nxt);
        const char* nA = has_next ? (const char*)g.A + (size_t)nxt.pm * tstep + (size_t)nxt.kt0 * kstep : cA; const char* nB = has_next ? (const char*)g.Bt + (size_t)nxt.pn * tstep + (size_t)nxt.kt0 * kstep : cB;
        const int nt = cur.nkt;
        for (int t = 0; t < nt; t += 2) {
            const bool last = (t == nt - 2);
            const char* a1 = cA + (size_t)(t + 1) * kstep;
            const char* a2 = last ? nA : cA + (size_t)(t + 2) * kstep; const char* b2 = last ? nB : cB + (size_t)(t + 2) * kstep;
            const char* a3 = a2 + kstep; const char* b3 = b2 + kstep;
            if (last && has_next) S.a_ready(nxt);
            PG8_LDB(B0, 0, 0); PG8_SCHED; PG8_LDA(At, 0, 0); PG8_STAGE(PG8_SA(1, 1), a1 + hstep, voffA);
            PG8_WAIT_L(8); PG8_BAR; PG8_WAIT_L(0); PG8_MMA(0, 0, At, B0); PG8_BAR; PG8_SCHED;
            PG8_LDB(B1, 0, 1); PG8_STAGE(PG8_SB(0, 0), b2, voffB);
            PG8_BAR; PG8_WAIT_L(0); PG8_MMA(0, 1, At, B1); PG8_BAR;
            PG8_LDA(At, 0, 1); PG8_STAGE(PG8_SA(0, 0), a2, voffA);
            PG8_BAR; PG8_WAIT_L(0); PG8_MMA(1, 0, At, B0); PG8_BAR; PG8_SCHED;
            PG8_STAGE(PG8_SB(0, 1), b2 + hstep, voffB);
            PG8_WAIT_V(6); PG8_BAR; PG8_MMA(1, 1, At, B1); PG8_BAR;
            PG8_LDB(B0, 1, 0); PG8_SCHED; PG8_LDA(At, 1, 0); PG8_STAGE(PG8_SA(0, 1), a2 + hstep, voffA);
            PG8_WAIT_L(8); PG8_BAR; PG8_WAIT_L(0); PG8_MMA(0, 0, At, B0); PG8_BAR; PG8_SCHED;
            PG8_LDB(B1, 1, 1); PG8_STAGE(PG8_SB(1, 0), b3, voffB);
            PG8_BAR; PG8_WAIT_L(0); PG8_MMA(0, 1, At, B1); PG8_BAR;
            PG8_LDA(At, 1, 1); PG8_STAGE(PG8_SA(1, 0), a3, voffA);
            PG8_BAR; PG8_WAIT_L(0); PG8_MMA(1, 0, At, B0); PG8_BAR; PG8_SCHED;
            PG8_STAGE(PG8_SB(1, 1), b3 + hstep, voffB);
            PG8_WAIT_V(6); PG8_BAR; PG8_MMA(1, 1, At, B1); PG8_BAR;
        }
        PG8_STAMP();
        if constexpr (!Epi::AFTER_DRAIN) { E(acc, cur, wr, wc, fr, fq); S.done(cur); }
        PG8_STAMP();
        if (!has_next) break;
#pragma unroll
        for (int a = 0; a < 2; ++a)
#pragma unroll
            for (int b = 0; b < 2; ++b)
#pragma unroll
                for (int m = 0; m < 4; ++m)
#pragma unroll
                    for (int n = 0; n < 2; ++n) acc[a][b][m][n] = (f32x4){0.f, 0.f, 0.f, 0.f};
        cur = nxt; cA = nA; cB = nB; ++ui;
    }
    PG8_WAIT_V(0);
    if (wr == 0) PG8_BAR;
    PG8_BAR;
    if constexpr (Epi::AFTER_DRAIN) { E.fused(acc, cur, wr, wc, fr, fq, lds, wid, lane); S.done(cur); }
    PG8_STAMP();
    if (STAMP && wid == 0) { stamps[lane] = lane < nts ? (((unsigned long long)(unsigned)ts_hi << 32) | (unsigned)ts_lo) : 0ull;
        if (lane == 62) stamps[62] = rt_entry; if (lane == 63) stamps[63] = (unsigned long long)wall_clock64(); }
#undef PG8_STAMP
#undef PG8_SA
#undef PG8_SB
#undef PG8_STAGE
#undef PG8_LDA
#undef PG8_LDB
#undef PG8_MMA
#undef PG8_WAIT_V
#undef PG8_WAIT_L
#undef PG8_BAR
#undef PG8_SCHED
}
}

using pg8::bf16_t; using pg8::bf16x8; using pg8::f32x4; using pg8::Unit;
#define LAS __attribute__((address_space(3)))
#define DI __device__ __forceinline__
typedef float f32x16 __attribute__((ext_vector_type(16)));
typedef float f32x2 __attribute__((ext_vector_type(2)));
typedef unsigned u32x4 __attribute__((ext_vector_type(4)));
typedef unsigned u32x2 __attribute__((ext_vector_type(2)));

constexpr int D = 2048, TP = 16384, NS = 128, MR = TP + NS, MP = 16640;
constexpr int NZ = 12800, DFF = 5632, NAB = 2 * DFF;
constexpr int ZQ = 0, ZK = 1536, ZV = 3072, ZQH = 4608, ZFH = 5632, ZIH = 6656, ZGH = 7680, ZGA = 8704, ZGB = 10752;
constexpr int NMODROW = 33, NMOD = 6 * D;
constexpr float EPS = 1e-6f;
constexpr float ATT_SCALE = 0.08838834764831845f;
constexpr size_t OFF_Y = 0;
constexpr size_t OFF_KVP0 = (size_t)MR * D;
constexpr size_t OFF_KVP1 = OFF_KVP0 + 128 * 1024;
constexpr size_t OFF_KVP2 = OFF_KVP1 + 512 * 1024;
constexpr size_t OFF_HGP = OFF_KVP2 + 2048 * 1024;
constexpr size_t OFF_CVP = OFF_HGP + 8 * 128 * 128;
constexpr size_t OFF_KVS0 = OFF_CVP + 2 * DFF;
constexpr size_t OFF_KVS1 = OFF_KVS0 + (size_t)32 * 128 * 1024;
constexpr size_t OFF_KVS2 = OFF_KVS1 + (size_t)32 * 512 * 1024;
constexpr size_t OFF_HGS = OFF_KVS2 + (size_t)32 * 2048 * 1024;
constexpr size_t OFF_CVS = OFF_HGS + (size_t)32 * 8 * 128 * 128;
constexpr size_t OUT_TOTAL = OFF_CVS + (size_t)32 * 2 * DFF;
static_assert(OUT_TOTAL == 129346560, "output size");
constexpr size_t WS_WIN = 1u << 20;
constexpr size_t WS_WPA = WS_WIN + (size_t)NZ * D * 2;
constexpr size_t WS_WPB = WS_WPA + (size_t)2048 * 512 * 2;
constexpr size_t WS_WO = WS_WPB + (size_t)2048 * 1024 * 2;
constexpr size_t WS_WAB = WS_WO + (size_t)2048 * 2048 * 2;
constexpr size_t WS_WDN = WS_WAB + (size_t)NAB * D * 2;
constexpr size_t WS_MOD = WS_WDN + (size_t)D * DFF * 2;
constexpr size_t WS_ROPE = WS_MOD + (size_t)NMODROW * NMOD * 4;
constexpr size_t WS_Z = WS_ROPE + (size_t)MP * 32 * 4;
constexpr size_t WS_AB = WS_Z;
constexpr size_t WS_H = WS_Z + (size_t)MP * NZ * 2;
constexpr size_t WS_OG = WS_H + (size_t)MP * D * 2;
constexpr size_t WS_LSE = WS_OG + (size_t)3 * MP * 512 * 2;
constexpr size_t WS_OATT = WS_LSE + (size_t)3 * MP * 4 * 4;
constexpr size_t WS_OHG = WS_OATT + (size_t)MP * 512 * 2;
constexpr size_t WS_YMIX = WS_OHG + (size_t)MP * 1024 * 2;
constexpr size_t WS_BLK_END = WS_YMIX + (size_t)MP * D * 2;
constexpr size_t WS_G = WS_OG;
static_assert(WS_G + (size_t)MP * DFF * 2 <= WS_BLK_END + (32u << 20), "g overlay");
static_assert((size_t)MP * NAB * 2 <= (size_t)MP * NZ * 2, "ab overlay");
constexpr size_t WS_HS = WS_BLK_END;
constexpr size_t WS_HD = WS_HS + (size_t)256 * 8 * 128 * 128 * 4;
constexpr size_t WS_TMP = WS_HS;
constexpr size_t WS_ACC_WO = WS_Z;
constexpr size_t WS_ACC_DN = WS_Z;
constexpr size_t WS_ACC_UP = WS_TMP + (64u << 20);
constexpr int NSP_WO = 8, NSP_DN = 22, NSP_UP = 8, NSP_PA = 2, NSP_PB = 4;
constexpr size_t WS_ACC_PA = WS_H, WS_ACC_PB = WS_H + (size_t)NSP_PA * NS * D * 4;
static_assert((size_t)NSP_UP * NS * NAB * 4 + (64u << 20) <= (size_t)MP * D * 4, "up partials");
constexpr size_t WS_END = WS_TMP + (size_t)MP * D * 4 + (1u << 20);
static_assert(WS_HD + (size_t)256 * 8 * 128 * 4 <= WS_END, "hd");
static_assert(WS_WIN % 256 == 0 && WS_MOD % 256 == 0 && WS_ROPE % 256 == 0 && WS_Z % 256 == 0 && WS_H % 256 == 0 && WS_OG % 256 == 0 && WS_LSE % 256 == 0 && WS_OATT % 256 == 0 && WS_OHG % 256 == 0 && WS_YMIX % 256 == 0 && WS_HS % 256 == 0 && WS_HD % 256 == 0, "align");
constexpr int LDS_BYTES = 131072 + 4096 + 256;
constexpr int NPH = 18;

struct Params { const float* in[25]; float* out; unsigned char* ws; int ph_lo, ph_hi; };

DI float bf2f(unsigned b) { return __uint_as_float(b << 16); }
DI float bflo(unsigned w) { return __uint_as_float(w << 16); }
DI float bfhi(unsigned w) { return __uint_as_float(w & 0xffff0000u); }
DI unsigned pk2(float lo, float hi) { unsigned r; asm("v_cvt_pk_bf16_f32 %0, %1, %2" : "=v"(r) : "v"(lo), "v"(hi)); return r; }
DI float sigm(float x) { return __builtin_amdgcn_rcpf(1.f + __expf(-x)); }
DI float silu(float x) { return x * __builtin_amdgcn_rcpf(1.f + __expf(-x)); }
DI float wave_sum(float v) {
#pragma unroll
    for (int o = 32; o >= 1; o >>= 1) v += __shfl_xor(v, o);
    return v;
}
DI float wave_max(float v) {
#pragma unroll
    for (int o = 32; o >= 1; o >>= 1) v = fmaxf(v, __shfl_xor(v, o));
    return v;
}
DI void lds_fence() { asm volatile("s_waitcnt lgkmcnt(0)" ::: "memory"); __builtin_amdgcn_wave_barrier(); }
DI bf16x8 gat8(const LAS bf16_t* p, int stride) {
    bf16x8 r;
#pragma unroll
    for (int j = 0; j < 8; ++j) r[j] = (short)p[j * stride];
    return r;
}
DI bf16x8 ld8(const LAS bf16_t* p) { return *(const LAS bf16x8*)p; }
typedef short s16x4 __attribute__((ext_vector_type(4)));
template <int OFF> DI s16x4 tr_read(unsigned vb) { s16x4 r; asm volatile("ds_read_b64_tr_b16 %0, %1 offset:%2" : "=&v"(r) : "v"(vb), "i"(OFF) : "memory"); return r; }
DI f32x4 mfma16(bf16x8 a, bf16x8 b, f32x4 c) { return __builtin_amdgcn_mfma_f32_16x16x32_bf16(a, b, c, 0, 0, 0); }
DI f32x16 mfma32(bf16x8 a, bf16x8 b, f32x16 c) { return __builtin_amdgcn_mfma_f32_32x32x16_bf16(a, b, c, 0, 0, 0); }
DI void unpack8(u32x4 w, float (&f)[8]) { f[0] = bflo(w.x); f[1] = bfhi(w.x); f[2] = bflo(w.y); f[3] = bfhi(w.y); f[4] = bflo(w.z); f[5] = bfhi(w.z); f[6] = bflo(w.w); f[7] = bfhi(w.w); }
DI void atom_add(float* p, float v) { (void)__hip_atomic_fetch_add(p, v, __ATOMIC_RELAXED, __HIP_MEMORY_SCOPE_AGENT); }
DI void ld8f(const float* s, float (&f)[8]) { const f32x4 a = *(const f32x4*)s, b = *(const f32x4*)(s + 4); f[0] = a[0]; f[1] = a[1]; f[2] = a[2]; f[3] = a[3]; f[4] = b[0]; f[5] = b[1]; f[6] = b[2]; f[7] = b[3]; }
DI int crow_of(int r) { return r < TP ? 0 : 1 + ((r - TP) >> 2); }

struct EpiZ {
    static constexpr bool PERM = true, AFTER_DRAIN = false;
    bf16_t* Z; const float* rope; float* out; const float* c0; const float* c1; const float* c2;
    static constexpr int CPY_R0 = 32 * 124, CPY_R1 = 32 * 508, CPY_R2 = 32 * 2044, CPY_ROWS = CPY_R0 + CPY_R1 + CPY_R2, CPY_PER = 28;
    DI void cpy_row(int r, const float*& src, float*& dst) const {
        if (r < CPY_R0) { const int b = r / 124, rr = r - b * 124; src = c0 + ((size_t)(b * 128 + rr + 4)) * 1024; dst = out + OFF_KVS0 + ((size_t)(b * 128 + rr)) * 1024; }
        else if (r < CPY_R0 + CPY_R1) { r -= CPY_R0; const int b = r / 508, rr = r - b * 508; src = c1 + ((size_t)(b * 512 + rr + 4)) * 1024; dst = out + OFF_KVS1 + ((size_t)(b * 512 + rr)) * 1024; }
        else { r -= CPY_R0 + CPY_R1; const int b = r / 2044, rr = r - b * 2044; src = c2 + ((size_t)(b * 2048 + rr + 4)) * 1024; dst = out + OFF_KVS2 + ((size_t)(b * 2048 + rr)) * 1024; }
    }
    DI void operator()(const f32x4 (&acc)[2][2][4][2], const Unit& u, int wr, int wc, int fr, int fq) const {
        {
            int l4 = (wc * 64 + fq * 16 + fr) * 4; asm volatile("" : "+v"(l4));
            const int r0 = (u.pm * 50 + u.pn) * CPY_PER;
#pragma unroll
            for (int h2 = 0; h2 < 2; ++h2) {
                f32x4 v[7];
#pragma unroll
                for (int q = 0; q < 7; ++q) { int r = r0 + (h2 * 7 + q) * 2 + wr; r = r < CPY_ROWS ? r : r - CPY_ROWS; const float* sp; float* dp; cpy_row(r, sp, dp); v[q] = __builtin_nontemporal_load((const f32x4*)(sp + l4)); }
#pragma unroll
                for (int q = 0; q < 7; ++q) { int r = r0 + (h2 * 7 + q) * 2 + wr; r = r < CPY_ROWS ? r : r - CPY_ROWS; const float* sp; float* dp; cpy_row(r, sp, dp); __builtin_nontemporal_store(v[q], (f32x4*)(dp + l4)); }
            }
        }
        const int kind = u.pn < 6 ? 0 : (u.pn < 12 ? 1 : (u.pn < 18 ? 2 : 3));
        const bool do_rope = (kind <= 1) && (wc == 0);
        const int pnn = (kind == 1) ? u.pn - 6 : u.pn - 12;
        const int g = pnn >> 1, W = 128 << (2 * g);
        const size_t offp = g == 0 ? OFF_KVP0 : (g == 1 ? OFF_KVP1 : OFF_KVP2), offs = g == 0 ? OFF_KVS0 : (g == 1 ? OFF_KVS1 : OFF_KVS2);
        const float sg = (fq < 2) ? -1.f : 1.f;
#pragma unroll
        for (int ai = 0; ai < 2; ++ai)
#pragma unroll
            for (int m = 0; m < 4; ++m) {
                const int r = u.pm * 256 + ai * 128 + wr * 64 + m * 16 + fr;
                f32x4 cs0 = {0.f, 0.f, 0.f, 0.f}, cs1 = cs0, sn0 = cs0, sn1 = cs0;
                if (do_rope) { const float* rp = rope + (size_t)r * 32 + 8 * (fq & 1); cs0 = *(const f32x4*)rp; cs1 = *(const f32x4*)(rp + 4); sn0 = *(const f32x4*)(rp + 16); sn1 = *(const f32x4*)(rp + 20); }
#pragma unroll
                for (int bj = 0; bj < 2; ++bj) {
                    f32x4 v0 = acc[ai][bj][m][0], v1 = acc[ai][bj][m][1];
                    if (do_rope) {
                        f32x4 p0, p1;
#pragma unroll
                        for (int j = 0; j < 4; ++j) { p0[j] = __shfl_xor(v0[j], 32); p1[j] = __shfl_xor(v1[j], 32); }
                        v0 = v0 * cs0 + sg * (p0 * sn0); v1 = v1 * cs1 + sg * (p1 * sn1);
                    }
                    const int c = u.pn * 256 + bj * 128 + wc * 32 + 8 * fq;
                    u32x4 w; w.x = pk2(v0[0], v0[1]); w.y = pk2(v0[2], v0[3]); w.z = pk2(v1[0], v1[1]); w.w = pk2(v1[2], v1[3]);
                    *(u32x4*)(Z + (size_t)r * NZ + c) = w;
                    if (kind == 1 || kind == 2) {
                        const int hh = 2 * (pnn & 1) + bj, dd = wc * 32 + 8 * fq, kv = kind - 1;
                        if (u.pm < 64) {
                            if (256 * u.pm + 128 * ai >= TP - W) { float* dst = out + offp + ((size_t)(r - (TP - W)) * 2 + kv) * 512 + hh * 128 + dd; *(f32x4*)dst = v0; *(f32x4*)(dst + 4) = v1; }
                        } else if (ai == 0) {
                            const int b = (r - TP) >> 2, t = (r - TP) & 3; float* dst = out + offs + ((size_t)(b * W + W - 4 + t) * 2 + kv) * 512 + hh * 128 + dd; *(f32x4*)dst = v0; *(f32x4*)(dst + 4) = v1;
                        }
                    }
                }
            }
    }
};
struct EpiMix1 {
    static constexpr bool PERM = false, AFTER_DRAIN = false;
    const bf16_t* Z; float* TMP; float* accs;
    DI void operator()(const f32x4 (&acc)[2][2][4][2], const Unit& u, int wr, int wc, int fr, int fq) const {
        if (u.pm == 64) {
#pragma unroll
            for (int m = 0; m < 4; ++m)
#pragma unroll
                for (int bj = 0; bj < 2; ++bj)
#pragma unroll
                    for (int n = 0; n < 2; ++n) *(f32x4*)(accs + ((size_t)(u.kt0 >> 2) * NS + (wr * 64 + m * 16 + fr)) * D + u.pn * 256 + bj * 128 + wc * 32 + 16 * n + 4 * fq) = acc[0][bj][m][n];
            return;
        }
#pragma unroll
        for (int ai = 0; ai < 2; ++ai)
#pragma unroll
            for (int m = 0; m < 4; ++m) {
                const int r = u.pm * 256 + ai * 128 + wr * 64 + m * 16 + fr;
#pragma unroll
                for (int bj = 0; bj < 2; ++bj)
#pragma unroll
                    for (int n = 0; n < 2; ++n) {
                        const int c = u.pn * 256 + bj * 128 + wc * 32 + 16 * n + 4 * fq;
                        const u32x2 gw = *(const u32x2*)(Z + (size_t)r * NZ + ZGA + c);
                        f32x4 v = acc[ai][bj][m][n];
                        v[0] *= sigm(bflo(gw.x)); v[1] *= sigm(bfhi(gw.x)); v[2] *= sigm(bflo(gw.y)); v[3] *= sigm(bfhi(gw.y));
                        *(f32x4*)(TMP + (size_t)r * D + c) = v;
                    }
            }
    }
};
struct EpiMix2 {
    static constexpr bool PERM = false, AFTER_DRAIN = false;
    const bf16_t* Z; const float* TMP; bf16_t* Y; float* accs;
    DI void operator()(const f32x4 (&acc)[2][2][4][2], const Unit& u, int wr, int wc, int fr, int fq) const {
        if (u.pm == 64) {
#pragma unroll
            for (int m = 0; m < 4; ++m)
#pragma unroll
                for (int bj = 0; bj < 2; ++bj)
#pragma unroll
                    for (int n = 0; n < 2; ++n) *(f32x4*)(accs + ((size_t)(u.kt0 >> 2) * NS + (wr * 64 + m * 16 + fr)) * D + u.pn * 256 + bj * 128 + wc * 32 + 16 * n + 4 * fq) = acc[0][bj][m][n];
            return;
        }
#pragma unroll
        for (int ai = 0; ai < 2; ++ai)
#pragma unroll
            for (int m = 0; m < 4; ++m) {
                const int r = u.pm * 256 + ai * 128 + wr * 64 + m * 16 + fr;
#pragma unroll
                for (int bj = 0; bj < 2; ++bj)
#pragma unroll
                    for (int n = 0; n < 2; ++n) {
                        const int c = u.pn * 256 + bj * 128 + wc * 32 + 16 * n + 4 * fq;
                        const u32x2 gw = *(const u32x2*)(Z + (size_t)r * NZ + ZGB + c);
                        const f32x4 t = *(const f32x4*)(TMP + (size_t)r * D + c);
                        f32x4 v = acc[ai][bj][m][n];
                        v[0] = t[0] + v[0] * sigm(bflo(gw.x)); v[1] = t[1] + v[1] * sigm(bfhi(gw.x)); v[2] = t[2] + v[2] * sigm(bflo(gw.y)); v[3] = t[3] + v[3] * sigm(bfhi(gw.y));
                        u32x2 w; w.x = pk2(v[0], v[1]); w.y = pk2(v[2], v[3]);
                        *(u32x2*)(Y + (size_t)r * D + c) = w;
                    }
            }
    }
};
struct EpiWO {
    static constexpr bool PERM = false, AFTER_DRAIN = false;
    const float* xp; const float* xs; const float* mod; float* out; float* accs;
    DI void operator()(const f32x4 (&acc)[2][2][4][2], const Unit& u, int wr, int wc, int fr, int fq) const {
        if (u.pm == 64) {
#pragma unroll
            for (int m = 0; m < 4; ++m)
#pragma unroll
                for (int bj = 0; bj < 2; ++bj)
#pragma unroll
                    for (int n = 0; n < 2; ++n) {
                        float* d = accs + ((size_t)(u.kt0 >> 2) * NS + (wr * 64 + m * 16 + fr)) * D + u.pn * 256 + bj * 128 + wc * 32 + 16 * n + 4 * fq;
                        *(f32x4*)d = acc[0][bj][m][n];
                    }
            return;
        }
#pragma unroll
        for (int ai = 0; ai < 2; ++ai)
#pragma unroll
            for (int m = 0; m < 4; ++m) {
                const int r = u.pm * 256 + ai * 128 + wr * 64 + m * 16 + fr;
                if (r < MR) {
                    const float* xr = r < TP ? xp + (size_t)r * D : xs + (size_t)(r - TP) * D;
                    const float* g1 = mod + (size_t)crow_of(r) * NMOD + 2 * D;
#pragma unroll
                    for (int bj = 0; bj < 2; ++bj)
#pragma unroll
                        for (int n = 0; n < 2; ++n) {
                            const int c = u.pn * 256 + bj * 128 + wc * 32 + 16 * n + 4 * fq;
                            const f32x4 xv = *(const f32x4*)(xr + c), gv = *(const f32x4*)(g1 + c);
                            *(f32x4*)(out + (size_t)r * D + c) = xv + gv * acc[ai][bj][m][n];
                        }
                }
            }
    }
};
struct EpiDown {
    static constexpr bool PERM = false, AFTER_DRAIN = false;
    const float* mod; float* out; float* accs;
    DI void operator()(const f32x4 (&acc)[2][2][4][2], const Unit& u, int wr, int wc, int fr, int fq) const {
        if (u.pm == 64) {
#pragma unroll
            for (int m = 0; m < 4; ++m)
#pragma unroll
                for (int bj = 0; bj < 2; ++bj)
#pragma unroll
                    for (int n = 0; n < 2; ++n) {
                        float* d = accs + ((size_t)(u.kt0 >> 2) * NS + (wr * 64 + m * 16 + fr)) * D + u.pn * 256 + bj * 128 + wc * 32 + 16 * n + 4 * fq;
                        *(f32x4*)d = acc[0][bj][m][n];
                    }
            return;
        }
#pragma unroll
        for (int ai = 0; ai < 2; ++ai)
#pragma unroll
            for (int m = 0; m < 4; ++m) {
                const int r = u.pm * 256 + ai * 128 + wr * 64 + m * 16 + fr;
                if (r < MR) {
                    const float* g2 = mod + (size_t)crow_of(r) * NMOD + 5 * D;
#pragma unroll
                    for (int bj = 0; bj < 2; ++bj)
#pragma unroll
                        for (int n = 0; n < 2; ++n) {
                            const int c = u.pn * 256 + bj * 128 + wc * 32 + 16 * n + 4 * fq;
                            float* o = out + (size_t)r * D + c;
                            const f32x4 xv = *(const f32x4*)o, gv = *(const f32x4*)(g2 + c);
                            *(f32x4*)o = xv + gv * acc[ai][bj][m][n];
                        }
                }
            }
    }
};
struct EpiUp {
    static constexpr bool PERM = true, AFTER_DRAIN = false;
    bf16_t* AB; bf16_t* G; float* out; float* accs; const float* cw; const float* cb; LAS float* xch;
    DI void operator()(const f32x4 (&acc)[2][2][4][2], const Unit& u, int wr, int wc, int fr, int fq) const {
        int cl = 32 * wc + 8 * fq;
        if (u.pm == 64) {
#pragma unroll
            for (int m = 0; m < 4; ++m)
#pragma unroll
                for (int bj = 0; bj < 2; ++bj)
#pragma unroll
                    for (int n = 0; n < 2; ++n) {
                        float* d = accs + ((size_t)(u.kt0 >> 2) * NS + (wr * 64 + m * 16 + fr)) * NAB + bj * DFF + 128 * u.pn + cl + 4 * n;
                        *(f32x4*)d = acc[0][bj][m][n];
                    }
            return;
        }
        asm volatile("" : "+v"(cl), "+v"(fr), "+v"(fq));
        const int lane = fq * 16 + fr;
        if (fr >= 14) {
#pragma unroll
            for (int ai = 0; ai < 2; ++ai) { LAS float* d = xch + ((2 * ai + wr) * 2 + (fr - 14)) * 128 + cl; *(LAS f32x4*)d = acc[ai][0][3][0]; *(LAS f32x4*)(d + 4) = acc[ai][0][3][1]; }
        }
        asm volatile("s_waitcnt lgkmcnt(0)" ::: "memory"); __builtin_amdgcn_s_barrier(); __builtin_amdgcn_s_barrier(); asm volatile("" ::: "memory");
        const int src1 = (lane & 48) | ((fr + 15) & 15), src2 = (lane & 48) | ((fr + 14) & 15);
#pragma unroll
        for (int n = 0; n < 2; ++n) {
            const int c = 128 * u.pn + cl + 4 * n;
            const f32x4 w0 = *(const f32x4*)(cw + c), w1 = *(const f32x4*)(cw + DFF + c), w2 = *(const f32x4*)(cw + 2 * DFF + c), bb = *(const f32x4*)(cb + c);
#pragma unroll
            for (int ai = 0; ai < 2; ++ai) {
                const int q = 2 * ai + wr;
                f32x4 y1 = {0.f, 0.f, 0.f, 0.f}, z1 = y1;
                if (q > 0) { y1 = *(const LAS f32x4*)(xch + ((q - 1) * 2 + 1) * 128 + cl + 4 * n); z1 = *(const LAS f32x4*)(xch + ((q - 1) * 2 + (fr == 0 ? 0 : 1)) * 128 + cl + 4 * n); }
#pragma unroll
                for (int m = 0; m < 4; ++m) {
                    const f32x4 av = acc[ai][0][m][n], bv = acc[ai][1][m][n];
                    f32x4 o;
#pragma unroll
                    for (int j = 0; j < 4; ++j) {
                        const float y = __shfl(av[j], src1), z = __shfl(av[j], src2);
                        const float a1 = fr >= 1 ? y : y1[j], a0 = fr >= 2 ? z : z1[j];
                        y1[j] = y; z1[j] = z;
                        const float uu = bb[j] + w0[j] * a0 + w1[j] * a1 + w2[j] * av[j];
                        o[j] = silu(uu) * bv[j];
                    }
                    const int rl = 128 * ai + 64 * wr + 16 * m + fr, rg = 256 * u.pm + rl;
                    u32x2 gw; gw.x = pk2(o[0], o[1]); gw.y = pk2(o[2], o[3]);
                    if (ai == 0 && m == 0 && wr == 0) {
                        if (!(fr < 2 && u.pm > 0)) *(u32x2*)(G + (size_t)rg * DFF + c) = gw;
                        if (fr < 2) {
                            u32x2 w; w.x = pk2(av[0], av[1]); w.y = pk2(av[2], av[3]); *(u32x2*)(AB + (size_t)rg * NAB + c) = w;
                            u32x2 x; x.x = pk2(bv[0], bv[1]); x.y = pk2(bv[2], bv[3]); *(u32x2*)(AB + (size_t)rg * NAB + DFF + c) = x;
                        }
                    } else {
                        *(u32x2*)(G + (size_t)rg * DFF + c) = gw;
                        if (ai == 1 && m == 3 && wr == 1) {
                            if (fr >= 14) {
                                u32x2 w; w.x = pk2(av[0], av[1]); w.y = pk2(av[2], av[3]); *(u32x2*)(AB + (size_t)rg * NAB + c) = w;
                                if (u.pm == 63) *(f32x4*)(out + OFF_CVP + (size_t)(rl - 254) * DFF + c) = av;
                            }
                        }
                    }
                    asm volatile("" ::: "memory");
                }
            }
        }
    }
};

DI void ph_mod(const Params& p, LAS unsigned char* L, float* mod) {
    LAS float* sS = (LAS float*)L;
    LAS float* sRed = (LAS float*)L;
    const int tid = threadIdx.x, cgp = tid % 24, ksub = tid / 24;
    const float* cpr = p.in[7]; const float* csm = p.in[8]; const float* wada = p.in[9]; const float* bada = p.in[10];
    for (int nb = blockIdx.x; nb < 256; nb += gridDim.x) {
        const int n0 = nb * 48;
        float acc[33][2];
#pragma unroll
        for (int r = 0; r < 33; ++r) { acc[r][0] = 0.f; acc[r][1] = 0.f; }
        for (int kc = 0; kc < 4; ++kc) {
            f32x2 wv[25];
#pragma unroll
            for (int q = 0; q < 25; ++q) { const int kk = ksub + 21 * q; wv[q] = (ksub < 21 && kk < 512) ? *(const f32x2*)(wada + (size_t)(kc * 512 + kk) * NMOD + n0 + 2 * cgp) : (f32x2){0.f, 0.f}; }
            for (int idx = tid; idx < 33 * 512; idx += 512) {
                const int r = idx >> 9, kk = idx & 511;
                const float c = r == 0 ? cpr[kc * 512 + kk] : csm[(r - 1) * D + kc * 512 + kk];
                sS[kk * 36 + r] = silu(c);
            }
            __syncthreads();
#pragma unroll
            for (int q = 0; q < 25; ++q) {
                const int kk = ksub + 21 * q;
                if (ksub < 21 && kk < 512) {
                    const f32x2 w = wv[q];
                    const LAS f32x4* sp = (const LAS f32x4*)(sS + kk * 36);
#pragma unroll
                    for (int r4 = 0; r4 < 9; ++r4) {
                        const f32x4 sv = sp[r4];
#pragma unroll
                        for (int j = 0; j < 4; ++j) { if (4 * r4 + j < 33) { acc[4 * r4 + j][0] += sv[j] * w[0]; acc[4 * r4 + j][1] += sv[j] * w[1]; } }
                    }
                }
            }
            __syncthreads();
        }
#pragma unroll
        for (int r0 = 0; r0 < 33; r0 += 11) {
            if (ksub < 21) {
#pragma unroll
                for (int i = 0; i < 11; ++i) { sRed[ksub * 528 + i * 48 + 2 * cgp] = acc[r0 + i][0]; sRed[ksub * 528 + i * 48 + 2 * cgp + 1] = acc[r0 + i][1]; }
            }
            __syncthreads();
            for (int o = tid; o < 528; o += 512) {
                float sum = 0.f;
                for (int k2 = 0; k2 < 21; ++k2) sum += sRed[k2 * 528 + o];
                const int i = o / 48, c = o % 48;
                mod[(size_t)(r0 + i) * NMOD + n0 + c] = sum + bada[n0 + c];
            }
            __syncthreads();
        }
    }
}
DI void tr_load(const float* W, int N, int r, int lane, f32x4 (&v)[8]) {
    const int nblk = N / 32, kb = r / nblk, nb = r % nblk, k0 = 64 * kb, n0 = 32 * nb;
#pragma unroll
    for (int i = 0; i < 8; ++i) v[i] = *(const f32x4*)(W + (size_t)(k0 + 8 * i + (lane >> 3)) * N + n0 + 4 * (lane & 7));
}
DI void tr_finish(bf16_t* WT, int K, int N, int inter, int r, LAS float* scr, int lane, const f32x4 (&v)[8]) {
    const int nblk = N / 32, kb = r / nblk, nb = r % nblk, k0 = 64 * kb, n0 = 32 * nb;
#pragma unroll
    for (int i = 0; i < 8; ++i) { LAS float* dd = scr + (8 * i + (lane >> 3)) * 33 + 4 * (lane & 7); dd[0] = v[i][0]; dd[1] = v[i][1]; dd[2] = v[i][2]; dd[3] = v[i][3]; }
    lds_fence();
    const int c = lane & 7;
#pragma unroll
    for (int j = 0; j < 4; ++j) { const int n = (lane >> 3) + 8 * j; const LAS float* s = scr + (8 * c) * 33 + n;
        u32x4 o; o.x = pk2(s[0 * 33], s[1 * 33]); o.y = pk2(s[2 * 33], s[3 * 33]); o.z = pk2(s[4 * 33], s[5 * 33]); o.w = pk2(s[6 * 33], s[7 * 33]);
        const int na = n0 + n, drow = inter < 0 ? na : ((na >> 7) << 8) + inter * 128 + (na & 127);
        *(u32x4*)(WT + (size_t)drow * K + k0 + 8 * c) = o; }
    lds_fence();
}
constexpr int TR_I_IN = 32 * 400, TR_I_PA = 8 * 64, TR_I_PB = 16 * 64, TR_I_O = 32 * 64, TR_I_A = 32 * 176, TR_I_DN = 88 * 64;
constexpr int TR_NITEMS = TR_I_IN + TR_I_PA + TR_I_PB + TR_I_O + 2 * TR_I_A + TR_I_DN;
struct TrSrc { const float *w_in, *w_pa, *w_pb, *w_o, *w_a, *w_b, *w_dn; };
DI void tr_decode(const TrSrc& q, unsigned char* ws, int it, const float*& W, bf16_t*& WT, int& K, int& N, int& inter, int& r) {
    r = it; inter = -1;
    if (r < TR_I_IN) { W = q.w_in; WT = (bf16_t*)(ws + WS_WIN); K = D; N = NZ; return; } r -= TR_I_IN;
    if (r < TR_I_PA) { W = q.w_pa; WT = (bf16_t*)(ws + WS_WPA); K = 512; N = D; return; } r -= TR_I_PA;
    if (r < TR_I_PB) { W = q.w_pb; WT = (bf16_t*)(ws + WS_WPB); K = 1024; N = D; return; } r -= TR_I_PB;
    if (r < TR_I_O) { W = q.w_o; WT = (bf16_t*)(ws + WS_WO); K = D; N = D; return; } r -= TR_I_O;
    if (r < TR_I_A) { W = q.w_a; WT = (bf16_t*)(ws + WS_WAB); K = D; N = DFF; inter = 0; return; } r -= TR_I_A;
    if (r < TR_I_A) { W = q.w_b; WT = (bf16_t*)(ws + WS_WAB); K = D; N = DFF; inter = 1; return; } r -= TR_I_A;
    W = q.w_dn; WT = (bf16_t*)(ws + WS_WDN); K = DFF; N = D;
}
DI void ph_prologue(const Params& p, LAS unsigned char* L) {
    unsigned char* ws = p.ws;
    const int tid = threadIdx.x, lane = tid & 63, wave = tid >> 6;
    const int gw = blockIdx.x * 8 + wave, NGW = gridDim.x * 8;
    const size_t gtid = (size_t)blockIdx.x * 512 + tid, gstride = (size_t)gridDim.x * 512;
    ph_mod(p, L, (float*)(ws + WS_MOD));
    LAS float* scr = (LAS float*)(L + wave * 8448);
    const TrSrc tq{p.in[12], p.in[15], p.in[16], p.in[17], p.in[19], p.in[20], p.in[23]};
    for (int it = gw; it < TR_NITEMS; it += 2 * NGW) {
        const float* W0; bf16_t* T0; int K0, N0, i0, r0; tr_decode(tq, ws, it, W0, T0, K0, N0, i0, r0);
        const int it1 = it + NGW; const bool two = it1 < TR_NITEMS;
        const float* W1; bf16_t* T1; int K1, N1, i1, r1; tr_decode(tq, ws, two ? it1 : it, W1, T1, K1, N1, i1, r1);
        f32x4 v0[8], v1[8];
        tr_load(W0, N0, r0, lane, v0); tr_load(W1, N1, r1, lane, v1);
        tr_finish(T0, K0, N0, i0, r0, scr, lane, v0);
        if (two) tr_finish(T1, K1, N1, i1, r1, scr, lane, v1);
    }
    {
        float* rope = (float*)(ws + WS_ROPE);
        for (size_t idx = gtid; idx < (size_t)MR * 16; idx += gstride) {
            const int m = (int)(idx >> 4), i = (int)(idx & 15);
            const int pos = m < TP ? m : TP + ((m - TP) & 3);
            const float invf = (float)exp2(-(double)i * (18.931568569324174 / 16.0));
            const float ang = (float)pos * invf;
            const double x = (double)ang, n = rint(x * 0.15915494309189535);
            double rr = fma(-n, 6.283185307179586, x); rr = fma(-n, 2.4492935982947064e-16, rr);
            rope[(size_t)m * 32 + i] = cosf((float)rr); rope[(size_t)m * 32 + 16 + i] = sinf((float)rr);
        }
    }
}
DI const float* hn_src(const Params& p, const float* xbase, bool from_out, int m) {
    const bool fix = from_out && m >= TP;
    return (from_out && !fix) ? xbase + (size_t)m * D : (m < TP ? p.in[0] + (size_t)m * D : p.in[1] + (size_t)(m - TP) * D);
}
DI void ph_hnorm(const Params& p, float* xbase, bool from_out, const float* nw, int sh_idx, bf16_t* H) {
    const int lane = threadIdx.x & 63, wave = threadIdx.x >> 6, stride = gridDim.x * 8;
    const float* mod = (const float*)(p.ws + WS_MOD);
    int m = blockIdx.x * 8 + wave;
    f32x4 v[8];
    if (m < MR) { const float* xr = hn_src(p, xbase, from_out, m);
#pragma unroll
        for (int j = 0; j < 8; ++j) v[j] = *(const f32x4*)(xr + 4 * lane + 256 * j); }
    while (m < MR) {
        const int mn = m + stride; f32x4 vn[8];
        if (mn < MR) { const float* xr = hn_src(p, xbase, from_out, mn);
#pragma unroll
            for (int j = 0; j < 8; ++j) vn[j] = *(const f32x4*)(xr + 4 * lane + 256 * j); }
        const bool fix = from_out && m >= TP;
        const float* md = mod + (size_t)crow_of(m) * NMOD + sh_idx * D;
        float ss = 0.f;
#pragma unroll
        for (int j = 0; j < 8; ++j) { const int c = 4 * lane + 256 * j;
            if (fix) { f32x4 a = {0.f, 0.f, 0.f, 0.f}; for (int q = 0; q < NSP_WO; ++q) a = a + *(const f32x4*)((const float*)(p.ws + WS_ACC_WO) + ((size_t)q * NS + (m - TP)) * D + c); const f32x4 g = *(const f32x4*)(mod + (size_t)crow_of(m) * NMOD + 2 * D + c); v[j] = v[j] + g * a; *(f32x4*)(xbase + (size_t)m * D + c) = v[j]; }
            ss += v[j][0] * v[j][0] + v[j][1] * v[j][1] + v[j][2] * v[j][2] + v[j][3] * v[j][3]; }
        const float rstd = rsqrtf(wave_sum(ss) * (1.f / D) + EPS);
#pragma unroll
        for (int j = 0; j < 8; ++j) {
            const int c = 4 * lane + 256 * j;
            const f32x4 w = *(const f32x4*)(nw + c), shv = *(const f32x4*)(md + c), scv = *(const f32x4*)(md + D + c);
            const f32x4 o = (v[j] * rstd) * w * (1.f + scv) + shv;
            u32x2 q; q.x = pk2(o[0], o[1]); q.y = pk2(o[2], o[3]);
            *(u32x2*)(H + (size_t)m * D + c) = q;
        }
#pragma unroll
        for (int j = 0; j < 8; ++j) v[j] = vn[j];
        m = mn;
    }
}
DI void ph_final_norm(const Params& p) {
    const int lane = threadIdx.x & 63, wave = threadIdx.x >> 6, stride = gridDim.x * 8;
    const float* nw = p.in[24];
    int m = blockIdx.x * 8 + wave;
    f32x4 v[8];
    if (m < MR) {
#pragma unroll
        for (int j = 0; j < 8; ++j) v[j] = *(const f32x4*)(p.out + (size_t)m * D + 4 * lane + 256 * j); }
    while (m < MR) {
        const int mn = m + stride; f32x4 vn[8];
        if (mn < MR) {
#pragma unroll
            for (int j = 0; j < 8; ++j) vn[j] = *(const f32x4*)(p.out + (size_t)mn * D + 4 * lane + 256 * j); }
        float* xr = p.out + (size_t)m * D;
        float ss = 0.f;
#pragma unroll
        for (int j = 0; j < 8; ++j) { const int c = 4 * lane + 256 * j;
            if (m >= TP) { f32x4 a = {0.f, 0.f, 0.f, 0.f}; for (int q = 0; q < NSP_DN; ++q) a = a + *(const f32x4*)((const float*)(p.ws + WS_ACC_DN) + ((size_t)q * NS + (m - TP)) * D + c); const f32x4 g = *(const f32x4*)((const float*)(p.ws + WS_MOD) + (size_t)crow_of(m) * NMOD + 5 * D + c); v[j] = v[j] + g * a; }
            ss += v[j][0] * v[j][0] + v[j][1] * v[j][1] + v[j][2] * v[j][2] + v[j][3] * v[j][3]; }
        const float rstd = rsqrtf(wave_sum(ss) * (1.f / D) + EPS);
#pragma unroll
        for (int j = 0; j < 8; ++j) { const int c = 4 * lane + 256 * j; const f32x4 w = *(const f32x4*)(nw + c); *(f32x4*)(xr + c) = (v[j] * rstd) * w; }
#pragma unroll
        for (int j = 0; j < 8; ++j) v[j] = vn[j];
        m = mn;
    }
}

DI void attn_prompt_item(const bf16_t* Z, bf16_t* OG, float* LSE, LAS bf16_t* Vl, int item, int lane) {
    const int g = item >> 11, rem = item & 2047, hh = rem >> 9, bidx = rem & 511;
    const int dsh = 2 * g, nsh = 9 - dsh;
    const int res = bidx >> nsh, blk = bidx & ((1 << nsh) - 1);
    const int s0 = blk * 32, head = g * 4 + hh;
    const int qi = lane & 31, h = lane >> 5;
    const int tq = res + ((s0 + qi) << dsh);
    bf16x8 Qf[8];
    { const bf16_t* qp = Z + (size_t)tq * NZ + ZQ + head * 128 + 8 * h;
#pragma unroll
      for (int ks = 0; ks < 8; ++ks) Qf[ks] = *(const bf16x8*)(qp + 16 * ks); }
    float mrun = -INFINITY, lrun = 0.f;
    f32x16 O[4];
#pragma unroll
    for (int dt = 0; dt < 4; ++dt)
#pragma unroll
        for (int i = 0; i < 16; ++i) O[dt][i] = 0.f;
    const int sq = s0 + qi;
    const int vrow = lane >> 4, vch = lane & 15;
    const unsigned vtr = (unsigned)(unsigned long long)Vl + (unsigned)(((4 * h + ((lane & 15) >> 2)) * 136 + 16 * ((lane >> 4) & 1) + 4 * (lane & 3)) * 2);
    bf16x8 Kc[8]; u32x4 Vr[8];
#define ATT_LOAD_KV(kt_) do { const int kb_ = s0 - 128 + 32 * (kt_); int skl_ = kb_ + qi; skl_ = skl_ < 0 ? 0 : skl_; \
        const bf16_t* kp_ = Z + (size_t)(res + (skl_ << dsh)) * NZ + ZK + head * 128 + 8 * h; \
        _Pragma("unroll") for (int ks = 0; ks < 8; ++ks) Kc[ks] = *(const bf16x8*)(kp_ + 16 * ks); \
        _Pragma("unroll") for (int i = 0; i < 8; ++i) { int sv_ = kb_ + 4 * i + vrow; sv_ = sv_ < 0 ? 0 : sv_; \
            Vr[i] = *(const u32x4*)(Z + (size_t)(res + (sv_ << dsh)) * NZ + ZV + head * 128 + 8 * vch); } } while (0)
    ATT_LOAD_KV(4);
    for (int kt = 4; kt >= 0; --kt) {
        const int kb = s0 - 128 + 32 * kt;
        f32x16 S;
#pragma unroll
        for (int i = 0; i < 16; ++i) S[i] = 0.f;
#pragma unroll
        for (int ks = 0; ks < 8; ++ks) S = mfma32(Kc[ks], Qf[ks], S);
#pragma unroll
        for (int i = 0; i < 8; ++i) *(LAS u32x4*)(Vl + (4 * i + vrow) * 136 + 8 * vch) = Vr[i];
        if (kt > 0) ATT_LOAD_KV(kt - 1);
        float tmax = -INFINITY;
#pragma unroll
        for (int i = 0; i < 16; ++i) {
            const int sk = kb + (i & 3) + 8 * (i >> 2) + 4 * h;
            const bool valid = (sk >= 0) && (sk <= sq) && (sk >= sq - 128);
            S[i] = valid ? S[i] * ATT_SCALE : -INFINITY;
            tmax = fmaxf(tmax, S[i]);
        }
        tmax = fmaxf(tmax, __shfl_xor(tmax, 32));
        const float mn = fmaxf(mrun, tmax), alpha = __expf(mrun - mn);
        float ps = 0.f;
#pragma unroll
        for (int i = 0; i < 16; ++i) { S[i] = __expf(S[i] - mn); ps += S[i]; }
        ps += __shfl_xor(ps, 32);
        lrun = lrun * alpha + ps; mrun = mn;
#pragma unroll
        for (int dt = 0; dt < 4; ++dt) O[dt] = O[dt] * alpha;
        bf16x8 Pf[2];
#pragma unroll
        for (int s2 = 0; s2 < 2; ++s2) {
            u32x4 w; w.x = pk2(S[8 * s2 + 0], S[8 * s2 + 1]); w.y = pk2(S[8 * s2 + 2], S[8 * s2 + 3]); w.z = pk2(S[8 * s2 + 4], S[8 * s2 + 5]); w.w = pk2(S[8 * s2 + 6], S[8 * s2 + 7]);
            Pf[s2] = __builtin_bit_cast(bf16x8, w);
        }
        lds_fence();
        const s16x4 l00 = tr_read<0>(vtr), h00 = tr_read<2176>(vtr);
        const s16x4 l01 = tr_read<4352>(vtr), h01 = tr_read<6528>(vtr);
        const s16x4 l10 = tr_read<64>(vtr), h10 = tr_read<2240>(vtr);
        const s16x4 l11 = tr_read<4416>(vtr), h11 = tr_read<6592>(vtr);
        const s16x4 l20 = tr_read<128>(vtr), h20 = tr_read<2304>(vtr);
        const s16x4 l21 = tr_read<4480>(vtr), h21 = tr_read<6656>(vtr);
        const s16x4 l30 = tr_read<192>(vtr), h30 = tr_read<2368>(vtr);
        const s16x4 l31 = tr_read<4544>(vtr), h31 = tr_read<6720>(vtr);
        asm volatile("s_waitcnt lgkmcnt(0)" ::: "memory"); __builtin_amdgcn_sched_barrier(0);
#define PK8(L_, H_) (bf16x8){L_[0], L_[1], L_[2], L_[3], H_[0], H_[1], H_[2], H_[3]}
        O[0] = mfma32(PK8(l00, h00), Pf[0], O[0]);
        O[0] = mfma32(PK8(l01, h01), Pf[1], O[0]);
        O[1] = mfma32(PK8(l10, h10), Pf[0], O[1]);
        O[1] = mfma32(PK8(l11, h11), Pf[1], O[1]);
        O[2] = mfma32(PK8(l20, h20), Pf[0], O[2]);
        O[2] = mfma32(PK8(l21, h21), Pf[1], O[2]);
        O[3] = mfma32(PK8(l30, h30), Pf[0], O[3]);
        O[3] = mfma32(PK8(l31, h31), Pf[1], O[3]);
#undef PK8
        lds_fence();
    }
#undef ATT_LOAD_KV
    const float inv = 1.f / lrun;
    bf16_t* op = OG + ((size_t)g * MP + tq) * 512 + hh * 128 + 4 * h;
#pragma unroll
    for (int dt = 0; dt < 4; ++dt)
#pragma unroll
        for (int rq = 0; rq < 4; ++rq) {
            u32x2 w; w.x = pk2(O[dt][4 * rq] * inv, O[dt][4 * rq + 1] * inv); w.y = pk2(O[dt][4 * rq + 2] * inv, O[dt][4 * rq + 3] * inv);
            *(u32x2*)(op + 32 * dt + 8 * rq) = w;
        }
    if (h == 0) LSE[((size_t)g * MP + tq) * 4 + hh] = mrun + __logf(lrun);
}
DI const float* samp_row(const float* cache, const float* newkv, int b, int W, int rr) {
    return (rr >= W) ? newkv + ((size_t)(b * W + rr - 4) * 2) * 512 : cache + ((size_t)(b * W + rr) * 2) * 512;
}
DI void attn_sample_item(const Params& p, const bf16_t* Z, bf16_t* OG, float* LSE, int item, int lane) {
    const int b = item / 48, r48 = item % 48, t = r48 / 12, head = r48 % 12, g = head >> 2, hh = head & 3;
    const int dsh = 2 * g, W = 128 << dsh;
    const float* cache = p.in[2 + g];
    const float* newkv = p.out + (g == 0 ? OFF_KVS0 : (g == 1 ? OFF_KVS1 : OFF_KVS2));
    const int m = TP + b * 4 + t;
    const unsigned qq = *(const unsigned*)(Z + (size_t)m * NZ + ZQ + head * 128 + 2 * lane);
    const float q0 = bflo(qq) * ATT_SCALE, q1 = bfhi(qq) * ATT_SCALE;
    float mrun, lrun, o0, o1;
    {
        const float* rp = samp_row(cache, newkv, b, W, W + t - (128 << dsh)) + hh * 128 + 2 * lane;
        const f32x2 kk = *(const f32x2*)rp, vv = *(const f32x2*)(rp + 512);
        mrun = wave_sum(q0 * kk.x + q1 * kk.y); lrun = 1.f; o0 = vv.x; o1 = vv.y;
    }
    f32x2 kk[16], vv[16];
#pragma unroll
    for (int u = 0; u < 16; ++u) { const float* rp = samp_row(cache, newkv, b, W, W + t - (u << dsh)) + hh * 128 + 2 * lane; kk[u] = *(const f32x2*)rp; vv[u] = *(const f32x2*)(rp + 512); }
    for (int j0 = 0; j0 < 128; j0 += 16) {
        f32x2 kn[16], vn[16];
        if (j0 + 16 < 128) {
#pragma unroll
            for (int u = 0; u < 16; ++u) { const float* rp = samp_row(cache, newkv, b, W, W + t - ((j0 + 16 + u) << dsh)) + hh * 128 + 2 * lane; kn[u] = *(const f32x2*)rp; vn[u] = *(const f32x2*)(rp + 512); }
        }
        float pr[16];
#pragma unroll
        for (int u = 0; u < 16; ++u) pr[u] = q0 * kk[u].x + q1 * kk[u].y;
#pragma unroll
        for (int o = 32; o >= 1; o >>= 1) {
#pragma unroll
            for (int u = 0; u < 16; ++u) pr[u] += __shfl_xor(pr[u], o);
        }
        float bm = pr[0];
#pragma unroll
        for (int u = 1; u < 16; ++u) bm = fmaxf(bm, pr[u]);
        const float mn = fmaxf(mrun, bm), alpha = __expf(mrun - mn);
        lrun *= alpha; o0 *= alpha; o1 *= alpha; mrun = mn;
#pragma unroll
        for (int u = 0; u < 16; ++u) { const float pu = __expf(pr[u] - mn); lrun += pu; o0 += pu * vv[u].x; o1 += pu * vv[u].y; }
#pragma unroll
        for (int u = 0; u < 16; ++u) { kk[u] = kn[u]; vv[u] = vn[u]; }
    }
    const float inv = 1.f / lrun;
    *(unsigned*)(OG + ((size_t)g * MP + m) * 512 + hh * 128 + 2 * lane) = pk2(o0 * inv, o1 * inv);
    if (lane == 0) LSE[((size_t)g * MP + m) * 4 + hh] = mrun + __logf(lrun);
}

DI float hg_gates(const Params& p, const bf16_t (&fhr)[16], int h, LAS float* tot, float (&kk)[16], float (&bb)[16]) {
    const int tid = threadIdx.x, dk = tid & 127, part = tid >> 7;
    const float* lbp = p.in[13];
    const float lb = 1.f / (1.f + __expf(lbp[1024 + h * 128 + dk] - lbp[h * 128 + dk]));
    float cum = 0.f;
#pragma unroll
    for (int i = 0; i < 16; ++i) {
        const float fh = bf2f(fhr[i]);
        const float f = lb + (1.f - lb) * sigm(fh);
        kk[i] = 1.f - f; cum += __logf(f); bb[i] = cum;
    }
    tot[part * 128 + dk] = cum;
    __syncthreads();
    float off = 0.f, bl = 0.f;
#pragma unroll
    for (int q = 0; q < 4; ++q) { const float tv = tot[q * 128 + dk]; bl += tv; off += (q < part) ? tv : 0.f; }
#pragma unroll
    for (int i = 0; i < 16; ++i) bb[i] += off;
    return bl;
}
DI void hg_load_v(const bf16_t* Z, int n, int h, LAS bf16_t* Vs) {
    const int tid = threadIdx.x;
#pragma unroll
    for (int i = 0; i < 2; ++i) { const int e = tid + 512 * i, s = e >> 4, ch = e & 15;
        *(LAS u32x4*)(Vs + s * 136 + 8 * ch) = *(const u32x4*)(Z + (size_t)(64 * n + s) * NZ + ZIH + h * 128 + 8 * ch); }
}
struct HgaRegs { bf16_t fhr[16]; u32x4 vreg[2]; };
DI void hg_passA_load(const bf16_t* Z, int item, HgaRegs& R) {
    const int n = item >> 3, h = item & 7;
    const int tid = threadIdx.x, dk = tid & 127, part = tid >> 7;
#pragma unroll
    for (int i = 0; i < 16; ++i) R.fhr[i] = Z[(size_t)(64 * n + 16 * part + i) * NZ + ZFH + h * 128 + dk];
#pragma unroll
    for (int i = 0; i < 2; ++i) { const int e = tid + 512 * i; R.vreg[i] = *(const u32x4*)(Z + (size_t)(64 * n + (e >> 4)) * NZ + ZIH + h * 128 + 8 * (e & 15)); }
}
DI void hg_passA_item(const Params& p, float* HS, float* HD, LAS unsigned char* L, int item, const HgaRegs& R) {
    const int n = item >> 3, h = item & 7;
    const int tid = threadIdx.x, lane = tid & 63, wave = tid >> 6, dk = tid & 127, part = tid >> 7;
    LAS bf16_t* Kh = (LAS bf16_t*)L;
    LAS bf16_t* Vs = (LAS bf16_t*)(L + 17408);
    LAS float* tot = (LAS float*)(L + 34816);
    float kk[16], bb[16];
    const float bl = hg_gates(p, R.fhr, h, tot, kk, bb);
#pragma unroll
    for (int i = 0; i < 16; ++i) Kh[(16 * part + i) * 136 + dk] = (bf16_t)(pk2(kk[i] * __expf(bl - bb[i]), 0.f) & 0xffffu);
    if (part == 0) HD[(size_t)(n * 8 + h) * 128 + dk] = __expf(bl);
#pragma unroll
    for (int i = 0; i < 2; ++i) { const int e = tid + 512 * i; *(LAS u32x4*)(Vs + (e >> 4) * 136 + 8 * (e & 15)) = R.vreg[i]; }
    __syncthreads();
    f32x4 acc[8];
#pragma unroll
    for (int nt = 0; nt < 8; ++nt) acc[nt] = (f32x4){0.f, 0.f, 0.f, 0.f};
#pragma unroll
    for (int ks = 0; ks < 2; ++ks) {
        const bf16x8 A = gat8(Kh + (32 * ks + 8 * (lane >> 4)) * 136 + 16 * wave + (lane & 15), 136);
#pragma unroll
        for (int nt = 0; nt < 8; ++nt) { const bf16x8 B = gat8(Vs + (32 * ks + 8 * (lane >> 4)) * 136 + 16 * nt + (lane & 15), 136); acc[nt] = mfma16(A, B, acc[nt]); }
    }
    float* up = HS + ((size_t)(n * 8 + h) * 128) * 128;
#pragma unroll
    for (int nt = 0; nt < 8; ++nt)
#pragma unroll
        for (int r = 0; r < 4; ++r) up[(size_t)(16 * wave + 4 * (lane >> 4) + r) * 128 + 16 * nt + (lane & 15)] = acc[nt][r];
    __syncthreads();
}
DI void hg_scan(const Params& p, float* HS, const float* HD) {
    for (int e = blockIdx.x * 512 + threadIdx.x; e < 131072; e += gridDim.x * 512) {
        float S = 0.f;
        for (int n0 = 0; n0 < 256; n0 += 32) {
            float U[32], Dd[32];
#pragma unroll
            for (int j = 0; j < 32; ++j) { U[j] = HS[(size_t)(n0 + j) * 131072 + e]; Dd[j] = HD[(n0 + j) * 1024 + (e >> 7)]; }
#pragma unroll
            for (int j = 0; j < 32; ++j) { HS[(size_t)(n0 + j) * 131072 + e] = S; S = Dd[j] * S + U[j]; }
        }
        p.out[OFF_HGP + e] = S;
    }
}
struct HgcRegs { bf16_t fhr[16], qhr[16]; u32x4 vreg[2]; f32x4 sreg[8]; };
DI void hg_passC_load(const bf16_t* Z, const float* HS, int item, HgcRegs& R) {
    const int n = item >> 3, h = item & 7;
    const int tid = threadIdx.x, dk = tid & 127, part = tid >> 7;
#pragma unroll
    for (int i = 0; i < 16; ++i) { const size_t ro = (size_t)(64 * n + 16 * part + i) * NZ + h * 128 + dk; R.fhr[i] = Z[ro + ZFH]; R.qhr[i] = Z[ro + ZQH]; }
#pragma unroll
    for (int i = 0; i < 2; ++i) { const int e = tid + 512 * i; R.vreg[i] = *(const u32x4*)(Z + (size_t)(64 * n + (e >> 4)) * NZ + ZIH + h * 128 + 8 * (e & 15)); }
    const float* sp = HS + ((size_t)(n * 8 + h) * 128) * 128;
#pragma unroll
    for (int i = 0; i < 8; ++i) { const int e = tid + 512 * i; R.sreg[i] = *(const f32x4*)(sp + (e >> 5) * 128 + 4 * (e & 31)); }
}
DI void hg_passC_item(const Params& p, const bf16_t* Z, bf16_t* OHG, LAS unsigned char* L, int item, const HgcRegs& R) {
    const int n = item >> 3, h = item & 7;
    const int tid = threadIdx.x, lane = tid & 63, wave = tid >> 6, dk = tid & 127, part = tid >> 7;
    LAS bf16_t* Qs = (LAS bf16_t*)L;
    LAS bf16_t* Ks = (LAS bf16_t*)(L + 17408);
    LAS bf16_t* Vs = (LAS bf16_t*)(L + 34816);
    LAS bf16_t* Ss = (LAS bf16_t*)(L + 52224);
    LAS bf16_t* As = (LAS bf16_t*)(L + 87040);
    LAS float* tot = (LAS float*)(L + 96256);
    LAS float* red = (LAS float*)(L + 98304);
    float kk[16], bb[16];
    const int mt = wave >> 1, wh = wave & 1, lr = lane & 15, lq = lane >> 4;
    bf16_t ghr[16];
#pragma unroll
    for (int r = 0; r < 4; ++r)
#pragma unroll
        for (int j = 0; j < 4; ++j) ghr[r * 4 + j] = Z[(size_t)(64 * n + 16 * mt + 4 * lq + r) * NZ + ZGH + h * 128 + 16 * (4 * wh + j) + lr];
    (void)hg_gates(p, R.fhr, h, tot, kk, bb);
#pragma unroll
    for (int i = 0; i < 16; ++i) {
        const int s = 16 * part + i;
        const float qh = bf2f(R.qhr[i]);
        Qs[s * 136 + dk] = (bf16_t)(pk2(silu(qh) * __expf(bb[i]), 0.f) & 0xffffu);
        Ks[s * 136 + dk] = (bf16_t)(pk2(kk[i] * __expf(-bb[i]), 0.f) & 0xffffu);
    }
#pragma unroll
    for (int i = 0; i < 2; ++i) { const int e = tid + 512 * i; *(LAS u32x4*)(Vs + (e >> 4) * 136 + 8 * (e & 15)) = R.vreg[i]; }
#pragma unroll
    for (int i = 0; i < 8; ++i) { const int e = tid + 512 * i; u32x2 w; w.x = pk2(R.sreg[i][0], R.sreg[i][1]); w.y = pk2(R.sreg[i][2], R.sreg[i][3]); *(LAS u32x2*)(Ss + (e >> 5) * 136 + 4 * (e & 31)) = w; }
    __syncthreads();
    {
        f32x4 a2[2] = {{0.f, 0.f, 0.f, 0.f}, {0.f, 0.f, 0.f, 0.f}};
#pragma unroll
        for (int ks = 0; ks < 4; ++ks) {
            const bf16x8 A = ld8(Qs + (16 * mt + lr) * 136 + 32 * ks + 8 * lq);
#pragma unroll
            for (int j = 0; j < 2; ++j) { const bf16x8 B = ld8(Ks + (16 * (2 * wh + j) + lr) * 136 + 32 * ks + 8 * lq); a2[j] = mfma16(A, B, a2[j]); }
        }
#pragma unroll
        for (int j = 0; j < 2; ++j)
#pragma unroll
            for (int r = 0; r < 4; ++r) { const int t = 16 * mt + 4 * lq + r, s = 16 * (2 * wh + j) + lr; As[t * 72 + s] = (bf16_t)(pk2(s <= t ? a2[j][r] : 0.f, 0.f) & 0xffffu); }
    }
    __syncthreads();
    f32x4 acc[4];
#pragma unroll
    for (int j = 0; j < 4; ++j) acc[j] = (f32x4){0.f, 0.f, 0.f, 0.f};
#pragma unroll
    for (int ks = 0; ks < 2; ++ks) {
        const bf16x8 A = ld8(As + (16 * mt + lr) * 72 + 32 * ks + 8 * lq);
#pragma unroll
        for (int j = 0; j < 4; ++j) { const bf16x8 B = gat8(Vs + (32 * ks + 8 * lq) * 136 + 16 * (4 * wh + j) + lr, 136); acc[j] = mfma16(A, B, acc[j]); }
    }
#pragma unroll
    for (int ks = 0; ks < 4; ++ks) {
        const bf16x8 A = ld8(Qs + (16 * mt + lr) * 136 + 32 * ks + 8 * lq);
#pragma unroll
        for (int j = 0; j < 4; ++j) { const bf16x8 B = gat8(Ss + (32 * ks + 8 * lq) * 136 + 16 * (4 * wh + j) + lr, 136); acc[j] = mfma16(A, B, acc[j]); }
    }
#pragma unroll
    for (int r = 0; r < 4; ++r) {
        float ss = 0.f;
#pragma unroll
        for (int j = 0; j < 4; ++j) ss += acc[j][r] * acc[j][r];
        ss += __shfl_xor(ss, 1); ss += __shfl_xor(ss, 2); ss += __shfl_xor(ss, 4); ss += __shfl_xor(ss, 8);
        if (lr == 0) red[(16 * mt + 4 * lq + r) * 2 + wh] = ss;
    }
    __syncthreads();
    const float* hgw = p.in[14];
#pragma unroll
    for (int r = 0; r < 4; ++r) {
        const int tl = 16 * mt + 4 * lq + r, t = 64 * n + tl;
        const float rstd = rsqrtf((red[tl * 2] + red[tl * 2 + 1]) * (1.f / 128.f) + EPS);
#pragma unroll
        for (int j = 0; j < 4; ++j) {
            const int dv = 16 * (4 * wh + j) + lr;
            const float gh = bf2f(ghr[r * 4 + j]);
            OHG[(size_t)t * 1024 + h * 128 + dv] = (bf16_t)(pk2(acc[j][r] * rstd * hgw[dv] * silu(gh), 0.f) & 0xffffu);
        }
    }
    __syncthreads();
}
DI void hg_sample_item(const Params& p, const bf16_t* Z, bf16_t* OHG, LAS unsigned char* L, int item) {
    const int b = item >> 3, h = item & 7;
    const int tid = threadIdx.x, dv = tid & 127, dq = tid >> 7;
    LAS float* fS = (LAS float*)L;
    LAS float* kS = fS + 512;
    LAS float* qS = kS + 512;
    LAS float* red = qS + 512;
    LAS float* rs = red + 2048;
    const float* lbp = p.in[13];
    {
        const int t = tid >> 7, dk = tid & 127, m = TP + b * 4 + t;
        const float lb = 1.f / (1.f + __expf(lbp[1024 + h * 128 + dk] - lbp[h * 128 + dk]));
        const float fh = bf2f(Z[(size_t)m * NZ + ZFH + h * 128 + dk]), qh = bf2f(Z[(size_t)m * NZ + ZQH + h * 128 + dk]);
        const float f = lb + (1.f - lb) * sigm(fh);
        fS[tid] = f; kS[tid] = 1.f - f; qS[tid] = silu(qh);
    }
    float S[32];
    const float* s0 = p.in[5] + ((size_t)(b * 8 + h) * 128) * 128;
#pragma unroll
    for (int i = 0; i < 32; ++i) S[i] = s0[(size_t)(dq * 32 + i) * 128 + dv];
    __syncthreads();
#pragma unroll
    for (int t = 0; t < 4; ++t) {
        const int m = TP + b * 4 + t;
        const float v = bf2f(Z[(size_t)m * NZ + ZIH + h * 128 + dv]);
        float part = 0.f;
#pragma unroll
        for (int i = 0; i < 32; ++i) { const int dk = dq * 32 + i; S[i] = fS[t * 128 + dk] * S[i] + kS[t * 128 + dk] * v; part += S[i] * qS[t * 128 + dk]; }
        red[(t * 4 + dq) * 128 + dv] = part;
    }
    float* so = p.out + OFF_HGS + ((size_t)(b * 8 + h) * 128) * 128;
#pragma unroll
    for (int i = 0; i < 32; ++i) so[(size_t)(dq * 32 + i) * 128 + dv] = S[i];
    __syncthreads();
    {
        const int t = tid >> 7, m = TP + b * 4 + t;
        const float o = red[(t * 4 + 0) * 128 + dv] + red[(t * 4 + 1) * 128 + dv] + red[(t * 4 + 2) * 128 + dv] + red[(t * 4 + 3) * 128 + dv];
        const float ss = wave_sum(o * o);
        if ((tid & 63) == 0) rs[tid >> 6] = ss;
        __syncthreads();
        const float rstd = rsqrtf((rs[2 * t] + rs[2 * t + 1]) * (1.f / 128.f) + EPS);
        const float gh = bf2f(Z[(size_t)m * NZ + ZGH + h * 128 + dv]);
        OHG[(size_t)m * 1024 + h * 128 + dv] = (bf16_t)(pk2(o * rstd * p.in[14][dv] * silu(gh), 0.f) & 0xffffu);
    }
    __syncthreads();
}
DI void ph_merge(const bf16_t* OG, const float* LSE, bf16_t* OATT) {
    for (size_t idx = (size_t)blockIdx.x * 512 + threadIdx.x; idx < (size_t)MR * 64; idx += (size_t)gridDim.x * 512) {
        const int m = (int)(idx >> 6), c8 = (int)(idx & 63), hh = c8 >> 4;
        const float l0 = LSE[((size_t)0 * MP + m) * 4 + hh], l1 = LSE[((size_t)1 * MP + m) * 4 + hh], l2 = LSE[((size_t)2 * MP + m) * 4 + hh];
        const float mx = fmaxf(l0, fmaxf(l1, l2));
        float w0 = __expf(l0 - mx), w1 = __expf(l1 - mx), w2 = __expf(l2 - mx);
        const float inv = 1.f / (w0 + w1 + w2); w0 *= inv; w1 *= inv; w2 *= inv;
        float a[8], b[8], c[8];
        unpack8(*(const u32x4*)(OG + ((size_t)0 * MP + m) * 512 + 8 * c8), a);
        unpack8(*(const u32x4*)(OG + ((size_t)1 * MP + m) * 512 + 8 * c8), b);
        unpack8(*(const u32x4*)(OG + ((size_t)2 * MP + m) * 512 + 8 * c8), c);
        u32x4 o;
        o.x = pk2(w0 * a[0] + w1 * b[0] + w2 * c[0], w0 * a[1] + w1 * b[1] + w2 * c[1]);
        o.y = pk2(w0 * a[2] + w1 * b[2] + w2 * c[2], w0 * a[3] + w1 * b[3] + w2 * c[3]);
        o.z = pk2(w0 * a[4] + w1 * b[4] + w2 * c[4], w0 * a[5] + w1 * b[5] + w2 * c[5]);
        o.w = pk2(w0 * a[6] + w1 * b[6] + w2 * c[6], w0 * a[7] + w1 * b[7] + w2 * c[7]);
        *(u32x4*)(OATT + (size_t)m * 512 + 8 * c8) = o;
    }
}
DI void ld8p(const float* s, float (&f)[8]) {
    f32x4 a = {0.f, 0.f, 0.f, 0.f}, b = a;
#pragma unroll
    for (int q = 0; q < NSP_UP; ++q) { a = a + *(const f32x4*)(s + (size_t)q * NS * NAB); b = b + *(const f32x4*)(s + (size_t)q * NS * NAB + 4); }
    f[0] = a[0]; f[1] = a[1]; f[2] = a[2]; f[3] = a[3]; f[4] = b[0]; f[5] = b[1]; f[6] = b[2]; f[7] = b[3];
}
DI void ph_convact(const Params& p, const bf16_t* AB, bf16_t* G) {
    const float* cw = p.in[21]; const float* cb = p.in[22]; const float* sc = p.in[6];
    const float* ACC = (const float*)(p.ws + WS_ACC_UP);
    for (size_t idx = (size_t)blockIdx.x * 512 + threadIdx.x; idx < (size_t)(126 + NS) * 704; idx += (size_t)gridDim.x * 512) {
        const int ri = (int)(idx / 704), c = (int)(idx % 704) * 8;
        const int m = ri < 126 ? 256 * (1 + (ri >> 1)) + (ri & 1) : TP + (ri - 126);
        float a2[8], a1[8], a0[8], bl[8];
        if (m < TP) {
            unpack8(*(const u32x4*)(AB + (size_t)m * NAB + c), a2);
            unpack8(*(const u32x4*)(AB + (size_t)m * NAB + DFF + c), bl);
            if (m >= 1) unpack8(*(const u32x4*)(AB + (size_t)(m - 1) * NAB + c), a1); else { for (int j = 0; j < 8; ++j) a1[j] = 0.f; }
            if (m >= 2) unpack8(*(const u32x4*)(AB + (size_t)(m - 2) * NAB + c), a0); else { for (int j = 0; j < 8; ++j) a0[j] = 0.f; }
        } else {
            const int ms = m - TP, t = ms & 3, b = ms >> 2;
            ld8p(ACC + (size_t)ms * NAB + c, a2);
            ld8p(ACC + (size_t)ms * NAB + DFF + c, bl);
            if (t >= 1) ld8p(ACC + (size_t)(ms - 1) * NAB + c, a1); else ld8f(sc + (size_t)(b * 2 + 1) * DFF + c, a1);
            if (t >= 2) ld8p(ACC + (size_t)(ms - 2) * NAB + c, a0); else ld8f(sc + (size_t)(b * 2 + t) * DFF + c, a0);
            if (t >= 2) { float* d = p.out + OFF_CVS + (size_t)(b * 2 + t - 2) * DFF + c; *(f32x4*)d = (f32x4){a2[0], a2[1], a2[2], a2[3]}; *(f32x4*)(d + 4) = (f32x4){a2[4], a2[5], a2[6], a2[7]}; }
        }
        float w0[8], w1[8], w2[8], bb[8];
        ld8f(cw + c, w0); ld8f(cw + DFF + c, w1); ld8f(cw + 2 * DFF + c, w2); ld8f(cb + c, bb);
        float o[8];
#pragma unroll
        for (int j = 0; j < 8; ++j) { const float u = bb[j] + w0[j] * a0[j] + w1[j] * a1[j] + w2[j] * a2[j]; o[j] = silu(u) * bl[j]; }
        u32x4 w; w.x = pk2(o[0], o[1]); w.y = pk2(o[2], o[3]); w.z = pk2(o[4], o[5]); w.w = pk2(o[6], o[7]);
        *(u32x4*)(G + (size_t)m * DFF + c) = w;
    }
}

DI void ph_mixfix(const Params& p) {
    const bf16_t* Z = (const bf16_t*)(p.ws + WS_Z); const float* PA = (const float*)(p.ws + WS_ACC_PA); const float* PB = (const float*)(p.ws + WS_ACC_PB); bf16_t* Y = (bf16_t*)(p.ws + WS_YMIX);
    for (int idx = blockIdx.x * 512 + threadIdx.x; idx < NS * (D / 4); idx += gridDim.x * 512) {
        const int r = idx / (D / 4), c = (idx % (D / 4)) * 4;
        f32x4 a = {0.f, 0.f, 0.f, 0.f}, b = a;
#pragma unroll
        for (int q = 0; q < NSP_PA; ++q) a = a + *(const f32x4*)(PA + ((size_t)q * NS + r) * D + c);
#pragma unroll
        for (int q = 0; q < NSP_PB; ++q) b = b + *(const f32x4*)(PB + ((size_t)q * NS + r) * D + c);
        const u32x2 ga = *(const u32x2*)(Z + (size_t)(TP + r) * NZ + ZGA + c), gb = *(const u32x2*)(Z + (size_t)(TP + r) * NZ + ZGB + c);
        const float y0 = sigm(bflo(ga.x)) * a[0] + sigm(bflo(gb.x)) * b[0], y1 = sigm(bfhi(ga.x)) * a[1] + sigm(bfhi(gb.x)) * b[1];
        const float y2 = sigm(bflo(ga.y)) * a[2] + sigm(bflo(gb.y)) * b[2], y3 = sigm(bfhi(ga.y)) * a[3] + sigm(bfhi(gb.y)) * b[3];
        u32x2 w; w.x = pk2(y0, y1); w.y = pk2(y2, y3);
        *(u32x2*)(Y + (size_t)(TP + r) * D + c) = w;
    }
}
#define XB_TMO      128
#define XB_XCNT(j)  (256  + 64 * (j))
#define XB_XSUB(j)  (1280 + 64 * (j))
#define XB_XGEN(j)  (2304 + 64 * (j))
#define XB_TOP      3328
#define XB_TOPGEN   3392
#define XCD_BAR_WORDS 3456
#define XB_SPIN_CAP (1u << 18)

__device__ __forceinline__ unsigned xb_ld(unsigned* p)              { return __hip_atomic_load(p, __ATOMIC_RELAXED, __HIP_MEMORY_SCOPE_AGENT); }
__device__ __forceinline__ unsigned xb_add(unsigned* p, unsigned v) { return __hip_atomic_fetch_add(p, v, __ATOMIC_RELAXED, __HIP_MEMORY_SCOPE_AGENT); }
__device__ __forceinline__ unsigned xb_xcc_id() { return (unsigned)__builtin_amdgcn_s_getreg((3 << 11) | 20) & 0xFu; }
#define XB_SPIN(cond, bar) do { unsigned _sp = 0; while (cond) { __builtin_amdgcn_s_sleep(1); \
    if ((++_sp & 255u) == 0u) { if (xb_ld(&(bar)[XB_TMO])) break; if (_sp > XB_SPIN_CAP) { atomicAdd(&(bar)[XB_TMO], 1u); break; } } } } while (0)

struct XcdBarrier {
    unsigned* bar; unsigned x;
    volatile LAS unsigned* st;
};

__device__ __forceinline__ XcdBarrier xcd_barrier_post(unsigned* bar, volatile LAS unsigned* st) {
    XcdBarrier b; b.bar = bar; b.x = xb_xcc_id(); b.st = st;
    if (threadIdx.x == 0) (void)xb_add(&bar[XB_XCNT(b.x)], 1u);
    return b;
}
__device__ __forceinline__ void xcd_barrier_complete(unsigned* bar, unsigned x, unsigned& nloc, unsigned& nx) {
    const unsigned G = gridDim.x * gridDim.y * gridDim.z;
    unsigned sum, cnt, mine, sp = 0u;
    for (;;) {
        sum = 0u; cnt = 0u; mine = 0u;
#pragma unroll
        for (unsigned j = 0; j < 16; ++j) { const unsigned c = xb_ld(&bar[XB_XCNT(j)]); sum += c; cnt += (c > 0u) ? 1u : 0u; mine = (j == x) ? c : mine; }
        if (sum == G) break;
        __builtin_amdgcn_s_sleep(1);
        if ((++sp & 255u) == 0u) { if (xb_ld(&bar[XB_TMO])) break; if (sp > XB_SPIN_CAP) { atomicAdd(&bar[XB_TMO], 1u); break; } }
    }
    nloc = mine > 0u ? mine : 1u; nx = cnt > 0u ? cnt : 1u;
}

__device__ __forceinline__ void xcd_barrier(const XcdBarrier& b) {
    asm volatile("s_waitcnt vmcnt(0)" ::: "memory");
    __syncthreads();
    if (threadIdx.x == 0) {
        unsigned* bar = b.bar;
        __builtin_amdgcn_s_waitcnt(0);
        unsigned nloc = b.st[0], nx = b.st[1];
        if (nloc == 0u) { xcd_barrier_complete(bar, b.x, nloc, nx); b.st[0] = nloc; b.st[1] = nx; }
        const unsigned old = xb_add(&bar[XB_XSUB(b.x)], 1u);
        const unsigned gen = old / nloc;
        if (old + 1u == (gen + 1u) * nloc) {
            __builtin_amdgcn_fence(__ATOMIC_RELEASE, "agent");
            asm volatile("s_waitcnt vmcnt(0)" ::: "memory");
            const unsigned og = xb_add(&bar[XB_TOP], 1u);
            const unsigned tg = og / nx;
            if (og + 1u == (tg + 1u) * nx) xb_add(&bar[XB_TOPGEN], 1u);
            else XB_SPIN(xb_ld(&bar[XB_TOPGEN]) == tg, bar);
            __builtin_amdgcn_fence(__ATOMIC_ACQUIRE, "agent");
            xb_add(&bar[XB_XGEN(b.x)], 1u);
            asm volatile("s_waitcnt vmcnt(0)" ::: "memory");
        } else {
            XB_SPIN(xb_ld(&bar[XB_XGEN(b.x)]) == gen, bar);
            __builtin_amdgcn_fence(__ATOMIC_ACQUIRE, "agent");
            asm volatile("s_waitcnt vmcnt(0)" ::: "memory");
        }
    }
    __syncthreads();
}

template <class Epi> DI void run_gemm(LAS unsigned char* L, const bf16_t* A, const bf16_t* Bt, int N, int K, const Epi& E) {
    pg8::Gemm g{A, Bt, MP, N, K}; pg8::StaticOrder S; S.init(MP, N, K, (int)gridDim.x, (int)blockIdx.x);
    pg8::gemm_phase<Epi, pg8::StaticOrder, false>(L, g, S, E, nullptr);
}
template <class Epi> DI void run_gemm_split(LAS unsigned char* L, const bf16_t* A, const bf16_t* Bt, int N, int K, const Epi& E) {
    pg8::Gemm g{A, Bt, MP, N, K}; pg8::SplitOrder S; S.init(N, K, (int)gridDim.x, (int)blockIdx.x);
    pg8::gemm_phase<Epi, pg8::SplitOrder, false>(L, g, S, E, nullptr);
}

__global__ void __launch_bounds__(512, 2) mega(Params p) {
    extern __shared__ __attribute__((aligned(16))) unsigned char lds[];
    LAS unsigned char* L = (LAS unsigned char*)lds;
    cg::grid_group grid = cg::this_grid();
    unsigned char* ws = p.ws;
    const int lo = p.ph_lo, hi = p.ph_hi;
    const int tid = threadIdx.x, lane = tid & 63, wave = tid >> 6;
    bf16_t* Z = (bf16_t*)(ws + WS_Z);
    bf16_t* H = (bf16_t*)(ws + WS_H);
    float* MOD = (float*)(ws + WS_MOD);
#define IN(k) (lo <= (k) && (k) < hi)
    XcdBarrier xbar; xbar.bar = (unsigned*)ws; xbar.x = 0; xbar.st = (volatile LAS unsigned*)(L + 131072 + 4096);
    if (hi - lo > 1) {
        if (threadIdx.x < 2) xbar.st[threadIdx.x] = 0u;
        __syncthreads();
        xbar = xcd_barrier_post((unsigned*)ws, (volatile LAS unsigned*)(L + 131072 + 4096));
        grid.sync();
    }
#define SEAM(k) do { if (IN(k) && IN((k) + 1)) xcd_barrier(xbar); } while (0)
#define SOFT(k) do { if (IN(k) && IN((k) + 1)) __syncthreads(); } while (0)
    if (IN(0)) ph_prologue(p, L);
    SEAM(0);
    if (IN(1)) ph_hnorm(p, nullptr, false, p.in[11], 0, H);
    SEAM(1);
    if (IN(2)) { EpiZ E{Z, (const float*)(ws + WS_ROPE), p.out, p.in[2], p.in[3], p.in[4]}; run_gemm(L, H, (const bf16_t*)(ws + WS_WIN), NZ, D, E); }
    SEAM(2);
    if (IN(3)) {
        HgaRegs RA;
        int it = blockIdx.x;
        if (it < 2048) hg_passA_load(Z, it, RA);
        while (it < 2048) {
            const int itn = it + gridDim.x; HgaRegs RB;
            if (itn < 2048) hg_passA_load(Z, itn, RB);
            hg_passA_item(p, (float*)(ws + WS_HS), (float*)(ws + WS_HD), L, it, RA);
            RA = RB; it = itn;
        }
    }
    SOFT(3);
    if (IN(4)) {
        const int gw = blockIdx.x * 8 + wave, NGW = gridDim.x * 8;
        LAS bf16_t* Vl = (LAS bf16_t*)(L + wave * 8704);
        for (int base = 0; base < 6144; base += 3 * NGW)
            for (int j = 0; j < 3; ++j) { const int it = base + gw * 3 + j; if (it < 6144) attn_prompt_item(Z, (bf16_t*)(ws + WS_OG), (float*)(ws + WS_LSE), Vl, it, lane); }
    }
    SOFT(4);
    if (IN(5)) { const int gw = blockIdx.x * 8 + wave, NGW = gridDim.x * 8; for (int it = gw; it < 1536; it += NGW) attn_sample_item(p, Z, (bf16_t*)(ws + WS_OG), (float*)(ws + WS_LSE), it, lane); }
    SEAM(5);
    if (IN(6)) hg_scan(p, (float*)(ws + WS_HS), (const float*)(ws + WS_HD));
    SEAM(6);
    if (IN(7)) {
        HgcRegs RA;
        int it = blockIdx.x;
        if (it < 2048) hg_passC_load(Z, (const float*)(ws + WS_HS), it, RA);
        while (it < 2048) {
            const int itn = it + gridDim.x; HgcRegs RB;
            if (itn < 2048) hg_passC_load(Z, (const float*)(ws + WS_HS), itn, RB);
            hg_passC_item(p, Z, (bf16_t*)(ws + WS_OHG), L, it, RA);
            RA = RB; it = itn;
        }
    }
    SOFT(7);
    if (IN(8)) for (int it = blockIdx.x; it < 256; it += gridDim.x) hg_sample_item(p, Z, (bf16_t*)(ws + WS_OHG), L, it);
    SOFT(8);
    if (IN(9)) ph_merge((const bf16_t*)(ws + WS_OG), (const float*)(ws + WS_LSE), (bf16_t*)(ws + WS_OATT));
    SEAM(9);
    if (IN(10)) {
        { EpiMix1 E{Z, (float*)(ws + WS_TMP), (float*)(ws + WS_ACC_PA)}; run_gemm_split(L, (const bf16_t*)(ws + WS_OATT), (const bf16_t*)(ws + WS_WPA), D, 512, E); }
        { EpiMix2 E{Z, (const float*)(ws + WS_TMP), (bf16_t*)(ws + WS_YMIX), (float*)(ws + WS_ACC_PB)}; run_gemm_split(L, (const bf16_t*)(ws + WS_OHG), (const bf16_t*)(ws + WS_WPB), D, 1024, E); }
    }
    SEAM(10);
    if (IN(11)) ph_mixfix(p);
    SEAM(11);
    if (IN(12)) { EpiWO E{p.in[0], p.in[1], MOD, p.out, (float*)(ws + WS_ACC_WO)}; run_gemm_split(L, (const bf16_t*)(ws + WS_YMIX), (const bf16_t*)(ws + WS_WO), D, D, E); }
    SEAM(12);
    if (IN(13)) ph_hnorm(p, p.out, true, p.in[18], 3, H);
    SEAM(13);
    if (IN(14)) { EpiUp E{(bf16_t*)(ws + WS_AB), (bf16_t*)(ws + WS_G), p.out, (float*)(ws + WS_ACC_UP), p.in[21], p.in[22], (LAS float*)(L + 131072)}; run_gemm_split(L, H, (const bf16_t*)(ws + WS_WAB), NAB, D, E); }
    SEAM(14);
    if (IN(15)) ph_convact(p, (const bf16_t*)(ws + WS_AB), (bf16_t*)(ws + WS_G));
    SEAM(15);
    if (IN(16)) { EpiDown E{MOD, p.out, (float*)(ws + WS_ACC_DN)}; run_gemm_split(L, (const bf16_t*)(ws + WS_G), (const bf16_t*)(ws + WS_WDN), D, DFF, E); }
    SEAM(16);
    if (IN(17)) ph_final_norm(p);
#undef IN
#undef SEAM
#undef SOFT
}

#ifndef MK_MULTI
#define MK_MULTI 0
#endif
extern "C" void kernel_launch(void* const* d_in, const int* in_sizes, int n_in, void* d_out, int out_size, void* d_ws, size_t ws_size, hipStream_t stream) {
    static int grid = 0;
    if (grid == 0) {
        if (n_in != 25 || (size_t)out_size != OUT_TOTAL || ws_size < WS_END) { fprintf(stderr, "kernel_launch: unexpected shapes: n_in %d out %d ws %zu (need %zu)\n", n_in, out_size, ws_size, (size_t)WS_END); grid = -1; return; }
        int dev = 0, cus = 0, per_cu = 0;
        hipGetDevice(&dev);
        hipDeviceGetAttribute(&cus, hipDeviceAttributeMultiprocessorCount, dev);
        if (hipFuncSetAttribute((const void*)mega, hipFuncAttributeMaxDynamicSharedMemorySize, LDS_BYTES) != hipSuccess) { fprintf(stderr, "kernel_launch: hipFuncSetAttribute failed\n"); grid = -1; return; }
        if (hipOccupancyMaxActiveBlocksPerMultiprocessor(&per_cu, (const void*)mega, 512, LDS_BYTES) != hipSuccess || per_cu < 1) { fprintf(stderr, "kernel_launch: occupancy query failed (%d)\n", per_cu); (void)hipGetLastError(); per_cu = 1; }
        grid = cus * 1;
        if (grid < 1) grid = -1;
    }
    if (grid < 0) return;
    Params p{};
    for (int i = 0; i < 25; ++i) p.in[i] = (const float*)d_in[i];
    p.out = (float*)d_out; p.ws = (unsigned char*)d_ws;
#ifndef DUP_MASK
#define DUP_MASK 0
#endif
#if MK_MULTI
    for (int ph = 0; ph < NPH; ++ph) for (int rep = 0; rep < (((DUP_MASK >> ph) & 1) ? 2 : 1); ++rep) { p.ph_lo = ph; p.ph_hi = ph + 1; hipLaunchKernelGGL(mega, dim3(grid), dim3(512), LDS_BYTES, stream, p); }
#else
    p.ph_lo = 0; p.ph_hi = NPH;
    if (hipMemsetAsync(d_ws, 0, 16384, stream) != hipSuccess) { fprintf(stderr, "kernel_launch: memset of the barrier words failed\n"); return; }
    void* args[] = {&p};
    hipError_t e = hipLaunchCooperativeKernel((const void*)mega, dim3(grid), dim3(512), args, LDS_BYTES, stream);
    if (e != hipSuccess) fprintf(stderr, "cooperative launch failed: %s (grid %d)\n", hipGetErrorString(e), grid);
#endif
}
```

```cpp
#include <hip/hip_runtime.h>
#include <hip/hip_cooperative_groups.h>
#include <cstdio>
namespace cg = cooperative_groups;
namespace pg8 {
#define PG8_LAS __attribute__((address_space(3)))
typedef unsigned short bf16_t;
typedef short bf16x8 __attribute__((ext_vector_type(8)));
typedef float f32x4 __attribute__((ext_vector_type(4)));
typedef unsigned u32x4 __attribute__((ext_vector_type(4)));
constexpr int BM = 256, BK = 64, HALF = 128, HTB = HALF * BK * 2  , STAGE_BYTES = 8 * HTB, NXCD = 8, WGM = 8;

__host__ __device__ __forceinline__ int lds_byte(int r, int c) { const int st = (r >> 4) * 2 + (c >> 5), rr = r & 15, cc = c & 31, ob = rr * 64 + cc * 2; return st * 1024 + (ob ^ (((ob >> 9) & 1) << 5)); }
__host__ __device__ __forceinline__ void stage_rc(int b, int& R, int& C) { const int st = b / 1024, sb = b % 1024, swz = sb ^ (((sb >> 9) & 1) << 5); R = (st >> 1) * 16 + swz / 64; C = (st & 1) * 32 + (swz % 64) / 2; }
__host__ __device__ __forceinline__ int perm32(int rho) { const int n = rho >> 4, i = rho & 15; return 8 * (i >> 2) + 4 * n + (i & 3); }

struct Unit { int pm, pn, kt0, nkt; };
struct Gemm { const bf16_t* A; const bf16_t* Bt; int M, N, K; };

struct StaticOrder {
    int nM, nN, nwg, G, c, nkt;
    __host__ __device__ void init(int M, int N, int K, int G_, int c_) { nM = M / BM; nN = N / BM; nwg = nM * nN; G = G_; c = c_; nkt = K / BK; }
    __host__ __device__ bool next(int i, Unit& u) const {
        const long L = (long)i * G + c; if (L >= nwg) return false;
        int wgid = (int)L; { const int q = nwg / NXCD, r = nwg % NXCD, xcd = wgid % NXCD, off = wgid / NXCD; wgid = (xcd < r ? xcd * (q + 1) : r * (q + 1) + (xcd - r) * q) + off; }
        const int nig = WGM * nN, gid = wgid / nig, fm = gid * WGM, gsz = (nM - fm) < WGM ? (nM - fm) : WGM;
        u.pm = fm + ((wgid % nig) % gsz); u.pn = (wgid % nig) / gsz; u.kt0 = 0; u.nkt = nkt; return true;
    }
    __device__ __forceinline__ void a_ready(const Unit&) const {}
    __device__ __forceinline__ void done(const Unit&) const {}
};
struct SplitOrder {
    int nN, nwg, G, c, nkt, nsp;
    __host__ __device__ void init(int N, int K, int G_, int c_) { nN = N / BM; nwg = 64 * nN; G = G_; c = c_; nkt = K / BK; nsp = nkt / 4; }
    __host__ __device__ bool next(int i, Unit& u) const {
        const long L = (long)i * G + c;
        if (L < nwg) {
            int wgid = (int)L; { const int q = nwg / NXCD, r = nwg % NXCD, xcd = wgid % NXCD, off = wgid / NXCD; wgid = (xcd < r ? xcd * (q + 1) : r * (q + 1) + (xcd - r) * q) + off; }
            const int nig = WGM * nN, gid = wgid / nig, fm = gid * WGM, gsz = (64 - fm) < WGM ? (64 - fm) : WGM;
            u.pm = fm + ((wgid % nig) % gsz); u.pn = (wgid % nig) / gsz; u.kt0 = 0; u.nkt = nkt; return true;
        }
        const long j = L - nwg; if (j >= (long)nN * nsp) return false;
        u.pm = 64; u.pn = (int)(j % nN); u.kt0 = 4 * (int)(j / nN); u.nkt = 4; return true;
    }
    __device__ __forceinline__ void a_ready(const Unit&) const {}
    __device__ __forceinline__ void done(const Unit&) const {}
};
template <class Epi, class Sched, bool STAMP = false>
__device__ __forceinline__ void gemm_phase(PG8_LAS unsigned char* lds, const Gemm g, const Sched& S, const Epi& E, unsigned long long* stamps) {
    const int tid = threadIdx.x, wid = __builtin_amdgcn_readfirstlane(tid >> 6), lane = tid & 63, wr = wid >> 2, wc = wid & 3, fr = lane & 15, fq = lane >> 4;
    const int K = g.K;
    int ts_lo = 0, ts_hi = 0, nts = 0; const unsigned long long rt_entry = STAMP ? (unsigned long long)wall_clock64() : 0ull;
#define PG8_STAMP() do { if (STAMP && wid == 0 && nts < 64) { const unsigned long long _c = (unsigned long long)clock64(); \
        ts_lo = (lane == nts) ? (int)(unsigned)_c : ts_lo; ts_hi = (lane == nts) ? (int)(unsigned)(_c >> 32) : ts_hi; ++nts; } } while (0)
    PG8_STAMP();
    unsigned voffA[2], voffB[2];
#pragma unroll
    for (int i = 0; i < 2; ++i) { int R, C; stage_rc(tid * 16 + i * 8192, R, C); const int Rb = Epi::PERM ? ((R & ~31) + perm32(R & 31)) : R;
        voffA[i] = (unsigned)(R * K + C) * 2u; voffB[i] = (unsigned)(Rb * K + C) * 2u; }
    const size_t kstep = (size_t)(BK * 2);
    const size_t hstep = (size_t)HALF * K * 2;
    const size_t tstep = 2 * hstep;
    const unsigned ldsw = (unsigned)wid * 1024u;
    const int aoff = lds_byte(wr * 64 + fr, fq * 8), boff = lds_byte(wc * 32 + fr, fq * 8);
#define PG8_SA(b, h) (((b) * 2 + (h)) * HTB)
#define PG8_SB(b, h) ((4 + (b) * 2 + (h)) * HTB)
#define PG8_STAGE(bufoff, gbase, voff) do { _Pragma("unroll") for (int _i = 0; _i < 2; ++_i) \
        __builtin_amdgcn_global_load_lds((const unsigned*)((const char*)(gbase) + (voff)[_i]), (PG8_LAS unsigned*)(lds + (bufoff) + ldsw + _i * 8192), 16, 0, 0); } while (0)
#define PG8_LDA(dst, b, h) do { _Pragma("unroll") for (int m = 0; m < 4; ++m) _Pragma("unroll") for (int k = 0; k < 2; ++k) dst[m][k] = *(const PG8_LAS bf16x8*)(lds + PG8_SA(b, h) + aoff + m * 2048 + k * 1024); } while (0)
#define PG8_LDB(dst, b, h) do { _Pragma("unroll") for (int n = 0; n < 2; ++n) _Pragma("unroll") for (int k = 0; k < 2; ++k) dst[n][k] = *(const PG8_LAS bf16x8*)(lds + PG8_SB(b, h) + boff + n * 2048 + k * 1024); } while (0)
#define PG8_MMA(ai, bj, At, Bt) do { __builtin_amdgcn_s_setprio(1); _Pragma("unroll") for (int m = 0; m < 4; ++m) _Pragma("unroll") for (int n = 0; n < 2; ++n) _Pragma("unroll") for (int k = 0; k < 2; ++k) \
        acc[ai][bj][m][n] = __builtin_amdgcn_mfma_f32_16x16x32_bf16(Bt[n][k], At[m][k], acc[ai][bj][m][n], 0, 0, 0); __builtin_amdgcn_s_setprio(0); } while (0)
#define PG8_WAIT_V(n) asm volatile("s_waitcnt vmcnt(" #n ")" ::: "memory")
#define PG8_WAIT_L(n) asm volatile("s_waitcnt lgkmcnt(" #n ")" ::: "memory")
#define PG8_BAR __builtin_amdgcn_s_barrier()
#define PG8_SCHED __builtin_amdgcn_sched_barrier(0)
    Unit cur, nxt; int ui = 0;
    if (!S.next(0, cur)) return;
    f32x4 acc[2][2][4][2];
#pragma unroll
    for (int a = 0; a < 2; ++a)
#pragma unroll
        for (int b = 0; b < 2; ++b)
#pragma unroll
            for (int m = 0; m < 4; ++m)
#pragma unroll
                for (int n = 0; n < 2; ++n) acc[a][b][m][n] = (f32x4){0.f, 0.f, 0.f, 0.f};
    bf16x8 At[4][2], B0[2][2], B1[2][2];
    const char* cA = (const char*)g.A + (size_t)cur.pm * tstep + (size_t)cur.kt0 * kstep; const char* cB = (const char*)g.Bt + (size_t)cur.pn * tstep + (size_t)cur.kt0 * kstep;
    S.a_ready(cur);
    PG8_STAGE(PG8_SB(0, 0), cB, voffB); PG8_STAGE(PG8_SA(0, 0), cA, voffA); PG8_STAGE(PG8_SB(0, 1), cB + hstep, voffB); PG8_STAGE(PG8_SA(0, 1), cA + hstep, voffA);
    if (wr == 1) PG8_BAR;
    PG8_WAIT_V(4); PG8_BAR;
    PG8_STAGE(PG8_SB(1, 0), cB + kstep, voffB); PG8_STAGE(PG8_SA(1, 0), cA + kstep, voffA); PG8_STAGE(PG8_SB(1, 1), cB + hstep + kstep, voffB);
    PG8_WAIT_V(6); PG8_BAR;
    PG8_STAMP();
    for (;;) {
        const bool has_next = S.next(ui + 1, nxt);
        const char* nA = has_next ? (const char*)g.A + (size_t)nxt.pm * tstep + (size_t)nxt.kt0 * kstep : cA; const char* nB = has_next ? (const char*)g.Bt + (size_t)nxt.pn * tstep + (size_t)nxt.kt0 * kstep : cB;
        const int nt = cur.nkt;
        for (int t = 0; t < nt; t += 2) {
            const bool last = (t == nt - 2);
            const char* a1 = cA + (size_t)(t + 1) * kstep;
            const char* a2 = last ? nA : cA + (size_t)(t + 2) * kstep; const char* b2 = last ? nB : cB + (size_t)(t + 2) * kstep;
            const char* a3 = a2 + kstep; const char* b3 = b2 + kstep;
            if (last && has_next) S.a_ready(nxt);
            PG8_LDB(B0, 0, 0); PG8_SCHED; PG8_LDA(At, 0, 0); PG8_STAGE(PG8_SA(1, 1), a1 + hstep, voffA);
            PG8_WAIT_L(8); PG8_BAR; PG8_WAIT_L(0); PG8_MMA(0, 0, At, B0); PG8_BAR; PG8_SCHED;
            PG8_LDB(B1, 0, 1); PG8_STAGE(PG8_SB(0, 0), b2, voffB);
            PG8_BAR; PG8_WAIT_L(0); PG8_MMA(0, 1, At, B1); PG8_BAR;
            PG8_LDA(At, 0, 1); PG8_STAGE(PG8_SA(0, 0), a2, voffA);
            PG8_BAR; PG8_WAIT_L(0); PG8_MMA(1, 0, At, B0); PG8_BAR; PG8_SCHED;
            PG8_STAGE(PG8_SB(0, 1), b2 + hstep, voffB);
            PG8_WAIT_V(6); PG8_BAR; PG8_MMA(1, 1, At, B1); PG8_BAR;
            PG8_LDB(B0, 1, 0); PG8_SCHED; PG8_LDA(At, 1, 0); PG8_STAGE(PG8_SA(0, 1), a2 + hstep, voffA);
            PG8_WAIT_L(8); PG8_BAR; PG8_WAIT_L(0); PG8_MMA(0, 0, At, B0); PG8_BAR; PG8_SCHED;
            PG8_LDB(B1, 1, 1); PG8_STAGE(PG8_SB(1, 0), b3, voffB);
            PG8_BAR; PG8_WAIT_L(0); PG8_MMA(0, 1, At, B1); PG8_BAR;
            PG8_LDA(At, 1, 1); PG8_STAGE(PG8_SA(1, 0), a3, voffA);
            PG8_BAR; PG8_WAIT_L(0); PG8_MMA(1, 0, At, B0); PG8_BAR; PG8_SCHED;
            PG8_STAGE(PG8_SB(1, 1), b3 + hstep, voffB);
            PG8_WAIT_V(6); PG8_BAR; PG8_MMA(1, 1, At, B1); PG8_BAR;
        }
        PG8_STAMP();
        if constexpr (!Epi::AFTER_DRAIN) { E(acc, cur, wr, wc, fr, fq); S.done(cur); }
        PG8_STAMP();
        if (!has_next) break;
#pragma unroll
        for (int a = 0; a < 2; ++a)
#pragma unroll
            for (int b = 0; b < 2; ++b)
#pragma unroll
                for (int m = 0; m < 4; ++m)
#pragma unroll
                    for (int n = 0; n < 2; ++n) acc[a][b][m][n] = (f32x4){0.f, 0.f, 0.f, 0.f};
        cur = nxt; cA = nA; cB = nB; ++ui;
    }
    PG8_WAIT_V(0);
    if (wr == 0) PG8_BAR;
    PG8_BAR;
    if constexpr (Epi::AFTER_DRAIN) { E.fused(acc, cur, wr, wc, fr, fq, lds, wid, lane); S.done(cur); }
    PG8_STAMP();
    if (STAMP && wid == 0) { stamps[lane] = lane < nts ? (((unsigned long long)(unsigned)ts_hi << 32) | (unsigned)ts_lo) : 0ull;
        if (lane == 62) stamps[62] = rt_entry; if (lane == 63) stamps[63] = (unsigned long long)wall_clock64(); }
#undef PG8_STAMP
#undef PG8_SA
#undef PG8_SB
#undef PG8_STAGE
#undef PG8_LDA
#undef PG8_LDB
#undef PG8_MMA
#undef PG8_WAIT_V
#undef PG8_WAIT_L
#undef PG8_BAR
#undef PG8_SCHED
}
}

using pg8::bf16_t; using pg8::bf16x8; using pg8::f32x4; using pg8::Unit;
#define LAS __attribute__((address_space(3)))
#define DI __device__ __forceinline__
typedef float f32x16 __attribute__((ext_vector_type(16)));
typedef float f32x2 __attribute__((ext_vector_type(2)));
typedef unsigned u32x4 __attribute__((ext_vector_type(4)));
typedef unsigned u32x2 __attribute__((ext_vector_type(2)));

constexpr int D = 2048, TP = 16384, NS = 128, MR = TP + NS, MP = 16640;
constexpr int NZ = 12800, DFF = 5632, NAB = 2 * DFF;
constexpr int ZQ = 0, ZK = 1536, ZV = 3072, ZQH = 4608, ZFH = 5632, ZIH = 6656, ZGH = 7680, ZGA = 8704, ZGB = 10752;
constexpr int NMODROW = 33, NMOD = 6 * D;
constexpr float EPS = 1e-6f;
constexpr float ATT_SCALE = 0.08838834764831845f;
constexpr size_t OFF_Y = 0;
constexpr size_t OFF_KVP0 = (size_t)MR * D;
constexpr size_t OFF_KVP1 = OFF_KVP0 + 128 * 1024;
constexpr size_t OFF_KVP2 = OFF_KVP1 + 512 * 1024;
constexpr size_t OFF_HGP = OFF_KVP2 + 2048 * 1024;
constexpr size_t OFF_CVP = OFF_HGP + 8 * 128 * 128;
constexpr size_t OFF_KVS0 = OFF_CVP + 2 * DFF;
constexpr size_t OFF_KVS1 = OFF_KVS0 + (size_t)32 * 128 * 1024;
constexpr size_t OFF_KVS2 = OFF_KVS1 + (size_t)32 * 512 * 1024;
constexpr size_t OFF_HGS = OFF_KVS2 + (size_t)32 * 2048 * 1024;
constexpr size_t OFF_CVS = OFF_HGS + (size_t)32 * 8 * 128 * 128;
constexpr size_t OUT_TOTAL = OFF_CVS + (size_t)32 * 2 * DFF;
static_assert(OUT_TOTAL == 129346560, "output size");
constexpr size_t WS_WIN = 1u << 20;
constexpr size_t WS_WPA = WS_WIN + (size_t)NZ * D * 2;
constexpr size_t WS_WPB = WS_WPA + (size_t)2048 * 512 * 2;
constexpr size_t WS_WO = WS_WPB + (size_t)2048 * 1024 * 2;
constexpr size_t WS_WAB = WS_WO + (size_t)2048 * 2048 * 2;
constexpr size_t WS_WDN = WS_WAB + (size_t)NAB * D * 2;
constexpr size_t WS_MOD = WS_WDN + (size_t)D * DFF * 2;
constexpr size_t WS_ROPE = WS_MOD + (size_t)NMODROW * NMOD * 4;
constexpr size_t WS_Z = WS_ROPE + (size_t)MP * 32 * 4;
constexpr size_t WS_AB = WS_Z;
constexpr size_t WS_H = WS_Z + (size_t)MP * NZ * 2;
constexpr size_t WS_OG = WS_H + (size_t)MP * D * 2;
constexpr size_t WS_LSE = WS_OG + (size_t)3 * MP * 512 * 2;
constexpr size_t WS_OATT = WS_LSE + (size_t)3 * MP * 4 * 4;
constexpr size_t WS_OHG = WS_OATT + (size_t)MP * 512 * 2;
constexpr size_t WS_YMIX = WS_OHG + (size_t)MP * 1024 * 2;
constexpr size_t WS_BLK_END = WS_YMIX + (size_t)MP * D * 2;
constexpr size_t WS_G = WS_OG;
static_assert(WS_G + (size_t)MP * DFF * 2 <= WS_BLK_END + (32u << 20), "g overlay");
static_assert((size_t)MP * NAB * 2 <= (size_t)MP * NZ * 2, "ab overlay");
constexpr size_t WS_HS = WS_BLK_END;
constexpr size_t WS_HD = WS_HS + (size_t)256 * 8 * 128 * 128 * 4;
constexpr size_t WS_TMP = WS_HS;
constexpr size_t WS_ACC_WO = WS_Z;
constexpr size_t WS_ACC_DN = WS_Z;
constexpr size_t WS_ACC_UP = WS_TMP + (64u << 20);
constexpr int NSP_WO = 8, NSP_DN = 22, NSP_UP = 8, NSP_PA = 2, NSP_PB = 4;
constexpr size_t WS_ACC_PA = WS_H, WS_ACC_PB = WS_H + (size_t)NSP_PA * NS * D * 4;
static_assert((size_t)NSP_UP * NS * NAB * 4 + (64u << 20) <= (size_t)MP * D * 4, "up partials");
constexpr size_t WS_END = WS_TMP + (size_t)MP * D * 4 + (1u << 20);
static_assert(WS_HD + (size_t)256 * 8 * 128 * 4 <= WS_END, "hd");
static_assert(WS_WIN % 256 == 0 && WS_MOD % 256 == 0 && WS_ROPE % 256 == 0 && WS_Z % 256 == 0 && WS_H % 256 == 0 && WS_OG % 256 == 0 && WS_LSE % 256 == 0 && WS_OATT % 256 == 0 && WS_OHG % 256 == 0 && WS_YMIX % 256 == 0 && WS_HS % 256 == 0 && WS_HD % 256 == 0, "align");
constexpr int LDS_BYTES = 131072 + 4096 + 256;
constexpr int NPH = 18;

struct Params { const float* in[25]; float* out; unsigned char* ws; int ph_lo, ph_hi; };

DI float bf2f(unsigned b) { return __uint_as_float(b << 16); }
DI float bflo(unsigned w) { return __uint_as_float(w << 16); }
DI float bfhi(unsigned w) { return __uint_as_float(w & 0xffff0000u); }
DI unsigned pk2(float lo, float hi) { unsigned r; asm("v_cvt_pk_bf16_f32 %0, %1, %2" : "=v"(r) : "v"(lo), "v"(hi)); return r; }
DI float sigm(float x) { return __builtin_amdgcn_rcpf(1.f + __expf(-x)); }
DI float silu(float x) { return x * __builtin_amdgcn_rcpf(1.f + __expf(-x)); }
DI float wave_sum(float v) {
#pragma unroll
    for (int o = 32; o >= 1; o >>= 1) v += __shfl_xor(v, o);
    return v;
}
DI float wave_max(float v) {
#pragma unroll
    for (int o = 32; o >= 1; o >>= 1) v = fmaxf(v, __shfl_xor(v, o));
    return v;
}
DI void lds_fence() { asm volatile("s_waitcnt lgkmcnt(0)" ::: "memory"); __builtin_amdgcn_wave_barrier(); }
DI bf16x8 gat8(const LAS bf16_t* p, int stride) {
    bf16x8 r;
#pragma unroll
    for (int j = 0; j < 8; ++j) r[j] = (short)p[j * stride];
    return r;
}
DI bf16x8 ld8(const LAS bf16_t* p) { return *(const LAS bf16x8*)p; }
typedef short s16x4 __attribute__((ext_vector_type(4)));
template <int OFF> DI s16x4 tr_read(unsigned vb) { s16x4 r; asm volatile("ds_read_b64_tr_b16 %0, %1 offset:%2" : "=&v"(r) : "v"(vb), "i"(OFF) : "memory"); return r; }
DI f32x4 mfma16(bf16x8 a, bf16x8 b, f32x4 c) { return __builtin_amdgcn_mfma_f32_16x16x32_bf16(a, b, c, 0, 0, 0); }
DI f32x16 mfma32(bf16x8 a, bf16x8 b, f32x16 c) { return __builtin_amdgcn_mfma_f32_32x32x16_bf16(a, b, c, 0, 0, 0); }
DI void unpack8(u32x4 w, float (&f)[8]) { f[0] = bflo(w.x); f[1] = bfhi(w.x); f[2] = bflo(w.y); f[3] = bfhi(w.y); f[4] = bflo(w.z); f[5] = bfhi(w.z); f[6] = bflo(w.w); f[7] = bfhi(w.w); }
DI void atom_add(float* p, float v) { (void)__hip_atomic_fetch_add(p, v, __ATOMIC_RELAXED, __HIP_MEMORY_SCOPE_AGENT); }
DI void ld8f(const float* s, float (&f)[8]) { const f32x4 a = *(const f32x4*)s, b = *(const f32x4*)(s + 4); f[0] = a[0]; f[1] = a[1]; f[2] = a[2]; f[3] = a[3]; f[4] = b[0]; f[5] = b[1]; f[6] = b[2]; f[7] = b[3]; }
DI int crow_of(int r) { return r < TP ? 0 : 1 + ((r - TP) >> 2); }

struct EpiZ {
    static constexpr bool PERM = true, AFTER_DRAIN = false;
    bf16_t* Z; const float* rope; float* out; const float* c0; const float* c1; const float* c2;
    static constexpr int CPY_R0 = 32 * 124, CPY_R1 = 32 * 508, CPY_R2 = 32 * 2044, CPY_ROWS = CPY_R0 + CPY_R1 + CPY_R2, CPY_PER = 28;
    DI void cpy_row(int r, const float*& src, float*& dst) const {
        if (r < CPY_R0) { const int b = r / 124, rr = r - b * 124; src = c0 + ((size_t)(b * 128 + rr + 4)) * 1024; dst = out + OFF_KVS0 + ((size_t)(b * 128 + rr)) * 1024; }
        else if (r < CPY_R0 + CPY_R1) { r -= CPY_R0; const int b = r / 508, rr = r - b * 508; src = c1 + ((size_t)(b * 512 + rr + 4)) * 1024; dst = out + OFF_KVS1 + ((size_t)(b * 512 + rr)) * 1024; }
        else { r -= CPY_R0 + CPY_R1; const int b = r / 2044, rr = r - b * 2044; src = c2 + ((size_t)(b * 2048 + rr + 4)) * 1024; dst = out + OFF_KVS2 + ((size_t)(b * 2048 + rr)) * 1024; }
    }
    DI void operator()(const f32x4 (&acc)[2][2][4][2], const Unit& u, int wr, int wc, int fr, int fq) const {
        {
            int l4 = (wc * 64 + fq * 16 + fr) * 4; asm volatile("" : "+v"(l4));
            const int r0 = (u.pm * 50 + u.pn) * CPY_PER;
#pragma unroll
            for (int h2 = 0; h2 < 2; ++h2) {
                f32x4 v[7];
#pragma unroll
                for (int q = 0; q < 7; ++q) { int r = r0 + (h2 * 7 + q) * 2 + wr; r = r < CPY_ROWS ? r : r - CPY_ROWS; const float* sp; float* dp; cpy_row(r, sp, dp); v[q] = __builtin_nontemporal_load((const f32x4*)(sp + l4)); }
#pragma unroll
                for (int q = 0; q < 7; ++q) { int r = r0 + (h2 * 7 + q) * 2 + wr; r = r < CPY_ROWS ? r : r - CPY_ROWS; const float* sp; float* dp; cpy_row(r, sp, dp); __builtin_nontemporal_store(v[q], (f32x4*)(dp + l4)); }
            }
        }
        const int kind = u.pn < 6 ? 0 : (u.pn < 12 ? 1 : (u.pn < 18 ? 2 : 3));
        const bool do_rope = (kind <= 1) && (wc == 0);
        const int pnn = (kind == 1) ? u.pn - 6 : u.pn - 12;
        const int g = pnn >> 1, W = 128 << (2 * g);
        const size_t offp = g == 0 ? OFF_KVP0 : (g == 1 ? OFF_KVP1 : OFF_KVP2), offs = g == 0 ? OFF_KVS0 : (g == 1 ? OFF_KVS1 : OFF_KVS2);
        const float sg = (fq < 2) ? -1.f : 1.f;
#pragma unroll
        for (int ai = 0; ai < 2; ++ai)
#pragma unroll
            for (int m = 0; m < 4; ++m) {
                const int r = u.pm * 256 + ai * 128 + wr * 64 + m * 16 + fr;
                f32x4 cs0 = {0.f, 0.f, 0.f, 0.f}, cs1 = cs0, sn0 = cs0, sn1 = cs0;
                if (do_rope) { const float* rp = rope + (size_t)r * 32 + 8 * (fq & 1); cs0 = *(const f32x4*)rp; cs1 = *(const f32x4*)(rp + 4); sn0 = *(const f32x4*)(rp + 16); sn1 = *(const f32x4*)(rp + 20); }
#pragma unroll
                for (int bj = 0; bj < 2; ++bj) {
                    f32x4 v0 = acc[ai][bj][m][0], v1 = acc[ai][bj][m][1];
                    if (do_rope) {
                        f32x4 p0, p1;
#pragma unroll
                        for (int j = 0; j < 4; ++j) { p0[j] = __shfl_xor(v0[j], 32); p1[j] = __shfl_xor(v1[j], 32); }
                        v0 = v0 * cs0 + sg * (p0 * sn0); v1 = v1 * cs1 + sg * (p1 * sn1);
                    }
                    const int c = u.pn * 256 + bj * 128 + wc * 32 + 8 * fq;
                    u32x4 w; w.x = pk2(v0[0], v0[1]); w.y = pk2(v0[2], v0[3]); w.z = pk2(v1[0], v1[1]); w.w = pk2(v1[2], v1[3]);
                    *(u32x4*)(Z + (size_t)r * NZ + c) = w;
                    if (kind == 1 || kind == 2) {
                        const int hh = 2 * (pnn & 1) + bj, dd = wc * 32 + 8 * fq, kv = kind - 1;
                        if (u.pm < 64) {
                            if (256 * u.pm + 128 * ai >= TP - W) { float* dst = out + offp + ((size_t)(r - (TP - W)) * 2 + kv) * 512 + hh * 128 + dd; *(f32x4*)dst = v0; *(f32x4*)(dst + 4) = v1; }
                        } else if (ai == 0) {
                            const int b = (r - TP) >> 2, t = (r - TP) & 3; float* dst = out + offs + ((size_t)(b * W + W - 4 + t) * 2 + kv) * 512 + hh * 128 + dd; *(f32x4*)dst = v0; *(f32x4*)(dst + 4) = v1;
                        }
                    }
                }
            }
    }
};
struct EpiMix1 {
    static constexpr bool PERM = false, AFTER_DRAIN = false;
    const bf16_t* Z; float* TMP; float* accs;
    DI void operator()(const f32x4 (&acc)[2][2][4][2], const Unit& u, int wr, int wc, int fr, int fq) const {
        if (u.pm == 64) {
#pragma unroll
            for (int m = 0; m < 4; ++m)
#pragma unroll
                for (int bj = 0; bj < 2; ++bj)
#pragma unroll
                    for (int n = 0; n < 2; ++n) *(f32x4*)(accs + ((size_t)(u.kt0 >> 2) * NS + (wr * 64 + m * 16 + fr)) * D + u.pn * 256 + bj * 128 + wc * 32 + 16 * n + 4 * fq) = acc[0][bj][m][n];
            return;
        }
#pragma unroll
        for (int ai = 0; ai < 2; ++ai)
#pragma unroll
            for (int m = 0; m < 4; ++m) {
                const int r = u.pm * 256 + ai * 128 + wr * 64 + m * 16 + fr;
#pragma unroll
                for (int bj = 0; bj < 2; ++bj)
#pragma unroll
                    for (int n = 0; n < 2; ++n) {
                        const int c = u.pn * 256 + bj * 128 + wc * 32 + 16 * n + 4 * fq;
                        const u32x2 gw = *(const u32x2*)(Z + (size_t)r * NZ + ZGA + c);
                        f32x4 v = acc[ai][bj][m][n];
                        v[0] *= sigm(bflo(gw.x)); v[1] *= sigm(bfhi(gw.x)); v[2] *= sigm(bflo(gw.y)); v[3] *= sigm(bfhi(gw.y));
                        *(f32x4*)(TMP + (size_t)r * D + c) = v;
                    }
            }
    }
};
struct EpiMix2 {
    static constexpr bool PERM = false, AFTER_DRAIN = false;
    const bf16_t* Z; const float* TMP; bf16_t* Y; float* accs;
    DI void operator()(const f32x4 (&acc)[2][2][4][2], const Unit& u, int wr, int wc, int fr, int fq) const {
        if (u.pm == 64) {
#pragma unroll
            for (int m = 0; m < 4; ++m)
#pragma unroll
                for (int bj = 0; bj < 2; ++bj)
#pragma unroll
                    for (int n = 0; n < 2; ++n) *(f32x4*)(accs + ((size_t)(u.kt0 >> 2) * NS + (wr * 64 + m * 16 + fr)) * D + u.pn * 256 + bj * 128 + wc * 32 + 16 * n + 4 * fq) = acc[0][bj][m][n];
            return;
        }
#pragma unroll
        for (int ai = 0; ai < 2; ++ai)
#pragma unroll
            for (int m = 0; m < 4; ++m) {
                const int r = u.pm * 256 + ai * 128 + wr * 64 + m * 16 + fr;
#pragma unroll
                for (int bj = 0; bj < 2; ++bj)
#pragma unroll
                    for (int n = 0; n < 2; ++n) {
                        const int c = u.pn * 256 + bj * 128 + wc * 32 + 16 * n + 4 * fq;
                        const u32x2 gw = *(const u32x2*)(Z + (size_t)r * NZ + ZGB + c);
                        const f32x4 t = *(const f32x4*)(TMP + (size_t)r * D + c);
                        f32x4 v = acc[ai][bj][m][n];
                        v[0] = t[0] + v[0] * sigm(bflo(gw.x)); v[1] = t[1] + v[1] * sigm(bfhi(gw.x)); v[2] = t[2] + v[2] * sigm(bflo(gw.y)); v[3] = t[3] + v[3] * sigm(bfhi(gw.y));
                        u32x2 w; w.x = pk2(v[0], v[1]); w.y = pk2(v[2], v[3]);
                        *(u32x2*)(Y + (size_t)r * D + c) = w;
                    }
            }
    }
};
struct EpiWO {
    static constexpr bool PERM = false, AFTER_DRAIN = false;
    const float* xp; const float* xs; const float* mod; float* out; float* accs;
    DI void operator()(const f32x4 (&acc)[2][2][4][2], const Unit& u, int wr, int wc, int fr, int fq) const {
        if (u.pm == 64) {
#pragma unroll
            for (int m = 0; m < 4; ++m)
#pragma unroll
                for (int bj = 0; bj < 2; ++bj)
#pragma unroll
                    for (int n = 0; n < 2; ++n) {
                        float* d = accs + ((size_t)(u.kt0 >> 2) * NS + (wr * 64 + m * 16 + fr)) * D + u.pn * 256 + bj * 128 + wc * 32 + 16 * n + 4 * fq;
                        *(f32x4*)d = acc[0][bj][m][n];
                    }
            return;
        }
#pragma unroll
        for (int ai = 0; ai < 2; ++ai)
#pragma unroll
            for (int m = 0; m < 4; ++m) {
                const int r = u.pm * 256 + ai * 128 + wr * 64 + m * 16 + fr;
                if (r < MR) {
                    const float* xr = r < TP ? xp + (size_t)r * D : xs + (size_t)(r - TP) * D;
                    const float* g1 = mod + (size_t)crow_of(r) * NMOD + 2 * D;
#pragma unroll
                    for (int bj = 0; bj < 2; ++bj)
#pragma unroll
                        for (int n = 0; n < 2; ++n) {
                            const int c = u.pn * 256 + bj * 128 + wc * 32 + 16 * n + 4 * fq;
                            const f32x4 xv = *(const f32x4*)(xr + c), gv = *(const f32x4*)(g1 + c);
                            *(f32x4*)(out + (size_t)r * D + c) = xv + gv * acc[ai][bj][m][n];
                        }
                }
            }
    }
};
struct EpiDown {
    static constexpr bool PERM = false, AFTER_DRAIN = false;
    const float* mod; float* out; float* accs;
    DI void operator()(const f32x4 (&acc)[2][2][4][2], const Unit& u, int wr, int wc, int fr, int fq) const {
        if (u.pm == 64) {
#pragma unroll
            for (int m = 0; m < 4; ++m)
#pragma unroll
                for (int bj = 0; bj < 2; ++bj)
#pragma unroll
                    for (int n = 0; n < 2; ++n) {
                        float* d = accs + ((size_t)(u.kt0 >> 2) * NS + (wr * 64 + m * 16 + fr)) * D + u.pn * 256 + bj * 128 + wc * 32 + 16 * n + 4 * fq;
                        *(f32x4*)d = acc[0][bj][m][n];
                    }
            return;
        }
#pragma unroll
        for (int ai = 0; ai < 2; ++ai)
#pragma unroll
            for (int m = 0; m < 4; ++m) {
                const int r = u.pm * 256 + ai * 128 + wr * 64 + m * 16 + fr;
                if (r < MR) {
                    const float* g2 = mod + (size_t)crow_of(r) * NMOD + 5 * D;
#pragma unroll
                    for (int bj = 0; bj < 2; ++bj)
#pragma unroll
                        for (int n = 0; n < 2; ++n) {
                            const int c = u.pn * 256 + bj * 128 + wc * 32 + 16 * n + 4 * fq;
                            float* o = out + (size_t)r * D + c;
                            const f32x4 xv = *(const f32x4*)o, gv = *(const f32x4*)(g2 + c);
                            *(f32x4*)o = xv + gv * acc[ai][bj][m][n];
                        }
                }
            }
    }
};
struct EpiUp {
    static constexpr bool PERM = true, AFTER_DRAIN = false;
    bf16_t* AB; bf16_t* G; float* out; float* accs; const float* cw; const float* cb; LAS float* xch;
    DI void operator()(const f32x4 (&acc)[2][2][4][2], const Unit& u, int wr, int wc, int fr, int fq) const {
        int cl = 32 * wc + 8 * fq;
        if (u.pm == 64) {
#pragma unroll
            for (int m = 0; m < 4; ++m)
#pragma unroll
                for (int bj = 0; bj < 2; ++bj)
#pragma unroll
                    for (int n = 0; n < 2; ++n) {
                        float* d = accs + ((size_t)(u.kt0 >> 2) * NS + (wr * 64 + m * 16 + fr)) * NAB + bj * DFF + 128 * u.pn + cl + 4 * n;
                        *(f32x4*)d = acc[0][bj][m][n];
                    }
            return;
        }
        asm volatile("" : "+v"(cl), "+v"(fr), "+v"(fq));
        const int lane = fq * 16 + fr;
        if (fr >= 14) {
#pragma unroll
            for (int ai = 0; ai < 2; ++ai) { LAS float* d = xch + ((2 * ai + wr) * 2 + (fr - 14)) * 128 + cl; *(LAS f32x4*)d = acc[ai][0][3][0]; *(LAS f32x4*)(d + 4) = acc[ai][0][3][1]; }
        }
        asm volatile("s_waitcnt lgkmcnt(0)" ::: "memory"); __builtin_amdgcn_s_barrier(); __builtin_amdgcn_s_barrier(); asm volatile("" ::: "memory");
        const int src1 = (lane & 48) | ((fr + 15) & 15), src2 = (lane & 48) | ((fr + 14) & 15);
#pragma unroll
        for (int n = 0; n < 2; ++n) {
            const int c = 128 * u.pn + cl + 4 * n;
            const f32x4 w0 = *(const f32x4*)(cw + c), w1 = *(const f32x4*)(cw + DFF + c), w2 = *(const f32x4*)(cw + 2 * DFF + c), bb = *(const f32x4*)(cb + c);
#pragma unroll
            for (int ai = 0; ai < 2; ++ai) {
                const int q = 2 * ai + wr;
                f32x4 y1 = {0.f, 0.f, 0.f, 0.f}, z1 = y1;
                if (q > 0) { y1 = *(const LAS f32x4*)(xch + ((q - 1) * 2 + 1) * 128 + cl + 4 * n); z1 = *(const LAS f32x4*)(xch + ((q - 1) * 2 + (fr == 0 ? 0 : 1)) * 128 + cl + 4 * n); }
#pragma unroll
                for (int m = 0; m < 4; ++m) {
                    const f32x4 av = acc[ai][0][m][n], bv = acc[ai][1][m][n];
                    f32x4 o;
#pragma unroll
                    for (int j = 0; j < 4; ++j) {
                        const float y = __shfl(av[j], src1), z = __shfl(av[j], src2);
                        const float a1 = fr >= 1 ? y : y1[j], a0 = fr >= 2 ? z : z1[j];
                        y1[j] = y; z1[j] = z;
                        const float uu = bb[j] + w0[j] * a0 + w1[j] * a1 + w2[j] * av[j];
                        o[j] = silu(uu) * bv[j];
                    }
                    const int rl = 128 * ai + 64 * wr + 16 * m + fr, rg = 256 * u.pm + rl;
                    u32x2 gw; gw.x = pk2(o[0], o[1]); gw.y = pk2(o[2], o[3]);
                    if (ai == 0 && m == 0 && wr == 0) {
                        if (!(fr < 2 && u.pm > 0)) *(u32x2*)(G + (size_t)rg * DFF + c) = gw;
                        if (fr < 2) {
                            u32x2 w; w.x = pk2(av[0], av[1]); w.y = pk2(av[2], av[3]); *(u32x2*)(AB + (size_t)rg * NAB + c) = w;
                            u32x2 x; x.x = pk2(bv[0], bv[1]); x.y = pk2(bv[2], bv[3]); *(u32x2*)(AB + (size_t)rg * NAB + DFF + c) = x;
                        }
                    } else {
                        *(u32x2*)(G + (size_t)rg * DFF + c) = gw;
                        if (ai == 1 && m == 3 && wr == 1) {
                            if (fr >= 14) {
                                u32x2 w; w.x = pk2(av[0], av[1]); w.y = pk2(av[2], av[3]); *(u32x2*)(AB + (size_t)rg * NAB + c) = w;
                                if (u.pm == 63) *(f32x4*)(out + OFF_CVP + (size_t)(rl - 254) * DFF + c) = av;
                            }
                        }
                    }
                    asm volatile("" ::: "memory");
                }
            }
        }
    }
};

DI void ph_mod(const Params& p, LAS unsigned char* L, float* mod) {
    LAS float* sS = (LAS float*)L;
    LAS float* sRed = (LAS float*)L;
    const int tid = threadIdx.x, cgp = tid % 24, ksub = tid / 24;
    const float* cpr = p.in[7]; const float* csm = p.in[8]; const float* wada = p.in[9]; const float* bada = p.in[10];
    for (int nb = blockIdx.x; nb < 256; nb += gridDim.x) {
        const int n0 = nb * 48;
        float acc[33][2];
#pragma unroll
        for (int r = 0; r < 33; ++r) { acc[r][0] = 0.f; acc[r][1] = 0.f; }
        for (int kc = 0; kc < 4; ++kc) {
            f32x2 wv[25];
#pragma unroll
            for (int q = 0; q < 25; ++q) { const int kk = ksub + 21 * q; wv[q] = (ksub < 21 && kk < 512) ? *(const f32x2*)(wada + (size_t)(kc * 512 + kk) * NMOD + n0 + 2 * cgp) : (f32x2){0.f, 0.f}; }
            for (int idx = tid; idx < 33 * 512; idx += 512) {
                const int r = idx >> 9, kk = idx & 511;
                const float c = r == 0 ? cpr[kc * 512 + kk] : csm[(r - 1) * D + kc * 512 + kk];
                sS[kk * 36 + r] = silu(c);
            }
            __syncthreads();
#pragma unroll
            for (int q = 0; q < 25; ++q) {
                const int kk = ksub + 21 * q;
                if (ksub < 21 && kk < 512) {
                    const f32x2 w = wv[q];
                    const LAS f32x4* sp = (const LAS f32x4*)(sS + kk * 36);
#pragma unroll
                    for (int r4 = 0; r4 < 9; ++r4) {
                        const f32x4 sv = sp[r4];
#pragma unroll
                        for (int j = 0; j < 4; ++j) { if (4 * r4 + j < 33) { acc[4 * r4 + j][0] += sv[j] * w[0]; acc[4 * r4 + j][1] += sv[j] * w[1]; } }
                    }
                }
            }
            __syncthreads();
        }
#pragma unroll
        for (int r0 = 0; r0 < 33; r0 += 11) {
            if (ksub < 21) {
#pragma unroll
                for (int i = 0; i < 11; ++i) { sRed[ksub * 528 + i * 48 + 2 * cgp] = acc[r0 + i][0]; sRed[ksub * 528 + i * 48 + 2 * cgp + 1] = acc[r0 + i][1]; }
            }
            __syncthreads();
            for (int o = tid; o < 528; o += 512) {
                float sum = 0.f;
                for (int k2 = 0; k2 < 21; ++k2) sum += sRed[k2 * 528 + o];
                const int i = o / 48, c = o % 48;
                mod[(size_t)(r0 + i) * NMOD + n0 + c] = sum + bada[n0 + c];
            }
            __syncthreads();
        }
    }
}
DI void tr_load(const float* W, int N, int r, int lane, f32x4 (&v)[8]) {
    const int nblk = N / 32, kb = r / nblk, nb = r % nblk, k0 = 64 * kb, n0 = 32 * nb;
#pragma unroll
    for (int i = 0; i < 8; ++i) v[i] = *(const f32x4*)(W + (size_t)(k0 + 8 * i + (lane >> 3)) * N + n0 + 4 * (lane & 7));
}
DI void tr_finish(bf16_t* WT, int K, int N, int inter, int r, LAS float* scr, int lane, const f32x4 (&v)[8]) {
    const int nblk = N / 32, kb = r / nblk, nb = r % nblk, k0 = 64 * kb, n0 = 32 * nb;
#pragma unroll
    for (int i = 0; i < 8; ++i) { LAS float* dd = scr + (8 * i + (lane >> 3)) * 33 + 4 * (lane & 7); dd[0] = v[i][0]; dd[1] = v[i][1]; dd[2] = v[i][2]; dd[3] = v[i][3]; }
    lds_fence();
    const int c = lane & 7;
#pragma unroll
    for (int j = 0; j < 4; ++j) { const int n = (lane >> 3) + 8 * j; const LAS float* s = scr + (8 * c) * 33 + n;
        u32x4 o; o.x = pk2(s[0 * 33], s[1 * 33]); o.y = pk2(s[2 * 33], s[3 * 33]); o.z = pk2(s[4 * 33], s[5 * 33]); o.w = pk2(s[6 * 33], s[7 * 33]);
        const int na = n0 + n, drow = inter < 0 ? na : ((na >> 7) << 8) + inter * 128 + (na & 127);
        *(u32x4*)(WT + (size_t)drow * K + k0 + 8 * c) = o; }
    lds_fence();
}
constexpr int TR_I_IN = 32 * 400, TR_I_PA = 8 * 64, TR_I_PB = 16 * 64, TR_I_O = 32 * 64, TR_I_A = 32 * 176, TR_I_DN = 88 * 64;
constexpr int TR_NITEMS = TR_I_IN + TR_I_PA + TR_I_PB + TR_I_O + 2 * TR_I_A + TR_I_DN;
struct TrSrc { const float *w_in, *w_pa, *w_pb, *w_o, *w_a, *w_b, *w_dn; };
DI void tr_decode(const TrSrc& q, unsigned char* ws, int it, const float*& W, bf16_t*& WT, int& K, int& N, int& inter, int& r) {
    r = it; inter = -1;
    if (r < TR_I_IN) { W = q.w_in; WT = (bf16_t*)(ws + WS_WIN); K = D; N = NZ; return; } r -= TR_I_IN;
    if (r < TR_I_PA) { W = q.w_pa; WT = (bf16_t*)(ws + WS_WPA); K = 512; N = D; return; } r -= TR_I_PA;
    if (r < TR_I_PB) { W = q.w_pb; WT = (bf16_t*)(ws + WS_WPB); K = 1024; N = D; return; } r -= TR_I_PB;
    if (r < TR_I_O) { W = q.w_o; WT = (bf16_t*)(ws + WS_WO); K = D; N = D; return; } r -= TR_I_O;
    if (r < TR_I_A) { W = q.w_a; WT = (bf16_t*)(ws + WS_WAB); K = D; N = DFF; inter = 0; return; } r -= TR_I_A;
    if (r < TR_I_A) { W = q.w_b; WT = (bf16_t*)(ws + WS_WAB); K = D; N = DFF; inter = 1; return; } r -= TR_I_A;
    W = q.w_dn; WT = (bf16_t*)(ws + WS_WDN); K = DFF; N = D;
}
DI void ph_prologue(const Params& p, LAS unsigned char* L) {
    unsigned char* ws = p.ws;
    const int tid = threadIdx.x, lane = tid & 63, wave = tid >> 6;
    const int gw = blockIdx.x * 8 + wave, NGW = gridDim.x * 8;
    const size_t gtid = (size_t)blockIdx.x * 512 + tid, gstride = (size_t)gridDim.x * 512;
    ph_mod(p, L, (float*)(ws + WS_MOD));
    LAS float* scr = (LAS float*)(L + wave * 8448);
    const TrSrc tq{p.in[12], p.in[15], p.in[16], p.in[17], p.in[19], p.in[20], p.in[23]};
    for (int it = gw; it < TR_NITEMS; it += 2 * NGW) {
        const float* W0; bf16_t* T0; int K0, N0, i0, r0; tr_decode(tq, ws, it, W0, T0, K0, N0, i0, r0);
        const int it1 = it + NGW; const bool two = it1 < TR_NITEMS;
        const float* W1; bf16_t* T1; int K1, N1, i1, r1; tr_decode(tq, ws, two ? it1 : it, W1, T1, K1, N1, i1, r1);
        f32x4 v0[8], v1[8];
        tr_load(W0, N0, r0, lane, v0); tr_load(W1, N1, r1, lane, v1);
        tr_finish(T0, K0, N0, i0, r0, scr, lane, v0);
        if (two) tr_finish(T1, K1, N1, i1, r1, scr, lane, v1);
    }
    {
        float* rope = (float*)(ws + WS_ROPE);
        for (size_t idx = gtid; idx < (size_t)MR * 16; idx += gstride) {
            const int m = (int)(idx >> 4), i = (int)(idx & 15);
            const int pos = m < TP ? m : TP + ((m - TP) & 3);
            const float invf = (float)exp2(-(double)i * (18.931568569324174 / 16.0));
            const float ang = (float)pos * invf;
            const double x = (double)ang, n = rint(x * 0.15915494309189535);
            double rr = fma(-n, 6.283185307179586, x); rr = fma(-n, 2.4492935982947064e-16, rr);
            rope[(size_t)m * 32 + i] = cosf((float)rr); rope[(size_t)m * 32 + 16 + i] = sinf((float)rr);
        }
    }
}
DI const float* hn_src(const Params& p, const float* xbase, bool from_out, int m) {
    const bool fix = from_out && m >= TP;
    return (from_out && !fix) ? xbase + (size_t)m * D : (m < TP ? p.in[0] + (size_t)m * D : p.in[1] + (size_t)(m - TP) * D);
}
DI void ph_hnorm(const Params& p, float* xbase, bool from_out, const float* nw, int sh_idx, bf16_t* H) {
    const int lane = threadIdx.x & 63, wave = threadIdx.x >> 6, stride = gridDim.x * 8;
    const float* mod = (const float*)(p.ws + WS_MOD);
    int m = blockIdx.x * 8 + wave;
    f32x4 v[8];
    if (m < MR) { const float* xr = hn_src(p, xbase, from_out, m);
#pragma unroll
        for (int j = 0; j < 8; ++j) v[j] = *(const f32x4*)(xr + 4 * lane + 256 * j); }
    while (m < MR) {
        const int mn = m + stride; f32x4 vn[8];
        if (mn < MR) { const float* xr = hn_src(p, xbase, from_out, mn);
#pragma unroll
            for (int j = 0; j < 8; ++j) vn[j] = *(const f32x4*)(xr + 4 * lane + 256 * j); }
        const bool fix = from_out && m >= TP;
        const float* md = mod + (size_t)crow_of(m) * NMOD + sh_idx * D;
        float ss = 0.f;
#pragma unroll
        for (int j = 0; j < 8; ++j) { const int c = 4 * lane + 256 * j;
            if (fix) { f32x4 a = {0.f, 0.f, 0.f, 0.f}; for (int q = 0; q < NSP_WO; ++q) a = a + *(const f32x4*)((const float*)(p.ws + WS_ACC_WO) + ((size_t)q * NS + (m - TP)) * D + c); const f32x4 g = *(const f32x4*)(mod + (size_t)crow_of(m) * NMOD + 2 * D + c); v[j] = v[j] + g * a; *(f32x4*)(xbase + (size_t)m * D + c) = v[j]; }
            ss += v[j][0] * v[j][0] + v[j][1] * v[j][1] + v[j][2] * v[j][2] + v[j][3] * v[j][3]; }
        const float rstd = rsqrtf(wave_sum(ss) * (1.f / D) + EPS);
#pragma unroll
        for (int j = 0; j < 8; ++j) {
            const int c = 4 * lane + 256 * j;
            const f32x4 w = *(const f32x4*)(nw + c), shv = *(const f32x4*)(md + c), scv = *(const f32x4*)(md + D + c);
            const f32x4 o = (v[j] * rstd) * w * (1.f + scv) + shv;
            u32x2 q; q.x = pk2(o[0], o[1]); q.y = pk2(o[2], o[3]);
            *(u32x2*)(H + (size_t)m * D + c) = q;
        }
#pragma unroll
        for (int j = 0; j < 8; ++j) v[j] = vn[j];
        m = mn;
    }
}
DI void ph_final_norm(const Params& p) {
    const int lane = threadIdx.x & 63, wave = threadIdx.x >> 6, stride = gridDim.x * 8;
    const float* nw = p.in[24];
    int m = blockIdx.x * 8 + wave;
    f32x4 v[8];
    if (m < MR) {
#pragma unroll
        for (int j = 0; j < 8; ++j) v[j] = *(const f32x4*)(p.out + (size_t)m * D + 4 * lane + 256 * j); }
    while (m < MR) {
        const int mn = m + stride; f32x4 vn[8];
        if (mn < MR) {
#pragma unroll
            for (int j = 0; j < 8; ++j) vn[j] = *(const f32x4*)(p.out + (size_t)mn * D + 4 * lane + 256 * j); }
        float* xr = p.out + (size_t)m * D;
        float ss = 0.f;
#pragma unroll
        for (int j = 0; j < 8; ++j) { const int c = 4 * lane + 256 * j;
            if (m >= TP) { f32x4 a = {0.f, 0.f, 0.f, 0.f}; for (int q = 0; q < NSP_DN; ++q) a = a + *(const f32x4*)((const float*)(p.ws + WS_ACC_DN) + ((size_t)q * NS + (m - TP)) * D + c); const f32x4 g = *(const f32x4*)((const float*)(p.ws + WS_MOD) + (size_t)crow_of(m) * NMOD + 5 * D + c); v[j] = v[j] + g * a; }
            ss += v[j][0] * v[j][0] + v[j][1] * v[j][1] + v[j][2] * v[j][2] + v[j][3] * v[j][3]; }
        const float rstd = rsqrtf(wave_sum(ss) * (1.f / D) + EPS);
#pragma unroll
        for (int j = 0; j < 8; ++j) { const int c = 4 * lane + 256 * j; const f32x4 w = *(const f32x4*)(nw + c); *(f32x4*)(xr + c) = (v[j] * rstd) * w; }
#pragma unroll
        for (int j = 0; j < 8; ++j) v[j] = vn[j];
        m = mn;
    }
}

DI void attn_prompt_item(const bf16_t* Z, bf16_t* OG, float* LSE, LAS bf16_t* Vl, int item, int lane) {
    const int g = item >> 11, rem = item & 2047, hh = rem >> 9, bidx = rem & 511;
    const int dsh = 2 * g, nsh = 9 - dsh;
    const int res = bidx >> nsh, blk = bidx & ((1 << nsh) - 1);
    const int s0 = blk * 32, head = g * 4 + hh;
    const int qi = lane & 31, h = lane >> 5;
    const int tq = res + ((s0 + qi) << dsh);
    bf16x8 Qf[8];
    { const bf16_t* qp = Z + (size_t)tq * NZ + ZQ + head * 128 + 8 * h;
#pragma unroll
      for (int ks = 0; ks < 8; ++ks) Qf[ks] = *(const bf16x8*)(qp + 16 * ks); }
    float mrun = -INFINITY, lrun = 0.f;
    f32x16 O[4];
#pragma unroll
    for (int dt = 0; dt < 4; ++dt)
#pragma unroll
        for (int i = 0; i < 16; ++i) O[dt][i] = 0.f;
    const int sq = s0 + qi;
    const int vrow = lane >> 4, vch = lane & 15;
    const unsigned vtr = (unsigned)(unsigned long long)Vl + (unsigned)(((4 * h + ((lane & 15) >> 2)) * 136 + 16 * ((lane >> 4) & 1) + 4 * (lane & 3)) * 2);
    bf16x8 Kc[8]; u32x4 Vr[8];
#define ATT_LOAD_KV(kt_) do { const int kb_ = s0 - 128 + 32 * (kt_); int skl_ = kb_ + qi; skl_ = skl_ < 0 ? 0 : skl_; \
        const bf16_t* kp_ = Z + (size_t)(res + (skl_ << dsh)) * NZ + ZK + head * 128 + 8 * h; \
        _Pragma("unroll") for (int ks = 0; ks < 8; ++ks) Kc[ks] = *(const bf16x8*)(kp_ + 16 * ks); \
        _Pragma("unroll") for (int i = 0; i < 8; ++i) { int sv_ = kb_ + 4 * i + vrow; sv_ = sv_ < 0 ? 0 : sv_; \
            Vr[i] = *(const u32x4*)(Z + (size_t)(res + (sv_ << dsh)) * NZ + ZV + head * 128 + 8 * vch); } } while (0)
    ATT_LOAD_KV(4);
    for (int kt = 4; kt >= 0; --kt) {
        const int kb = s0 - 128 + 32 * kt;
        f32x16 S;
#pragma unroll
        for (int i = 0; i < 16; ++i) S[i] = 0.f;
#pragma unroll
        for (int ks = 0; ks < 8; ++ks) S = mfma32(Kc[ks], Qf[ks], S);
#pragma unroll
        for (int i = 0; i < 8; ++i) *(LAS u32x4*)(Vl + (4 * i + vrow) * 136 + 8 * vch) = Vr[i];
        if (kt > 0) ATT_LOAD_KV(kt - 1);
        float tmax = -INFINITY;
        if (kt >= 1 && kt <= 3 && kb >= 0) {
#pragma unroll
            for (int i = 0; i < 16; ++i) { S[i] = S[i] * ATT_SCALE; tmax = fmaxf(tmax, S[i]); }
        } else {
#pragma unroll
            for (int i = 0; i < 16; ++i) {
                const int sk = kb + (i & 3) + 8 * (i >> 2) + 4 * h;
                const bool valid = (sk >= 0) && (sk <= sq) && (sk >= sq - 128);
                S[i] = valid ? S[i] * ATT_SCALE : -INFINITY;
                tmax = fmaxf(tmax, S[i]);
            }
        }
        tmax = fmaxf(tmax, __shfl_xor(tmax, 32));
        const float mn = fmaxf(mrun, tmax), alpha = __expf(mrun - mn);
        float ps = 0.f;
#pragma unroll
        for (int i = 0; i < 16; ++i) { S[i] = __expf(S[i] - mn); ps += S[i]; }
        ps += __shfl_xor(ps, 32);
        lrun = lrun * alpha + ps; mrun = mn;
#pragma unroll
        for (int dt = 0; dt < 4; ++dt) O[dt] = O[dt] * alpha;
        bf16x8 Pf[2];
#pragma unroll
        for (int s2 = 0; s2 < 2; ++s2) {
            u32x4 w; w.x = pk2(S[8 * s2 + 0], S[8 * s2 + 1]); w.y = pk2(S[8 * s2 + 2], S[8 * s2 + 3]); w.z = pk2(S[8 * s2 + 4], S[8 * s2 + 5]); w.w = pk2(S[8 * s2 + 6], S[8 * s2 + 7]);
            Pf[s2] = __builtin_bit_cast(bf16x8, w);
        }
        lds_fence();
        const s16x4 l00 = tr_read<0>(vtr), h00 = tr_read<2176>(vtr);
        const s16x4 l01 = tr_read<4352>(vtr), h01 = tr_read<6528>(vtr);
        const s16x4 l10 = tr_read<64>(vtr), h10 = tr_read<2240>(vtr);
        const s16x4 l11 = tr_read<4416>(vtr), h11 = tr_read<6592>(vtr);
        const s16x4 l20 = tr_read<128>(vtr), h20 = tr_read<2304>(vtr);
        const s16x4 l21 = tr_read<4480>(vtr), h21 = tr_read<6656>(vtr);
        const s16x4 l30 = tr_read<192>(vtr), h30 = tr_read<2368>(vtr);
        const s16x4 l31 = tr_read<4544>(vtr), h31 = tr_read<6720>(vtr);
        asm volatile("s_waitcnt lgkmcnt(0)" ::: "memory"); __builtin_amdgcn_sched_barrier(0);
#define PK8(L_, H_) (bf16x8){L_[0], L_[1], L_[2], L_[3], H_[0], H_[1], H_[2], H_[3]}
        O[0] = mfma32(PK8(l00, h00), Pf[0], O[0]);
        O[0] = mfma32(PK8(l01, h01), Pf[1], O[0]);
        O[1] = mfma32(PK8(l10, h10), Pf[0], O[1]);
        O[1] = mfma32(PK8(l11, h11), Pf[1], O[1]);
        O[2] = mfma32(PK8(l20, h20), Pf[0], O[2]);
        O[2] = mfma32(PK8(l21, h21), Pf[1], O[2]);
        O[3] = mfma32(PK8(l30, h30), Pf[0], O[3]);
        O[3] = mfma32(PK8(l31, h31), Pf[1], O[3]);
#undef PK8
        lds_fence();
    }
#undef ATT_LOAD_KV
    const float inv = 1.f / lrun;
    bf16_t* op = OG + ((size_t)g * MP + tq) * 512 + hh * 128 + 4 * h;
#pragma unroll
    for (int dt = 0; dt < 4; ++dt)
#pragma unroll
        for (int rq = 0; rq < 4; ++rq) {
            u32x2 w; w.x = pk2(O[dt][4 * rq] * inv, O[dt][4 * rq + 1] * inv); w.y = pk2(O[dt][4 * rq + 2] * inv, O[dt][4 * rq + 3] * inv);
            *(u32x2*)(op + 32 * dt + 8 * rq) = w;
        }
    if (h == 0) LSE[((size_t)g * MP + tq) * 4 + hh] = mrun + __logf(lrun);
}
DI const float* samp_row(const float* cache, const float* newkv, int b, int W, int rr) {
    return (rr >= W) ? newkv + ((size_t)(b * W + rr - 4) * 2) * 512 : cache + ((size_t)(b * W + rr) * 2) * 512;
}
DI void attn_sample_item(const Params& p, const bf16_t* Z, bf16_t* OG, float* LSE, int item, int lane) {
    const int b = item / 48, r48 = item % 48, t = r48 / 12, head = r48 % 12, g = head >> 2, hh = head & 3;
    const int dsh = 2 * g, W = 128 << dsh;
    const float* cache = p.in[2 + g];
    const float* newkv = p.out + (g == 0 ? OFF_KVS0 : (g == 1 ? OFF_KVS1 : OFF_KVS2));
    const int m = TP + b * 4 + t;
    const unsigned qq = *(const unsigned*)(Z + (size_t)m * NZ + ZQ + head * 128 + 2 * lane);
    const float q0 = bflo(qq) * ATT_SCALE, q1 = bfhi(qq) * ATT_SCALE;
    float mrun, lrun, o0, o1;
    {
        const float* rp = samp_row(cache, newkv, b, W, W + t - (128 << dsh)) + hh * 128 + 2 * lane;
        const f32x2 kk = *(const f32x2*)rp, vv = *(const f32x2*)(rp + 512);
        mrun = wave_sum(q0 * kk.x + q1 * kk.y); lrun = 1.f; o0 = vv.x; o1 = vv.y;
    }
    f32x2 kk[16], vv[16];
#pragma unroll
    for (int u = 0; u < 16; ++u) { const float* rp = samp_row(cache, newkv, b, W, W + t - (u << dsh)) + hh * 128 + 2 * lane; kk[u] = *(const f32x2*)rp; vv[u] = *(const f32x2*)(rp + 512); }
    for (int j0 = 0; j0 < 128; j0 += 16) {
        f32x2 kn[16], vn[16];
        if (j0 + 16 < 128) {
#pragma unroll
            for (int u = 0; u < 16; ++u) { const float* rp = samp_row(cache, newkv, b, W, W + t - ((j0 + 16 + u) << dsh)) + hh * 128 + 2 * lane; kn[u] = *(const f32x2*)rp; vn[u] = *(const f32x2*)(rp + 512); }
        }
        float pr[16];
#pragma unroll
        for (int u = 0; u < 16; ++u) pr[u] = q0 * kk[u].x + q1 * kk[u].y;
#pragma unroll
        for (int o = 32; o >= 1; o >>= 1) {
#pragma unroll
            for (int u = 0; u < 16; ++u) pr[u] += __shfl_xor(pr[u], o);
        }
        float bm = pr[0];
#pragma unroll
        for (int u = 1; u < 16; ++u) bm = fmaxf(bm, pr[u]);
        const float mn = fmaxf(mrun, bm), alpha = __expf(mrun - mn);
        lrun *= alpha; o0 *= alpha; o1 *= alpha; mrun = mn;
#pragma unroll
        for (int u = 0; u < 16; ++u) { const float pu = __expf(pr[u] - mn); lrun += pu; o0 += pu * vv[u].x; o1 += pu * vv[u].y; }
#pragma unroll
        for (int u = 0; u < 16; ++u) { kk[u] = kn[u]; vv[u] = vn[u]; }
    }
    const float inv = 1.f / lrun;
    *(unsigned*)(OG + ((size_t)g * MP + m) * 512 + hh * 128 + 2 * lane) = pk2(o0 * inv, o1 * inv);
    if (lane == 0) LSE[((size_t)g * MP + m) * 4 + hh] = mrun + __logf(lrun);
}

DI float hg_gates(const Params& p, const bf16_t (&fhr)[16], int h, LAS float* tot, float (&kk)[16], float (&bb)[16]) {
    const int tid = threadIdx.x, dk = tid & 127, part = tid >> 7;
    const float* lbp = p.in[13];
    const float lb = 1.f / (1.f + __expf(lbp[1024 + h * 128 + dk] - lbp[h * 128 + dk]));
    float cum = 0.f;
#pragma unroll
    for (int i = 0; i < 16; ++i) {
        const float fh = bf2f(fhr[i]);
        const float f = lb + (1.f - lb) * sigm(fh);
        kk[i] = 1.f - f; cum += __logf(f); bb[i] = cum;
    }
    tot[part * 128 + dk] = cum;
    __syncthreads();
    float off = 0.f, bl = 0.f;
#pragma unroll
    for (int q = 0; q < 4; ++q) { const float tv = tot[q * 128 + dk]; bl += tv; off += (q < part) ? tv : 0.f; }
#pragma unroll
    for (int i = 0; i < 16; ++i) bb[i] += off;
    return bl;
}
DI void hg_load_v(const bf16_t* Z, int n, int h, LAS bf16_t* Vs) {
    const int tid = threadIdx.x;
#pragma unroll
    for (int i = 0; i < 2; ++i) { const int e = tid + 512 * i, s = e >> 4, ch = e & 15;
        *(LAS u32x4*)(Vs + s * 136 + 8 * ch) = *(const u32x4*)(Z + (size_t)(64 * n + s) * NZ + ZIH + h * 128 + 8 * ch); }
}
struct HgaRegs { bf16_t fhr[16]; u32x4 vreg[2]; };
DI void hg_passA_load(const bf16_t* Z, int item, HgaRegs& R) {
    const int n = item >> 3, h = item & 7;
    const int tid = threadIdx.x, dk = tid & 127, part = tid >> 7;
#pragma unroll
    for (int i = 0; i < 16; ++i) R.fhr[i] = Z[(size_t)(64 * n + 16 * part + i) * NZ + ZFH + h * 128 + dk];
#pragma unroll
    for (int i = 0; i < 2; ++i) { const int e = tid + 512 * i; R.vreg[i] = *(const u32x4*)(Z + (size_t)(64 * n + (e >> 4)) * NZ + ZIH + h * 128 + 8 * (e & 15)); }
}
DI void hg_passA_item(const Params& p, float* HS, float* HD, LAS unsigned char* L, int item, const HgaRegs& R) {
    const int n = item >> 3, h = item & 7;
    const int tid = threadIdx.x, lane = tid & 63, wave = tid >> 6, dk = tid & 127, part = tid >> 7;
    LAS bf16_t* Kh = (LAS bf16_t*)L;
    LAS bf16_t* Vs = (LAS bf16_t*)(L + 17408);
    LAS float* tot = (LAS float*)(L + 34816);
    float kk[16], bb[16];
    const float bl = hg_gates(p, R.fhr, h, tot, kk, bb);
#pragma unroll
    for (int i = 0; i < 16; ++i) Kh[(16 * part + i) * 136 + dk] = (bf16_t)(pk2(kk[i] * __expf(bl - bb[i]), 0.f) & 0xffffu);
    if (part == 0) HD[(size_t)(n * 8 + h) * 128 + dk] = __expf(bl);
#pragma unroll
    for (int i = 0; i < 2; ++i) { const int e = tid + 512 * i; *(LAS u32x4*)(Vs + (e >> 4) * 136 + 8 * (e & 15)) = R.vreg[i]; }
    __syncthreads();
    f32x4 acc[8];
#pragma unroll
    for (int nt = 0; nt < 8; ++nt) acc[nt] = (f32x4){0.f, 0.f, 0.f, 0.f};
#pragma unroll
    for (int ks = 0; ks < 2; ++ks) {
        const bf16x8 A = gat8(Kh + (32 * ks + 8 * (lane >> 4)) * 136 + 16 * wave + (lane & 15), 136);
#pragma unroll
        for (int nt = 0; nt < 8; ++nt) { const bf16x8 B = gat8(Vs + (32 * ks + 8 * (lane >> 4)) * 136 + 16 * nt + (lane & 15), 136); acc[nt] = mfma16(A, B, acc[nt]); }
    }
    float* up = HS + ((size_t)(n * 8 + h) * 128) * 128;
#pragma unroll
    for (int nt = 0; nt < 8; ++nt)
#pragma unroll
        for (int r = 0; r < 4; ++r) up[(size_t)(16 * wave + 4 * (lane >> 4) + r) * 128 + 16 * nt + (lane & 15)] = acc[nt][r];
    __syncthreads();
}
DI void hg_scan(const Params& p, float* HS, const float* HD) {
    for (int e = blockIdx.x * 512 + threadIdx.x; e < 131072; e += gridDim.x * 512) {
        float S = 0.f;
        for (int n0 = 0; n0 < 256; n0 += 32) {
            float U[32], Dd[32];
#pragma unroll
            for (int j = 0; j < 32; ++j) { U[j] = HS[(size_t)(n0 + j) * 131072 + e]; Dd[j] = HD[(n0 + j) * 1024 + (e >> 7)]; }
#pragma unroll
            for (int j = 0; j < 32; ++j) { HS[(size_t)(n0 + j) * 131072 + e] = S; S = Dd[j] * S + U[j]; }
        }
        p.out[OFF_HGP + e] = S;
    }
}
struct HgcRegs { bf16_t fhr[16], qhr[16]; u32x4 vreg[2]; f32x4 sreg[8]; };
DI void hg_passC_load(const bf16_t* Z, const float* HS, int item, HgcRegs& R) {
    const int n = item >> 3, h = item & 7;
    const int tid = threadIdx.x, dk = tid & 127, part = tid >> 7;
#pragma unroll
    for (int i = 0; i < 16; ++i) { const size_t ro = (size_t)(64 * n + 16 * part + i) * NZ + h * 128 + dk; R.fhr[i] = Z[ro + ZFH]; R.qhr[i] = Z[ro + ZQH]; }
#pragma unroll
    for (int i = 0; i < 2; ++i) { const int e = tid + 512 * i; R.vreg[i] = *(const u32x4*)(Z + (size_t)(64 * n + (e >> 4)) * NZ + ZIH + h * 128 + 8 * (e & 15)); }
    const float* sp = HS + ((size_t)(n * 8 + h) * 128) * 128;
#pragma unroll
    for (int i = 0; i < 8; ++i) { const int e = tid + 512 * i; R.sreg[i] = *(const f32x4*)(sp + (e >> 5) * 128 + 4 * (e & 31)); }
}
DI void hg_passC_item(const Params& p, const bf16_t* Z, bf16_t* OHG, LAS unsigned char* L, int item, const HgcRegs& R) {
    const int n = item >> 3, h = item & 7;
    const int tid = threadIdx.x, lane = tid & 63, wave = tid >> 6, dk = tid & 127, part = tid >> 7;
    LAS bf16_t* Qs = (LAS bf16_t*)L;
    LAS bf16_t* Ks = (LAS bf16_t*)(L + 17408);
    LAS bf16_t* Vs = (LAS bf16_t*)(L + 34816);
    LAS bf16_t* Ss = (LAS bf16_t*)(L + 52224);
    LAS bf16_t* As = (LAS bf16_t*)(L + 87040);
    LAS float* tot = (LAS float*)(L + 96256);
    LAS float* red = (LAS float*)(L + 98304);
    float kk[16], bb[16];
    const int mt = wave >> 1, wh = wave & 1, lr = lane & 15, lq = lane >> 4;
    bf16_t ghr[16];
#pragma unroll
    for (int r = 0; r < 4; ++r)
#pragma unroll
        for (int j = 0; j < 4; ++j) ghr[r * 4 + j] = Z[(size_t)(64 * n + 16 * mt + 4 * lq + r) * NZ + ZGH + h * 128 + 16 * (4 * wh + j) + lr];
    (void)hg_gates(p, R.fhr, h, tot, kk, bb);
#pragma unroll
    for (int i = 0; i < 16; ++i) {
        const int s = 16 * part + i;
        const float qh = bf2f(R.qhr[i]);
        Qs[s * 136 + dk] = (bf16_t)(pk2(silu(qh) * __expf(bb[i]), 0.f) & 0xffffu);
        Ks[s * 136 + dk] = (bf16_t)(pk2(kk[i] * __expf(-bb[i]), 0.f) & 0xffffu);
    }
#pragma unroll
    for (int i = 0; i < 2; ++i) { const int e = tid + 512 * i; *(LAS u32x4*)(Vs + (e >> 4) * 136 + 8 * (e & 15)) = R.vreg[i]; }
#pragma unroll
    for (int i = 0; i < 8; ++i) { const int e = tid + 512 * i; u32x2 w; w.x = pk2(R.sreg[i][0], R.sreg[i][1]); w.y = pk2(R.sreg[i][2], R.sreg[i][3]); *(LAS u32x2*)(Ss + (e >> 5) * 136 + 4 * (e & 31)) = w; }
    __syncthreads();
    {
        f32x4 a2[2] = {{0.f, 0.f, 0.f, 0.f}, {0.f, 0.f, 0.f, 0.f}};
#pragma unroll
        for (int ks = 0; ks < 4; ++ks) {
            const bf16x8 A = ld8(Qs + (16 * mt + lr) * 136 + 32 * ks + 8 * lq);
#pragma unroll
            for (int j = 0; j < 2; ++j) { const bf16x8 B = ld8(Ks + (16 * (2 * wh + j) + lr) * 136 + 32 * ks + 8 * lq); a2[j] = mfma16(A, B, a2[j]); }
        }
#pragma unroll
        for (int j = 0; j < 2; ++j)
#pragma unroll
            for (int r = 0; r < 4; ++r) { const int t = 16 * mt + 4 * lq + r, s = 16 * (2 * wh + j) + lr; As[t * 72 + s] = (bf16_t)(pk2(s <= t ? a2[j][r] : 0.f, 0.f) & 0xffffu); }
    }
    __syncthreads();
    f32x4 acc[4];
#pragma unroll
    for (int j = 0; j < 4; ++j) acc[j] = (f32x4){0.f, 0.f, 0.f, 0.f};
#pragma unroll
    for (int ks = 0; ks < 2; ++ks) {
        const bf16x8 A = ld8(As + (16 * mt + lr) * 72 + 32 * ks + 8 * lq);
#pragma unroll
        for (int j = 0; j < 4; ++j) { const bf16x8 B = gat8(Vs + (32 * ks + 8 * lq) * 136 + 16 * (4 * wh + j) + lr, 136); acc[j] = mfma16(A, B, acc[j]); }
    }
#pragma unroll
    for (int ks = 0; ks < 4; ++ks) {
        const bf16x8 A = ld8(Qs + (16 * mt + lr) * 136 + 32 * ks + 8 * lq);
#pragma unroll
        for (int j = 0; j < 4; ++j) { const bf16x8 B = gat8(Ss + (32 * ks + 8 * lq) * 136 + 16 * (4 * wh + j) + lr, 136); acc[j] = mfma16(A, B, acc[j]); }
    }
#pragma unroll
    for (int r = 0; r < 4; ++r) {
        float ss = 0.f;
#pragma unroll
        for (int j = 0; j < 4; ++j) ss += acc[j][r] * acc[j][r];
        ss += __shfl_xor(ss, 1); ss += __shfl_xor(ss, 2); ss += __shfl_xor(ss, 4); ss += __shfl_xor(ss, 8);
        if (lr == 0) red[(16 * mt + 4 * lq + r) * 2 + wh] = ss;
    }
    __syncthreads();
    const float* hgw = p.in[14];
#pragma unroll
    for (int r = 0; r < 4; ++r) {
        const int tl = 16 * mt + 4 * lq + r, t = 64 * n + tl;
        const float rstd = rsqrtf((red[tl * 2] + red[tl * 2 + 1]) * (1.f / 128.f) + EPS);
#pragma unroll
        for (int j = 0; j < 4; ++j) {
            const int dv = 16 * (4 * wh + j) + lr;
            const float gh = bf2f(ghr[r * 4 + j]);
            OHG[(size_t)t * 1024 + h * 128 + dv] = (bf16_t)(pk2(acc[j][r] * rstd * hgw[dv] * silu(gh), 0.f) & 0xffffu);
        }
    }
    __syncthreads();
}
DI void hg_sample_item(const Params& p, const bf16_t* Z, bf16_t* OHG, LAS unsigned char* L, int item) {
    const int b = item >> 3, h = item & 7;
    const int tid = threadIdx.x, dv = tid & 127, dq = tid >> 7;
    LAS float* fS = (LAS float*)L;
    LAS float* kS = fS + 512;
    LAS float* qS = kS + 512;
    LAS float* red = qS + 512;
    LAS float* rs = red + 2048;
    const float* lbp = p.in[13];
    {
        const int t = tid >> 7, dk = tid & 127, m = TP + b * 4 + t;
        const float lb = 1.f / (1.f + __expf(lbp[1024 + h * 128 + dk] - lbp[h * 128 + dk]));
        const float fh = bf2f(Z[(size_t)m * NZ + ZFH + h * 128 + dk]), qh = bf2f(Z[(size_t)m * NZ + ZQH + h * 128 + dk]);
        const float f = lb + (1.f - lb) * sigm(fh);
        fS[tid] = f; kS[tid] = 1.f - f; qS[tid] = silu(qh);
    }
    float S[32];
    const float* s0 = p.in[5] + ((size_t)(b * 8 + h) * 128) * 128;
#pragma unroll
    for (int i = 0; i < 32; ++i) S[i] = s0[(size_t)(dq * 32 + i) * 128 + dv];
    __syncthreads();
#pragma unroll
    for (int t = 0; t < 4; ++t) {
        const int m = TP + b * 4 + t;
        const float v = bf2f(Z[(size_t)m * NZ + ZIH + h * 128 + dv]);
        float part = 0.f;
#pragma unroll
        for (int i = 0; i < 32; ++i) { const int dk = dq * 32 + i; S[i] = fS[t * 128 + dk] * S[i] + kS[t * 128 + dk] * v; part += S[i] * qS[t * 128 + dk]; }
        red[(t * 4 + dq) * 128 + dv] = part;
    }
    float* so = p.out + OFF_HGS + ((size_t)(b * 8 + h) * 128) * 128;
#pragma unroll
    for (int i = 0; i < 32; ++i) so[(size_t)(dq * 32 + i) * 128 + dv] = S[i];
    __syncthreads();
    {
        const int t = tid >> 7, m = TP + b * 4 + t;
        const float o = red[(t * 4 + 0) * 128 + dv] + red[(t * 4 + 1) * 128 + dv] + red[(t * 4 + 2) * 128 + dv] + red[(t * 4 + 3) * 128 + dv];
        const float ss = wave_sum(o * o);
        if ((tid & 63) == 0) rs[tid >> 6] = ss;
        __syncthreads();
        const float rstd = rsqrtf((rs[2 * t] + rs[2 * t + 1]) * (1.f / 128.f) + EPS);
        const float gh = bf2f(Z[(size_t)m * NZ + ZGH + h * 128 + dv]);
        OHG[(size_t)m * 1024 + h * 128 + dv] = (bf16_t)(pk2(o * rstd * p.in[14][dv] * silu(gh), 0.f) & 0xffffu);
    }
    __syncthreads();
}
DI void ph_merge(const bf16_t* OG, const float* LSE, bf16_t* OATT) {
    for (size_t idx = (size_t)blockIdx.x * 512 + threadIdx.x; idx < (size_t)MR * 64; idx += (size_t)gridDim.x * 512) {
        const int m = (int)(idx >> 6), c8 = (int)(idx & 63), hh = c8 >> 4;
        const float l0 = LSE[((size_t)0 * MP + m) * 4 + hh], l1 = LSE[((size_t)1 * MP + m) * 4 + hh], l2 = LSE[((size_t)2 * MP + m) * 4 + hh];
        const float mx = fmaxf(l0, fmaxf(l1, l2));
        float w0 = __expf(l0 - mx), w1 = __expf(l1 - mx), w2 = __expf(l2 - mx);
        const float inv = 1.f / (w0 + w1 + w2); w0 *= inv; w1 *= inv; w2 *= inv;
        float a[8], b[8], c[8];
        unpack8(*(const u32x4*)(OG + ((size_t)0 * MP + m) * 512 + 8 * c8), a);
        unpack8(*(const u32x4*)(OG + ((size_t)1 * MP + m) * 512 + 8 * c8), b);
        unpack8(*(const u32x4*)(OG + ((size_t)2 * MP + m) * 512 + 8 * c8), c);
        u32x4 o;
        o.x = pk2(w0 * a[0] + w1 * b[0] + w2 * c[0], w0 * a[1] + w1 * b[1] + w2 * c[1]);
        o.y = pk2(w0 * a[2] + w1 * b[2] + w2 * c[2], w0 * a[3] + w1 * b[3] + w2 * c[3]);
        o.z = pk2(w0 * a[4] + w1 * b[4] + w2 * c[4], w0 * a[5] + w1 * b[5] + w2 * c[5]);
        o.w = pk2(w0 * a[6] + w1 * b[6] + w2 * c[6], w0 * a[7] + w1 * b[7] + w2 * c[7]);
        *(u32x4*)(OATT + (size_t)m * 512 + 8 * c8) = o;
    }
}
DI void ld8p(const float* s, float (&f)[8]) {
    f32x4 a = {0.f, 0.f, 0.f, 0.f}, b = a;
#pragma unroll
    for (int q = 0; q < NSP_UP; ++q) { a = a + *(const f32x4*)(s + (size_t)q * NS * NAB); b = b + *(const f32x4*)(s + (size_t)q * NS * NAB + 4); }
    f[0] = a[0]; f[1] = a[1]; f[2] = a[2]; f[3] = a[3]; f[4] = b[0]; f[5] = b[1]; f[6] = b[2]; f[7] = b[3];
}
DI void ph_convact(const Params& p, const bf16_t* AB, bf16_t* G) {
    const float* cw = p.in[21]; const float* cb = p.in[22]; const float* sc = p.in[6];
    const float* ACC = (const float*)(p.ws + WS_ACC_UP);
    for (size_t idx = (size_t)blockIdx.x * 512 + threadIdx.x; idx < (size_t)(126 + NS) * 704; idx += (size_t)gridDim.x * 512) {
        const int ri = (int)(idx / 704), c = (int)(idx % 704) * 8;
        const int m = ri < 126 ? 256 * (1 + (ri >> 1)) + (ri & 1) : TP + (ri - 126);
        float a2[8], a1[8], a0[8], bl[8];
        if (m < TP) {
            unpack8(*(const u32x4*)(AB + (size_t)m * NAB + c), a2);
            unpack8(*(const u32x4*)(AB + (size_t)m * NAB + DFF + c), bl);
            if (m >= 1) unpack8(*(const u32x4*)(AB + (size_t)(m - 1) * NAB + c), a1); else { for (int j = 0; j < 8; ++j) a1[j] = 0.f; }
            if (m >= 2) unpack8(*(const u32x4*)(AB + (size_t)(m - 2) * NAB + c), a0); else { for (int j = 0; j < 8; ++j) a0[j] = 0.f; }
        } else {
            const int ms = m - TP, t = ms & 3, b = ms >> 2;
            ld8p(ACC + (size_t)ms * NAB + c, a2);
            ld8p(ACC + (size_t)ms * NAB + DFF + c, bl);
            if (t >= 1) ld8p(ACC + (size_t)(ms - 1) * NAB + c, a1); else ld8f(sc + (size_t)(b * 2 + 1) * DFF + c, a1);
            if (t >= 2) ld8p(ACC + (size_t)(ms - 2) * NAB + c, a0); else ld8f(sc + (size_t)(b * 2 + t) * DFF + c, a0);
            if (t >= 2) { float* d = p.out + OFF_CVS + (size_t)(b * 2 + t - 2) * DFF + c; *(f32x4*)d = (f32x4){a2[0], a2[1], a2[2], a2[3]}; *(f32x4*)(d + 4) = (f32x4){a2[4], a2[5], a2[6], a2[7]}; }
        }
        float w0[8], w1[8], w2[8], bb[8];
        ld8f(cw + c, w0); ld8f(cw + DFF + c, w1); ld8f(cw + 2 * DFF + c, w2); ld8f(cb + c, bb);
        float o[8];
#pragma unroll
        for (int j = 0; j < 8; ++j) { const float u = bb[j] + w0[j] * a0[j] + w1[j] * a1[j] + w2[j] * a2[j]; o[j] = silu(u) * bl[j]; }
        u32x4 w; w.x = pk2(o[0], o[1]); w.y = pk2(o[2], o[3]); w.z = pk2(o[4], o[5]); w.w = pk2(o[6], o[7]);
        *(u32x4*)(G + (size_t)m * DFF + c) = w;
    }
}

DI void ph_mixfix(const Params& p) {
    const bf16_t* Z = (const bf16_t*)(p.ws + WS_Z); const float* PA = (const float*)(p.ws + WS_ACC_PA); const float* PB = (const float*)(p.ws + WS_ACC_PB); bf16_t* Y = (bf16_t*)(p.ws + WS_YMIX);
    for (int idx = blockIdx.x * 512 + threadIdx.x; idx < NS * (D / 4); idx += gridDim.x * 512) {
        const int r = idx / (D / 4), c = (idx % (D / 4)) * 4;
        f32x4 a = {0.f, 0.f, 0.f, 0.f}, b = a;
#pragma unroll
        for (int q = 0; q < NSP_PA; ++q) a = a + *(const f32x4*)(PA + ((size_t)q * NS + r) * D + c);
#pragma unroll
        for (int q = 0; q < NSP_PB; ++q) b = b + *(const f32x4*)(PB + ((size_t)q * NS + r) * D + c);
        const u32x2 ga = *(const u32x2*)(Z + (size_t)(TP + r) * NZ + ZGA + c), gb = *(const u32x2*)(Z + (size_t)(TP + r) * NZ + ZGB + c);
        const float y0 = sigm(bflo(ga.x)) * a[0] + sigm(bflo(gb.x)) * b[0], y1 = sigm(bfhi(ga.x)) * a[1] + sigm(bfhi(gb.x)) * b[1];
        const float y2 = sigm(bflo(ga.y)) * a[2] + sigm(bflo(gb.y)) * b[2], y3 = sigm(bfhi(ga.y)) * a[3] + sigm(bfhi(gb.y)) * b[3];
        u32x2 w; w.x = pk2(y0, y1); w.y = pk2(y2, y3);
        *(u32x2*)(Y + (size_t)(TP + r) * D + c) = w;
    }
}
#define XB_TMO      128
#define XB_XCNT(j)  (256  + 64 * (j))
#define XB_XSUB(j)  (1280 + 64 * (j))
#define XB_XGEN(j)  (2304 + 64 * (j))
#define XB_TOP      3328
#define XB_TOPGEN   3392
#define XCD_BAR_WORDS 3456
#define XB_SPIN_CAP (1u << 18)

__device__ __forceinline__ unsigned xb_ld(unsigned* p)              { return __hip_atomic_load(p, __ATOMIC_RELAXED, __HIP_MEMORY_SCOPE_AGENT); }
__device__ __forceinline__ unsigned xb_add(unsigned* p, unsigned v) { return __hip_atomic_fetch_add(p, v, __ATOMIC_RELAXED, __HIP_MEMORY_SCOPE_AGENT); }
__device__ __forceinline__ unsigned xb_xcc_id() { return (unsigned)__builtin_amdgcn_s_getreg((3 << 11) | 20) & 0xFu; }
#define XB_SPIN(cond, bar) do { unsigned _sp = 0; while (cond) { __builtin_amdgcn_s_sleep(1); \
    if ((++_sp & 255u) == 0u) { if (xb_ld(&(bar)[XB_TMO])) break; if (_sp > XB_SPIN_CAP) { atomicAdd(&(bar)[XB_TMO], 1u); break; } } } } while (0)

struct XcdBarrier {
    unsigned* bar; unsigned x;
    volatile LAS unsigned* st;
};

__device__ __forceinline__ XcdBarrier xcd_barrier_post(unsigned* bar, volatile LAS unsigned* st) {
    XcdBarrier b; b.bar = bar; b.x = xb_xcc_id(); b.st = st;
    if (threadIdx.x == 0) (void)xb_add(&bar[XB_XCNT(b.x)], 1u);
    return b;
}
__device__ __forceinline__ void xcd_barrier_complete(unsigned* bar, unsigned x, unsigned& nloc, unsigned& nx) {
    const unsigned G = gridDim.x * gridDim.y * gridDim.z;
    unsigned sum, cnt, mine, sp = 0u;
    for (;;) {
        sum = 0u; cnt = 0u; mine = 0u;
#pragma unroll
        for (unsigned j = 0; j < 16; ++j) { const unsigned c = xb_ld(&bar[XB_XCNT(j)]); sum += c; cnt += (c > 0u) ? 1u : 0u; mine = (j == x) ? c : mine; }
        if (sum == G) break;
        __builtin_amdgcn_s_sleep(1);
        if ((++sp & 255u) == 0u) { if (xb_ld(&bar[XB_TMO])) break; if (sp > XB_SPIN_CAP) { atomicAdd(&bar[XB_TMO], 1u); break; } }
    }
    nloc = mine > 0u ? mine : 1u; nx = cnt > 0u ? cnt : 1u;
}

__device__ __forceinline__ void xcd_barrier(const XcdBarrier& b) {
    asm volatile("s_waitcnt vmcnt(0)" ::: "memory");
    __syncthreads();
    if (threadIdx.x == 0) {
        unsigned* bar = b.bar;
        __builtin_amdgcn_s_waitcnt(0);
        unsigned nloc = b.st[0], nx = b.st[1];
        if (nloc == 0u) { xcd_barrier_complete(bar, b.x, nloc, nx); b.st[0] = nloc; b.st[1] = nx; }
        const unsigned old = xb_add(&bar[XB_XSUB(b.x)], 1u);
        const unsigned gen = old / nloc;
        if (old + 1u == (gen + 1u) * nloc) {
            __builtin_amdgcn_fence(__ATOMIC_RELEASE, "agent");
            asm volatile("s_waitcnt vmcnt(0)" ::: "memory");
            const unsigned og = xb_add(&bar[XB_TOP], 1u);
            const unsigned tg = og / nx;
            if (og + 1u == (tg + 1u) * nx) xb_add(&bar[XB_TOPGEN], 1u);
            else XB_SPIN(xb_ld(&bar[XB_TOPGEN]) == tg, bar);
            __builtin_amdgcn_fence(__ATOMIC_ACQUIRE, "agent");
            xb_add(&bar[XB_XGEN(b.x)], 1u);
            asm volatile("s_waitcnt vmcnt(0)" ::: "memory");
        } else {
            XB_SPIN(xb_ld(&bar[XB_XGEN(b.x)]) == gen, bar);
            __builtin_amdgcn_fence(__ATOMIC_ACQUIRE, "agent");
            asm volatile("s_waitcnt vmcnt(0)" ::: "memory");
        }
    }
    __syncthreads();
}

template <class Epi> DI void run_gemm(LAS unsigned char* L, const bf16_t* A, const bf16_t* Bt, int N, int K, const Epi& E) {
    pg8::Gemm g{A, Bt, MP, N, K}; pg8::StaticOrder S; S.init(MP, N, K, (int)gridDim.x, (int)blockIdx.x);
    pg8::gemm_phase<Epi, pg8::StaticOrder, false>(L, g, S, E, nullptr);
}
template <class Epi> DI void run_gemm_split(LAS unsigned char* L, const bf16_t* A, const bf16_t* Bt, int N, int K, const Epi& E) {
    pg8::Gemm g{A, Bt, MP, N, K}; pg8::SplitOrder S; S.init(N, K, (int)gridDim.x, (int)blockIdx.x);
    pg8::gemm_phase<Epi, pg8::SplitOrder, false>(L, g, S, E, nullptr);
}

__global__ void __launch_bounds__(512, 2) mega(Params p) {
    extern __shared__ __attribute__((aligned(16))) unsigned char lds[];
    LAS unsigned char* L = (LAS unsigned char*)lds;
    cg::grid_group grid = cg::this_grid();
    unsigned char* ws = p.ws;
    const int lo = p.ph_lo, hi = p.ph_hi;
    const int tid = threadIdx.x, lane = tid & 63, wave = tid >> 6;
    bf16_t* Z = (bf16_t*)(ws + WS_Z);
    bf16_t* H = (bf16_t*)(ws + WS_H);
    float* MOD = (float*)(ws + WS_MOD);
#define IN(k) (lo <= (k) && (k) < hi)
    XcdBarrier xbar; xbar.bar = (unsigned*)ws; xbar.x = 0; xbar.st = (volatile LAS unsigned*)(L + 131072 + 4096);
    if (hi - lo > 1) {
        if (threadIdx.x < 2) xbar.st[threadIdx.x] = 0u;
        __syncthreads();
        xbar = xcd_barrier_post((unsigned*)ws, (volatile LAS unsigned*)(L + 131072 + 4096));
        grid.sync();
    }
#define SEAM(k) do { if (IN(k) && IN((k) + 1)) xcd_barrier(xbar); } while (0)
#define SOFT(k) do { if (IN(k) && IN((k) + 1)) __syncthreads(); } while (0)
    if (IN(0)) ph_prologue(p, L);
    SEAM(0);
    if (IN(1)) ph_hnorm(p, nullptr, false, p.in[11], 0, H);
    SEAM(1);
    if (IN(2)) { EpiZ E{Z, (const float*)(ws + WS_ROPE), p.out, p.in[2], p.in[3], p.in[4]}; run_gemm(L, H, (const bf16_t*)(ws + WS_WIN), NZ, D, E); }
    SEAM(2);
    if (IN(3)) {
        HgaRegs RA;
        int it = blockIdx.x;
        if (it < 2048) hg_passA_load(Z, it, RA);
        while (it < 2048) {
            const int itn = it + gridDim.x; HgaRegs RB;
            if (itn < 2048) hg_passA_load(Z, itn, RB);
            hg_passA_item(p, (float*)(ws + WS_HS), (float*)(ws + WS_HD), L, it, RA);
            RA = RB; it = itn;
        }
    }
    SOFT(3);
    if (IN(4)) {
        const int gw = blockIdx.x * 8 + wave, NGW = gridDim.x * 8;
        LAS bf16_t* Vl = (LAS bf16_t*)(L + wave * 8704);
        for (int base = 0; base < 6144; base += 3 * NGW)
            for (int j = 0; j < 3; ++j) { const int it = base + gw * 3 + j; if (it < 6144) attn_prompt_item(Z, (bf16_t*)(ws + WS_OG), (float*)(ws + WS_LSE), Vl, it, lane); }
    }
    SOFT(4);
    if (IN(5)) { const int gw = blockIdx.x * 8 + wave, NGW = gridDim.x * 8; for (int it = gw; it < 1536; it += NGW) attn_sample_item(p, Z, (bf16_t*)(ws + WS_OG), (float*)(ws + WS_LSE), it, lane); }
    SEAM(5);
    if (IN(6)) hg_scan(p, (float*)(ws + WS_HS), (const float*)(ws + WS_HD));
    SEAM(6);
    if (IN(7)) {
        HgcRegs RA;
        int it = blockIdx.x;
        if (it < 2048) hg_passC_load(Z, (const float*)(ws + WS_HS), it, RA);
        while (it < 2048) {
            const int itn = it + gridDim.x; HgcRegs RB;
            if (itn < 2048) hg_passC_load(Z, (const float*)(ws + WS_HS), itn, RB);
            hg_passC_item(p, Z, (bf16_t*)(ws + WS_OHG), L, it, RA);
            RA = RB; it = itn;
        }
    }
    SOFT(7);
    if (IN(8)) for (int it = blockIdx.x; it < 256; it += gridDim.x) hg_sample_item(p, Z, (bf16_t*)(ws + WS_OHG), L, it);
    SOFT(8);
    if (IN(9)) ph_merge((const bf16_t*)(ws + WS_OG), (const float*)(ws + WS_LSE), (bf16_t*)(ws + WS_OATT));
    SEAM(9);
    if (IN(10)) {
        { EpiMix1 E{Z, (float*)(ws + WS_TMP), (float*)(ws + WS_ACC_PA)}; run_gemm_split(L, (const bf16_t*)(ws + WS_OATT), (const bf16_t*)(ws + WS_WPA), D, 512, E); }
        { EpiMix2 E{Z, (const float*)(ws + WS_TMP), (bf16_t*)(ws + WS_YMIX), (float*)(ws + WS_ACC_PB)}; run_gemm_split(L, (const bf16_t*)(ws + WS_OHG), (const bf16_t*)(ws + WS_WPB), D, 1024, E); }
    }
    SEAM(10);
    if (IN(11)) ph_mixfix(p);
    SEAM(11);
    if (IN(12)) { EpiWO E{p.in[0], p.in[1], MOD, p.out, (float*)(ws + WS_ACC_WO)}; run_gemm_split(L, (const bf16_t*)(ws + WS_YMIX), (const bf16_t*)(ws + WS_WO), D, D, E); }
    SEAM(12);
    if (IN(13)) ph_hnorm(p, p.out, true, p.in[18], 3, H);
    SEAM(13);
    if (IN(14)) { EpiUp E{(bf16_t*)(ws + WS_AB), (bf16_t*)(ws + WS_G), p.out, (float*)(ws + WS_ACC_UP), p.in[21], p.in[22], (LAS float*)(L + 131072)}; run_gemm_split(L, H, (const bf16_t*)(ws + WS_WAB), NAB, D, E); }
    SEAM(14);
    if (IN(15)) ph_convact(p, (const bf16_t*)(ws + WS_AB), (bf16_t*)(ws + WS_G));
    SEAM(15);
    if (IN(16)) { EpiDown E{MOD, p.out, (float*)(ws + WS_ACC_DN)}; run_gemm_split(L, (const bf16_t*)(ws + WS_G), (const bf16_t*)(ws + WS_WDN), D, DFF, E); }
    SEAM(16);
    if (IN(17)) ph_final_norm(p);
#undef IN
#undef SEAM
#undef SOFT
}

#ifndef MK_MULTI
#define MK_MULTI 0
#endif
extern "C" void kernel_launch(void* const* d_in, const int* in_sizes, int n_in, void* d_out, int out_size, void* d_ws, size_t ws_size, hipStream_t stream) {
    static int grid = 0;
    if (grid == 0) {
        if (n_in != 25 || (size_t)out_size != OUT_TOTAL || ws_size < WS_END) { fprintf(stderr, "kernel_launch: unexpected shapes: n_in %d out %d ws %zu (need %zu)\n", n_in, out_size, ws_size, (size_t)WS_END); grid = -1; return; }
        int dev = 0, cus = 0, per_cu = 0;
        hipGetDevice(&dev);
        hipDeviceGetAttribute(&cus, hipDeviceAttributeMultiprocessorCount, dev);
        if (hipFuncSetAttribute((const void*)mega, hipFuncAttributeMaxDynamicSharedMemorySize, LDS_BYTES) != hipSuccess) { fprintf(stderr, "kernel_launch: hipFuncSetAttribute failed\n"); grid = -1; return; }
        if (hipOccupancyMaxActiveBlocksPerMultiprocessor(&per_cu, (const void*)mega, 512, LDS_BYTES) != hipSuccess || per_cu < 1) { fprintf(stderr, "kernel_launch: occupancy query failed (%d)\n", per_cu); (void)hipGetLastError(); per_cu = 1; }
        grid = cus * 1;
        if (grid < 1) grid = -1;
    }
    if (grid < 0) return;
    Params p{};
    for (int i = 0; i < 25; ++i) p.in[i] = (const float*)d_in[i];
    p.out = (float*)d_out; p.ws = (unsigned char*)d_ws;
#ifndef DUP_MASK
#define DUP_MASK 0
#endif
#if MK_MULTI
    for (int ph = 0; ph < NPH; ++ph) for (int rep = 0; rep < (((DUP_MASK >> ph) & 1) ? 2 : 1); ++rep) { p.ph_lo = ph; p.ph_hi = ph + 1; hipLaunchKernelGGL(mega, dim3(grid), dim3(512), LDS_BYTES, stream, p); }
#else
    p.ph_lo = 0; p.ph_hi = NPH;
    if (hipMemsetAsync(d_ws, 0, 16384, stream) != hipSuccess) { fprintf(stderr, "kernel_launch: memset of the barrier words failed\n"); return; }
    void* args[] = {&p};
    hipError_t e = hipLaunchCooperativeKernel((const void*)mega, dim3(grid), dim3(512), args, LDS_BYTES, stream);
    if (e != hipSuccess) fprintf(stderr, "cooperative launch failed: %s (grid %d)\n", hipGetErrorString(e), grid);
#endif
}
```

```cpp
#include <hip/hip_runtime.h>
#include <hip/hip_cooperative_groups.h>
#include <cstdio>
namespace cg = cooperative_groups;
namespace pg8 {
#define PG8_LAS __attribute__((address_space(3)))
typedef unsigned short bf16_t;
typedef short bf16x8 __attribute__((ext_vector_type(8)));
typedef float f32x4 __attribute__((ext_vector_type(4)));
typedef unsigned u32x4 __attribute__((ext_vector_type(4)));
constexpr int BM = 256, BK = 64, HALF = 128, HTB = HALF * BK * 2  , STAGE_BYTES = 8 * HTB, NXCD = 8, WGM = 8;

__host__ __device__ __forceinline__ int lds_byte(int r, int c) { const int st = (r >> 4) * 2 + (c >> 5), rr = r & 15, cc = c & 31, ob = rr * 64 + cc * 2; return st * 1024 + (ob ^ (((ob >> 9) & 1) << 5)); }
__host__ __device__ __forceinline__ void stage_rc(int b, int& R, int& C) { const int st = b / 1024, sb = b % 1024, swz = sb ^ (((sb >> 9) & 1) << 5); R = (st >> 1) * 16 + swz / 64; C = (st & 1) * 32 + (swz % 64) / 2; }
__host__ __device__ __forceinline__ int perm32(int rho) { const int n = rho >> 4, i = rho & 15; return 8 * (i >> 2) + 4 * n + (i & 3); }

struct Unit { int pm, pn, kt0, nkt; };
struct Gemm { const bf16_t* A; const bf16_t* Bt; int M, N, K; };

struct StaticOrder {
    int nM, nN, nwg, G, c, nkt;
    __host__ __device__ void init(int M, int N, int K, int G_, int c_) { nM = M / BM; nN = N / BM; nwg = nM * nN; G = G_; c = c_; nkt = K / BK; }
    __host__ __device__ bool next(int i, Unit& u) const {
        const long L = (long)i * G + c; if (L >= nwg) return false;
        int wgid = (int)L; { const int q = nwg / NXCD, r = nwg % NXCD, xcd = wgid % NXCD, off = wgid / NXCD; wgid = (xcd < r ? xcd * (q + 1) : r * (q + 1) + (xcd - r) * q) + off; }
        const int nig = WGM * nN, gid = wgid / nig, fm = gid * WGM, gsz = (nM - fm) < WGM ? (nM - fm) : WGM;
        u.pm = fm + ((wgid % nig) % gsz); u.pn = (wgid % nig) / gsz; u.kt0 = 0; u.nkt = nkt; return true;
    }
    __device__ __forceinline__ void a_ready(const Unit&) const {}
    __device__ __forceinline__ void done(const Unit&) const {}
};
struct SplitOrder {
    int nN, nwg, G, c, nkt, nsp;
    __host__ __device__ void init(int N, int K, int G_, int c_) { nN = N / BM; nwg = 64 * nN; G = G_; c = c_; nkt = K / BK; nsp = nkt / 4; }
    __host__ __device__ bool next(int i, Unit& u) const {
        const long L = (long)i * G + c;
        if (L < nwg) {
            int wgid = (int)L; { const int q = nwg / NXCD, r = nwg % NXCD, xcd = wgid % NXCD, off = wgid / NXCD; wgid = (xcd < r ? xcd * (q + 1) : r * (q + 1) + (xcd - r) * q) + off; }
            const int nig = WGM * nN, gid = wgid / nig, fm = gid * WGM, gsz = (64 - fm) < WGM ? (64 - fm) : WGM;
            u.pm = fm + ((wgid % nig) % gsz); u.pn = (wgid % nig) / gsz; u.kt0 = 0; u.nkt = nkt; return true;
        }
        const long j = L - nwg; if (j >= (long)nN * nsp) return false;
        u.pm = 64; u.pn = (int)(j % nN); u.kt0 = 4 * (int)(j / nN); u.nkt = 4; return true;
    }
    __device__ __forceinline__ void a_ready(const Unit&) const {}
    __device__ __forceinline__ void done(const Unit&) const {}
};
template <class Epi, class Sched, bool STAMP = false>
__device__ __forceinline__ void gemm_phase(PG8_LAS unsigned char* lds, const Gemm g, const Sched& S, const Epi& E, unsigned long long* stamps) {
    const int tid = threadIdx.x, wid = __builtin_amdgcn_readfirstlane(tid >> 6), lane = tid & 63, wr = wid >> 2, wc = wid & 3, fr = lane & 15, fq = lane >> 4;
    const int K = g.K;
    int ts_lo = 0, ts_hi = 0, nts = 0; const unsigned long long rt_entry = STAMP ? (unsigned long long)wall_clock64() : 0ull;
#define PG8_STAMP() do { if (STAMP && wid == 0 && nts < 64) { const unsigned long long _c = (unsigned long long)clock64(); \
        ts_lo = (lane == nts) ? (int)(unsigned)_c : ts_lo; ts_hi = (lane == nts) ? (int)(unsigned)(_c >> 32) : ts_hi; ++nts; } } while (0)
    PG8_STAMP();
    unsigned voffA[2], voffB[2];
#pragma unroll
    for (int i = 0; i < 2; ++i) { int R, C; stage_rc(tid * 16 + i * 8192, R, C); const int Rb = Epi::PERM ? ((R & ~31) + perm32(R & 31)) : R;
        voffA[i] = (unsigned)(R * K + C) * 2u; voffB[i] = (unsigned)(Rb * K + C) * 2u; }
    const size_t kstep = (size_t)(BK * 2);
    const size_t hstep = (size_t)HALF * K * 2;
    const size_t tstep = 2 * hstep;
    const unsigned ldsw = (unsigned)wid * 1024u;
    const int aoff = lds_byte(wr * 64 + fr, fq * 8), boff = lds_byte(wc * 32 + fr, fq * 8);
#define PG8_SA(b, h) (((b) * 2 + (h)) * HTB)
#define PG8_SB(b, h) ((4 + (b) * 2 + (h)) * HTB)
#define PG8_STAGE(bufoff, gbase, voff) do { _Pragma("unroll") for (int _i = 0; _i < 2; ++_i) \
        __builtin_amdgcn_global_load_lds((const unsigned*)((const char*)(gbase) + (voff)[_i]), (PG8_LAS unsigned*)(lds + (bufoff) + ldsw + _i * 8192), 16, 0, 0); } while (0)
#define PG8_LDA(dst, b, h) do { _Pragma("unroll") for (int m = 0; m < 4; ++m) _Pragma("unroll") for (int k = 0; k < 2; ++k) dst[m][k] = *(const PG8_LAS bf16x8*)(lds + PG8_SA(b, h) + aoff + m * 2048 + k * 1024); } while (0)
#define PG8_LDB(dst, b, h) do { _Pragma("unroll") for (int n = 0; n < 2; ++n) _Pragma("unroll") for (int k = 0; k < 2; ++k) dst[n][k] = *(const PG8_LAS bf16x8*)(lds + PG8_SB(b, h) + boff + n * 2048 + k * 1024); } while (0)
#define PG8_MMA(ai, bj, At, Bt) do { __builtin_amdgcn_s_setprio(1); _Pragma("unroll") for (int m = 0; m < 4; ++m) _Pragma("unroll") for (int n = 0; n < 2; ++n) _Pragma("unroll") for (int k = 0; k < 2; ++k) \
        acc[ai][bj][m][n] = __builtin_amdgcn_mfma_f32_16x16x32_bf16(Bt[n][k], At[m][k], acc[ai][bj][m][n], 0, 0, 0); __builtin_amdgcn_s_setprio(0); } while (0)
#define PG8_WAIT_V(n) asm volatile("s_waitcnt vmcnt(" #n ")" ::: "memory")
#define PG8_WAIT_L(n) asm volatile("s_waitcnt lgkmcnt(" #n ")" ::: "memory")
#define PG8_BAR __builtin_amdgcn_s_barrier()
#define PG8_SCHED __builtin_amdgcn_sched_barrier(0)
    Unit cur, nxt; int ui = 0;
    if (!S.next(0, cur)) return;
    f32x4 acc[2][2][4][2];
#pragma unroll
    for (int a = 0; a < 2; ++a)
#pragma unroll
        for (int b = 0; b < 2; ++b)
#pragma unroll
            for (int m = 0; m < 4; ++m)
#pragma unroll
                for (int n = 0; n < 2; ++n) acc[a][b][m][n] = (f32x4){0.f, 0.f, 0.f, 0.f};
    bf16x8 At[4][2], B0[2][2], B1[2][2];
    const char* cA = (const char*)g.A + (size_t)cur.pm * tstep + (size_t)cur.kt0 * kstep; const char* cB = (const char*)g.Bt + (size_t)cur.pn * tstep + (size_t)cur.kt0 * kstep;
    S.a_ready(cur);
    PG8_STAGE(PG8_SB(0, 0), cB, voffB); PG8_STAGE(PG8_SA(0, 0), cA, voffA); PG8_STAGE(PG8_SB(0, 1), cB + hstep, voffB); PG8_STAGE(PG8_SA(0, 1), cA + hstep, voffA);
    if (wr == 1) PG8_BAR;
    PG8_WAIT_V(4); PG8_BAR;
    PG8_STAGE(PG8_SB(1, 0), cB + kstep, voffB); PG8_STAGE(PG8_SA(1, 0), cA + kstep, voffA); PG8_STAGE(PG8_SB(1, 1), cB + hstep + kstep, voffB);
    PG8_WAIT_V(6); PG8_BAR;
    PG8_STAMP();
    for (;;) {
        const bool has_next = S.next(ui + 1, nxt);
        const char* nA = has_next ? (const char*)g.A + (size_t)nxt.pm * tstep + (size_t)nxt.kt0 * kstep : cA; const char* nB = has_next ? (const char*)g.Bt + (size_t)nxt.pn * tstep + (size_t)nxt.kt0 * kstep : cB;
        const int nt = cur.nkt;
        for (int t = 0; t < nt; t += 2) {
            const bool last = (t == nt - 2);
            const char* a1 = cA + (size_t)(t + 1) * kstep;
            const char* a2 = last ? nA : cA + (size_t)(t + 2) * kstep; const char* b2 = last ? nB : cB + (size_t)(t + 2) * kstep;
            const char* a3 = a2 + kstep; const char* b3 = b2 + kstep;
            if (last && has_next) S.a_ready(nxt);
            PG8_LDB(B0, 0, 0); PG8_SCHED; PG8_LDA(At, 0, 0); PG8_STAGE(PG8_SA(1, 1), a1 + hstep, voffA);
            PG8_WAIT_L(8); PG8_BAR; PG8_WAIT_L(0); PG8_MMA(0, 0, At, B0); PG8_BAR; PG8_SCHED;
            PG8_LDB(B1, 0, 1); PG8_STAGE(PG8_SB(0, 0), b2, voffB);
            PG8_BAR; PG8_WAIT_L(0); PG8_MMA(0, 1, At, B1); PG8_BAR;
            PG8_LDA(At, 0, 1); PG8_STAGE(PG8_SA(0, 0), a2, voffA);
            PG8_BAR; PG8_WAIT_L(0); PG8_MMA(1, 0, At, B0); PG8_BAR; PG8_SCHED;
            PG8_STAGE(PG8_SB(0, 1), b2 + hstep, voffB);
            PG8_WAIT_V(6); PG8_BAR; PG8_MMA(1, 1, At, B1); PG8_BAR;
            PG8_LDB(B0, 1, 0); PG8_SCHED; PG8_LDA(At, 1, 0); PG8_STAGE(PG8_SA(0, 1), a2 + hstep, voffA);
            PG8_WAIT_L(8); PG8_BAR; PG8_WAIT_L(0); PG8_MMA(0, 0, At, B0); PG8_BAR; PG8_SCHED;
            PG8_LDB(B1, 1, 1); PG8_STAGE(PG8_SB(1, 0), b3, voffB);
            PG8_BAR; PG8_WAIT_L(0); PG8_MMA(0, 1, At, B1); PG8_BAR;
            PG8_LDA(At, 1, 1); PG8_STAGE(PG8_SA(1, 0), a3, voffA);
            PG8_BAR; PG8_WAIT_L(0); PG8_MMA(1, 0, At, B0); PG8_BAR; PG8_SCHED;
            PG8_STAGE(PG8_SB(1, 1), b3 + hstep, voffB);
            PG8_WAIT_V(6); PG8_BAR; PG8_MMA(1, 1, At, B1); PG8_BAR;
        }
        PG8_STAMP();
        if constexpr (!Epi::AFTER_DRAIN) { E(acc, cur, wr, wc, fr, fq); S.done(cur); }
        PG8_STAMP();
        if (!has_next) break;
#pragma unroll
        for (int a = 0; a < 2; ++a)
#pragma unroll
            for (int b = 0; b < 2; ++b)
#pragma unroll
                for (int m = 0; m < 4; ++m)
#pragma unroll
                    for (int n = 0; n < 2; ++n) acc[a][b][m][n] = (f32x4){0.f, 0.f, 0.f, 0.f};
        cur = nxt; cA = nA; cB = nB; ++ui;
    }
    PG8_WAIT_V(0);
    if (wr == 0) PG8_BAR;
    PG8_BAR;
    if constexpr (Epi::AFTER_DRAIN) { E.fused(acc, cur, wr, wc, fr, fq, lds, wid, lane); S.done(cur); }
    PG8_STAMP();
    if (STAMP && wid == 0) { stamps[lane] = lane < nts ? (((unsigned long long)(unsigned)ts_hi << 32) | (unsigned)ts_lo) : 0ull;
        if (lane == 62) stamps[62] = rt_entry; if (lane == 63) stamps[63] = (unsigned long long)wall_clock64(); }
#undef PG8_STAMP
#undef PG8_SA
#undef PG8_SB
#undef PG8_STAGE
#undef PG8_LDA
#undef PG8_LDB
#undef PG8_MMA
#undef PG8_WAIT_V
#undef PG8_WAIT_L
#undef PG8_BAR
#undef PG8_SCHED
}
}

using pg8::bf16_t; using pg8::bf16x8; using pg8::f32x4; using pg8::Unit;
#define LAS __attribute__((address_space(3)))
#define DI __device__ __forceinline__
typedef float f32x16 __attribute__((ext_vector_type(16)));
typedef float f32x2 __attribute__((ext_vector_type(2)));
typedef unsigned u32x4 __attribute__((ext_vector_type(4)));
typedef unsigned u32x2 __attribute__((ext_vector_type(2)));

constexpr int D = 2048, TP = 16384, NS = 128, MR = TP + NS, MP = 16640;
constexpr int NZ = 12800, DFF = 5632, NAB = 2 * DFF;
constexpr int ZQ = 0, ZK = 1536, ZV = 3072, ZQH = 4608, ZFH = 5632, ZIH = 6656, ZGH = 7680, ZGA = 8704, ZGB = 10752;
constexpr int NMODROW = 33, NMOD = 6 * D;
constexpr float EPS = 1e-6f;
constexpr float ATT_SCALE = 0.08838834764831845f;
constexpr size_t OFF_Y = 0;
constexpr size_t OFF_KVP0 = (size_t)MR * D;
constexpr size_t OFF_KVP1 = OFF_KVP0 + 128 * 1024;
constexpr size_t OFF_KVP2 = OFF_KVP1 + 512 * 1024;
constexpr size_t OFF_HGP = OFF_KVP2 + 2048 * 1024;
constexpr size_t OFF_CVP = OFF_HGP + 8 * 128 * 128;
constexpr size_t OFF_KVS0 = OFF_CVP + 2 * DFF;
constexpr size_t OFF_KVS1 = OFF_KVS0 + (size_t)32 * 128 * 1024;
constexpr size_t OFF_KVS2 = OFF_KVS1 + (size_t)32 * 512 * 1024;
constexpr size_t OFF_HGS = OFF_KVS2 + (size_t)32 * 2048 * 1024;
constexpr size_t OFF_CVS = OFF_HGS + (size_t)32 * 8 * 128 * 128;
constexpr size_t OUT_TOTAL = OFF_CVS + (size_t)32 * 2 * DFF;
static_assert(OUT_TOTAL == 129346560, "output size");
constexpr size_t WS_WIN = 1u << 20;
constexpr size_t WS_WPA = WS_WIN + (size_t)NZ * D * 2;
constexpr size_t WS_WPB = WS_WPA + (size_t)2048 * 512 * 2;
constexpr size_t WS_WO = WS_WPB + (size_t)2048 * 1024 * 2;
constexpr size_t WS_WAB = WS_WO + (size_t)2048 * 2048 * 2;
constexpr size_t WS_WDN = WS_WAB + (size_t)NAB * D * 2;
constexpr size_t WS_MOD = WS_WDN + (size_t)D * DFF * 2;
constexpr size_t WS_ROPE = WS_MOD + (size_t)NMODROW * NMOD * 4;
constexpr size_t WS_Z = WS_ROPE + (size_t)MP * 32 * 4;
constexpr size_t WS_AB = WS_Z;
constexpr size_t WS_H = WS_Z + (size_t)MP * NZ * 2;
constexpr size_t WS_OG = WS_H + (size_t)MP * D * 2;
constexpr size_t WS_LSE = WS_OG + (size_t)3 * MP * 512 * 2;
constexpr size_t WS_OATT = WS_LSE + (size_t)3 * MP * 4 * 4;
constexpr size_t WS_OHG = WS_OATT + (size_t)MP * 512 * 2;
constexpr size_t WS_YMIX = WS_OHG + (size_t)MP * 1024 * 2;
constexpr size_t WS_BLK_END = WS_YMIX + (size_t)MP * D * 2;
constexpr size_t WS_G = WS_OG;
static_assert(WS_G + (size_t)MP * DFF * 2 <= WS_BLK_END + (32u << 20), "g overlay");
static_assert((size_t)MP * NAB * 2 <= (size_t)MP * NZ * 2, "ab overlay");
constexpr size_t WS_HS = WS_BLK_END;
constexpr size_t WS_HD = WS_HS + (size_t)256 * 8 * 128 * 128 * 4;
constexpr size_t WS_TMP = WS_HS;
constexpr size_t WS_ACC_WO = WS_Z;
constexpr size_t WS_ACC_DN = WS_Z;
constexpr size_t WS_ACC_UP = WS_TMP + (64u << 20);
constexpr int NSP_WO = 8, NSP_DN = 22, NSP_UP = 8, NSP_PA = 2, NSP_PB = 4;
constexpr size_t WS_ACC_PA = WS_H, WS_ACC_PB = WS_H + (size_t)NSP_PA * NS * D * 4;
static_assert((size_t)NSP_UP * NS * NAB * 4 + (64u << 20) <= (size_t)MP * D * 4, "up partials");
constexpr size_t WS_END = WS_TMP + (size_t)MP * D * 4 + (1u << 20);
static_assert(WS_HD + (size_t)256 * 8 * 128 * 4 <= WS_END, "hd");
static_assert(WS_WIN % 256 == 0 && WS_MOD % 256 == 0 && WS_ROPE % 256 == 0 && WS_Z % 256 == 0 && WS_H % 256 == 0 && WS_OG % 256 == 0 && WS_LSE % 256 == 0 && WS_OATT % 256 == 0 && WS_OHG % 256 == 0 && WS_YMIX % 256 == 0 && WS_HS % 256 == 0 && WS_HD % 256 == 0, "align");
constexpr int LDS_BYTES = 131072 + 4096 + 256;
constexpr int NPH = 18;

struct Params { const float* in[25]; float* out; unsigned char* ws; int ph_lo, ph_hi; };

DI float bf2f(unsigned b) { return __uint_as_float(b << 16); }
DI float bflo(unsigned w) { return __uint_as_float(w << 16); }
DI float bfhi(unsigned w) { return __uint_as_float(w & 0xffff0000u); }
DI unsigned pk2(float lo, float hi) { unsigned r; asm("v_cvt_pk_bf16_f32 %0, %1, %2" : "=v"(r) : "v"(lo), "v"(hi)); return r; }
DI float sigm(float x) { return __builtin_amdgcn_rcpf(1.f + __expf(-x)); }
DI float silu(float x) { return x * __builtin_amdgcn_rcpf(1.f + __expf(-x)); }
DI float wave_sum(float v) {
#pragma unroll
    for (int o = 32; o >= 1; o >>= 1) v += __shfl_xor(v, o);
    return v;
}
DI float wave_max(float v) {
#pragma unroll
    for (int o = 32; o >= 1; o >>= 1) v = fmaxf(v, __shfl_xor(v, o));
    return v;
}
DI void lds_fence() { asm volatile("s_waitcnt lgkmcnt(0)" ::: "memory"); __builtin_amdgcn_wave_barrier(); }
DI bf16x8 gat8(const LAS bf16_t* p, int stride) {
    bf16x8 r;
#pragma unroll
    for (int j = 0; j < 8; ++j) r[j] = (short)p[j * stride];
    return r;
}
DI bf16x8 ld8(const LAS bf16_t* p) { return *(const LAS bf16x8*)p; }
typedef short s16x4 __attribute__((ext_vector_type(4)));
template <int OFF> DI s16x4 tr_read(unsigned vb) { s16x4 r; asm volatile("ds_read_b64_tr_b16 %0, %1 offset:%2" : "=&v"(r) : "v"(vb), "i"(OFF) : "memory"); return r; }
DI f32x4 mfma16(bf16x8 a, bf16x8 b, f32x4 c) { return __builtin_amdgcn_mfma_f32_16x16x32_bf16(a, b, c, 0, 0, 0); }
DI f32x16 mfma32(bf16x8 a, bf16x8 b, f32x16 c) { return __builtin_amdgcn_mfma_f32_32x32x16_bf16(a, b, c, 0, 0, 0); }
DI void unpack8(u32x4 w, float (&f)[8]) { f[0] = bflo(w.x); f[1] = bfhi(w.x); f[2] = bflo(w.y); f[3] = bfhi(w.y); f[4] = bflo(w.z); f[5] = bfhi(w.z); f[6] = bflo(w.w); f[7] = bfhi(w.w); }
DI void atom_add(float* p, float v) { (void)__hip_atomic_fetch_add(p, v, __ATOMIC_RELAXED, __HIP_MEMORY_SCOPE_AGENT); }
DI void ld8f(const float* s, float (&f)[8]) { const f32x4 a = *(const f32x4*)s, b = *(const f32x4*)(s + 4); f[0] = a[0]; f[1] = a[1]; f[2] = a[2]; f[3] = a[3]; f[4] = b[0]; f[5] = b[1]; f[6] = b[2]; f[7] = b[3]; }
DI int crow_of(int r) { return r < TP ? 0 : 1 + ((r - TP) >> 2); }

struct EpiZ {
    static constexpr bool PERM = true, AFTER_DRAIN = false;
    bf16_t* Z; const float* rope; float* out; const float* c0; const float* c1; const float* c2;
    static constexpr int CPY_R0 = 32 * 124, CPY_R1 = 32 * 508, CPY_R2 = 32 * 2044, CPY_ROWS = CPY_R0 + CPY_R1 + CPY_R2, CPY_PER = 28;
    DI void cpy_row(int r, const float*& src, float*& dst) const {
        if (r < CPY_R0) { const int b = r / 124, rr = r - b * 124; src = c0 + ((size_t)(b * 128 + rr + 4)) * 1024; dst = out + OFF_KVS0 + ((size_t)(b * 128 + rr)) * 1024; }
        else if (r < CPY_R0 + CPY_R1) { r -= CPY_R0; const int b = r / 508, rr = r - b * 508; src = c1 + ((size_t)(b * 512 + rr + 4)) * 1024; dst = out + OFF_KVS1 + ((size_t)(b * 512 + rr)) * 1024; }
        else { r -= CPY_R0 + CPY_R1; const int b = r / 2044, rr = r - b * 2044; src = c2 + ((size_t)(b * 2048 + rr + 4)) * 1024; dst = out + OFF_KVS2 + ((size_t)(b * 2048 + rr)) * 1024; }
    }
    DI void operator()(const f32x4 (&acc)[2][2][4][2], const Unit& u, int wr, int wc, int fr, int fq) const {
        {
            int l4 = (wc * 64 + fq * 16 + fr) * 4; asm volatile("" : "+v"(l4));
            const int r0 = (u.pm * 50 + u.pn) * CPY_PER;
#pragma unroll
            for (int h2 = 0; h2 < 2; ++h2) {
                f32x4 v[7];
#pragma unroll
                for (int q = 0; q < 7; ++q) { int r = r0 + (h2 * 7 + q) * 2 + wr; r = r < CPY_ROWS ? r : r - CPY_ROWS; const float* sp; float* dp; cpy_row(r, sp, dp); v[q] = __builtin_nontemporal_load((const f32x4*)(sp + l4)); }
#pragma unroll
                for (int q = 0; q < 7; ++q) { int r = r0 + (h2 * 7 + q) * 2 + wr; r = r < CPY_ROWS ? r : r - CPY_ROWS; const float* sp; float* dp; cpy_row(r, sp, dp); __builtin_nontemporal_store(v[q], (f32x4*)(dp + l4)); }
            }
        }
        const int kind = u.pn < 6 ? 0 : (u.pn < 12 ? 1 : (u.pn < 18 ? 2 : 3));
        const bool do_rope = (kind <= 1) && (wc == 0);
        const int pnn = (kind == 1) ? u.pn - 6 : u.pn - 12;
        const int g = pnn >> 1, W = 128 << (2 * g);
        const size_t offp = g == 0 ? OFF_KVP0 : (g == 1 ? OFF_KVP1 : OFF_KVP2), offs = g == 0 ? OFF_KVS0 : (g == 1 ? OFF_KVS1 : OFF_KVS2);
        const float sg = (fq < 2) ? -1.f : 1.f;
#pragma unroll
        for (int ai = 0; ai < 2; ++ai)
#pragma unroll
            for (int m = 0; m < 4; ++m) {
                const int r = u.pm * 256 + ai * 128 + wr * 64 + m * 16 + fr;
                f32x4 cs0 = {0.f, 0.f, 0.f, 0.f}, cs1 = cs0, sn0 = cs0, sn1 = cs0;
                if (do_rope) { const float* rp = rope + (size_t)r * 32 + 8 * (fq & 1); cs0 = *(const f32x4*)rp; cs1 = *(const f32x4*)(rp + 4); sn0 = *(const f32x4*)(rp + 16); sn1 = *(const f32x4*)(rp + 20); }
#pragma unroll
                for (int bj = 0; bj < 2; ++bj) {
                    f32x4 v0 = acc[ai][bj][m][0], v1 = acc[ai][bj][m][1];
                    if (do_rope) {
                        f32x4 p0, p1;
#pragma unroll
                        for (int j = 0; j < 4; ++j) { p0[j] = __shfl_xor(v0[j], 32); p1[j] = __shfl_xor(v1[j], 32); }
                        v0 = v0 * cs0 + sg * (p0 * sn0); v1 = v1 * cs1 + sg * (p1 * sn1);
                    }
                    const int c = u.pn * 256 + bj * 128 + wc * 32 + 8 * fq;
                    u32x4 w; w.x = pk2(v0[0], v0[1]); w.y = pk2(v0[2], v0[3]); w.z = pk2(v1[0], v1[1]); w.w = pk2(v1[2], v1[3]);
                    *(u32x4*)(Z + (size_t)r * NZ + c) = w;
                    if (kind == 1 || kind == 2) {
                        const int hh = 2 * (pnn & 1) + bj, dd = wc * 32 + 8 * fq, kv = kind - 1;
                        if (u.pm < 64) {
                            if (256 * u.pm + 128 * ai >= TP - W) { float* dst = out + offp + ((size_t)(r - (TP - W)) * 2 + kv) * 512 + hh * 128 + dd; *(f32x4*)dst = v0; *(f32x4*)(dst + 4) = v1; }
                        } else if (ai == 0) {
                            const int b = (r - TP) >> 2, t = (r - TP) & 3; float* dst = out + offs + ((size_t)(b * W + W - 4 + t) * 2 + kv) * 512 + hh * 128 + dd; *(f32x4*)dst = v0; *(f32x4*)(dst + 4) = v1;
                        }
                    }
                }
            }
    }
};
struct EpiMix1 {
    static constexpr bool PERM = false, AFTER_DRAIN = false;
    const bf16_t* Z; float* TMP; float* accs;
    DI void operator()(const f32x4 (&acc)[2][2][4][2], const Unit& u, int wr, int wc, int fr, int fq) const {
        if (u.pm == 64) {
#pragma unroll
            for (int m = 0; m < 4; ++m)
#pragma unroll
                for (int bj = 0; bj < 2; ++bj)
#pragma unroll
                    for (int n = 0; n < 2; ++n) *(f32x4*)(accs + ((size_t)(u.kt0 >> 2) * NS + (wr * 64 + m * 16 + fr)) * D + u.pn * 256 + bj * 128 + wc * 32 + 16 * n + 4 * fq) = acc[0][bj][m][n];
            return;
        }
#pragma unroll
        for (int ai = 0; ai < 2; ++ai)
#pragma unroll
            for (int m = 0; m < 4; ++m) {
                const int r = u.pm * 256 + ai * 128 + wr * 64 + m * 16 + fr;
#pragma unroll
                for (int bj = 0; bj < 2; ++bj)
#pragma unroll
                    for (int n = 0; n < 2; ++n) {
                        const int c = u.pn * 256 + bj * 128 + wc * 32 + 16 * n + 4 * fq;
                        const u32x2 gw = *(const u32x2*)(Z + (size_t)r * NZ + ZGA + c);
                        f32x4 v = acc[ai][bj][m][n];
                        v[0] *= sigm(bflo(gw.x)); v[1] *= sigm(bfhi(gw.x)); v[2] *= sigm(bflo(gw.y)); v[3] *= sigm(bfhi(gw.y));
                        *(f32x4*)(TMP + (size_t)r * D + c) = v;
                    }
            }
    }
};
struct EpiMix2 {
    static constexpr bool PERM = false, AFTER_DRAIN = false;
    const bf16_t* Z; const float* TMP; bf16_t* Y; float* accs;
    DI void operator()(const f32x4 (&acc)[2][2][4][2], const Unit& u, int wr, int wc, int fr, int fq) const {
        if (u.pm == 64) {
#pragma unroll
            for (int m = 0; m < 4; ++m)
#pragma unroll
                for (int bj = 0; bj < 2; ++bj)
#pragma unroll
                    for (int n = 0; n < 2; ++n) *(f32x4*)(accs + ((size_t)(u.kt0 >> 2) * NS + (wr * 64 + m * 16 + fr)) * D + u.pn * 256 + bj * 128 + wc * 32 + 16 * n + 4 * fq) = acc[0][bj][m][n];
            return;
        }
#pragma unroll
        for (int ai = 0; ai < 2; ++ai)
#pragma unroll
            for (int m = 0; m < 4; ++m) {
                const int r = u.pm * 256 + ai * 128 + wr * 64 + m * 16 + fr;
#pragma unroll
                for (int bj = 0; bj < 2; ++bj)
#pragma unroll
                    for (int n = 0; n < 2; ++n) {
                        const int c = u.pn * 256 + bj * 128 + wc * 32 + 16 * n + 4 * fq;
                        const u32x2 gw = *(const u32x2*)(Z + (size_t)r * NZ + ZGB + c);
                        const f32x4 t = *(const f32x4*)(TMP + (size_t)r * D + c);
                        f32x4 v = acc[ai][bj][m][n];
                        v[0] = t[0] + v[0] * sigm(bflo(gw.x)); v[1] = t[1] + v[1] * sigm(bfhi(gw.x)); v[2] = t[2] + v[2] * sigm(bflo(gw.y)); v[3] = t[3] + v[3] * sigm(bfhi(gw.y));
                        u32x2 w; w.x = pk2(v[0], v[1]); w.y = pk2(v[2], v[3]);
                        *(u32x2*)(Y + (size_t)r * D + c) = w;
                    }
            }
    }
};
struct EpiWO {
    static constexpr bool PERM = false, AFTER_DRAIN = false;
    const float* xp; const float* xs; const float* mod; float* out; float* accs;
    DI void operator()(const f32x4 (&acc)[2][2][4][2], const Unit& u, int wr, int wc, int fr, int fq) const {
        if (u.pm == 64) {
#pragma unroll
            for (int m = 0; m < 4; ++m)
#pragma unroll
                for (int bj = 0; bj < 2; ++bj)
#pragma unroll
                    for (int n = 0; n < 2; ++n) {
                        float* d = accs + ((size_t)(u.kt0 >> 2) * NS + (wr * 64 + m * 16 + fr)) * D + u.pn * 256 + bj * 128 + wc * 32 + 16 * n + 4 * fq;
                        *(f32x4*)d = acc[0][bj][m][n];
                    }
            return;
        }
#pragma unroll
        for (int ai = 0; ai < 2; ++ai)
#pragma unroll
            for (int m = 0; m < 4; ++m) {
                const int r = u.pm * 256 + ai * 128 + wr * 64 + m * 16 + fr;
                if (r < MR) {
                    const float* xr = r < TP ? xp + (size_t)r * D : xs + (size_t)(r - TP) * D;
                    const float* g1 = mod + (size_t)crow_of(r) * NMOD + 2 * D;
#pragma unroll
                    for (int bj = 0; bj < 2; ++bj)
#pragma unroll
                        for (int n = 0; n < 2; ++n) {
                            const int c = u.pn * 256 + bj * 128 + wc * 32 + 16 * n + 4 * fq;
                            const f32x4 xv = *(const f32x4*)(xr + c), gv = *(const f32x4*)(g1 + c);
                            *(f32x4*)(out + (size_t)r * D + c) = xv + gv * acc[ai][bj][m][n];
                        }
                }
            }
    }
};
struct EpiDown {
    static constexpr bool PERM = false, AFTER_DRAIN = false;
    const float* mod; float* out; float* accs;
    DI void operator()(const f32x4 (&acc)[2][2][4][2], const Unit& u, int wr, int wc, int fr, int fq) const {
        if (u.pm == 64) {
#pragma unroll
            for (int m = 0; m < 4; ++m)
#pragma unroll
                for (int bj = 0; bj < 2; ++bj)
#pragma unroll
                    for (int n = 0; n < 2; ++n) {
                        float* d = accs + ((size_t)(u.kt0 >> 2) * NS + (wr * 64 + m * 16 + fr)) * D + u.pn * 256 + bj * 128 + wc * 32 + 16 * n + 4 * fq;
                        *(f32x4*)d = acc[0][bj][m][n];
                    }
            return;
        }
#pragma unroll
        for (int ai = 0; ai < 2; ++ai)
#pragma unroll
            for (int m = 0; m < 4; ++m) {
                const int r = u.pm * 256 + ai * 128 + wr * 64 + m * 16 + fr;
                if (r < MR) {
                    const float* g2 = mod + (size_t)crow_of(r) * NMOD + 5 * D;
#pragma unroll
                    for (int bj = 0; bj < 2; ++bj)
#pragma unroll
                        for (int n = 0; n < 2; ++n) {
                            const int c = u.pn * 256 + bj * 128 + wc * 32 + 16 * n + 4 * fq;
                            float* o = out + (size_t)r * D + c;
                            const f32x4 xv = *(const f32x4*)o, gv = *(const f32x4*)(g2 + c);
                            *(f32x4*)o = xv + gv * acc[ai][bj][m][n];
                        }
                }
            }
    }
};
struct EpiUp {
    static constexpr bool PERM = true, AFTER_DRAIN = false;
    bf16_t* AB; bf16_t* G; float* out; float* accs; const float* cw; const float* cb; LAS float* xch;
    DI void operator()(const f32x4 (&acc)[2][2][4][2], const Unit& u, int wr, int wc, int fr, int fq) const {
        int cl = 32 * wc + 8 * fq;
        if (u.pm == 64) {
#pragma unroll
            for (int m = 0; m < 4; ++m)
#pragma unroll
                for (int bj = 0; bj < 2; ++bj)
#pragma unroll
                    for (int n = 0; n < 2; ++n) {
                        float* d = accs + ((size_t)(u.kt0 >> 2) * NS + (wr * 64 + m * 16 + fr)) * NAB + bj * DFF + 128 * u.pn + cl + 4 * n;
                        *(f32x4*)d = acc[0][bj][m][n];
                    }
            return;
        }
        asm volatile("" : "+v"(cl), "+v"(fr), "+v"(fq));
        const int lane = fq * 16 + fr;
        if (fr >= 14) {
#pragma unroll
            for (int ai = 0; ai < 2; ++ai) { LAS float* d = xch + ((2 * ai + wr) * 2 + (fr - 14)) * 128 + cl; *(LAS f32x4*)d = acc[ai][0][3][0]; *(LAS f32x4*)(d + 4) = acc[ai][0][3][1]; }
        }
        asm volatile("s_waitcnt lgkmcnt(0)" ::: "memory"); __builtin_amdgcn_s_barrier(); __builtin_amdgcn_s_barrier(); asm volatile("" ::: "memory");
        const int src1 = (lane & 48) | ((fr + 15) & 15), src2 = (lane & 48) | ((fr + 14) & 15);
#pragma unroll
        for (int n = 0; n < 2; ++n) {
            const int c = 128 * u.pn + cl + 4 * n;
            const f32x4 w0 = *(const f32x4*)(cw + c), w1 = *(const f32x4*)(cw + DFF + c), w2 = *(const f32x4*)(cw + 2 * DFF + c), bb = *(const f32x4*)(cb + c);
#pragma unroll
            for (int ai = 0; ai < 2; ++ai) {
                const int q = 2 * ai + wr;
                f32x4 y1 = {0.f, 0.f, 0.f, 0.f}, z1 = y1;
                if (q > 0) { y1 = *(const LAS f32x4*)(xch + ((q - 1) * 2 + 1) * 128 + cl + 4 * n); z1 = *(const LAS f32x4*)(xch + ((q - 1) * 2 + (fr == 0 ? 0 : 1)) * 128 + cl + 4 * n); }
#pragma unroll
                for (int m = 0; m < 4; ++m) {
                    const f32x4 av = acc[ai][0][m][n], bv = acc[ai][1][m][n];
                    f32x4 o;
#pragma unroll
                    for (int j = 0; j < 4; ++j) {
                        const float y = __shfl(av[j], src1), z = __shfl(av[j], src2);
                        const float a1 = fr >= 1 ? y : y1[j], a0 = fr >= 2 ? z : z1[j];
                        y1[j] = y; z1[j] = z;
                        const float uu = bb[j] + w0[j] * a0 + w1[j] * a1 + w2[j] * av[j];
                        o[j] = silu(uu) * bv[j];
                    }
                    const int rl = 128 * ai + 64 * wr + 16 * m + fr, rg = 256 * u.pm + rl;
                    u32x2 gw; gw.x = pk2(o[0], o[1]); gw.y = pk2(o[2], o[3]);
                    if (ai == 0 && m == 0 && wr == 0) {
                        if (!(fr < 2 && u.pm > 0)) *(u32x2*)(G + (size_t)rg * DFF + c) = gw;
                        if (fr < 2) {
                            u32x2 w; w.x = pk2(av[0], av[1]); w.y = pk2(av[2], av[3]); *(u32x2*)(AB + (size_t)rg * NAB + c) = w;
                            u32x2 x; x.x = pk2(bv[0], bv[1]); x.y = pk2(bv[2], bv[3]); *(u32x2*)(AB + (size_t)rg * NAB + DFF + c) = x;
                        }
                    } else {
                        *(u32x2*)(G + (size_t)rg * DFF + c) = gw;
                        if (ai == 1 && m == 3 && wr == 1) {
                            if (fr >= 14) {
                                u32x2 w; w.x = pk2(av[0], av[1]); w.y = pk2(av[2], av[3]); *(u32x2*)(AB + (size_t)rg * NAB + c) = w;
                                if (u.pm == 63) *(f32x4*)(out + OFF_CVP + (size_t)(rl - 254) * DFF + c) = av;
                            }
                        }
                    }
                    asm volatile("" ::: "memory");
                }
            }
        }
    }
};

DI void ph_mod(const Params& p, LAS unsigned char* L, float* mod) {
    LAS float* sS = (LAS float*)L;
    LAS float* sRed = (LAS float*)L;
    const int tid = threadIdx.x, cgp = tid % 24, ksub = tid / 24;
    const float* cpr = p.in[7]; const float* csm = p.in[8]; const float* wada = p.in[9]; const float* bada = p.in[10];
    for (int nb = blockIdx.x; nb < 256; nb += gridDim.x) {
        const int n0 = nb * 48;
        float acc[33][2];
#pragma unroll
        for (int r = 0; r < 33; ++r) { acc[r][0] = 0.f; acc[r][1] = 0.f; }
        for (int kc = 0; kc < 4; ++kc) {
            f32x2 wv[25];
#pragma unroll
            for (int q = 0; q < 25; ++q) { const int kk = ksub + 21 * q; wv[q] = (ksub < 21 && kk < 512) ? *(const f32x2*)(wada + (size_t)(kc * 512 + kk) * NMOD + n0 + 2 * cgp) : (f32x2){0.f, 0.f}; }
            for (int idx = tid; idx < 33 * 512; idx += 512) {
                const int r = idx >> 9, kk = idx & 511;
                const float c = r == 0 ? cpr[kc * 512 + kk] : csm[(r - 1) * D + kc * 512 + kk];
                sS[kk * 36 + r] = silu(c);
            }
            __syncthreads();
#pragma unroll
            for (int q = 0; q < 25; ++q) {
                const int kk = ksub + 21 * q;
                if (ksub < 21 && kk < 512) {
                    const f32x2 w = wv[q];
                    const LAS f32x4* sp = (const LAS f32x4*)(sS + kk * 36);
#pragma unroll
                    for (int r4 = 0; r4 < 9; ++r4) {
                        const f32x4 sv = sp[r4];
#pragma unroll
                        for (int j = 0; j < 4; ++j) { if (4 * r4 + j < 33) { acc[4 * r4 + j][0] += sv[j] * w[0]; acc[4 * r4 + j][1] += sv[j] * w[1]; } }
                    }
                }
            }
            __syncthreads();
        }
#pragma unroll
        for (int r0 = 0; r0 < 33; r0 += 11) {
            if (ksub < 21) {
#pragma unroll
                for (int i = 0; i < 11; ++i) { sRed[ksub * 528 + i * 48 + 2 * cgp] = acc[r0 + i][0]; sRed[ksub * 528 + i * 48 + 2 * cgp + 1] = acc[r0 + i][1]; }
            }
            __syncthreads();
            for (int o = tid; o < 528; o += 512) {
                float sum = 0.f;
                for (int k2 = 0; k2 < 21; ++k2) sum += sRed[k2 * 528 + o];
                const int i = o / 48, c = o % 48;
                mod[(size_t)(r0 + i) * NMOD + n0 + c] = sum + bada[n0 + c];
            }
            __syncthreads();
        }
    }
}
DI void tr_load(const float* W, int N, int r, int lane, f32x4 (&v)[8]) {
    const int nblk = N / 32, kb = r / nblk, nb = r % nblk, k0 = 64 * kb, n0 = 32 * nb;
#pragma unroll
    for (int i = 0; i < 8; ++i) v[i] = *(const f32x4*)(W + (size_t)(k0 + 8 * i + (lane >> 3)) * N + n0 + 4 * (lane & 7));
}
DI void tr_finish(bf16_t* WT, int K, int N, int inter, int r, LAS float* scr, int lane, const f32x4 (&v)[8]) {
    const int nblk = N / 32, kb = r / nblk, nb = r % nblk, k0 = 64 * kb, n0 = 32 * nb;
#pragma unroll
    for (int i = 0; i < 8; ++i) { LAS float* dd = scr + (8 * i + (lane >> 3)) * 33 + 4 * (lane & 7); dd[0] = v[i][0]; dd[1] = v[i][1]; dd[2] = v[i][2]; dd[3] = v[i][3]; }
    lds_fence();
    const int c = lane & 7;
#pragma unroll
    for (int j = 0; j < 4; ++j) { const int n = (lane >> 3) + 8 * j; const LAS float* s = scr + (8 * c) * 33 + n;
        u32x4 o; o.x = pk2(s[0 * 33], s[1 * 33]); o.y = pk2(s[2 * 33], s[3 * 33]); o.z = pk2(s[4 * 33], s[5 * 33]); o.w = pk2(s[6 * 33], s[7 * 33]);
        const int na = n0 + n, drow = inter < 0 ? na : ((na >> 7) << 8) + inter * 128 + (na & 127);
        *(u32x4*)(WT + (size_t)drow * K + k0 + 8 * c) = o; }
    lds_fence();
}
constexpr int TR_I_IN = 32 * 400, TR_I_PA = 8 * 64, TR_I_PB = 16 * 64, TR_I_O = 32 * 64, TR_I_A = 32 * 176, TR_I_DN = 88 * 64;
constexpr int TR_NITEMS = TR_I_IN + TR_I_PA + TR_I_PB + TR_I_O + 2 * TR_I_A + TR_I_DN;
struct TrSrc { const float *w_in, *w_pa, *w_pb, *w_o, *w_a, *w_b, *w_dn; };
DI void tr_decode(const TrSrc& q, unsigned char* ws, int it, const float*& W, bf16_t*& WT, int& K, int& N, int& inter, int& r) {
    r = it; inter = -1;
    if (r < TR_I_IN) { W = q.w_in; WT = (bf16_t*)(ws + WS_WIN); K = D; N = NZ; return; } r -= TR_I_IN;
    if (r < TR_I_PA) { W = q.w_pa; WT = (bf16_t*)(ws + WS_WPA); K = 512; N = D; return; } r -= TR_I_PA;
    if (r < TR_I_PB) { W = q.w_pb; WT = (bf16_t*)(ws + WS_WPB); K = 1024; N = D; return; } r -= TR_I_PB;
    if (r < TR_I_O) { W = q.w_o; WT = (bf16_t*)(ws + WS_WO); K = D; N = D; return; } r -= TR_I_O;
    if (r < TR_I_A) { W = q.w_a; WT = (bf16_t*)(ws + WS_WAB); K = D; N = DFF; inter = 0; return; } r -= TR_I_A;
    if (r < TR_I_A) { W = q.w_b; WT = (bf16_t*)(ws + WS_WAB); K = D; N = DFF; inter = 1; return; } r -= TR_I_A;
    W = q.w_dn; WT = (bf16_t*)(ws + WS_WDN); K = DFF; N = D;
}
DI void ph_prologue(const Params& p, LAS unsigned char* L) {
    unsigned char* ws = p.ws;
    const int tid = threadIdx.x, lane = tid & 63, wave = tid >> 6;
    const int gw = blockIdx.x * 8 + wave, NGW = gridDim.x * 8;
    const size_t gtid = (size_t)blockIdx.x * 512 + tid, gstride = (size_t)gridDim.x * 512;
    ph_mod(p, L, (float*)(ws + WS_MOD));
    LAS float* scr = (LAS float*)(L + wave * 8448);
    const TrSrc tq{p.in[12], p.in[15], p.in[16], p.in[17], p.in[19], p.in[20], p.in[23]};
    for (int it = gw; it < TR_NITEMS; it += 2 * NGW) {
        const float* W0; bf16_t* T0; int K0, N0, i0, r0; tr_decode(tq, ws, it, W0, T0, K0, N0, i0, r0);
        const int it1 = it + NGW; const bool two = it1 < TR_NITEMS;
        const float* W1; bf16_t* T1; int K1, N1, i1, r1; tr_decode(tq, ws, two ? it1 : it, W1, T1, K1, N1, i1, r1);
        f32x4 v0[8], v1[8];
        tr_load(W0, N0, r0, lane, v0); tr_load(W1, N1, r1, lane, v1);
        tr_finish(T0, K0, N0, i0, r0, scr, lane, v0);
        if (two) tr_finish(T1, K1, N1, i1, r1, scr, lane, v1);
    }
    {
        float* rope = (float*)(ws + WS_ROPE);
        for (size_t idx = gtid; idx < (size_t)MR * 16; idx += gstride) {
            const int m = (int)(idx >> 4), i = (int)(idx & 15);
            const int pos = m < TP ? m : TP + ((m - TP) & 3);
            const float invf = (float)exp2(-(double)i * (18.931568569324174 / 16.0));
            const float ang = (float)pos * invf;
            const double x = (double)ang, n = rint(x * 0.15915494309189535);
            double rr = fma(-n, 6.283185307179586, x); rr = fma(-n, 2.4492935982947064e-16, rr);
            rope[(size_t)m * 32 + i] = cosf((float)rr); rope[(size_t)m * 32 + 16 + i] = sinf((float)rr);
        }
    }
}
DI const float* hn_src(const Params& p, const float* xbase, bool from_out, int m) {
    const bool fix = from_out && m >= TP;
    return (from_out && !fix) ? xbase + (size_t)m * D : (m < TP ? p.in[0] + (size_t)m * D : p.in[1] + (size_t)(m - TP) * D);
}
DI void ph_hnorm(const Params& p, float* xbase, bool from_out, const float* nw, int sh_idx, bf16_t* H) {
    const int lane = threadIdx.x & 63, wave = threadIdx.x >> 6, stride = gridDim.x * 8;
    const float* mod = (const float*)(p.ws + WS_MOD);
    int m = blockIdx.x * 8 + wave;
    f32x4 v[8];
    if (m < MR) { const float* xr = hn_src(p, xbase, from_out, m);
#pragma unroll
        for (int j = 0; j < 8; ++j) v[j] = *(const f32x4*)(xr + 4 * lane + 256 * j); }
    while (m < MR) {
        const int mn = m + stride; f32x4 vn[8];
        if (mn < MR) { const float* xr = hn_src(p, xbase, from_out, mn);
#pragma unroll
            for (int j = 0; j < 8; ++j) vn[j] = *(const f32x4*)(xr + 4 * lane + 256 * j); }
        const bool fix = from_out && m >= TP;
        const float* md = mod + (size_t)crow_of(m) * NMOD + sh_idx * D;
        float ss = 0.f;
#pragma unroll
        for (int j = 0; j < 8; ++j) { const int c = 4 * lane + 256 * j;
            if (fix) { f32x4 a = {0.f, 0.f, 0.f, 0.f}; for (int q = 0; q < NSP_WO; ++q) a = a + *(const f32x4*)((const float*)(p.ws + WS_ACC_WO) + ((size_t)q * NS + (m - TP)) * D + c); const f32x4 g = *(const f32x4*)(mod + (size_t)crow_of(m) * NMOD + 2 * D + c); v[j] = v[j] + g * a; *(f32x4*)(xbase + (size_t)m * D + c) = v[j]; }
            ss += v[j][0] * v[j][0] + v[j][1] * v[j][1] + v[j][2] * v[j][2] + v[j][3] * v[j][3]; }
        const float rstd = rsqrtf(wave_sum(ss) * (1.f / D) + EPS);
#pragma unroll
        for (int j = 0; j < 8; ++j) {
            const int c = 4 * lane + 256 * j;
            const f32x4 w = *(const f32x4*)(nw + c), shv = *(const f32x4*)(md + c), scv = *(const f32x4*)(md + D + c);
            const f32x4 o = (v[j] * rstd) * w * (1.f + scv) + shv;
            u32x2 q; q.x = pk2(o[0], o[1]); q.y = pk2(o[2], o[3]);
            *(u32x2*)(H + (size_t)m * D + c) = q;
        }
#pragma unroll
        for (int j = 0; j < 8; ++j) v[j] = vn[j];
        m = mn;
    }
}
DI void ph_final_norm(const Params& p) {
    const int lane = threadIdx.x & 63, wave = threadIdx.x >> 6, stride = gridDim.x * 8;
    const float* nw = p.in[24];
    int m = blockIdx.x * 8 + wave;
    f32x4 v[8];
    if (m < MR) {
#pragma unroll
        for (int j = 0; j < 8; ++j) v[j] = *(const f32x4*)(p.out + (size_t)m * D + 4 * lane + 256 * j); }
    while (m < MR) {
        const int mn = m + stride; f32x4 vn[8];
        if (mn < MR) {
#pragma unroll
            for (int j = 0; j < 8; ++j) vn[j] = *(const f32x4*)(p.out + (size_t)mn * D + 4 * lane + 256 * j); }
        float* xr = p.out + (size_t)m * D;
        float ss = 0.f;
#pragma unroll
        for (int j = 0; j < 8; ++j) { const int c = 4 * lane + 256 * j;
            if (m >= TP) { f32x4 a = {0.f, 0.f, 0.f, 0.f}; for (int q = 0; q < NSP_DN; ++q) a = a + *(const f32x4*)((const float*)(p.ws + WS_ACC_DN) + ((size_t)q * NS + (m - TP)) * D + c); const f32x4 g = *(const f32x4*)((const float*)(p.ws + WS_MOD) + (size_t)crow_of(m) * NMOD + 5 * D + c); v[j] = v[j] + g * a; }
            ss += v[j][0] * v[j][0] + v[j][1] * v[j][1] + v[j][2] * v[j][2] + v[j][3] * v[j][3]; }
        const float rstd = rsqrtf(wave_sum(ss) * (1.f / D) + EPS);
#pragma unroll
        for (int j = 0; j < 8; ++j) { const int c = 4 * lane + 256 * j; const f32x4 w = *(const f32x4*)(nw + c); *(f32x4*)(xr + c) = (v[j] * rstd) * w; }
#pragma unroll
        for (int j = 0; j < 8; ++j) v[j] = vn[j];
        m = mn;
    }
}

DI void attn_prompt_item(const bf16_t* Z, bf16_t* OG, float* LSE, LAS bf16_t* Vl, int item, int lane) {
    const int g = item >> 11, rem = item & 2047, hh = rem >> 9, bidx = rem & 511;
    const int dsh = 2 * g, nsh = 9 - dsh;
    const int res = bidx >> nsh, blk = bidx & ((1 << nsh) - 1);
    const int s0 = blk * 32, head = g * 4 + hh;
    const int qi = lane & 31, h = lane >> 5;
    const int tq = res + ((s0 + qi) << dsh);
    bf16x8 Qf[8];
    { const bf16_t* qp = Z + (size_t)tq * NZ + ZQ + head * 128 + 8 * h;
#pragma unroll
      for (int ks = 0; ks < 8; ++ks) Qf[ks] = *(const bf16x8*)(qp + 16 * ks); }
    float mrun = -INFINITY, lrun = 0.f;
    f32x16 O[4];
#pragma unroll
    for (int dt = 0; dt < 4; ++dt)
#pragma unroll
        for (int i = 0; i < 16; ++i) O[dt][i] = 0.f;
    const int sq = s0 + qi;
    const int vrow = lane >> 4, vch = lane & 15;
    const unsigned vtr = (unsigned)(unsigned long long)Vl + (unsigned)(((4 * h + ((lane & 15) >> 2)) * 136 + 16 * ((lane >> 4) & 1) + 4 * (lane & 3)) * 2);
    bf16x8 Kc[8]; u32x4 Vr[8];
#define ATT_LOAD_KV(kt_) do { const int kb_ = s0 - 128 + 32 * (kt_); int skl_ = kb_ + qi; skl_ = skl_ < 0 ? 0 : skl_; \
        const bf16_t* kp_ = Z + (size_t)(res + (skl_ << dsh)) * NZ + ZK + head * 128 + 8 * h; \
        _Pragma("unroll") for (int ks = 0; ks < 8; ++ks) Kc[ks] = *(const bf16x8*)(kp_ + 16 * ks); \
        _Pragma("unroll") for (int i = 0; i < 8; ++i) { int sv_ = kb_ + 4 * i + vrow; sv_ = sv_ < 0 ? 0 : sv_; \
            Vr[i] = *(const u32x4*)(Z + (size_t)(res + (sv_ << dsh)) * NZ + ZV + head * 128 + 8 * vch); } } while (0)
    ATT_LOAD_KV(4);
    for (int kt = 4; kt >= 0; --kt) {
        const int kb = s0 - 128 + 32 * kt;
        f32x16 S;
#pragma unroll
        for (int i = 0; i < 16; ++i) S[i] = 0.f;
#pragma unroll
        for (int ks = 0; ks < 8; ++ks) S = mfma32(Kc[ks], Qf[ks], S);
#pragma unroll
        for (int i = 0; i < 8; ++i) *(LAS u32x4*)(Vl + (4 * i + vrow) * 136 + 8 * vch) = Vr[i];
        if (kt > 0) ATT_LOAD_KV(kt - 1);
        float tmax = -INFINITY;
        if (kt >= 1 && kt <= 3 && kb >= 0) {
#pragma unroll
            for (int i = 0; i < 16; ++i) { S[i] = S[i] * ATT_SCALE; tmax = fmaxf(tmax, S[i]); }
        } else {
#pragma unroll
            for (int i = 0; i < 16; ++i) {
                const int sk = kb + (i & 3) + 8 * (i >> 2) + 4 * h;
                const bool valid = (sk >= 0) && (sk <= sq) && (sk >= sq - 128);
                S[i] = valid ? S[i] * ATT_SCALE : -INFINITY;
                tmax = fmaxf(tmax, S[i]);
            }
        }
        tmax = fmaxf(tmax, __shfl_xor(tmax, 32));
        const float mn = fmaxf(mrun, tmax), alpha = __expf(mrun - mn);
        float ps = 0.f;
#pragma unroll
        for (int i = 0; i < 16; ++i) { S[i] = __expf(S[i] - mn); ps += S[i]; }
        ps += __shfl_xor(ps, 32);
        lrun = lrun * alpha + ps; mrun = mn;
#pragma unroll
        for (int dt = 0; dt < 4; ++dt) O[dt] = O[dt] * alpha;
        bf16x8 Pf[2];
#pragma unroll
        for (int s2 = 0; s2 < 2; ++s2) {
            u32x4 w; w.x = pk2(S[8 * s2 + 0], S[8 * s2 + 1]); w.y = pk2(S[8 * s2 + 2], S[8 * s2 + 3]); w.z = pk2(S[8 * s2 + 4], S[8 * s2 + 5]); w.w = pk2(S[8 * s2 + 6], S[8 * s2 + 7]);
            Pf[s2] = __builtin_bit_cast(bf16x8, w);
        }
        lds_fence();
        const s16x4 l00 = tr_read<0>(vtr), h00 = tr_read<2176>(vtr);
        const s16x4 l01 = tr_read<4352>(vtr), h01 = tr_read<6528>(vtr);
        const s16x4 l10 = tr_read<64>(vtr), h10 = tr_read<2240>(vtr);
        const s16x4 l11 = tr_read<4416>(vtr), h11 = tr_read<6592>(vtr);
        const s16x4 l20 = tr_read<128>(vtr), h20 = tr_read<2304>(vtr);
        const s16x4 l21 = tr_read<4480>(vtr), h21 = tr_read<6656>(vtr);
        const s16x4 l30 = tr_read<192>(vtr), h30 = tr_read<2368>(vtr);
        const s16x4 l31 = tr_read<4544>(vtr), h31 = tr_read<6720>(vtr);
        asm volatile("s_waitcnt lgkmcnt(0)" ::: "memory"); __builtin_amdgcn_sched_barrier(0);
#define PK8(L_, H_) (bf16x8){L_[0], L_[1], L_[2], L_[3], H_[0], H_[1], H_[2], H_[3]}
        O[0] = mfma32(PK8(l00, h00), Pf[0], O[0]);
        O[0] = mfma32(PK8(l01, h01), Pf[1], O[0]);
        O[1] = mfma32(PK8(l10, h10), Pf[0], O[1]);
        O[1] = mfma32(PK8(l11, h11), Pf[1], O[1]);
        O[2] = mfma32(PK8(l20, h20), Pf[0], O[2]);
        O[2] = mfma32(PK8(l21, h21), Pf[1], O[2]);
        O[3] = mfma32(PK8(l30, h30), Pf[0], O[3]);
        O[3] = mfma32(PK8(l31, h31), Pf[1], O[3]);
#undef PK8
        lds_fence();
    }
#undef ATT_LOAD_KV
    const float inv = 1.f / lrun;
    bf16_t* op = OG + ((size_t)g * MP + tq) * 512 + hh * 128 + 4 * h;
#pragma unroll
    for (int dt = 0; dt < 4; ++dt)
#pragma unroll
        for (int rq = 0; rq < 4; ++rq) {
            u32x2 w; w.x = pk2(O[dt][4 * rq] * inv, O[dt][4 * rq + 1] * inv); w.y = pk2(O[dt][4 * rq + 2] * inv, O[dt][4 * rq + 3] * inv);
            *(u32x2*)(op + 32 * dt + 8 * rq) = w;
        }
    if (h == 0) LSE[((size_t)g * MP + tq) * 4 + hh] = mrun + __logf(lrun);
}
DI const float* samp_row(const float* cache, const float* newkv, int b, int W, int rr) {
    return (rr >= W) ? newkv + ((size_t)(b * W + rr - 4) * 2) * 512 : cache + ((size_t)(b * W + rr) * 2) * 512;
}
DI void attn_sample_item(const Params& p, const bf16_t* Z, bf16_t* OG, float* LSE, int item, int lane) {
    const int b = item / 48, r48 = item % 48, t = r48 / 12, head = r48 % 12, g = head >> 2, hh = head & 3;
    const int dsh = 2 * g, W = 128 << dsh;
    const float* cache = p.in[2 + g];
    const float* newkv = p.out + (g == 0 ? OFF_KVS0 : (g == 1 ? OFF_KVS1 : OFF_KVS2));
    const int m = TP + b * 4 + t;
    const unsigned qq = *(const unsigned*)(Z + (size_t)m * NZ + ZQ + head * 128 + 2 * lane);
    const float q0 = bflo(qq) * ATT_SCALE, q1 = bfhi(qq) * ATT_SCALE;
    float mrun, lrun, o0, o1;
    {
        const float* rp = samp_row(cache, newkv, b, W, W + t - (128 << dsh)) + hh * 128 + 2 * lane;
        const f32x2 kk = *(const f32x2*)rp, vv = *(const f32x2*)(rp + 512);
        mrun = wave_sum(q0 * kk.x + q1 * kk.y); lrun = 1.f; o0 = vv.x; o1 = vv.y;
    }
    f32x2 kk[16], vv[16];
#pragma unroll
    for (int u = 0; u < 16; ++u) { const float* rp = samp_row(cache, newkv, b, W, W + t - (u << dsh)) + hh * 128 + 2 * lane; kk[u] = *(const f32x2*)rp; vv[u] = *(const f32x2*)(rp + 512); }
    for (int j0 = 0; j0 < 128; j0 += 16) {
        f32x2 kn[16], vn[16];
        if (j0 + 16 < 128) {
#pragma unroll
            for (int u = 0; u < 16; ++u) { const float* rp = samp_row(cache, newkv, b, W, W + t - ((j0 + 16 + u) << dsh)) + hh * 128 + 2 * lane; kn[u] = *(const f32x2*)rp; vn[u] = *(const f32x2*)(rp + 512); }
        }
        float pr[16];
#pragma unroll
        for (int u = 0; u < 16; ++u) pr[u] = q0 * kk[u].x + q1 * kk[u].y;
#pragma unroll
        for (int o = 32; o >= 1; o >>= 1) {
#pragma unroll
            for (int u = 0; u < 16; ++u) pr[u] += __shfl_xor(pr[u], o);
        }
        float bm = pr[0];
#pragma unroll
        for (int u = 1; u < 16; ++u) bm = fmaxf(bm, pr[u]);
        const float mn = fmaxf(mrun, bm), alpha = __expf(mrun - mn);
        lrun *= alpha; o0 *= alpha; o1 *= alpha; mrun = mn;
#pragma unroll
        for (int u = 0; u < 16; ++u) { const float pu = __expf(pr[u] - mn); lrun += pu; o0 += pu * vv[u].x; o1 += pu * vv[u].y; }
#pragma unroll
        for (int u = 0; u < 16; ++u) { kk[u] = kn[u]; vv[u] = vn[u]; }
    }
    const float inv = 1.f / lrun;
    *(unsigned*)(OG + ((size_t)g * MP + m) * 512 + hh * 128 + 2 * lane) = pk2(o0 * inv, o1 * inv);
    if (lane == 0) LSE[((size_t)g * MP + m) * 4 + hh] = mrun + __logf(lrun);
}

DI float hg_gates(const Params& p, const bf16_t (&fhr)[16], int h, LAS float* tot, float (&kk)[16], float (&bb)[16]) {
    const int tid = threadIdx.x, dk = tid & 127, part = tid >> 7;
    const float* lbp = p.in[13];
    const float lb = 1.f / (1.f + __expf(lbp[1024 + h * 128 + dk] - lbp[h * 128 + dk]));
    float cum = 0.f;
#pragma unroll
    for (int i = 0; i < 16; ++i) {
        const float fh = bf2f(fhr[i]);
        const float f = lb + (1.f - lb) * sigm(fh);
        kk[i] = 1.f - f; cum += __logf(f); bb[i] = cum;
    }
    tot[part * 128 + dk] = cum;
    __syncthreads();
    float off = 0.f, bl = 0.f;
#pragma unroll
    for (int q = 0; q < 4; ++q) { const float tv = tot[q * 128 + dk]; bl += tv; off += (q < part) ? tv : 0.f; }
#pragma unroll
    for (int i = 0; i < 16; ++i) bb[i] += off;
    return bl;
}
DI void hg_load_v(const bf16_t* Z, int n, int h, LAS bf16_t* Vs) {
    const int tid = threadIdx.x;
#pragma unroll
    for (int i = 0; i < 2; ++i) { const int e = tid + 512 * i, s = e >> 4, ch = e & 15;
        *(LAS u32x4*)(Vs + s * 136 + 8 * ch) = *(const u32x4*)(Z + (size_t)(64 * n + s) * NZ + ZIH + h * 128 + 8 * ch); }
}
struct HgaRegs { bf16_t fhr[16]; u32x4 vreg[2]; };
DI void hg_passA_load(const bf16_t* Z, int item, HgaRegs& R) {
    const int n = item >> 3, h = item & 7;
    const int tid = threadIdx.x, dk = tid & 127, part = tid >> 7;
#pragma unroll
    for (int i = 0; i < 16; ++i) R.fhr[i] = Z[(size_t)(64 * n + 16 * part + i) * NZ + ZFH + h * 128 + dk];
#pragma unroll
    for (int i = 0; i < 2; ++i) { const int e = tid + 512 * i; R.vreg[i] = *(const u32x4*)(Z + (size_t)(64 * n + (e >> 4)) * NZ + ZIH + h * 128 + 8 * (e & 15)); }
}
DI void hg_passA_item(const Params& p, float* HS, float* HD, LAS unsigned char* L, int item, const HgaRegs& R) {
    const int n = item >> 3, h = item & 7;
    const int tid = threadIdx.x, lane = tid & 63, wave = tid >> 6, dk = tid & 127, part = tid >> 7;
    LAS bf16_t* Kh = (LAS bf16_t*)L;
    LAS bf16_t* Vs = (LAS bf16_t*)(L + 17408);
    LAS float* tot = (LAS float*)(L + 34816);
    float kk[16], bb[16];
    const float bl = hg_gates(p, R.fhr, h, tot, kk, bb);
#pragma unroll
    for (int i = 0; i < 16; ++i) Kh[(16 * part + i) * 136 + dk] = (bf16_t)(pk2(kk[i] * __expf(bl - bb[i]), 0.f) & 0xffffu);
    if (part == 0) HD[(size_t)(n * 8 + h) * 128 + dk] = __expf(bl);
#pragma unroll
    for (int i = 0; i < 2; ++i) { const int e = tid + 512 * i; *(LAS u32x4*)(Vs + (e >> 4) * 136 + 8 * (e & 15)) = R.vreg[i]; }
    __syncthreads();
    f32x4 acc[8];
#pragma unroll
    for (int nt = 0; nt < 8; ++nt) acc[nt] = (f32x4){0.f, 0.f, 0.f, 0.f};
    const unsigned trq = (unsigned)(((8 * (lane >> 4) + ((lane & 15) >> 2)) * 136 + 4 * (lane & 3)) * 2);
    const unsigned trA = (unsigned)(unsigned long long)Kh + trq + 32u * (unsigned)wave, trB = (unsigned)(unsigned long long)Vs + trq;
#define PK8(L_, H_) (bf16x8){L_[0], L_[1], L_[2], L_[3], H_[0], H_[1], H_[2], H_[3]}
    { const s16x4 al = tr_read<0>(trA), ah = tr_read<1088>(trA);
      const s16x4 l0 = tr_read<0>(trB), h0 = tr_read<1088>(trB);
      const s16x4 l1 = tr_read<32>(trB), h1 = tr_read<1120>(trB);
      const s16x4 l2 = tr_read<64>(trB), h2 = tr_read<1152>(trB);
      const s16x4 l3 = tr_read<96>(trB), h3 = tr_read<1184>(trB);
      const s16x4 l4 = tr_read<128>(trB), h4 = tr_read<1216>(trB);
      const s16x4 l5 = tr_read<160>(trB), h5 = tr_read<1248>(trB);
      const s16x4 l6 = tr_read<192>(trB), h6 = tr_read<1280>(trB);
      const s16x4 l7 = tr_read<224>(trB), h7 = tr_read<1312>(trB);
      asm volatile("s_waitcnt lgkmcnt(0)" ::: "memory"); __builtin_amdgcn_sched_barrier(0);
      const bf16x8 A = PK8(al, ah);
      acc[0] = mfma16(A, PK8(l0, h0), acc[0]);
      acc[1] = mfma16(A, PK8(l1, h1), acc[1]);
      acc[2] = mfma16(A, PK8(l2, h2), acc[2]);
      acc[3] = mfma16(A, PK8(l3, h3), acc[3]);
      acc[4] = mfma16(A, PK8(l4, h4), acc[4]);
      acc[5] = mfma16(A, PK8(l5, h5), acc[5]);
      acc[6] = mfma16(A, PK8(l6, h6), acc[6]);
      acc[7] = mfma16(A, PK8(l7, h7), acc[7]);
    }
    { const s16x4 al = tr_read<8704>(trA), ah = tr_read<9792>(trA);
      const s16x4 l0 = tr_read<8704>(trB), h0 = tr_read<9792>(trB);
      const s16x4 l1 = tr_read<8736>(trB), h1 = tr_read<9824>(trB);
      const s16x4 l2 = tr_read<8768>(trB), h2 = tr_read<9856>(trB);
      const s16x4 l3 = tr_read<8800>(trB), h3 = tr_read<9888>(trB);
      const s16x4 l4 = tr_read<8832>(trB), h4 = tr_read<9920>(trB);
      const s16x4 l5 = tr_read<8864>(trB), h5 = tr_read<9952>(trB);
      const s16x4 l6 = tr_read<8896>(trB), h6 = tr_read<9984>(trB);
      const s16x4 l7 = tr_read<8928>(trB), h7 = tr_read<10016>(trB);
      asm volatile("s_waitcnt lgkmcnt(0)" ::: "memory"); __builtin_amdgcn_sched_barrier(0);
      const bf16x8 A = PK8(al, ah);
      acc[0] = mfma16(A, PK8(l0, h0), acc[0]);
      acc[1] = mfma16(A, PK8(l1, h1), acc[1]);
      acc[2] = mfma16(A, PK8(l2, h2), acc[2]);
      acc[3] = mfma16(A, PK8(l3, h3), acc[3]);
      acc[4] = mfma16(A, PK8(l4, h4), acc[4]);
      acc[5] = mfma16(A, PK8(l5, h5), acc[5]);
      acc[6] = mfma16(A, PK8(l6, h6), acc[6]);
      acc[7] = mfma16(A, PK8(l7, h7), acc[7]);
    }
#undef PK8
    float* up = HS + ((size_t)(n * 8 + h) * 128) * 128;
#pragma unroll
    for (int nt = 0; nt < 8; ++nt)
#pragma unroll
        for (int r = 0; r < 4; ++r) up[(size_t)(16 * wave + 4 * (lane >> 4) + r) * 128 + 16 * nt + (lane & 15)] = acc[nt][r];
    __syncthreads();
}
DI void hg_scan(const Params& p, float* HS, const float* HD) {
    for (int e = blockIdx.x * 512 + threadIdx.x; e < 131072; e += gridDim.x * 512) {
        float S = 0.f;
        for (int n0 = 0; n0 < 256; n0 += 32) {
            float U[32], Dd[32];
#pragma unroll
            for (int j = 0; j < 32; ++j) { U[j] = HS[(size_t)(n0 + j) * 131072 + e]; Dd[j] = HD[(n0 + j) * 1024 + (e >> 7)]; }
#pragma unroll
            for (int j = 0; j < 32; ++j) { HS[(size_t)(n0 + j) * 131072 + e] = S; S = Dd[j] * S + U[j]; }
        }
        p.out[OFF_HGP + e] = S;
    }
}
struct HgcRegs { bf16_t fhr[16], qhr[16]; u32x4 vreg[2]; f32x4 sreg[8]; };
DI void hg_passC_load(const bf16_t* Z, const float* HS, int item, HgcRegs& R) {
    const int n = item >> 3, h = item & 7;
    const int tid = threadIdx.x, dk = tid & 127, part = tid >> 7;
#pragma unroll
    for (int i = 0; i < 16; ++i) { const size_t ro = (size_t)(64 * n + 16 * part + i) * NZ + h * 128 + dk; R.fhr[i] = Z[ro + ZFH]; R.qhr[i] = Z[ro + ZQH]; }
#pragma unroll
    for (int i = 0; i < 2; ++i) { const int e = tid + 512 * i; R.vreg[i] = *(const u32x4*)(Z + (size_t)(64 * n + (e >> 4)) * NZ + ZIH + h * 128 + 8 * (e & 15)); }
    const float* sp = HS + ((size_t)(n * 8 + h) * 128) * 128;
#pragma unroll
    for (int i = 0; i < 8; ++i) { const int e = tid + 512 * i; R.sreg[i] = *(const f32x4*)(sp + (e >> 5) * 128 + 4 * (e & 31)); }
}
DI void hg_passC_item(const Params& p, const bf16_t* Z, bf16_t* OHG, LAS unsigned char* L, int item, const HgcRegs& R) {
    const int n = item >> 3, h = item & 7;
    const int tid = threadIdx.x, lane = tid & 63, wave = tid >> 6, dk = tid & 127, part = tid >> 7;
    LAS bf16_t* Qs = (LAS bf16_t*)L;
    LAS bf16_t* Ks = (LAS bf16_t*)(L + 17408);
    LAS bf16_t* Vs = (LAS bf16_t*)(L + 34816);
    LAS bf16_t* Ss = (LAS bf16_t*)(L + 52224);
    LAS bf16_t* As = (LAS bf16_t*)(L + 87040);
    LAS float* tot = (LAS float*)(L + 96256);
    LAS float* red = (LAS float*)(L + 98304);
    float kk[16], bb[16];
    const int mt = wave >> 1, wh = wave & 1, lr = lane & 15, lq = lane >> 4;
    bf16_t ghr[16];
#pragma unroll
    for (int r = 0; r < 4; ++r)
#pragma unroll
        for (int j = 0; j < 4; ++j) ghr[r * 4 + j] = Z[(size_t)(64 * n + 16 * mt + 4 * lq + r) * NZ + ZGH + h * 128 + 16 * (4 * wh + j) + lr];
    (void)hg_gates(p, R.fhr, h, tot, kk, bb);
#pragma unroll
    for (int i = 0; i < 16; ++i) {
        const int s = 16 * part + i;
        const float qh = bf2f(R.qhr[i]);
        Qs[s * 136 + dk] = (bf16_t)(pk2(silu(qh) * __expf(bb[i]), 0.f) & 0xffffu);
        Ks[s * 136 + dk] = (bf16_t)(pk2(kk[i] * __expf(-bb[i]), 0.f) & 0xffffu);
    }
#pragma unroll
    for (int i = 0; i < 2; ++i) { const int e = tid + 512 * i; *(LAS u32x4*)(Vs + (e >> 4) * 136 + 8 * (e & 15)) = R.vreg[i]; }
#pragma unroll
    for (int i = 0; i < 8; ++i) { const int e = tid + 512 * i; u32x2 w; w.x = pk2(R.sreg[i][0], R.sreg[i][1]); w.y = pk2(R.sreg[i][2], R.sreg[i][3]); *(LAS u32x2*)(Ss + (e >> 5) * 136 + 4 * (e & 31)) = w; }
    __syncthreads();
    {
        f32x4 a2[2] = {{0.f, 0.f, 0.f, 0.f}, {0.f, 0.f, 0.f, 0.f}};
#pragma unroll
        for (int ks = 0; ks < 4; ++ks) {
            const bf16x8 A = ld8(Qs + (16 * mt + lr) * 136 + 32 * ks + 8 * lq);
#pragma unroll
            for (int j = 0; j < 2; ++j) { const bf16x8 B = ld8(Ks + (16 * (2 * wh + j) + lr) * 136 + 32 * ks + 8 * lq); a2[j] = mfma16(A, B, a2[j]); }
        }
#pragma unroll
        for (int j = 0; j < 2; ++j)
#pragma unroll
            for (int r = 0; r < 4; ++r) { const int t = 16 * mt + 4 * lq + r, s = 16 * (2 * wh + j) + lr; As[t * 72 + s] = (bf16_t)(pk2(s <= t ? a2[j][r] : 0.f, 0.f) & 0xffffu); }
    }
    __syncthreads();
    f32x4 acc[4];
#pragma unroll
    for (int j = 0; j < 4; ++j) acc[j] = (f32x4){0.f, 0.f, 0.f, 0.f};
    const unsigned trq = (unsigned)(((8 * lq + (lr >> 2)) * 136 + 64 * wh + 4 * (lr & 3)) * 2);
    const unsigned trV = (unsigned)(unsigned long long)Vs + trq, trS = (unsigned)(unsigned long long)Ss + trq;
#define PK8(L_, H_) (bf16x8){L_[0], L_[1], L_[2], L_[3], H_[0], H_[1], H_[2], H_[3]}
    { const bf16x8 A = ld8(As + (16 * mt + lr) * 72 + 0 + 8 * lq);
      const s16x4 l0 = tr_read<0>(trV), h0 = tr_read<1088>(trV);
      const s16x4 l1 = tr_read<32>(trV), h1 = tr_read<1120>(trV);
      const s16x4 l2 = tr_read<64>(trV), h2 = tr_read<1152>(trV);
      const s16x4 l3 = tr_read<96>(trV), h3 = tr_read<1184>(trV);
      asm volatile("s_waitcnt lgkmcnt(0)" ::: "memory"); __builtin_amdgcn_sched_barrier(0);
      acc[0] = mfma16(A, PK8(l0, h0), acc[0]);
      acc[1] = mfma16(A, PK8(l1, h1), acc[1]);
      acc[2] = mfma16(A, PK8(l2, h2), acc[2]);
      acc[3] = mfma16(A, PK8(l3, h3), acc[3]);
    }
    { const bf16x8 A = ld8(As + (16 * mt + lr) * 72 + 32 + 8 * lq);
      const s16x4 l0 = tr_read<8704>(trV), h0 = tr_read<9792>(trV);
      const s16x4 l1 = tr_read<8736>(trV), h1 = tr_read<9824>(trV);
      const s16x4 l2 = tr_read<8768>(trV), h2 = tr_read<9856>(trV);
      const s16x4 l3 = tr_read<8800>(trV), h3 = tr_read<9888>(trV);
      asm volatile("s_waitcnt lgkmcnt(0)" ::: "memory"); __builtin_amdgcn_sched_barrier(0);
      acc[0] = mfma16(A, PK8(l0, h0), acc[0]);
      acc[1] = mfma16(A, PK8(l1, h1), acc[1]);
      acc[2] = mfma16(A, PK8(l2, h2), acc[2]);
      acc[3] = mfma16(A, PK8(l3, h3), acc[3]);
    }
    { const bf16x8 A = ld8(Qs + (16 * mt + lr) * 136 + 0 + 8 * lq);
      const s16x4 l0 = tr_read<0>(trS), h0 = tr_read<1088>(trS);
      const s16x4 l1 = tr_read<32>(trS), h1 = tr_read<1120>(trS);
      const s16x4 l2 = tr_read<64>(trS), h2 = tr_read<1152>(trS);
      const s16x4 l3 = tr_read<96>(trS), h3 = tr_read<1184>(trS);
      asm volatile("s_waitcnt lgkmcnt(0)" ::: "memory"); __builtin_amdgcn_sched_barrier(0);
      acc[0] = mfma16(A, PK8(l0, h0), acc[0]);
      acc[1] = mfma16(A, PK8(l1, h1), acc[1]);
      acc[2] = mfma16(A, PK8(l2, h2), acc[2]);
      acc[3] = mfma16(A, PK8(l3, h3), acc[3]);
    }
    { const bf16x8 A = ld8(Qs + (16 * mt + lr) * 136 + 32 + 8 * lq);
      const s16x4 l0 = tr_read<8704>(trS), h0 = tr_read<9792>(trS);
      const s16x4 l1 = tr_read<8736>(trS), h1 = tr_read<9824>(trS);
      const s16x4 l2 = tr_read<8768>(trS), h2 = tr_read<9856>(trS);
      const s16x4 l3 = tr_read<8800>(trS), h3 = tr_read<9888>(trS);
      asm volatile("s_waitcnt lgkmcnt(0)" ::: "memory"); __builtin_amdgcn_sched_barrier(0);
      acc[0] = mfma16(A, PK8(l0, h0), acc[0]);
      acc[1] = mfma16(A, PK8(l1, h1), acc[1]);
      acc[2] = mfma16(A, PK8(l2, h2), acc[2]);
      acc[3] = mfma16(A, PK8(l3, h3), acc[3]);
    }
    { const bf16x8 A = ld8(Qs + (16 * mt + lr) * 136 + 64 + 8 * lq);
      const s16x4 l0 = tr_read<17408>(trS), h0 = tr_read<18496>(trS);
      const s16x4 l1 = tr_read<17440>(trS), h1 = tr_read<18528>(trS);
      const s16x4 l2 = tr_read<17472>(trS), h2 = tr_read<18560>(trS);
      const s16x4 l3 = tr_read<17504>(trS), h3 = tr_read<18592>(trS);
      asm volatile("s_waitcnt lgkmcnt(0)" ::: "memory"); __builtin_amdgcn_sched_barrier(0);
      acc[0] = mfma16(A, PK8(l0, h0), acc[0]);
      acc[1] = mfma16(A, PK8(l1, h1), acc[1]);
      acc[2] = mfma16(A, PK8(l2, h2), acc[2]);
      acc[3] = mfma16(A, PK8(l3, h3), acc[3]);
    }
    { const bf16x8 A = ld8(Qs + (16 * mt + lr) * 136 + 96 + 8 * lq);
      const s16x4 l0 = tr_read<26112>(trS), h0 = tr_read<27200>(trS);
      const s16x4 l1 = tr_read<26144>(trS), h1 = tr_read<27232>(trS);
      const s16x4 l2 = tr_read<26176>(trS), h2 = tr_read<27264>(trS);
      const s16x4 l3 = tr_read<26208>(trS), h3 = tr_read<27296>(trS);
      asm volatile("s_waitcnt lgkmcnt(0)" ::: "memory"); __builtin_amdgcn_sched_barrier(0);
      acc[0] = mfma16(A, PK8(l0, h0), acc[0]);
      acc[1] = mfma16(A, PK8(l1, h1), acc[1]);
      acc[2] = mfma16(A, PK8(l2, h2), acc[2]);
      acc[3] = mfma16(A, PK8(l3, h3), acc[3]);
    }
#undef PK8
#pragma unroll
    for (int r = 0; r < 4; ++r) {
        float ss = 0.f;
#pragma unroll
        for (int j = 0; j < 4; ++j) ss += acc[j][r] * acc[j][r];
        ss += __shfl_xor(ss, 1); ss += __shfl_xor(ss, 2); ss += __shfl_xor(ss, 4); ss += __shfl_xor(ss, 8);
        if (lr == 0) red[(16 * mt + 4 * lq + r) * 2 + wh] = ss;
    }
    __syncthreads();
    const float* hgw = p.in[14];
#pragma unroll
    for (int r = 0; r < 4; ++r) {
        const int tl = 16 * mt + 4 * lq + r, t = 64 * n + tl;
        const float rstd = rsqrtf((red[tl * 2] + red[tl * 2 + 1]) * (1.f / 128.f) + EPS);
#pragma unroll
        for (int j = 0; j < 4; ++j) {
            const int dv = 16 * (4 * wh + j) + lr;
            const float gh = bf2f(ghr[r * 4 + j]);
            OHG[(size_t)t * 1024 + h * 128 + dv] = (bf16_t)(pk2(acc[j][r] * rstd * hgw[dv] * silu(gh), 0.f) & 0xffffu);
        }
    }
    __syncthreads();
}
DI void hg_sample_item(const Params& p, const bf16_t* Z, bf16_t* OHG, LAS unsigned char* L, int item) {
    const int b = item >> 3, h = item & 7;
    const int tid = threadIdx.x, dv = tid & 127, dq = tid >> 7;
    LAS float* fS = (LAS float*)L;
    LAS float* kS = fS + 512;
    LAS float* qS = kS + 512;
    LAS float* red = qS + 512;
    LAS float* rs = red + 2048;
    const float* lbp = p.in[13];
    {
        const int t = tid >> 7, dk = tid & 127, m = TP + b * 4 + t;
        const float lb = 1.f / (1.f + __expf(lbp[1024 + h * 128 + dk] - lbp[h * 128 + dk]));
        const float fh = bf2f(Z[(size_t)m * NZ + ZFH + h * 128 + dk]), qh = bf2f(Z[(size_t)m * NZ + ZQH + h * 128 + dk]);
        const float f = lb + (1.f - lb) * sigm(fh);
        fS[tid] = f; kS[tid] = 1.f - f; qS[tid] = silu(qh);
    }
    float S[32];
    const float* s0 = p.in[5] + ((size_t)(b * 8 + h) * 128) * 128;
#pragma unroll
    for (int i = 0; i < 32; ++i) S[i] = s0[(size_t)(dq * 32 + i) * 128 + dv];
    __syncthreads();
#pragma unroll
    for (int t = 0; t < 4; ++t) {
        const int m = TP + b * 4 + t;
        const float v = bf2f(Z[(size_t)m * NZ + ZIH + h * 128 + dv]);
        float part = 0.f;
#pragma unroll
        for (int i = 0; i < 32; ++i) { const int dk = dq * 32 + i; S[i] = fS[t * 128 + dk] * S[i] + kS[t * 128 + dk] * v; part += S[i] * qS[t * 128 + dk]; }
        red[(t * 4 + dq) * 128 + dv] = part;
    }
    float* so = p.out + OFF_HGS + ((size_t)(b * 8 + h) * 128) * 128;
#pragma unroll
    for (int i = 0; i < 32; ++i) so[(size_t)(dq * 32 + i) * 128 + dv] = S[i];
    __syncthreads();
    {
        const int t = tid >> 7, m = TP + b * 4 + t;
        const float o = red[(t * 4 + 0) * 128 + dv] + red[(t * 4 + 1) * 128 + dv] + red[(t * 4 + 2) * 128 + dv] + red[(t * 4 + 3) * 128 + dv];
        const float ss = wave_sum(o * o);
        if ((tid & 63) == 0) rs[tid >> 6] = ss;
        __syncthreads();
        const float rstd = rsqrtf((rs[2 * t] + rs[2 * t + 1]) * (1.f / 128.f) + EPS);
        const float gh = bf2f(Z[(size_t)m * NZ + ZGH + h * 128 + dv]);
        OHG[(size_t)m * 1024 + h * 128 + dv] = (bf16_t)(pk2(o * rstd * p.in[14][dv] * silu(gh), 0.f) & 0xffffu);
    }
    __syncthreads();
}
DI void ph_merge(const bf16_t* OG, const float* LSE, bf16_t* OATT) {
    for (size_t idx = (size_t)blockIdx.x * 512 + threadIdx.x; idx < (size_t)MR * 64; idx += (size_t)gridDim.x * 512) {
        const int m = (int)(idx >> 6), c8 = (int)(idx & 63), hh = c8 >> 4;
        const float l0 = LSE[((size_t)0 * MP + m) * 4 + hh], l1 = LSE[((size_t)1 * MP + m) * 4 + hh], l2 = LSE[((size_t)2 * MP + m) * 4 + hh];
        const float mx = fmaxf(l0, fmaxf(l1, l2));
        float w0 = __expf(l0 - mx), w1 = __expf(l1 - mx), w2 = __expf(l2 - mx);
        const float inv = 1.f / (w0 + w1 + w2); w0 *= inv; w1 *= inv; w2 *= inv;
        float a[8], b[8], c[8];
        unpack8(*(const u32x4*)(OG + ((size_t)0 * MP + m) * 512 + 8 * c8), a);
        unpack8(*(const u32x4*)(OG + ((size_t)1 * MP + m) * 512 + 8 * c8), b);
        unpack8(*(const u32x4*)(OG + ((size_t)2 * MP + m) * 512 + 8 * c8), c);
        u32x4 o;
        o.x = pk2(w0 * a[0] + w1 * b[0] + w2 * c[0], w0 * a[1] + w1 * b[1] + w2 * c[1]);
        o.y = pk2(w0 * a[2] + w1 * b[2] + w2 * c[2], w0 * a[3] + w1 * b[3] + w2 * c[3]);
        o.z = pk2(w0 * a[4] + w1 * b[4] + w2 * c[4], w0 * a[5] + w1 * b[5] + w2 * c[5]);
        o.w = pk2(w0 * a[6] + w1 * b[6] + w2 * c[6], w0 * a[7] + w1 * b[7] + w2 * c[7]);
        *(u32x4*)(OATT + (size_t)m * 512 + 8 * c8) = o;
    }
}
DI void ld8p(const float* s, float (&f)[8]) {
    f32x4 a = {0.f, 0.f, 0.f, 0.f}, b = a;
#pragma unroll
    for (int q = 0; q < NSP_UP; ++q) { a = a + *(const f32x4*)(s + (size_t)q * NS * NAB); b = b + *(const f32x4*)(s + (size_t)q * NS * NAB + 4); }
    f[0] = a[0]; f[1] = a[1]; f[2] = a[2]; f[3] = a[3]; f[4] = b[0]; f[5] = b[1]; f[6] = b[2]; f[7] = b[3];
}
DI void ph_convact(const Params& p, const bf16_t* AB, bf16_t* G) {
    const float* cw = p.in[21]; const float* cb = p.in[22]; const float* sc = p.in[6];
    const float* ACC = (const float*)(p.ws + WS_ACC_UP);
    for (size_t idx = (size_t)blockIdx.x * 512 + threadIdx.x; idx < (size_t)(126 + NS) * 704; idx += (size_t)gridDim.x * 512) {
        const int ri = (int)(idx / 704), c = (int)(idx % 704) * 8;
        const int m = ri < 126 ? 256 * (1 + (ri >> 1)) + (ri & 1) : TP + (ri - 126);
        float a2[8], a1[8], a0[8], bl[8];
        if (m < TP) {
            unpack8(*(const u32x4*)(AB + (size_t)m * NAB + c), a2);
            unpack8(*(const u32x4*)(AB + (size_t)m * NAB + DFF + c), bl);
            if (m >= 1) unpack8(*(const u32x4*)(AB + (size_t)(m - 1) * NAB + c), a1); else { for (int j = 0; j < 8; ++j) a1[j] = 0.f; }
            if (m >= 2) unpack8(*(const u32x4*)(AB + (size_t)(m - 2) * NAB + c), a0); else { for (int j = 0; j < 8; ++j) a0[j] = 0.f; }
        } else {
            const int ms = m - TP, t = ms & 3, b = ms >> 2;
            ld8p(ACC + (size_t)ms * NAB + c, a2);
            ld8p(ACC + (size_t)ms * NAB + DFF + c, bl);
            if (t >= 1) ld8p(ACC + (size_t)(ms - 1) * NAB + c, a1); else ld8f(sc + (size_t)(b * 2 + 1) * DFF + c, a1);
            if (t >= 2) ld8p(ACC + (size_t)(ms - 2) * NAB + c, a0); else ld8f(sc + (size_t)(b * 2 + t) * DFF + c, a0);
            if (t >= 2) { float* d = p.out + OFF_CVS + (size_t)(b * 2 + t - 2) * DFF + c; *(f32x4*)d = (f32x4){a2[0], a2[1], a2[2], a2[3]}; *(f32x4*)(d + 4) = (f32x4){a2[4], a2[5], a2[6], a2[7]}; }
        }
        float w0[8], w1[8], w2[8], bb[8];
        ld8f(cw + c, w0); ld8f(cw + DFF + c, w1); ld8f(cw + 2 * DFF + c, w2); ld8f(cb + c, bb);
        float o[8];
#pragma unroll
        for (int j = 0; j < 8; ++j) { const float u = bb[j] + w0[j] * a0[j] + w1[j] * a1[j] + w2[j] * a2[j]; o[j] = silu(u) * bl[j]; }
        u32x4 w; w.x = pk2(o[0], o[1]); w.y = pk2(o[2], o[3]); w.z = pk2(o[4], o[5]); w.w = pk2(o[6], o[7]);
        *(u32x4*)(G + (size_t)m * DFF + c) = w;
    }
}

DI void ph_mixfix(const Params& p) {
    const bf16_t* Z = (const bf16_t*)(p.ws + WS_Z); const float* PA = (const float*)(p.ws + WS_ACC_PA); const float* PB = (const float*)(p.ws + WS_ACC_PB); bf16_t* Y = (bf16_t*)(p.ws + WS_YMIX);
    for (int idx = blockIdx.x * 512 + threadIdx.x; idx < NS * (D / 4); idx += gridDim.x * 512) {
        const int r = idx / (D / 4), c = (idx % (D / 4)) * 4;
        f32x4 a = {0.f, 0.f, 0.f, 0.f}, b = a;
#pragma unroll
        for (int q = 0; q < NSP_PA; ++q) a = a + *(const f32x4*)(PA + ((size_t)q * NS + r) * D + c);
#pragma unroll
        for (int q = 0; q < NSP_PB; ++q) b = b + *(const f32x4*)(PB + ((size_t)q * NS + r) * D + c);
        const u32x2 ga = *(const u32x2*)(Z + (size_t)(TP + r) * NZ + ZGA + c), gb = *(const u32x2*)(Z + (size_t)(TP + r) * NZ + ZGB + c);
        const float y0 = sigm(bflo(ga.x)) * a[0] + sigm(bflo(gb.x)) * b[0], y1 = sigm(bfhi(ga.x)) * a[1] + sigm(bfhi(gb.x)) * b[1];
        const float y2 = sigm(bflo(ga.y)) * a[2] + sigm(bflo(gb.y)) * b[2], y3 = sigm(bfhi(ga.y)) * a[3] + sigm(bfhi(gb.y)) * b[3];
        u32x2 w; w.x = pk2(y0, y1); w.y = pk2(y2, y3);
        *(u32x2*)(Y + (size_t)(TP + r) * D + c) = w;
    }
}
#define XB_TMO      128
#define XB_XCNT(j)  (256  + 64 * (j))
#define XB_XSUB(j)  (1280 + 64 * (j))
#define XB_XGEN(j)  (2304 + 64 * (j))
#define XB_TOP      3328
#define XB_TOPGEN   3392
#define XCD_BAR_WORDS 3456
#define XB_SPIN_CAP (1u << 18)

__device__ __forceinline__ unsigned xb_ld(unsigned* p)              { return __hip_atomic_load(p, __ATOMIC_RELAXED, __HIP_MEMORY_SCOPE_AGENT); }
__device__ __forceinline__ unsigned xb_add(unsigned* p, unsigned v) { return __hip_atomic_fetch_add(p, v, __ATOMIC_RELAXED, __HIP_MEMORY_SCOPE_AGENT); }
__device__ __forceinline__ unsigned xb_xcc_id() { return (unsigned)__builtin_amdgcn_s_getreg((3 << 11) | 20) & 0xFu; }
#define XB_SPIN(cond, bar) do { unsigned _sp = 0; while (cond) { __builtin_amdgcn_s_sleep(1); \
    if ((++_sp & 255u) == 0u) { if (xb_ld(&(bar)[XB_TMO])) break; if (_sp > XB_SPIN_CAP) { atomicAdd(&(bar)[XB_TMO], 1u); break; } } } } while (0)

struct XcdBarrier {
    unsigned* bar; unsigned x;
    volatile LAS unsigned* st;
};

__device__ __forceinline__ XcdBarrier xcd_barrier_post(unsigned* bar, volatile LAS unsigned* st) {
    XcdBarrier b; b.bar = bar; b.x = xb_xcc_id(); b.st = st;
    if (threadIdx.x == 0) (void)xb_add(&bar[XB_XCNT(b.x)], 1u);
    return b;
}
__device__ __forceinline__ void xcd_barrier_complete(unsigned* bar, unsigned x, unsigned& nloc, unsigned& nx) {
    const unsigned G = gridDim.x * gridDim.y * gridDim.z;
    unsigned sum, cnt, mine, sp = 0u;
    for (;;) {
        sum = 0u; cnt = 0u; mine = 0u;
#pragma unroll
        for (unsigned j = 0; j < 16; ++j) { const unsigned c = xb_ld(&bar[XB_XCNT(j)]); sum += c; cnt += (c > 0u) ? 1u : 0u; mine = (j == x) ? c : mine; }
        if (sum == G) break;
        __builtin_amdgcn_s_sleep(1);
        if ((++sp & 255u) == 0u) { if (xb_ld(&bar[XB_TMO])) break; if (sp > XB_SPIN_CAP) { atomicAdd(&bar[XB_TMO], 1u); break; } }
    }
    nloc = mine > 0u ? mine : 1u; nx = cnt > 0u ? cnt : 1u;
}

__device__ __forceinline__ void xcd_barrier(const XcdBarrier& b) {
    asm volatile("s_waitcnt vmcnt(0)" ::: "memory");
    __syncthreads();
    if (threadIdx.x == 0) {
        unsigned* bar = b.bar;
        __builtin_amdgcn_s_waitcnt(0);
        unsigned nloc = b.st[0], nx = b.st[1];
        if (nloc == 0u) { xcd_barrier_complete(bar, b.x, nloc, nx); b.st[0] = nloc; b.st[1] = nx; }
        const unsigned old = xb_add(&bar[XB_XSUB(b.x)], 1u);
        const unsigned gen = old / nloc;
        if (old + 1u == (gen + 1u) * nloc) {
            __builtin_amdgcn_fence(__ATOMIC_RELEASE, "agent");
            asm volatile("s_waitcnt vmcnt(0)" ::: "memory");
            const unsigned og = xb_add(&bar[XB_TOP], 1u);
            const unsigned tg = og / nx;
            if (og + 1u == (tg + 1u) * nx) xb_add(&bar[XB_TOPGEN], 1u);
            else XB_SPIN(xb_ld(&bar[XB_TOPGEN]) == tg, bar);
            __builtin_amdgcn_fence(__ATOMIC_ACQUIRE, "agent");
            xb_add(&bar[XB_XGEN(b.x)], 1u);
            asm volatile("s_waitcnt vmcnt(0)" ::: "memory");
        } else {
            XB_SPIN(xb_ld(&bar[XB_XGEN(b.x)]) == gen, bar);
            __builtin_amdgcn_fence(__ATOMIC_ACQUIRE, "agent");
            asm volatile("s_waitcnt vmcnt(0)" ::: "memory");
        }
    }
    __syncthreads();
}

template <class Epi> DI void run_gemm(LAS unsigned char* L, const bf16_t* A, const bf16_t* Bt, int N, int K, const Epi& E) {
    pg8::Gemm g{A, Bt, MP, N, K}; pg8::StaticOrder S; S.init(MP, N, K, (int)gridDim.x, (int)blockIdx.x);
    pg8::gemm_phase<Epi, pg8::StaticOrder, false>(L, g, S, E, nullptr);
}
template <class Epi> DI void run_gemm_split(LAS unsigned char* L, const bf16_t* A, const bf16_t* Bt, int N, int K, const Epi& E) {
    pg8::Gemm g{A, Bt, MP, N, K}; pg8::SplitOrder S; S.init(N, K, (int)gridDim.x, (int)blockIdx.x);
    pg8::gemm_phase<Epi, pg8::SplitOrder, false>(L, g, S, E, nullptr);
}

__global__ void __launch_bounds__(512, 2) mega(Params p) {
    extern __shared__ __attribute__((aligned(16))) unsigned char lds[];
    LAS unsigned char* L = (LAS unsigned char*)lds;
    cg::grid_group grid = cg::this_grid();
    unsigned char* ws = p.ws;
    const int lo = p.ph_lo, hi = p.ph_hi;
    const int tid = threadIdx.x, lane = tid & 63, wave = tid >> 6;
    bf16_t* Z = (bf16_t*)(ws + WS_Z);
    bf16_t* H = (bf16_t*)(ws + WS_H);
    float* MOD = (float*)(ws + WS_MOD);
#define IN(k) (lo <= (k) && (k) < hi)
    XcdBarrier xbar; xbar.bar = (unsigned*)ws; xbar.x = 0; xbar.st = (volatile LAS unsigned*)(L + 131072 + 4096);
    if (hi - lo > 1) {
        if (threadIdx.x < 2) xbar.st[threadIdx.x] = 0u;
        __syncthreads();
        xbar = xcd_barrier_post((unsigned*)ws, (volatile LAS unsigned*)(L + 131072 + 4096));
        grid.sync();
    }
#define SEAM(k) do { if (IN(k) && IN((k) + 1)) xcd_barrier(xbar); } while (0)
#define SOFT(k) do { if (IN(k) && IN((k) + 1)) __syncthreads(); } while (0)
    if (IN(0)) ph_prologue(p, L);
    SEAM(0);
    if (IN(1)) ph_hnorm(p, nullptr, false, p.in[11], 0, H);
    SEAM(1);
    if (IN(2)) { EpiZ E{Z, (const float*)(ws + WS_ROPE), p.out, p.in[2], p.in[3], p.in[4]}; run_gemm(L, H, (const bf16_t*)(ws + WS_WIN), NZ, D, E); }
    SEAM(2);
    if (IN(3)) {
        HgaRegs RA;
        int it = blockIdx.x;
        if (it < 2048) hg_passA_load(Z, it, RA);
        while (it < 2048) {
            const int itn = it + gridDim.x; HgaRegs RB;
            if (itn < 2048) hg_passA_load(Z, itn, RB);
            hg_passA_item(p, (float*)(ws + WS_HS), (float*)(ws + WS_HD), L, it, RA);
            RA = RB; it = itn;
        }
    }
    SOFT(3);
    if (IN(4)) {
        const int gw = blockIdx.x * 8 + wave, NGW = gridDim.x * 8;
        LAS bf16_t* Vl = (LAS bf16_t*)(L + wave * 8704);
        for (int base = 0; base < 6144; base += 3 * NGW)
            for (int j = 0; j < 3; ++j) { const int it = base + gw * 3 + j; if (it < 6144) attn_prompt_item(Z, (bf16_t*)(ws + WS_OG), (float*)(ws + WS_LSE), Vl, it, lane); }
    }
    SOFT(4);
    if (IN(5)) { const int gw = blockIdx.x * 8 + wave, NGW = gridDim.x * 8; for (int it = gw; it < 1536; it += NGW) attn_sample_item(p, Z, (bf16_t*)(ws + WS_OG), (float*)(ws + WS_LSE), it, lane); }
    SEAM(5);
    if (IN(6)) hg_scan(p, (float*)(ws + WS_HS), (const float*)(ws + WS_HD));
    SEAM(6);
    if (IN(7)) {
        HgcRegs RA;
        int it = blockIdx.x;
        if (it < 2048) hg_passC_load(Z, (const float*)(ws + WS_HS), it, RA);
        while (it < 2048) {
            const int itn = it + gridDim.x; HgcRegs RB;
            if (itn < 2048) hg_passC_load(Z, (const float*)(ws + WS_HS), itn, RB);
            hg_passC_item(p, Z, (bf16_t*)(ws + WS_OHG), L, it, RA);
            RA = RB; it = itn;
        }
    }
    SOFT(7);
    if (IN(8)) for (int it = blockIdx.x; it < 256; it += gridDim.x) hg_sample_item(p, Z, (bf16_t*)(ws + WS_OHG), L, it);
    SOFT(8);
    if (IN(9)) ph_merge((const bf16_t*)(ws + WS_OG), (const float*)(ws + WS_LSE), (bf16_t*)(ws + WS_OATT));
    SEAM(9);
    if (IN(10)) {
        { EpiMix1 E{Z, (float*)(ws + WS_TMP), (float*)(ws + WS_ACC_PA)}; run_gemm_split(L, (const bf16_t*)(ws + WS_OATT), (const bf16_t*)(ws + WS_WPA), D, 512, E); }
        { EpiMix2 E{Z, (const float*)(ws + WS_TMP), (bf16_t*)(ws + WS_YMIX), (float*)(ws + WS_ACC_PB)}; run_gemm_split(L, (const bf16_t*)(ws + WS_OHG), (const bf16_t*)(ws + WS_WPB), D, 1024, E); }
    }
    SEAM(10);
    if (IN(11)) ph_mixfix(p);
    SEAM(11);
    if (IN(12)) { EpiWO E{p.in[0], p.in[1], MOD, p.out, (float*)(ws + WS_ACC_WO)}; run_gemm_split(L, (const bf16_t*)(ws + WS_YMIX), (const bf16_t*)(ws + WS_WO), D, D, E); }
    SEAM(12);
    if (IN(13)) ph_hnorm(p, p.out, true, p.in[18], 3, H);
    SEAM(13);
    if (IN(14)) { EpiUp E{(bf16_t*)(ws + WS_AB), (bf16_t*)(ws + WS_G), p.out, (float*)(ws + WS_ACC_UP), p.in[21], p.in[22], (LAS float*)(L + 131072)}; run_gemm_split(L, H, (const bf16_t*)(ws + WS_WAB), NAB, D, E); }
    SEAM(14);
    if (IN(15)) ph_convact(p, (const bf16_t*)(ws + WS_AB), (bf16_t*)(ws + WS_G));
    SEAM(15);
    if (IN(16)) { EpiDown E{MOD, p.out, (float*)(ws + WS_ACC_DN)}; run_gemm_split(L, (const bf16_t*)(ws + WS_G), (const bf16_t*)(ws + WS_WDN), D, DFF, E); }
    SEAM(16);
    if (IN(17)) ph_final_norm(p);
#undef IN
#undef SEAM
#undef SOFT
}

#ifndef MK_MULTI
#define MK_MULTI 0
#endif
extern "C" void kernel_launch(void* const* d_in, const int* in_sizes, int n_in, void* d_out, int out_size, void* d_ws, size_t ws_size, hipStream_t stream) {
    static int grid = 0;
    if (grid == 0) {
        if (n_in != 25 || (size_t)out_size != OUT_TOTAL || ws_size < WS_END) { fprintf(stderr, "kernel_launch: unexpected shapes: n_in %d out %d ws %zu (need %zu)\n", n_in, out_size, ws_size, (size_t)WS_END); grid = -1; return; }
        int dev = 0, cus = 0, per_cu = 0;
        hipGetDevice(&dev);
        hipDeviceGetAttribute(&cus, hipDeviceAttributeMultiprocessorCount, dev);
        if (hipFuncSetAttribute((const void*)mega, hipFuncAttributeMaxDynamicSharedMemorySize, LDS_BYTES) != hipSuccess) { fprintf(stderr, "kernel_launch: hipFuncSetAttribute failed\n"); grid = -1; return; }
        if (hipOccupancyMaxActiveBlocksPerMultiprocessor(&per_cu, (const void*)mega, 512, LDS_BYTES) != hipSuccess || per_cu < 1) { fprintf(stderr, "kernel_launch: occupancy query failed (%d)\n", per_cu); (void)hipGetLastError(); per_cu = 1; }
        grid = cus * 1;
        if (grid < 1) grid = -1;
    }
    if (grid < 0) return;
    Params p{};
    for (int i = 0; i < 25; ++i) p.in[i] = (const float*)d_in[i];
    p.out = (float*)d_out; p.ws = (unsigned char*)d_ws;
#ifndef DUP_MASK
#define DUP_MASK 0
#endif
#if MK_MULTI
    for (int ph = 0; ph < NPH; ++ph) for (int rep = 0; rep < (((DUP_MASK >> ph) & 1) ? 2 : 1); ++rep) { p.ph_lo = ph; p.ph_hi = ph + 1; hipLaunchKernelGGL(mega, dim3(grid), dim3(512), LDS_BYTES, stream, p); }
#else
    p.ph_lo = 0; p.ph_hi = NPH;
    if (hipMemsetAsync(d_ws, 0, 16384, stream) != hipSuccess) { fprintf(stderr, "kernel_launch: memset of the barrier words failed\n"); return; }
    void* args[] = {&p};
    hipError_t e = hipLaunchCooperativeKernel((const void*)mega, dim3(grid), dim3(512), args, LDS_BYTES, stream);
    if (e != hipSuccess) fprintf(stderr, "cooperative launch failed: %s (grid %d)\n", hipGetErrorString(e), grid);
#endif
}
```

```cpp
#include <hip/hip_runtime.h>
#include <hip/hip_cooperative_groups.h>
#include <cstdio>
namespace cg = cooperative_groups;
namespace pg8 {
#define PG8_LAS __attribute__((address_space(3)))
typedef unsigned short bf16_t;
typedef short bf16x8 __attribute__((ext_vector_type(8)));
typedef float f32x4 __attribute__((ext_vector_type(4)));
typedef unsigned u32x4 __attribute__((ext_vector_type(4)));
constexpr int BM = 256, BK = 64, HALF = 128, HTB = HALF * BK * 2  , STAGE_BYTES = 8 * HTB, NXCD = 8, WGM = 8;

__host__ __device__ __forceinline__ int lds_byte(int r, int c) { const int st = (r >> 4) * 2 + (c >> 5), rr = r & 15, cc = c & 31, ob = rr * 64 + cc * 2; return st * 1024 + (ob ^ (((ob >> 9) & 1) << 5)); }
__host__ __device__ __forceinline__ void stage_rc(int b, int& R, int& C) { const int st = b / 1024, sb = b % 1024, swz = sb ^ (((sb >> 9) & 1) << 5); R = (st >> 1) * 16 + swz / 64; C = (st & 1) * 32 + (swz % 64) / 2; }
__host__ __device__ __forceinline__ int perm32(int rho) { const int n = rho >> 4, i = rho & 15; return 8 * (i >> 2) + 4 * n + (i & 3); }

struct Unit { int pm, pn, kt0, nkt; };
struct Gemm { const bf16_t* A; const bf16_t* Bt; int M, N, K; };

struct StaticOrder {
    int nM, nN, nwg, G, c, nkt;
    __host__ __device__ void init(int M, int N, int K, int G_, int c_) { nM = M / BM; nN = N / BM; nwg = nM * nN; G = G_; c = c_; nkt = K / BK; }
    __host__ __device__ bool next(int i, Unit& u) const {
        const long L = (long)i * G + c; if (L >= nwg) return false;
        int wgid = (int)L; { const int q = nwg / NXCD, r = nwg % NXCD, xcd = wgid % NXCD, off = wgid / NXCD; wgid = (xcd < r ? xcd * (q + 1) : r * (q + 1) + (xcd - r) * q) + off; }
        const int nig = WGM * nN, gid = wgid / nig, fm = gid * WGM, gsz = (nM - fm) < WGM ? (nM - fm) : WGM;
        u.pm = fm + ((wgid % nig) % gsz); u.pn = (wgid % nig) / gsz; u.kt0 = 0; u.nkt = nkt; return true;
    }
    __device__ __forceinline__ void a_ready(const Unit&) const {}
    __device__ __forceinline__ void done(const Unit&) const {}
};
struct SplitOrder {
    int nN, nwg, G, c, nkt, nsp;
    __host__ __device__ void init(int N, int K, int G_, int c_) { nN = N / BM; nwg = 64 * nN; G = G_; c = c_; nkt = K / BK; nsp = nkt / 4; }
    __host__ __device__ bool next(int i, Unit& u) const {
        const long L = (long)i * G + c;
        if (L < nwg) {
            int wgid = (int)L; { const int q = nwg / NXCD, r = nwg % NXCD, xcd = wgid % NXCD, off = wgid / NXCD; wgid = (xcd < r ? xcd * (q + 1) : r * (q + 1) + (xcd - r) * q) + off; }
            const int nig = WGM * nN, gid = wgid / nig, fm = gid * WGM, gsz = (64 - fm) < WGM ? (64 - fm) : WGM;
            u.pm = fm + ((wgid % nig) % gsz); u.pn = (wgid % nig) / gsz; u.kt0 = 0; u.nkt = nkt; return true;
        }
        const long j = L - nwg; if (j >= (long)nN * nsp) return false;
        u.pm = 64; u.pn = (int)(j % nN); u.kt0 = 4 * (int)(j / nN); u.nkt = 4; return true;
    }
    __device__ __forceinline__ void a_ready(const Unit&) const {}
    __device__ __forceinline__ void done(const Unit&) const {}
};
template <class Epi, class Sched, bool STAMP = false>
__device__ __forceinline__ void gemm_phase(PG8_LAS unsigned char* lds, const Gemm g, const Sched& S, const Epi& E, unsigned long long* stamps) {
    const int tid = threadIdx.x, wid = __builtin_amdgcn_readfirstlane(tid >> 6), lane = tid & 63, wr = wid >> 2, wc = wid & 3, fr = lane & 15, fq = lane >> 4;
    const int K = g.K;
    int ts_lo = 0, ts_hi = 0, nts = 0; const unsigned long long rt_entry = STAMP ? (unsigned long long)wall_clock64() : 0ull;
#define PG8_STAMP() do { if (STAMP && wid == 0 && nts < 64) { const unsigned long long _c = (unsigned long long)clock64(); \
        ts_lo = (lane == nts) ? (int)(unsigned)_c : ts_lo; ts_hi = (lane == nts) ? (int)(unsigned)(_c >> 32) : ts_hi; ++nts; } } while (0)
    PG8_STAMP();
    unsigned voffA[2], voffB[2];
#pragma unroll
    for (int i = 0; i < 2; ++i) { int R, C; stage_rc(tid * 16 + i * 8192, R, C); const int Rb = Epi::PERM ? ((R & ~31) + perm32(R & 31)) : R;
        voffA[i] = (unsigned)(R * K + C) * 2u; voffB[i] = (unsigned)(Rb * K + C) * 2u; }
    const size_t kstep = (size_t)(BK * 2);
    const size_t hstep = (size_t)HALF * K * 2;
    const size_t tstep = 2 * hstep;
    const unsigned ldsw = (unsigned)wid * 1024u;
    const int aoff = lds_byte(wr * 64 + fr, fq * 8), boff = lds_byte(wc * 32 + fr, fq * 8);
#define PG8_SA(b, h) (((b) * 2 + (h)) * HTB)
#define PG8_SB(b, h) ((4 + (b) * 2 + (h)) * HTB)
#define PG8_STAGE(bufoff, gbase, voff) do { _Pragma("unroll") for (int _i = 0; _i < 2; ++_i) \
        __builtin_amdgcn_global_load_lds((const unsigned*)((const char*)(gbase) + (voff)[_i]), (PG8_LAS unsigned*)(lds + (bufoff) + ldsw + _i * 8192), 16, 0, 0); } while (0)
#define PG8_LDA(dst, b, h) do { _Pragma("unroll") for (int m = 0; m < 4; ++m) _Pragma("unroll") for (int k = 0; k < 2; ++k) dst[m][k] = *(const PG8_LAS bf16x8*)(lds + PG8_SA(b, h) + aoff + m * 2048 + k * 1024); } while (0)
#define PG8_LDB(dst, b, h) do { _Pragma("unroll") for (int n = 0; n < 2; ++n) _Pragma("unroll") for (int k = 0; k < 2; ++k) dst[n][k] = *(const PG8_LAS bf16x8*)(lds + PG8_SB(b, h) + boff + n * 2048 + k * 1024); } while (0)
#define PG8_MMA(ai, bj, At, Bt) do { __builtin_amdgcn_s_setprio(1); _Pragma("unroll") for (int m = 0; m < 4; ++m) _Pragma("unroll") for (int n = 0; n < 2; ++n) _Pragma("unroll") for (int k = 0; k < 2; ++k) \
        acc[ai][bj][m][n] = __builtin_amdgcn_mfma_f32_16x16x32_bf16(Bt[n][k], At[m][k], acc[ai][bj][m][n], 0, 0, 0); __builtin_amdgcn_s_setprio(0); } while (0)
#define PG8_WAIT_V(n) asm volatile("s_waitcnt vmcnt(" #n ")" ::: "memory")
#define PG8_WAIT_L(n) asm volatile("s_waitcnt lgkmcnt(" #n ")" ::: "memory")
#define PG8_BAR __builtin_amdgcn_s_barrier()
#define PG8_SCHED __builtin_amdgcn_sched_barrier(0)
    Unit cur, nxt; int ui = 0;
    if (!S.next(0, cur)) return;
    f32x4 acc[2][2][4][2];
#pragma unroll
    for (int a = 0; a < 2; ++a)
#pragma unroll
        for (int b = 0; b < 2; ++b)
#pragma unroll
            for (int m = 0; m < 4; ++m)
#pragma unroll
                for (int n = 0; n < 2; ++n) acc[a][b][m][n] = (f32x4){0.f, 0.f, 0.f, 0.f};
    bf16x8 At[4][2], B0[2][2], B1[2][2];
    const char* cA = (const char*)g.A + (size_t)cur.pm * tstep + (size_t)cur.kt0 * kstep; const char* cB = (const char*)g.Bt + (size_t)cur.pn * tstep + (size_t)cur.kt0 * kstep;
    S.a_ready(cur);
    PG8_STAGE(PG8_SB(0, 0), cB, voffB); PG8_STAGE(PG8_SA(0, 0), cA, voffA); PG8_STAGE(PG8_SB(0, 1), cB + hstep, voffB); PG8_STAGE(PG8_SA(0, 1), cA + hstep, voffA);
    if (wr == 1) PG8_BAR;
    PG8_WAIT_V(4); PG8_BAR;
    PG8_STAGE(PG8_SB(1, 0), cB + kstep, voffB); PG8_STAGE(PG8_SA(1, 0), cA + kstep, voffA); PG8_STAGE(PG8_SB(1, 1), cB + hstep + kstep, voffB);
    PG8_WAIT_V(6); PG8_BAR;
    PG8_STAMP();
    for (;;) {
        const bool has_next = S.next(ui + 1, nxt);
        const char* nA = has_next ? (const char*)g.A + (size_t)nxt.pm * tstep + (size_t)nxt.kt0 * kstep : cA; const char* nB = has_next ? (const char*)g.Bt + (size_t)nxt.pn * tstep + (size_t)nxt.kt0 * kstep : cB;
        const int nt = cur.nkt;
        for (int t = 0; t < nt; t += 2) {
            const bool last = (t == nt - 2);
            const char* a1 = cA + (size_t)(t + 1) * kstep;
            const char* a2 = last ? nA : cA + (size_t)(t + 2) * kstep; const char* b2 = last ? nB : cB + (size_t)(t + 2) * kstep;
            const char* a3 = a2 + kstep; const char* b3 = b2 + kstep;
            if (last && has_next) S.a_ready(nxt);
            PG8_LDB(B0, 0, 0); PG8_SCHED; PG8_LDA(At, 0, 0); PG8_STAGE(PG8_SA(1, 1), a1 + hstep, voffA);
            PG8_WAIT_L(8); PG8_BAR; PG8_WAIT_L(0); PG8_MMA(0, 0, At, B0); PG8_BAR; PG8_SCHED;
            PG8_LDB(B1, 0, 1); PG8_STAGE(PG8_SB(0, 0), b2, voffB);
            PG8_BAR; PG8_WAIT_L(0); PG8_MMA(0, 1, At, B1); PG8_BAR;
            PG8_LDA(At, 0, 1); PG8_STAGE(PG8_SA(0, 0), a2, voffA);
            PG8_BAR; PG8_WAIT_L(0); PG8_MMA(1, 0, At, B0); PG8_BAR; PG8_SCHED;
            PG8_STAGE(PG8_SB(0, 1), b2 + hstep, voffB);
            PG8_WAIT_V(6); PG8_BAR; PG8_MMA(1, 1, At, B1); PG8_BAR;
            PG8_LDB(B0, 1, 0); PG8_SCHED; PG8_LDA(At, 1, 0); PG8_STAGE(PG8_SA(0, 1), a2 + hstep, voffA);
            PG8_WAIT_L(8); PG8_BAR; PG8_WAIT_L(0); PG8_MMA(0, 0, At, B0); PG8_BAR; PG8_SCHED;
            PG8_LDB(B1, 1, 1); PG8_STAGE(PG8_SB(1, 0), b3, voffB);
            PG8_BAR; PG8_WAIT_L(0); PG8_MMA(0, 1, At, B1); PG8_BAR;
            PG8_LDA(At, 1, 1); PG8_STAGE(PG8_SA(1, 0), a3, voffA);
            PG8_BAR; PG8_WAIT_L(0); PG8_MMA(1, 0, At, B0); PG8_BAR; PG8_SCHED;
            PG8_STAGE(PG8_SB(1, 1), b3 + hstep, voffB);
            PG8_WAIT_V(6); PG8_BAR; PG8_MMA(1, 1, At, B1); PG8_BAR;
        }
        PG8_STAMP();
        if constexpr (!Epi::AFTER_DRAIN) { E(acc, cur, wr, wc, fr, fq); S.done(cur); }
        PG8_STAMP();
        if (!has_next) break;
#pragma unroll
        for (int a = 0; a < 2; ++a)
#pragma unroll
            for (int b = 0; b < 2; ++b)
#pragma unroll
                for (int m = 0; m < 4; ++m)
#pragma unroll
                    for (int n = 0; n < 2; ++n) acc[a][b][m][n] = (f32x4){0.f, 0.f, 0.f, 0.f};
        cur = nxt; cA = nA; cB = nB; ++ui;
    }
    PG8_WAIT_V(0);
    if (wr == 0) PG8_BAR;
    PG8_BAR;
    if constexpr (Epi::AFTER_DRAIN) { E.fused(acc, cur, wr, wc, fr, fq, lds, wid, lane); S.done(cur); }
    PG8_STAMP();
    if (STAMP && wid == 0) { stamps[lane] = lane < nts ? (((unsigned long long)(unsigned)ts_hi << 32) | (unsigned)ts_lo) : 0ull;
        if (lane == 62) stamps[62] = rt_entry; if (lane == 63) stamps[63] = (unsigned long long)wall_clock64(); }
#undef PG8_STAMP
#undef PG8_SA
#undef PG8_SB
#undef PG8_STAGE
#undef PG8_LDA
#undef PG8_LDB
#undef PG8_MMA
#undef PG8_WAIT_V
#undef PG8_WAIT_L
#undef PG8_BAR
#undef PG8_SCHED
}
}

using pg8::bf16_t; using pg8::bf16x8; using pg8::f32x4; using pg8::Unit;
#define LAS __attribute__((address_space(3)))
#define DI __device__ __forceinline__
typedef float f32x16 __attribute__((ext_vector_type(16)));
typedef float f32x2 __attribute__((ext_vector_type(2)));
typedef unsigned u32x4 __attribute__((ext_vector_type(4)));
typedef unsigned u32x2 __attribute__((ext_vector_type(2)));

constexpr int D = 2048, TP = 16384, NS = 128, MR = TP + NS, MP = 16640;
constexpr int NZ = 12800, DFF = 5632, NAB = 2 * DFF;
constexpr int ZQ = 0, ZK = 1536, ZV = 3072, ZQH = 4608, ZFH = 5632, ZIH = 6656, ZGH = 7680, ZGA = 8704, ZGB = 10752;
constexpr int NMODROW = 33, NMOD = 6 * D;
constexpr float EPS = 1e-6f;
constexpr float ATT_SCALE = 0.08838834764831845f;
constexpr size_t OFF_Y = 0;
constexpr size_t OFF_KVP0 = (size_t)MR * D;
constexpr size_t OFF_KVP1 = OFF_KVP0 + 128 * 1024;
constexpr size_t OFF_KVP2 = OFF_KVP1 + 512 * 1024;
constexpr size_t OFF_HGP = OFF_KVP2 + 2048 * 1024;
constexpr size_t OFF_CVP = OFF_HGP + 8 * 128 * 128;
constexpr size_t OFF_KVS0 = OFF_CVP + 2 * DFF;
constexpr size_t OFF_KVS1 = OFF_KVS0 + (size_t)32 * 128 * 1024;
constexpr size_t OFF_KVS2 = OFF_KVS1 + (size_t)32 * 512 * 1024;
constexpr size_t OFF_HGS = OFF_KVS2 + (size_t)32 * 2048 * 1024;
constexpr size_t OFF_CVS = OFF_HGS + (size_t)32 * 8 * 128 * 128;
constexpr size_t OUT_TOTAL = OFF_CVS + (size_t)32 * 2 * DFF;
static_assert(OUT_TOTAL == 129346560, "output size");
constexpr size_t WS_WIN = 1u << 20;
constexpr size_t WS_WPA = WS_WIN + (size_t)NZ * D * 2;
constexpr size_t WS_WPB = WS_WPA + (size_t)2048 * 512 * 2;
constexpr size_t WS_WO = WS_WPB + (size_t)2048 * 1024 * 2;
constexpr size_t WS_WAB = WS_WO + (size_t)2048 * 2048 * 2;
constexpr size_t WS_WDN = WS_WAB + (size_t)NAB * D * 2;
constexpr size_t WS_MOD = WS_WDN + (size_t)D * DFF * 2;
constexpr size_t WS_ROPE = WS_MOD + (size_t)NMODROW * NMOD * 4;
constexpr size_t WS_Z = WS_ROPE + (size_t)MP * 32 * 4;
constexpr size_t WS_AB = WS_Z;
constexpr size_t WS_H = WS_Z + (size_t)MP * NZ * 2;
constexpr size_t WS_OG = WS_H + (size_t)MP * D * 2;
constexpr size_t WS_LSE = WS_OG + (size_t)3 * MP * 512 * 2;
constexpr size_t WS_OATT = WS_LSE + (size_t)3 * MP * 4 * 4;
constexpr size_t WS_OHG = WS_OATT + (size_t)MP * 512 * 2;
constexpr size_t WS_YMIX = WS_OHG + (size_t)MP * 1024 * 2;
constexpr size_t WS_BLK_END = WS_YMIX + (size_t)MP * D * 2;
constexpr size_t WS_G = WS_OG;
static_assert(WS_G + (size_t)MP * DFF * 2 <= WS_BLK_END + (32u << 20), "g overlay");
static_assert((size_t)MP * NAB * 2 <= (size_t)MP * NZ * 2, "ab overlay");
constexpr size_t WS_HS = WS_BLK_END;
constexpr size_t WS_HD = WS_HS + (size_t)256 * 8 * 128 * 128 * 4;
constexpr size_t WS_TMP = WS_HS;
constexpr size_t WS_ACC_WO = WS_Z;
constexpr size_t WS_ACC_DN = WS_Z;
constexpr size_t WS_ACC_UP = WS_TMP + (64u << 20);
constexpr int NSP_WO = 8, NSP_DN = 22, NSP_UP = 8, NSP_PA = 2, NSP_PB = 4;
constexpr size_t WS_ACC_PA = WS_H, WS_ACC_PB = WS_H + (size_t)NSP_PA * NS * D * 4;
static_assert((size_t)NSP_UP * NS * NAB * 4 + (64u << 20) <= (size_t)MP * D * 4, "up partials");
constexpr size_t WS_HS2 = WS_TMP + (size_t)MP * D * 4 + (1u << 20);
constexpr size_t WS_END = WS_HS2 + (size_t)256 * 8 * 128 * 128 * 2 + (1u << 20);
static_assert(WS_HD + (size_t)256 * 8 * 128 * 4 <= WS_END, "hd");
static_assert(WS_WIN % 256 == 0 && WS_MOD % 256 == 0 && WS_ROPE % 256 == 0 && WS_Z % 256 == 0 && WS_H % 256 == 0 && WS_OG % 256 == 0 && WS_LSE % 256 == 0 && WS_OATT % 256 == 0 && WS_OHG % 256 == 0 && WS_YMIX % 256 == 0 && WS_HS % 256 == 0 && WS_HD % 256 == 0, "align");
constexpr int LDS_BYTES = 131072 + 4096 + 256;
constexpr int NPH = 18;

struct Params { const float* in[25]; float* out; unsigned char* ws; int ph_lo, ph_hi; };

DI float bf2f(unsigned b) { return __uint_as_float(b << 16); }
DI float bflo(unsigned w) { return __uint_as_float(w << 16); }
DI float bfhi(unsigned w) { return __uint_as_float(w & 0xffff0000u); }
DI unsigned pk2(float lo, float hi) { unsigned r; asm("v_cvt_pk_bf16_f32 %0, %1, %2" : "=v"(r) : "v"(lo), "v"(hi)); return r; }
DI float sigm(float x) { return __builtin_amdgcn_rcpf(1.f + __expf(-x)); }
DI float silu(float x) { return x * __builtin_amdgcn_rcpf(1.f + __expf(-x)); }
DI float wave_sum(float v) {
#pragma unroll
    for (int o = 32; o >= 1; o >>= 1) v += __shfl_xor(v, o);
    return v;
}
DI float wave_max(float v) {
#pragma unroll
    for (int o = 32; o >= 1; o >>= 1) v = fmaxf(v, __shfl_xor(v, o));
    return v;
}
DI void lds_fence() { asm volatile("s_waitcnt lgkmcnt(0)" ::: "memory"); __builtin_amdgcn_wave_barrier(); }
DI bf16x8 gat8(const LAS bf16_t* p, int stride) {
    bf16x8 r;
#pragma unroll
    for (int j = 0; j < 8; ++j) r[j] = (short)p[j * stride];
    return r;
}
DI bf16x8 ld8(const LAS bf16_t* p) { return *(const LAS bf16x8*)p; }
typedef short s16x4 __attribute__((ext_vector_type(4)));
template <int OFF> DI s16x4 tr_read(unsigned vb) { s16x4 r; asm volatile("ds_read_b64_tr_b16 %0, %1 offset:%2" : "=&v"(r) : "v"(vb), "i"(OFF) : "memory"); return r; }
DI f32x4 mfma16(bf16x8 a, bf16x8 b, f32x4 c) { return __builtin_amdgcn_mfma_f32_16x16x32_bf16(a, b, c, 0, 0, 0); }
DI f32x16 mfma32(bf16x8 a, bf16x8 b, f32x16 c) { return __builtin_amdgcn_mfma_f32_32x32x16_bf16(a, b, c, 0, 0, 0); }
DI void unpack8(u32x4 w, float (&f)[8]) { f[0] = bflo(w.x); f[1] = bfhi(w.x); f[2] = bflo(w.y); f[3] = bfhi(w.y); f[4] = bflo(w.z); f[5] = bfhi(w.z); f[6] = bflo(w.w); f[7] = bfhi(w.w); }
DI void atom_add(float* p, float v) { (void)__hip_atomic_fetch_add(p, v, __ATOMIC_RELAXED, __HIP_MEMORY_SCOPE_AGENT); }
DI void ld8f(const float* s, float (&f)[8]) { const f32x4 a = *(const f32x4*)s, b = *(const f32x4*)(s + 4); f[0] = a[0]; f[1] = a[1]; f[2] = a[2]; f[3] = a[3]; f[4] = b[0]; f[5] = b[1]; f[6] = b[2]; f[7] = b[3]; }
DI int crow_of(int r) { return r < TP ? 0 : 1 + ((r - TP) >> 2); }

struct EpiZ {
    static constexpr bool PERM = true, AFTER_DRAIN = false;
    bf16_t* Z; const float* rope; float* out; const float* c0; const float* c1; const float* c2;
    static constexpr int CPY_R0 = 32 * 124, CPY_R1 = 32 * 508, CPY_R2 = 32 * 2044, CPY_ROWS = CPY_R0 + CPY_R1 + CPY_R2, CPY_PER = 28;
    DI void cpy_row(int r, const float*& src, float*& dst) const {
        if (r < CPY_R0) { const int b = r / 124, rr = r - b * 124; src = c0 + ((size_t)(b * 128 + rr + 4)) * 1024; dst = out + OFF_KVS0 + ((size_t)(b * 128 + rr)) * 1024; }
        else if (r < CPY_R0 + CPY_R1) { r -= CPY_R0; const int b = r / 508, rr = r - b * 508; src = c1 + ((size_t)(b * 512 + rr + 4)) * 1024; dst = out + OFF_KVS1 + ((size_t)(b * 512 + rr)) * 1024; }
        else { r -= CPY_R0 + CPY_R1; const int b = r / 2044, rr = r - b * 2044; src = c2 + ((size_t)(b * 2048 + rr + 4)) * 1024; dst = out + OFF_KVS2 + ((size_t)(b * 2048 + rr)) * 1024; }
    }
    DI void operator()(const f32x4 (&acc)[2][2][4][2], const Unit& u, int wr, int wc, int fr, int fq) const {
        {
            int l4 = (wc * 64 + fq * 16 + fr) * 4; asm volatile("" : "+v"(l4));
            const int r0 = (u.pm * 50 + u.pn) * CPY_PER;
#pragma unroll
            for (int h2 = 0; h2 < 2; ++h2) {
                f32x4 v[7];
#pragma unroll
                for (int q = 0; q < 7; ++q) { int r = r0 + (h2 * 7 + q) * 2 + wr; r = r < CPY_ROWS ? r : r - CPY_ROWS; const float* sp; float* dp; cpy_row(r, sp, dp); v[q] = __builtin_nontemporal_load((const f32x4*)(sp + l4)); }
#pragma unroll
                for (int q = 0; q < 7; ++q) { int r = r0 + (h2 * 7 + q) * 2 + wr; r = r < CPY_ROWS ? r : r - CPY_ROWS; const float* sp; float* dp; cpy_row(r, sp, dp); __builtin_nontemporal_store(v[q], (f32x4*)(dp + l4)); }
            }
        }
        const int kind = u.pn < 6 ? 0 : (u.pn < 12 ? 1 : (u.pn < 18 ? 2 : 3));
        const bool do_rope = (kind <= 1) && (wc == 0);
        const int pnn = (kind == 1) ? u.pn - 6 : u.pn - 12;
        const int g = pnn >> 1, W = 128 << (2 * g);
        const size_t offp = g == 0 ? OFF_KVP0 : (g == 1 ? OFF_KVP1 : OFF_KVP2), offs = g == 0 ? OFF_KVS0 : (g == 1 ? OFF_KVS1 : OFF_KVS2);
        const float sg = (fq < 2) ? -1.f : 1.f;
#pragma unroll
        for (int ai = 0; ai < 2; ++ai)
#pragma unroll
            for (int m = 0; m < 4; ++m) {
                const int r = u.pm * 256 + ai * 128 + wr * 64 + m * 16 + fr;
                f32x4 cs0 = {0.f, 0.f, 0.f, 0.f}, cs1 = cs0, sn0 = cs0, sn1 = cs0;
                if (do_rope) { const float* rp = rope + (size_t)r * 32 + 8 * (fq & 1); cs0 = *(const f32x4*)rp; cs1 = *(const f32x4*)(rp + 4); sn0 = *(const f32x4*)(rp + 16); sn1 = *(const f32x4*)(rp + 20); }
#pragma unroll
                for (int bj = 0; bj < 2; ++bj) {
                    f32x4 v0 = acc[ai][bj][m][0], v1 = acc[ai][bj][m][1];
                    if (do_rope) {
                        f32x4 p0, p1;
#pragma unroll
                        for (int j = 0; j < 4; ++j) { p0[j] = __shfl_xor(v0[j], 32); p1[j] = __shfl_xor(v1[j], 32); }
                        v0 = v0 * cs0 + sg * (p0 * sn0); v1 = v1 * cs1 + sg * (p1 * sn1);
                    }
                    const int c = u.pn * 256 + bj * 128 + wc * 32 + 8 * fq;
                    u32x4 w; w.x = pk2(v0[0], v0[1]); w.y = pk2(v0[2], v0[3]); w.z = pk2(v1[0], v1[1]); w.w = pk2(v1[2], v1[3]);
                    *(u32x4*)(Z + (size_t)r * NZ + c) = w;
                    if (kind == 1 || kind == 2) {
                        const int hh = 2 * (pnn & 1) + bj, dd = wc * 32 + 8 * fq, kv = kind - 1;
                        if (u.pm < 64) {
                            if (256 * u.pm + 128 * ai >= TP - W) { float* dst = out + offp + ((size_t)(r - (TP - W)) * 2 + kv) * 512 + hh * 128 + dd; *(f32x4*)dst = v0; *(f32x4*)(dst + 4) = v1; }
                        } else if (ai == 0) {
                            const int b = (r - TP) >> 2, t = (r - TP) & 3; float* dst = out + offs + ((size_t)(b * W + W - 4 + t) * 2 + kv) * 512 + hh * 128 + dd; *(f32x4*)dst = v0; *(f32x4*)(dst + 4) = v1;
                        }
                    }
                }
            }
    }
};
struct EpiMix1 {
    static constexpr bool PERM = false, AFTER_DRAIN = false;
    const bf16_t* Z; float* TMP; float* accs;
    DI void operator()(const f32x4 (&acc)[2][2][4][2], const Unit& u, int wr, int wc, int fr, int fq) const {
        if (u.pm == 64) {
#pragma unroll
            for (int m = 0; m < 4; ++m)
#pragma unroll
                for (int bj = 0; bj < 2; ++bj)
#pragma unroll
                    for (int n = 0; n < 2; ++n) *(f32x4*)(accs + ((size_t)(u.kt0 >> 2) * NS + (wr * 64 + m * 16 + fr)) * D + u.pn * 256 + bj * 128 + wc * 32 + 16 * n + 4 * fq) = acc[0][bj][m][n];
            return;
        }
#pragma unroll
        for (int ai = 0; ai < 2; ++ai)
#pragma unroll
            for (int m = 0; m < 4; ++m) {
                const int r = u.pm * 256 + ai * 128 + wr * 64 + m * 16 + fr;
#pragma unroll
                for (int bj = 0; bj < 2; ++bj)
#pragma unroll
                    for (int n = 0; n < 2; ++n) {
                        const int c = u.pn * 256 + bj * 128 + wc * 32 + 16 * n + 4 * fq;
                        const u32x2 gw = *(const u32x2*)(Z + (size_t)r * NZ + ZGA + c);
                        f32x4 v = acc[ai][bj][m][n];
                        v[0] *= sigm(bflo(gw.x)); v[1] *= sigm(bfhi(gw.x)); v[2] *= sigm(bflo(gw.y)); v[3] *= sigm(bfhi(gw.y));
                        *(f32x4*)(TMP + (size_t)r * D + c) = v;
                    }
            }
    }
};
struct EpiMix2 {
    static constexpr bool PERM = false, AFTER_DRAIN = false;
    const bf16_t* Z; const float* TMP; bf16_t* Y; float* accs;
    DI void operator()(const f32x4 (&acc)[2][2][4][2], const Unit& u, int wr, int wc, int fr, int fq) const {
        if (u.pm == 64) {
#pragma unroll
            for (int m = 0; m < 4; ++m)
#pragma unroll
                for (int bj = 0; bj < 2; ++bj)
#pragma unroll
                    for (int n = 0; n < 2; ++n) *(f32x4*)(accs + ((size_t)(u.kt0 >> 2) * NS + (wr * 64 + m * 16 + fr)) * D + u.pn * 256 + bj * 128 + wc * 32 + 16 * n + 4 * fq) = acc[0][bj][m][n];
            return;
        }
#pragma unroll
        for (int ai = 0; ai < 2; ++ai)
#pragma unroll
            for (int m = 0; m < 4; ++m) {
                const int r = u.pm * 256 + ai * 128 + wr * 64 + m * 16 + fr;
#pragma unroll
                for (int bj = 0; bj < 2; ++bj)
#pragma unroll
                    for (int n = 0; n < 2; ++n) {
                        const int c = u.pn * 256 + bj * 128 + wc * 32 + 16 * n + 4 * fq;
                        const u32x2 gw = *(const u32x2*)(Z + (size_t)r * NZ + ZGB + c);
                        const f32x4 t = *(const f32x4*)(TMP + (size_t)r * D + c);
                        f32x4 v = acc[ai][bj][m][n];
                        v[0] = t[0] + v[0] * sigm(bflo(gw.x)); v[1] = t[1] + v[1] * sigm(bfhi(gw.x)); v[2] = t[2] + v[2] * sigm(bflo(gw.y)); v[3] = t[3] + v[3] * sigm(bfhi(gw.y));
                        u32x2 w; w.x = pk2(v[0], v[1]); w.y = pk2(v[2], v[3]);
                        *(u32x2*)(Y + (size_t)r * D + c) = w;
                    }
            }
    }
};
struct EpiWO {
    static constexpr bool PERM = false, AFTER_DRAIN = false;
    const float* xp; const float* xs; const float* mod; float* out; float* accs;
    DI void operator()(const f32x4 (&acc)[2][2][4][2], const Unit& u, int wr, int wc, int fr, int fq) const {
        if (u.pm == 64) {
#pragma unroll
            for (int m = 0; m < 4; ++m)
#pragma unroll
                for (int bj = 0; bj < 2; ++bj)
#pragma unroll
                    for (int n = 0; n < 2; ++n) {
                        float* d = accs + ((size_t)(u.kt0 >> 2) * NS + (wr * 64 + m * 16 + fr)) * D + u.pn * 256 + bj * 128 + wc * 32 + 16 * n + 4 * fq;
                        *(f32x4*)d = acc[0][bj][m][n];
                    }
            return;
        }
#pragma unroll
        for (int ai = 0; ai < 2; ++ai)
#pragma unroll
            for (int m = 0; m < 4; ++m) {
                const int r = u.pm * 256 + ai * 128 + wr * 64 + m * 16 + fr;
                if (r < MR) {
                    const float* xr = r < TP ? xp + (size_t)r * D : xs + (size_t)(r - TP) * D;
                    const float* g1 = mod + (size_t)crow_of(r) * NMOD + 2 * D;
#pragma unroll
                    for (int bj = 0; bj < 2; ++bj)
#pragma unroll
                        for (int n = 0; n < 2; ++n) {
                            const int c = u.pn * 256 + bj * 128 + wc * 32 + 16 * n + 4 * fq;
                            const f32x4 xv = *(const f32x4*)(xr + c), gv = *(const f32x4*)(g1 + c);
                            *(f32x4*)(out + (size_t)r * D + c) = xv + gv * acc[ai][bj][m][n];
                        }
                }
            }
    }
};
struct EpiDown {
    static constexpr bool PERM = false, AFTER_DRAIN = false;
    const float* mod; float* out; float* accs;
    DI void operator()(const f32x4 (&acc)[2][2][4][2], const Unit& u, int wr, int wc, int fr, int fq) const {
        if (u.pm == 64) {
#pragma unroll
            for (int m = 0; m < 4; ++m)
#pragma unroll
                for (int bj = 0; bj < 2; ++bj)
#pragma unroll
                    for (int n = 0; n < 2; ++n) {
                        float* d = accs + ((size_t)(u.kt0 >> 2) * NS + (wr * 64 + m * 16 + fr)) * D + u.pn * 256 + bj * 128 + wc * 32 + 16 * n + 4 * fq;
                        *(f32x4*)d = acc[0][bj][m][n];
                    }
            return;
        }
#pragma unroll
        for (int ai = 0; ai < 2; ++ai)
#pragma unroll
            for (int m = 0; m < 4; ++m) {
                const int r = u.pm * 256 + ai * 128 + wr * 64 + m * 16 + fr;
                if (r < MR) {
                    const float* g2 = mod + (size_t)crow_of(r) * NMOD + 5 * D;
#pragma unroll
                    for (int bj = 0; bj < 2; ++bj)
#pragma unroll
                        for (int n = 0; n < 2; ++n) {
                            const int c = u.pn * 256 + bj * 128 + wc * 32 + 16 * n + 4 * fq;
                            float* o = out + (size_t)r * D + c;
                            const f32x4 xv = *(const f32x4*)o, gv = *(const f32x4*)(g2 + c);
                            *(f32x4*)o = xv + gv * acc[ai][bj][m][n];
                        }
                }
            }
    }
};
struct EpiUp {
    static constexpr bool PERM = true, AFTER_DRAIN = false;
    bf16_t* AB; bf16_t* G; float* out; float* accs; const float* cw; const float* cb; LAS float* xch;
    DI void operator()(const f32x4 (&acc)[2][2][4][2], const Unit& u, int wr, int wc, int fr, int fq) const {
        int cl = 32 * wc + 8 * fq;
        if (u.pm == 64) {
#pragma unroll
            for (int m = 0; m < 4; ++m)
#pragma unroll
                for (int bj = 0; bj < 2; ++bj)
#pragma unroll
                    for (int n = 0; n < 2; ++n) {
                        float* d = accs + ((size_t)(u.kt0 >> 2) * NS + (wr * 64 + m * 16 + fr)) * NAB + bj * DFF + 128 * u.pn + cl + 4 * n;
                        *(f32x4*)d = acc[0][bj][m][n];
                    }
            return;
        }
        asm volatile("" : "+v"(cl), "+v"(fr), "+v"(fq));
        const int lane = fq * 16 + fr;
        if (fr >= 14) {
#pragma unroll
            for (int ai = 0; ai < 2; ++ai) { LAS float* d = xch + ((2 * ai + wr) * 2 + (fr - 14)) * 128 + cl; *(LAS f32x4*)d = acc[ai][0][3][0]; *(LAS f32x4*)(d + 4) = acc[ai][0][3][1]; }
        }
        asm volatile("s_waitcnt lgkmcnt(0)" ::: "memory"); __builtin_amdgcn_s_barrier(); __builtin_amdgcn_s_barrier(); asm volatile("" ::: "memory");
        const int src1 = (lane & 48) | ((fr + 15) & 15), src2 = (lane & 48) | ((fr + 14) & 15);
#pragma unroll
        for (int n = 0; n < 2; ++n) {
            const int c = 128 * u.pn + cl + 4 * n;
            const f32x4 w0 = *(const f32x4*)(cw + c), w1 = *(const f32x4*)(cw + DFF + c), w2 = *(const f32x4*)(cw + 2 * DFF + c), bb = *(const f32x4*)(cb + c);
#pragma unroll
            for (int ai = 0; ai < 2; ++ai) {
                const int q = 2 * ai + wr;
                f32x4 y1 = {0.f, 0.f, 0.f, 0.f}, z1 = y1;
                if (q > 0) { y1 = *(const LAS f32x4*)(xch + ((q - 1) * 2 + 1) * 128 + cl + 4 * n); z1 = *(const LAS f32x4*)(xch + ((q - 1) * 2 + (fr == 0 ? 0 : 1)) * 128 + cl + 4 * n); }
#pragma unroll
                for (int m = 0; m < 4; ++m) {
                    const f32x4 av = acc[ai][0][m][n], bv = acc[ai][1][m][n];
                    f32x4 o;
#pragma unroll
                    for (int j = 0; j < 4; ++j) {
                        const float y = __shfl(av[j], src1), z = __shfl(av[j], src2);
                        const float a1 = fr >= 1 ? y : y1[j], a0 = fr >= 2 ? z : z1[j];
                        y1[j] = y; z1[j] = z;
                        const float uu = bb[j] + w0[j] * a0 + w1[j] * a1 + w2[j] * av[j];
                        o[j] = silu(uu) * bv[j];
                    }
                    const int rl = 128 * ai + 64 * wr + 16 * m + fr, rg = 256 * u.pm + rl;
                    u32x2 gw; gw.x = pk2(o[0], o[1]); gw.y = pk2(o[2], o[3]);
                    if (ai == 0 && m == 0 && wr == 0) {
                        if (!(fr < 2 && u.pm > 0)) *(u32x2*)(G + (size_t)rg * DFF + c) = gw;
                        if (fr < 2) {
                            u32x2 w; w.x = pk2(av[0], av[1]); w.y = pk2(av[2], av[3]); *(u32x2*)(AB + (size_t)rg * NAB + c) = w;
                            u32x2 x; x.x = pk2(bv[0], bv[1]); x.y = pk2(bv[2], bv[3]); *(u32x2*)(AB + (size_t)rg * NAB + DFF + c) = x;
                        }
                    } else {
                        *(u32x2*)(G + (size_t)rg * DFF + c) = gw;
                        if (ai == 1 && m == 3 && wr == 1) {
                            if (fr >= 14) {
                                u32x2 w; w.x = pk2(av[0], av[1]); w.y = pk2(av[2], av[3]); *(u32x2*)(AB + (size_t)rg * NAB + c) = w;
                                if (u.pm == 63) *(f32x4*)(out + OFF_CVP + (size_t)(rl - 254) * DFF + c) = av;
                            }
                        }
                    }
                    asm volatile("" ::: "memory");
                }
            }
        }
    }
};

DI void ph_mod(const Params& p, LAS unsigned char* L, float* mod) {
    LAS float* sS = (LAS float*)L;
    LAS float* sRed = (LAS float*)L;
    const int tid = threadIdx.x, cgp = tid % 24, ksub = tid / 24;
    const float* cpr = p.in[7]; const float* csm = p.in[8]; const float* wada = p.in[9]; const float* bada = p.in[10];
    for (int nb = blockIdx.x; nb < 256; nb += gridDim.x) {
        const int n0 = nb * 48;
        float acc[33][2];
#pragma unroll
        for (int r = 0; r < 33; ++r) { acc[r][0] = 0.f; acc[r][1] = 0.f; }
        for (int kc = 0; kc < 4; ++kc) {
            f32x2 wv[25];
#pragma unroll
            for (int q = 0; q < 25; ++q) { const int kk = ksub + 21 * q; wv[q] = (ksub < 21 && kk < 512) ? *(const f32x2*)(wada + (size_t)(kc * 512 + kk) * NMOD + n0 + 2 * cgp) : (f32x2){0.f, 0.f}; }
            for (int idx = tid; idx < 33 * 512; idx += 512) {
                const int r = idx >> 9, kk = idx & 511;
                const float c = r == 0 ? cpr[kc * 512 + kk] : csm[(r - 1) * D + kc * 512 + kk];
                sS[kk * 36 + r] = silu(c);
            }
            __syncthreads();
#pragma unroll
            for (int q = 0; q < 25; ++q) {
                const int kk = ksub + 21 * q;
                if (ksub < 21 && kk < 512) {
                    const f32x2 w = wv[q];
                    const LAS f32x4* sp = (const LAS f32x4*)(sS + kk * 36);
#pragma unroll
                    for (int r4 = 0; r4 < 9; ++r4) {
                        const f32x4 sv = sp[r4];
#pragma unroll
                        for (int j = 0; j < 4; ++j) { if (4 * r4 + j < 33) { acc[4 * r4 + j][0] += sv[j] * w[0]; acc[4 * r4 + j][1] += sv[j] * w[1]; } }
                    }
                }
            }
            __syncthreads();
        }
#pragma unroll
        for (int r0 = 0; r0 < 33; r0 += 11) {
            if (ksub < 21) {
#pragma unroll
                for (int i = 0; i < 11; ++i) { sRed[ksub * 528 + i * 48 + 2 * cgp] = acc[r0 + i][0]; sRed[ksub * 528 + i * 48 + 2 * cgp + 1] = acc[r0 + i][1]; }
            }
            __syncthreads();
            for (int o = tid; o < 528; o += 512) {
                float sum = 0.f;
                for (int k2 = 0; k2 < 21; ++k2) sum += sRed[k2 * 528 + o];
                const int i = o / 48, c = o % 48;
                mod[(size_t)(r0 + i) * NMOD + n0 + c] = sum + bada[n0 + c];
            }
            __syncthreads();
        }
    }
}
DI void tr_load(const float* W, int N, int r, int lane, f32x4 (&v)[8]) {
    const int nblk = N / 32, kb = r / nblk, nb = r % nblk, k0 = 64 * kb, n0 = 32 * nb;
#pragma unroll
    for (int i = 0; i < 8; ++i) v[i] = *(const f32x4*)(W + (size_t)(k0 + 8 * i + (lane >> 3)) * N + n0 + 4 * (lane & 7));
}
DI void tr_finish(bf16_t* WT, int K, int N, int inter, int r, LAS float* scr, int lane, const f32x4 (&v)[8]) {
    const int nblk = N / 32, kb = r / nblk, nb = r % nblk, k0 = 64 * kb, n0 = 32 * nb;
#pragma unroll
    for (int i = 0; i < 8; ++i) { LAS float* dd = scr + (8 * i + (lane >> 3)) * 33 + 4 * (lane & 7); dd[0] = v[i][0]; dd[1] = v[i][1]; dd[2] = v[i][2]; dd[3] = v[i][3]; }
    lds_fence();
    const int c = lane & 7;
#pragma unroll
    for (int j = 0; j < 4; ++j) { const int n = (lane >> 3) + 8 * j; const LAS float* s = scr + (8 * c) * 33 + n;
        u32x4 o; o.x = pk2(s[0 * 33], s[1 * 33]); o.y = pk2(s[2 * 33], s[3 * 33]); o.z = pk2(s[4 * 33], s[5 * 33]); o.w = pk2(s[6 * 33], s[7 * 33]);
        const int na = n0 + n, drow = inter < 0 ? na : ((na >> 7) << 8) + inter * 128 + (na & 127);
        *(u32x4*)(WT + (size_t)drow * K + k0 + 8 * c) = o; }
    lds_fence();
}
constexpr int TR_I_IN = 32 * 400, TR_I_PA = 8 * 64, TR_I_PB = 16 * 64, TR_I_O = 32 * 64, TR_I_A = 32 * 176, TR_I_DN = 88 * 64;
constexpr int TR_NITEMS = TR_I_IN + TR_I_PA + TR_I_PB + TR_I_O + 2 * TR_I_A + TR_I_DN;
struct TrSrc { const float *w_in, *w_pa, *w_pb, *w_o, *w_a, *w_b, *w_dn; };
DI void tr_decode(const TrSrc& q, unsigned char* ws, int it, const float*& W, bf16_t*& WT, int& K, int& N, int& inter, int& r) {
    r = it; inter = -1;
    if (r < TR_I_IN) { W = q.w_in; WT = (bf16_t*)(ws + WS_WIN); K = D; N = NZ; return; } r -= TR_I_IN;
    if (r < TR_I_PA) { W = q.w_pa; WT = (bf16_t*)(ws + WS_WPA); K = 512; N = D; return; } r -= TR_I_PA;
    if (r < TR_I_PB) { W = q.w_pb; WT = (bf16_t*)(ws + WS_WPB); K = 1024; N = D; return; } r -= TR_I_PB;
    if (r < TR_I_O) { W = q.w_o; WT = (bf16_t*)(ws + WS_WO); K = D; N = D; return; } r -= TR_I_O;
    if (r < TR_I_A) { W = q.w_a; WT = (bf16_t*)(ws + WS_WAB); K = D; N = DFF; inter = 0; return; } r -= TR_I_A;
    if (r < TR_I_A) { W = q.w_b; WT = (bf16_t*)(ws + WS_WAB); K = D; N = DFF; inter = 1; return; } r -= TR_I_A;
    W = q.w_dn; WT = (bf16_t*)(ws + WS_WDN); K = DFF; N = D;
}
DI void ph_prologue(const Params& p, LAS unsigned char* L) {
    unsigned char* ws = p.ws;
    const int tid = threadIdx.x, lane = tid & 63, wave = tid >> 6;
    const int gw = blockIdx.x * 8 + wave, NGW = gridDim.x * 8;
    const size_t gtid = (size_t)blockIdx.x * 512 + tid, gstride = (size_t)gridDim.x * 512;
    ph_mod(p, L, (float*)(ws + WS_MOD));
    LAS float* scr = (LAS float*)(L + wave * 8448);
    const TrSrc tq{p.in[12], p.in[15], p.in[16], p.in[17], p.in[19], p.in[20], p.in[23]};
    for (int it = gw; it < TR_NITEMS; it += 2 * NGW) {
        const float* W0; bf16_t* T0; int K0, N0, i0, r0; tr_decode(tq, ws, it, W0, T0, K0, N0, i0, r0);
        const int it1 = it + NGW; const bool two = it1 < TR_NITEMS;
        const float* W1; bf16_t* T1; int K1, N1, i1, r1; tr_decode(tq, ws, two ? it1 : it, W1, T1, K1, N1, i1, r1);
        f32x4 v0[8], v1[8];
        tr_load(W0, N0, r0, lane, v0); tr_load(W1, N1, r1, lane, v1);
        tr_finish(T0, K0, N0, i0, r0, scr, lane, v0);
        if (two) tr_finish(T1, K1, N1, i1, r1, scr, lane, v1);
    }
    {
        float* rope = (float*)(ws + WS_ROPE);
        for (size_t idx = gtid; idx < (size_t)MR * 16; idx += gstride) {
            const int m = (int)(idx >> 4), i = (int)(idx & 15);
            const int pos = m < TP ? m : TP + ((m - TP) & 3);
            const float invf = (float)exp2(-(double)i * (18.931568569324174 / 16.0));
            const float ang = (float)pos * invf;
            const double x = (double)ang, n = rint(x * 0.15915494309189535);
            double rr = fma(-n, 6.283185307179586, x); rr = fma(-n, 2.4492935982947064e-16, rr);
            rope[(size_t)m * 32 + i] = cosf((float)rr); rope[(size_t)m * 32 + 16 + i] = sinf((float)rr);
        }
    }
}
DI const float* hn_src(const Params& p, const float* xbase, bool from_out, int m) {
    const bool fix = from_out && m >= TP;
    return (from_out && !fix) ? xbase + (size_t)m * D : (m < TP ? p.in[0] + (size_t)m * D : p.in[1] + (size_t)(m - TP) * D);
}
DI void ph_hnorm(const Params& p, float* xbase, bool from_out, const float* nw, int sh_idx, bf16_t* H) {
    const int lane = threadIdx.x & 63, wave = threadIdx.x >> 6, stride = gridDim.x * 8;
    const float* mod = (const float*)(p.ws + WS_MOD);
    int m = blockIdx.x * 8 + wave;
    f32x4 v[8];
    if (m < MR) { const float* xr = hn_src(p, xbase, from_out, m);
#pragma unroll
        for (int j = 0; j < 8; ++j) v[j] = *(const f32x4*)(xr + 4 * lane + 256 * j); }
    while (m < MR) {
        const int mn = m + stride; f32x4 vn[8];
        if (mn < MR) { const float* xr = hn_src(p, xbase, from_out, mn);
#pragma unroll
            for (int j = 0; j < 8; ++j) vn[j] = *(const f32x4*)(xr + 4 * lane + 256 * j); }
        const bool fix = from_out && m >= TP;
        const float* md = mod + (size_t)crow_of(m) * NMOD + sh_idx * D;
        float ss = 0.f;
#pragma unroll
        for (int j = 0; j < 8; ++j) { const int c = 4 * lane + 256 * j;
            if (fix) { f32x4 a = {0.f, 0.f, 0.f, 0.f}; for (int q = 0; q < NSP_WO; ++q) a = a + *(const f32x4*)((const float*)(p.ws + WS_ACC_WO) + ((size_t)q * NS + (m - TP)) * D + c); const f32x4 g = *(const f32x4*)(mod + (size_t)crow_of(m) * NMOD + 2 * D + c); v[j] = v[j] + g * a; *(f32x4*)(xbase + (size_t)m * D + c) = v[j]; }
            ss += v[j][0] * v[j][0] + v[j][1] * v[j][1] + v[j][2] * v[j][2] + v[j][3] * v[j][3]; }
        const float rstd = rsqrtf(wave_sum(ss) * (1.f / D) + EPS);
#pragma unroll
        for (int j = 0; j < 8; ++j) {
            const int c = 4 * lane + 256 * j;
            const f32x4 w = *(const f32x4*)(nw + c), shv = *(const f32x4*)(md + c), scv = *(const f32x4*)(md + D + c);
            const f32x4 o = (v[j] * rstd) * w * (1.f + scv) + shv;
            u32x2 q; q.x = pk2(o[0], o[1]); q.y = pk2(o[2], o[3]);
            *(u32x2*)(H + (size_t)m * D + c) = q;
        }
#pragma unroll
        for (int j = 0; j < 8; ++j) v[j] = vn[j];
        m = mn;
    }
}
DI void ph_final_norm(const Params& p) {
    const int lane = threadIdx.x & 63, wave = threadIdx.x >> 6, stride = gridDim.x * 8;
    const float* nw = p.in[24];
    int m = blockIdx.x * 8 + wave;
    f32x4 v[8];
    if (m < MR) {
#pragma unroll
        for (int j = 0; j < 8; ++j) v[j] = *(const f32x4*)(p.out + (size_t)m * D + 4 * lane + 256 * j); }
    while (m < MR) {
        const int mn = m + stride; f32x4 vn[8];
        if (mn < MR) {
#pragma unroll
            for (int j = 0; j < 8; ++j) vn[j] = *(const f32x4*)(p.out + (size_t)mn * D + 4 * lane + 256 * j); }
        float* xr = p.out + (size_t)m * D;
        float ss = 0.f;
#pragma unroll
        for (int j = 0; j < 8; ++j) { const int c = 4 * lane + 256 * j;
            if (m >= TP) { f32x4 a = {0.f, 0.f, 0.f, 0.f}; for (int q = 0; q < NSP_DN; ++q) a = a + *(const f32x4*)((const float*)(p.ws + WS_ACC_DN) + ((size_t)q * NS + (m - TP)) * D + c); const f32x4 g = *(const f32x4*)((const float*)(p.ws + WS_MOD) + (size_t)crow_of(m) * NMOD + 5 * D + c); v[j] = v[j] + g * a; }
            ss += v[j][0] * v[j][0] + v[j][1] * v[j][1] + v[j][2] * v[j][2] + v[j][3] * v[j][3]; }
        const float rstd = rsqrtf(wave_sum(ss) * (1.f / D) + EPS);
#pragma unroll
        for (int j = 0; j < 8; ++j) { const int c = 4 * lane + 256 * j; const f32x4 w = *(const f32x4*)(nw + c); *(f32x4*)(xr + c) = (v[j] * rstd) * w; }
#pragma unroll
        for (int j = 0; j < 8; ++j) v[j] = vn[j];
        m = mn;
    }
}

DI void attn_prompt_item(const bf16_t* Z, bf16_t* OG, float* LSE, LAS bf16_t* Vl, int item, int lane) {
    const int g = item >> 11, rem = item & 2047, hh = rem >> 9, bidx = rem & 511;
    const int dsh = 2 * g, nsh = 9 - dsh;
    const int res = bidx >> nsh, blk = bidx & ((1 << nsh) - 1);
    const int s0 = blk * 32, head = g * 4 + hh;
    const int qi = lane & 31, h = lane >> 5;
    const int tq = res + ((s0 + qi) << dsh);
    bf16x8 Qf[8];
    { const bf16_t* qp = Z + (size_t)tq * NZ + ZQ + head * 128 + 8 * h;
#pragma unroll
      for (int ks = 0; ks < 8; ++ks) Qf[ks] = *(const bf16x8*)(qp + 16 * ks); }
    float mrun = -INFINITY, lrun = 0.f;
    f32x16 O[4];
#pragma unroll
    for (int dt = 0; dt < 4; ++dt)
#pragma unroll
        for (int i = 0; i < 16; ++i) O[dt][i] = 0.f;
    const int sq = s0 + qi;
    const int vrow = lane >> 4, vch = lane & 15;
    const unsigned vtr = (unsigned)(unsigned long long)Vl + (unsigned)(((4 * h + ((lane & 15) >> 2)) * 136 + 16 * ((lane >> 4) & 1) + 4 * (lane & 3)) * 2);
    bf16x8 Kc[8]; u32x4 Vr[8];
#define ATT_LOAD_KV(kt_) do { const int kb_ = s0 - 128 + 32 * (kt_); int skl_ = kb_ + qi; skl_ = skl_ < 0 ? 0 : skl_; \
        const bf16_t* kp_ = Z + (size_t)(res + (skl_ << dsh)) * NZ + ZK + head * 128 + 8 * h; \
        _Pragma("unroll") for (int ks = 0; ks < 8; ++ks) Kc[ks] = *(const bf16x8*)(kp_ + 16 * ks); \
        _Pragma("unroll") for (int i = 0; i < 8; ++i) { int sv_ = kb_ + 4 * i + vrow; sv_ = sv_ < 0 ? 0 : sv_; \
            Vr[i] = *(const u32x4*)(Z + (size_t)(res + (sv_ << dsh)) * NZ + ZV + head * 128 + 8 * vch); } } while (0)
    ATT_LOAD_KV(4);
    for (int kt = 4; kt >= 0; --kt) {
        const int kb = s0 - 128 + 32 * kt;
        f32x16 S;
#pragma unroll
        for (int i = 0; i < 16; ++i) S[i] = 0.f;
#pragma unroll
        for (int ks = 0; ks < 8; ++ks) S = mfma32(Kc[ks], Qf[ks], S);
#pragma unroll
        for (int i = 0; i < 8; ++i) *(LAS u32x4*)(Vl + (4 * i + vrow) * 136 + 8 * vch) = Vr[i];
        if (kt > 0) ATT_LOAD_KV(kt - 1);
        float tmax = -INFINITY;
        if (kt >= 1 && kt <= 3 && kb >= 0) {
#pragma unroll
            for (int i = 0; i < 16; ++i) { S[i] = S[i] * ATT_SCALE; tmax = fmaxf(tmax, S[i]); }
        } else {
#pragma unroll
            for (int i = 0; i < 16; ++i) {
                const int sk = kb + (i & 3) + 8 * (i >> 2) + 4 * h;
                const bool valid = (sk >= 0) && (sk <= sq) && (sk >= sq - 128);
                S[i] = valid ? S[i] * ATT_SCALE : -INFINITY;
                tmax = fmaxf(tmax, S[i]);
            }
        }
        tmax = fmaxf(tmax, __shfl_xor(tmax, 32));
        const float mn = fmaxf(mrun, tmax), alpha = __expf(mrun - mn);
        float ps = 0.f;
#pragma unroll
        for (int i = 0; i < 16; ++i) { S[i] = __expf(S[i] - mn); ps += S[i]; }
        ps += __shfl_xor(ps, 32);
        lrun = lrun * alpha + ps; mrun = mn;
#pragma unroll
        for (int dt = 0; dt < 4; ++dt) O[dt] = O[dt] * alpha;
        bf16x8 Pf[2];
#pragma unroll
        for (int s2 = 0; s2 < 2; ++s2) {
            u32x4 w; w.x = pk2(S[8 * s2 + 0], S[8 * s2 + 1]); w.y = pk2(S[8 * s2 + 2], S[8 * s2 + 3]); w.z = pk2(S[8 * s2 + 4], S[8 * s2 + 5]); w.w = pk2(S[8 * s2 + 6], S[8 * s2 + 7]);
            Pf[s2] = __builtin_bit_cast(bf16x8, w);
        }
        lds_fence();
        const s16x4 l00 = tr_read<0>(vtr), h00 = tr_read<2176>(vtr);
        const s16x4 l01 = tr_read<4352>(vtr), h01 = tr_read<6528>(vtr);
        const s16x4 l10 = tr_read<64>(vtr), h10 = tr_read<2240>(vtr);
        const s16x4 l11 = tr_read<4416>(vtr), h11 = tr_read<6592>(vtr);
        const s16x4 l20 = tr_read<128>(vtr), h20 = tr_read<2304>(vtr);
        const s16x4 l21 = tr_read<4480>(vtr), h21 = tr_read<6656>(vtr);
        const s16x4 l30 = tr_read<192>(vtr), h30 = tr_read<2368>(vtr);
        const s16x4 l31 = tr_read<4544>(vtr), h31 = tr_read<6720>(vtr);
        asm volatile("s_waitcnt lgkmcnt(0)" ::: "memory"); __builtin_amdgcn_sched_barrier(0);
#define PK8(L_, H_) (bf16x8){L_[0], L_[1], L_[2], L_[3], H_[0], H_[1], H_[2], H_[3]}
        O[0] = mfma32(PK8(l00, h00), Pf[0], O[0]);
        O[0] = mfma32(PK8(l01, h01), Pf[1], O[0]);
        O[1] = mfma32(PK8(l10, h10), Pf[0], O[1]);
        O[1] = mfma32(PK8(l11, h11), Pf[1], O[1]);
        O[2] = mfma32(PK8(l20, h20), Pf[0], O[2]);
        O[2] = mfma32(PK8(l21, h21), Pf[1], O[2]);
        O[3] = mfma32(PK8(l30, h30), Pf[0], O[3]);
        O[3] = mfma32(PK8(l31, h31), Pf[1], O[3]);
#undef PK8
        lds_fence();
    }
#undef ATT_LOAD_KV
    const float inv = 1.f / lrun;
    bf16_t* op = OG + ((size_t)g * MP + tq) * 512 + hh * 128 + 4 * h;
#pragma unroll
    for (int dt = 0; dt < 4; ++dt)
#pragma unroll
        for (int rq = 0; rq < 4; ++rq) {
            u32x2 w; w.x = pk2(O[dt][4 * rq] * inv, O[dt][4 * rq + 1] * inv); w.y = pk2(O[dt][4 * rq + 2] * inv, O[dt][4 * rq + 3] * inv);
            *(u32x2*)(op + 32 * dt + 8 * rq) = w;
        }
    if (h == 0) LSE[((size_t)g * MP + tq) * 4 + hh] = mrun + __logf(lrun);
}
DI const float* samp_row(const float* cache, const float* newkv, int b, int W, int rr) {
    return (rr >= W) ? newkv + ((size_t)(b * W + rr - 4) * 2) * 512 : cache + ((size_t)(b * W + rr) * 2) * 512;
}
DI void attn_sample_item(const Params& p, const bf16_t* Z, bf16_t* OG, float* LSE, int item, int lane) {
    const int b = item / 48, r48 = item % 48, t = r48 / 12, head = r48 % 12, g = head >> 2, hh = head & 3;
    const int dsh = 2 * g, W = 128 << dsh;
    const float* cache = p.in[2 + g];
    const float* newkv = p.out + (g == 0 ? OFF_KVS0 : (g == 1 ? OFF_KVS1 : OFF_KVS2));
    const int m = TP + b * 4 + t;
    const unsigned qq = *(const unsigned*)(Z + (size_t)m * NZ + ZQ + head * 128 + 2 * lane);
    const float q0 = bflo(qq) * ATT_SCALE, q1 = bfhi(qq) * ATT_SCALE;
    float mrun, lrun, o0, o1;
    {
        const float* rp = samp_row(cache, newkv, b, W, W + t - (128 << dsh)) + hh * 128 + 2 * lane;
        const f32x2 kk = *(const f32x2*)rp, vv = *(const f32x2*)(rp + 512);
        mrun = wave_sum(q0 * kk.x + q1 * kk.y); lrun = 1.f; o0 = vv.x; o1 = vv.y;
    }
    f32x2 kk[16], vv[16];
#pragma unroll
    for (int u = 0; u < 16; ++u) { const float* rp = samp_row(cache, newkv, b, W, W + t - (u << dsh)) + hh * 128 + 2 * lane; kk[u] = *(const f32x2*)rp; vv[u] = *(const f32x2*)(rp + 512); }
    for (int j0 = 0; j0 < 128; j0 += 16) {
        f32x2 kn[16], vn[16];
        if (j0 + 16 < 128) {
#pragma unroll
            for (int u = 0; u < 16; ++u) { const float* rp = samp_row(cache, newkv, b, W, W + t - ((j0 + 16 + u) << dsh)) + hh * 128 + 2 * lane; kn[u] = *(const f32x2*)rp; vn[u] = *(const f32x2*)(rp + 512); }
        }
        float pr[16];
#pragma unroll
        for (int u = 0; u < 16; ++u) pr[u] = q0 * kk[u].x + q1 * kk[u].y;
#pragma unroll
        for (int o = 32; o >= 1; o >>= 1) {
#pragma unroll
            for (int u = 0; u < 16; ++u) pr[u] += __shfl_xor(pr[u], o);
        }
        float bm = pr[0];
#pragma unroll
        for (int u = 1; u < 16; ++u) bm = fmaxf(bm, pr[u]);
        const float mn = fmaxf(mrun, bm), alpha = __expf(mrun - mn);
        lrun *= alpha; o0 *= alpha; o1 *= alpha; mrun = mn;
#pragma unroll
        for (int u = 0; u < 16; ++u) { const float pu = __expf(pr[u] - mn); lrun += pu; o0 += pu * vv[u].x; o1 += pu * vv[u].y; }
#pragma unroll
        for (int u = 0; u < 16; ++u) { kk[u] = kn[u]; vv[u] = vn[u]; }
    }
    const float inv = 1.f / lrun;
    *(unsigned*)(OG + ((size_t)g * MP + m) * 512 + hh * 128 + 2 * lane) = pk2(o0 * inv, o1 * inv);
    if (lane == 0) LSE[((size_t)g * MP + m) * 4 + hh] = mrun + __logf(lrun);
}

DI float hg_gates(const Params& p, const bf16_t (&fhr)[16], int h, LAS float* tot, float (&kk)[16], float (&bb)[16]) {
    const int tid = threadIdx.x, dk = tid & 127, part = tid >> 7;
    const float* lbp = p.in[13];
    const float lb = 1.f / (1.f + __expf(lbp[1024 + h * 128 + dk] - lbp[h * 128 + dk]));
    float cum = 0.f;
#pragma unroll
    for (int i = 0; i < 16; ++i) {
        const float fh = bf2f(fhr[i]);
        const float f = lb + (1.f - lb) * sigm(fh);
        kk[i] = 1.f - f; cum += __logf(f); bb[i] = cum;
    }
    tot[part * 128 + dk] = cum;
    __syncthreads();
    float off = 0.f, bl = 0.f;
#pragma unroll
    for (int q = 0; q < 4; ++q) { const float tv = tot[q * 128 + dk]; bl += tv; off += (q < part) ? tv : 0.f; }
#pragma unroll
    for (int i = 0; i < 16; ++i) bb[i] += off;
    return bl;
}
DI void hg_load_v(const bf16_t* Z, int n, int h, LAS bf16_t* Vs) {
    const int tid = threadIdx.x;
#pragma unroll
    for (int i = 0; i < 2; ++i) { const int e = tid + 512 * i, s = e >> 4, ch = e & 15;
        *(LAS u32x4*)(Vs + s * 136 + 8 * ch) = *(const u32x4*)(Z + (size_t)(64 * n + s) * NZ + ZIH + h * 128 + 8 * ch); }
}
struct HgaRegs { bf16_t fhr[16]; u32x4 vreg[2]; };
DI void hg_passA_load(const bf16_t* Z, int item, HgaRegs& R) {
    const int n = item >> 3, h = item & 7;
    const int tid = threadIdx.x, dk = tid & 127, part = tid >> 7;
#pragma unroll
    for (int i = 0; i < 16; ++i) R.fhr[i] = Z[(size_t)(64 * n + 16 * part + i) * NZ + ZFH + h * 128 + dk];
#pragma unroll
    for (int i = 0; i < 2; ++i) { const int e = tid + 512 * i; R.vreg[i] = *(const u32x4*)(Z + (size_t)(64 * n + (e >> 4)) * NZ + ZIH + h * 128 + 8 * (e & 15)); }
}
DI void hg_passA_item(const Params& p, float* HS, float* HD, LAS unsigned char* L, int item, const HgaRegs& R) {
    const int n = item >> 3, h = item & 7;
    const int tid = threadIdx.x, lane = tid & 63, wave = tid >> 6, dk = tid & 127, part = tid >> 7;
    LAS bf16_t* Kh = (LAS bf16_t*)L;
    LAS bf16_t* Vs = (LAS bf16_t*)(L + 17408);
    LAS float* tot = (LAS float*)(L + 34816);
    float kk[16], bb[16];
    const float bl = hg_gates(p, R.fhr, h, tot, kk, bb);
#pragma unroll
    for (int i = 0; i < 16; ++i) Kh[(16 * part + i) * 136 + dk] = (bf16_t)(pk2(kk[i] * __expf(bl - bb[i]), 0.f) & 0xffffu);
    if (part == 0) HD[(size_t)(n * 8 + h) * 128 + dk] = __expf(bl);
#pragma unroll
    for (int i = 0; i < 2; ++i) { const int e = tid + 512 * i; *(LAS u32x4*)(Vs + (e >> 4) * 136 + 8 * (e & 15)) = R.vreg[i]; }
    __syncthreads();
    f32x4 acc[8];
#pragma unroll
    for (int nt = 0; nt < 8; ++nt) acc[nt] = (f32x4){0.f, 0.f, 0.f, 0.f};
    const unsigned trq = (unsigned)(((8 * (lane >> 4) + ((lane & 15) >> 2)) * 136 + 4 * (lane & 3)) * 2);
    const unsigned trA = (unsigned)(unsigned long long)Kh + trq + 32u * (unsigned)wave, trB = (unsigned)(unsigned long long)Vs + trq;
#define PK8(L_, H_) (bf16x8){L_[0], L_[1], L_[2], L_[3], H_[0], H_[1], H_[2], H_[3]}
    { const s16x4 al = tr_read<0>(trA), ah = tr_read<1088>(trA);
      const s16x4 l0 = tr_read<0>(trB), h0 = tr_read<1088>(trB);
      const s16x4 l1 = tr_read<32>(trB), h1 = tr_read<1120>(trB);
      const s16x4 l2 = tr_read<64>(trB), h2 = tr_read<1152>(trB);
      const s16x4 l3 = tr_read<96>(trB), h3 = tr_read<1184>(trB);
      const s16x4 l4 = tr_read<128>(trB), h4 = tr_read<1216>(trB);
      const s16x4 l5 = tr_read<160>(trB), h5 = tr_read<1248>(trB);
      const s16x4 l6 = tr_read<192>(trB), h6 = tr_read<1280>(trB);
      const s16x4 l7 = tr_read<224>(trB), h7 = tr_read<1312>(trB);
      asm volatile("s_waitcnt lgkmcnt(0)" ::: "memory"); __builtin_amdgcn_sched_barrier(0);
      const bf16x8 A = PK8(al, ah);
      acc[0] = mfma16(A, PK8(l0, h0), acc[0]);
      acc[1] = mfma16(A, PK8(l1, h1), acc[1]);
      acc[2] = mfma16(A, PK8(l2, h2), acc[2]);
      acc[3] = mfma16(A, PK8(l3, h3), acc[3]);
      acc[4] = mfma16(A, PK8(l4, h4), acc[4]);
      acc[5] = mfma16(A, PK8(l5, h5), acc[5]);
      acc[6] = mfma16(A, PK8(l6, h6), acc[6]);
      acc[7] = mfma16(A, PK8(l7, h7), acc[7]);
    }
    { const s16x4 al = tr_read<8704>(trA), ah = tr_read<9792>(trA);
      const s16x4 l0 = tr_read<8704>(trB), h0 = tr_read<9792>(trB);
      const s16x4 l1 = tr_read<8736>(trB), h1 = tr_read<9824>(trB);
      const s16x4 l2 = tr_read<8768>(trB), h2 = tr_read<9856>(trB);
      const s16x4 l3 = tr_read<8800>(trB), h3 = tr_read<9888>(trB);
      const s16x4 l4 = tr_read<8832>(trB), h4 = tr_read<9920>(trB);
      const s16x4 l5 = tr_read<8864>(trB), h5 = tr_read<9952>(trB);
      const s16x4 l6 = tr_read<8896>(trB), h6 = tr_read<9984>(trB);
      const s16x4 l7 = tr_read<8928>(trB), h7 = tr_read<10016>(trB);
      asm volatile("s_waitcnt lgkmcnt(0)" ::: "memory"); __builtin_amdgcn_sched_barrier(0);
      const bf16x8 A = PK8(al, ah);
      acc[0] = mfma16(A, PK8(l0, h0), acc[0]);
      acc[1] = mfma16(A, PK8(l1, h1), acc[1]);
      acc[2] = mfma16(A, PK8(l2, h2), acc[2]);
      acc[3] = mfma16(A, PK8(l3, h3), acc[3]);
      acc[4] = mfma16(A, PK8(l4, h4), acc[4]);
      acc[5] = mfma16(A, PK8(l5, h5), acc[5]);
      acc[6] = mfma16(A, PK8(l6, h6), acc[6]);
      acc[7] = mfma16(A, PK8(l7, h7), acc[7]);
    }
#undef PK8
    float* up = HS + ((size_t)(n * 8 + h) * 128) * 128;
#pragma unroll
    for (int nt = 0; nt < 8; ++nt)
#pragma unroll
        for (int r = 0; r < 4; ++r) up[(size_t)(16 * wave + 4 * (lane >> 4) + r) * 128 + 16 * nt + (lane & 15)] = acc[nt][r];
    __syncthreads();
}
DI void hg_scan(const Params& p, const float* HS, bf16_t* HS2, const float* HD) {
    for (int e = blockIdx.x * 512 + threadIdx.x; e < 131072; e += gridDim.x * 512) {
        float S = 0.f;
        for (int n0 = 0; n0 < 256; n0 += 32) {
            float U[32], Dd[32];
#pragma unroll
            for (int j = 0; j < 32; ++j) { U[j] = HS[(size_t)(n0 + j) * 131072 + e]; Dd[j] = HD[(n0 + j) * 1024 + (e >> 7)]; }
#pragma unroll
            for (int j = 0; j < 32; ++j) { HS2[(size_t)(n0 + j) * 131072 + e] = (bf16_t)(pk2(S, 0.f) & 0xffffu); S = Dd[j] * S + U[j]; }
        }
        p.out[OFF_HGP + e] = S;
    }
}
struct HgcRegs { bf16_t fhr[16], qhr[16]; u32x4 vreg[2]; u32x4 sreg[4]; };
DI void hg_passC_load(const bf16_t* Z, const bf16_t* HS, int item, HgcRegs& R) {
    const int n = item >> 3, h = item & 7;
    const int tid = threadIdx.x, dk = tid & 127, part = tid >> 7;
#pragma unroll
    for (int i = 0; i < 16; ++i) { const size_t ro = (size_t)(64 * n + 16 * part + i) * NZ + h * 128 + dk; R.fhr[i] = Z[ro + ZFH]; R.qhr[i] = Z[ro + ZQH]; }
#pragma unroll
    for (int i = 0; i < 2; ++i) { const int e = tid + 512 * i; R.vreg[i] = *(const u32x4*)(Z + (size_t)(64 * n + (e >> 4)) * NZ + ZIH + h * 128 + 8 * (e & 15)); }
    const bf16_t* sp = HS + ((size_t)(n * 8 + h) * 128) * 128;
#pragma unroll
    for (int i = 0; i < 4; ++i) { const int e = tid + 512 * i; R.sreg[i] = *(const u32x4*)(sp + (e >> 4) * 128 + 8 * (e & 15)); }
}
DI void hg_passC_item(const Params& p, const bf16_t* Z, bf16_t* OHG, LAS unsigned char* L, int item, const HgcRegs& R) {
    const int n = item >> 3, h = item & 7;
    const int tid = threadIdx.x, lane = tid & 63, wave = tid >> 6, dk = tid & 127, part = tid >> 7;
    LAS bf16_t* Qs = (LAS bf16_t*)L;
    LAS bf16_t* Ks = (LAS bf16_t*)(L + 17408);
    LAS bf16_t* Vs = (LAS bf16_t*)(L + 34816);
    LAS bf16_t* Ss = (LAS bf16_t*)(L + 52224);
    LAS bf16_t* As = (LAS bf16_t*)(L + 87040);
    LAS float* tot = (LAS float*)(L + 96256);
    LAS float* red = (LAS float*)(L + 98304);
    float kk[16], bb[16];
    const int mt = wave >> 1, wh = wave & 1, lr = lane & 15, lq = lane >> 4;
    bf16_t ghr[16];
#pragma unroll
    for (int r = 0; r < 4; ++r)
#pragma unroll
        for (int j = 0; j < 4; ++j) ghr[r * 4 + j] = Z[(size_t)(64 * n + 16 * mt + 4 * lq + r) * NZ + ZGH + h * 128 + 16 * (4 * wh + j) + lr];
    (void)hg_gates(p, R.fhr, h, tot, kk, bb);
#pragma unroll
    for (int i = 0; i < 16; ++i) {
        const int s = 16 * part + i;
        const float qh = bf2f(R.qhr[i]);
        Qs[s * 136 + dk] = (bf16_t)(pk2(silu(qh) * __expf(bb[i]), 0.f) & 0xffffu);
        Ks[s * 136 + dk] = (bf16_t)(pk2(kk[i] * __expf(-bb[i]), 0.f) & 0xffffu);
    }
#pragma unroll
    for (int i = 0; i < 2; ++i) { const int e = tid + 512 * i; *(LAS u32x4*)(Vs + (e >> 4) * 136 + 8 * (e & 15)) = R.vreg[i]; }
#pragma unroll
    for (int i = 0; i < 4; ++i) { const int e = tid + 512 * i; *(LAS u32x4*)(Ss + (e >> 4) * 136 + 8 * (e & 15)) = R.sreg[i]; }
    __syncthreads();
    {
        f32x4 a2[2] = {{0.f, 0.f, 0.f, 0.f}, {0.f, 0.f, 0.f, 0.f}};
#pragma unroll
        for (int ks = 0; ks < 4; ++ks) {
            const bf16x8 A = ld8(Qs + (16 * mt + lr) * 136 + 32 * ks + 8 * lq);
#pragma unroll
            for (int j = 0; j < 2; ++j) { const bf16x8 B = ld8(Ks + (16 * (2 * wh + j) + lr) * 136 + 32 * ks + 8 * lq); a2[j] = mfma16(A, B, a2[j]); }
        }
#pragma unroll
        for (int j = 0; j < 2; ++j)
#pragma unroll
            for (int r = 0; r < 4; ++r) { const int t = 16 * mt + 4 * lq + r, s = 16 * (2 * wh + j) + lr; As[t * 72 + s] = (bf16_t)(pk2(s <= t ? a2[j][r] : 0.f, 0.f) & 0xffffu); }
    }
    __syncthreads();
    f32x4 acc[4];
#pragma unroll
    for (int j = 0; j < 4; ++j) acc[j] = (f32x4){0.f, 0.f, 0.f, 0.f};
    const unsigned trq = (unsigned)(((8 * lq + (lr >> 2)) * 136 + 64 * wh + 4 * (lr & 3)) * 2);
    const unsigned trV = (unsigned)(unsigned long long)Vs + trq, trS = (unsigned)(unsigned long long)Ss + trq;
#define PK8(L_, H_) (bf16x8){L_[0], L_[1], L_[2], L_[3], H_[0], H_[1], H_[2], H_[3]}
    { const bf16x8 A = ld8(As + (16 * mt + lr) * 72 + 0 + 8 * lq);
      const s16x4 l0 = tr_read<0>(trV), h0 = tr_read<1088>(trV);
      const s16x4 l1 = tr_read<32>(trV), h1 = tr_read<1120>(trV);
      const s16x4 l2 = tr_read<64>(trV), h2 = tr_read<1152>(trV);
      const s16x4 l3 = tr_read<96>(trV), h3 = tr_read<1184>(trV);
      asm volatile("s_waitcnt lgkmcnt(0)" ::: "memory"); __builtin_amdgcn_sched_barrier(0);
      acc[0] = mfma16(A, PK8(l0, h0), acc[0]);
      acc[1] = mfma16(A, PK8(l1, h1), acc[1]);
      acc[2] = mfma16(A, PK8(l2, h2), acc[2]);
      acc[3] = mfma16(A, PK8(l3, h3), acc[3]);
    }
    { const bf16x8 A = ld8(As + (16 * mt + lr) * 72 + 32 + 8 * lq);
      const s16x4 l0 = tr_read<8704>(trV), h0 = tr_read<9792>(trV);
      const s16x4 l1 = tr_read<8736>(trV), h1 = tr_read<9824>(trV);
      const s16x4 l2 = tr_read<8768>(trV), h2 = tr_read<9856>(trV);
      const s16x4 l3 = tr_read<8800>(trV), h3 = tr_read<9888>(trV);
      asm volatile("s_waitcnt lgkmcnt(0)" ::: "memory"); __builtin_amdgcn_sched_barrier(0);
      acc[0] = mfma16(A, PK8(l0, h0), acc[0]);
      acc[1] = mfma16(A, PK8(l1, h1), acc[1]);
      acc[2] = mfma16(A, PK8(l2, h2), acc[2]);
      acc[3] = mfma16(A, PK8(l3, h3), acc[3]);
    }
    { const bf16x8 A = ld8(Qs + (16 * mt + lr) * 136 + 0 + 8 * lq);
      const s16x4 l0 = tr_read<0>(trS), h0 = tr_read<1088>(trS);
      const s16x4 l1 = tr_read<32>(trS), h1 = tr_read<1120>(trS);
      const s16x4 l2 = tr_read<64>(trS), h2 = tr_read<1152>(trS);
      const s16x4 l3 = tr_read<96>(trS), h3 = tr_read<1184>(trS);
      asm volatile("s_waitcnt lgkmcnt(0)" ::: "memory"); __builtin_amdgcn_sched_barrier(0);
      acc[0] = mfma16(A, PK8(l0, h0), acc[0]);
      acc[1] = mfma16(A, PK8(l1, h1), acc[1]);
      acc[2] = mfma16(A, PK8(l2, h2), acc[2]);
      acc[3] = mfma16(A, PK8(l3, h3), acc[3]);
    }
    { const bf16x8 A = ld8(Qs + (16 * mt + lr) * 136 + 32 + 8 * lq);
      const s16x4 l0 = tr_read<8704>(trS), h0 = tr_read<9792>(trS);
      const s16x4 l1 = tr_read<8736>(trS), h1 = tr_read<9824>(trS);
      const s16x4 l2 = tr_read<8768>(trS), h2 = tr_read<9856>(trS);
      const s16x4 l3 = tr_read<8800>(trS), h3 = tr_read<9888>(trS);
      asm volatile("s_waitcnt lgkmcnt(0)" ::: "memory"); __builtin_amdgcn_sched_barrier(0);
      acc[0] = mfma16(A, PK8(l0, h0), acc[0]);
      acc[1] = mfma16(A, PK8(l1, h1), acc[1]);
      acc[2] = mfma16(A, PK8(l2, h2), acc[2]);
      acc[3] = mfma16(A, PK8(l3, h3), acc[3]);
    }
    { const bf16x8 A = ld8(Qs + (16 * mt + lr) * 136 + 64 + 8 * lq);
      const s16x4 l0 = tr_read<17408>(trS), h0 = tr_read<18496>(trS);
      const s16x4 l1 = tr_read<17440>(trS), h1 = tr_read<18528>(trS);
      const s16x4 l2 = tr_read<17472>(trS), h2 = tr_read<18560>(trS);
      const s16x4 l3 = tr_read<17504>(trS), h3 = tr_read<18592>(trS);
      asm volatile("s_waitcnt lgkmcnt(0)" ::: "memory"); __builtin_amdgcn_sched_barrier(0);
      acc[0] = mfma16(A, PK8(l0, h0), acc[0]);
      acc[1] = mfma16(A, PK8(l1, h1), acc[1]);
      acc[2] = mfma16(A, PK8(l2, h2), acc[2]);
      acc[3] = mfma16(A, PK8(l3, h3), acc[3]);
    }
    { const bf16x8 A = ld8(Qs + (16 * mt + lr) * 136 + 96 + 8 * lq);
      const s16x4 l0 = tr_read<26112>(trS), h0 = tr_read<27200>(trS);
      const s16x4 l1 = tr_read<26144>(trS), h1 = tr_read<27232>(trS);
      const s16x4 l2 = tr_read<26176>(trS), h2 = tr_read<27264>(trS);
      const s16x4 l3 = tr_read<26208>(trS), h3 = tr_read<27296>(trS);
      asm volatile("s_waitcnt lgkmcnt(0)" ::: "memory"); __builtin_amdgcn_sched_barrier(0);
      acc[0] = mfma16(A, PK8(l0, h0), acc[0]);
      acc[1] = mfma16(A, PK8(l1, h1), acc[1]);
      acc[2] = mfma16(A, PK8(l2, h2), acc[2]);
      acc[3] = mfma16(A, PK8(l3, h3), acc[3]);
    }
#undef PK8
#pragma unroll
    for (int r = 0; r < 4; ++r) {
        float ss = 0.f;
#pragma unroll
        for (int j = 0; j < 4; ++j) ss += acc[j][r] * acc[j][r];
        ss += __shfl_xor(ss, 1); ss += __shfl_xor(ss, 2); ss += __shfl_xor(ss, 4); ss += __shfl_xor(ss, 8);
        if (lr == 0) red[(16 * mt + 4 * lq + r) * 2 + wh] = ss;
    }
    __syncthreads();
    const float* hgw = p.in[14];
#pragma unroll
    for (int r = 0; r < 4; ++r) {
        const int tl = 16 * mt + 4 * lq + r, t = 64 * n + tl;
        const float rstd = rsqrtf((red[tl * 2] + red[tl * 2 + 1]) * (1.f / 128.f) + EPS);
#pragma unroll
        for (int j = 0; j < 4; ++j) {
            const int dv = 16 * (4 * wh + j) + lr;
            const float gh = bf2f(ghr[r * 4 + j]);
            OHG[(size_t)t * 1024 + h * 128 + dv] = (bf16_t)(pk2(acc[j][r] * rstd * hgw[dv] * silu(gh), 0.f) & 0xffffu);
        }
    }
    __syncthreads();
}
DI void hg_sample_item(const Params& p, const bf16_t* Z, bf16_t* OHG, LAS unsigned char* L, int item) {
    const int b = item >> 3, h = item & 7;
    const int tid = threadIdx.x, dv = tid & 127, dq = tid >> 7;
    LAS float* fS = (LAS float*)L;
    LAS float* kS = fS + 512;
    LAS float* qS = kS + 512;
    LAS float* red = qS + 512;
    LAS float* rs = red + 2048;
    const float* lbp = p.in[13];
    {
        const int t = tid >> 7, dk = tid & 127, m = TP + b * 4 + t;
        const float lb = 1.f / (1.f + __expf(lbp[1024 + h * 128 + dk] - lbp[h * 128 + dk]));
        const float fh = bf2f(Z[(size_t)m * NZ + ZFH + h * 128 + dk]), qh = bf2f(Z[(size_t)m * NZ + ZQH + h * 128 + dk]);
        const float f = lb + (1.f - lb) * sigm(fh);
        fS[tid] = f; kS[tid] = 1.f - f; qS[tid] = silu(qh);
    }
    float S[32];
    const float* s0 = p.in[5] + ((size_t)(b * 8 + h) * 128) * 128;
#pragma unroll
    for (int i = 0; i < 32; ++i) S[i] = s0[(size_t)(dq * 32 + i) * 128 + dv];
    __syncthreads();
#pragma unroll
    for (int t = 0; t < 4; ++t) {
        const int m = TP + b * 4 + t;
        const float v = bf2f(Z[(size_t)m * NZ + ZIH + h * 128 + dv]);
        float part = 0.f;
#pragma unroll
        for (int i = 0; i < 32; ++i) { const int dk = dq * 32 + i; S[i] = fS[t * 128 + dk] * S[i] + kS[t * 128 + dk] * v; part += S[i] * qS[t * 128 + dk]; }
        red[(t * 4 + dq) * 128 + dv] = part;
    }
    float* so = p.out + OFF_HGS + ((size_t)(b * 8 + h) * 128) * 128;
#pragma unroll
    for (int i = 0; i < 32; ++i) so[(size_t)(dq * 32 + i) * 128 + dv] = S[i];
    __syncthreads();
    {
        const int t = tid >> 7, m = TP + b * 4 + t;
        const float o = red[(t * 4 + 0) * 128 + dv] + red[(t * 4 + 1) * 128 + dv] + red[(t * 4 + 2) * 128 + dv] + red[(t * 4 + 3) * 128 + dv];
        const float ss = wave_sum(o * o);
        if ((tid & 63) == 0) rs[tid >> 6] = ss;
        __syncthreads();
        const float rstd = rsqrtf((rs[2 * t] + rs[2 * t + 1]) * (1.f / 128.f) + EPS);
        const float gh = bf2f(Z[(size_t)m * NZ + ZGH + h * 128 + dv]);
        OHG[(size_t)m * 1024 + h * 128 + dv] = (bf16_t)(pk2(o * rstd * p.in[14][dv] * silu(gh), 0.f) & 0xffffu);
    }
    __syncthreads();
}
DI void ph_merge(const bf16_t* OG, const float* LSE, bf16_t* OATT) {
    for (size_t idx = (size_t)blockIdx.x * 512 + threadIdx.x; idx < (size_t)MR * 64; idx += (size_t)gridDim.x * 512) {
        const int m = (int)(idx >> 6), c8 = (int)(idx & 63), hh = c8 >> 4;
        const float l0 = LSE[((size_t)0 * MP + m) * 4 + hh], l1 = LSE[((size_t)1 * MP + m) * 4 + hh], l2 = LSE[((size_t)2 * MP + m) * 4 + hh];
        const float mx = fmaxf(l0, fmaxf(l1, l2));
        float w0 = __expf(l0 - mx), w1 = __expf(l1 - mx), w2 = __expf(l2 - mx);
        const float inv = 1.f / (w0 + w1 + w2); w0 *= inv; w1 *= inv; w2 *= inv;
        float a[8], b[8], c[8];
        unpack8(*(const u32x4*)(OG + ((size_t)0 * MP + m) * 512 + 8 * c8), a);
        unpack8(*(const u32x4*)(OG + ((size_t)1 * MP + m) * 512 + 8 * c8), b);
        unpack8(*(const u32x4*)(OG + ((size_t)2 * MP + m) * 512 + 8 * c8), c);
        u32x4 o;
        o.x = pk2(w0 * a[0] + w1 * b[0] + w2 * c[0], w0 * a[1] + w1 * b[1] + w2 * c[1]);
        o.y = pk2(w0 * a[2] + w1 * b[2] + w2 * c[2], w0 * a[3] + w1 * b[3] + w2 * c[3]);
        o.z = pk2(w0 * a[4] + w1 * b[4] + w2 * c[4], w0 * a[5] + w1 * b[5] + w2 * c[5]);
        o.w = pk2(w0 * a[6] + w1 * b[6] + w2 * c[6], w0 * a[7] + w1 * b[7] + w2 * c[7]);
        *(u32x4*)(OATT + (size_t)m * 512 + 8 * c8) = o;
    }
}
DI void ld8p(const float* s, float (&f)[8]) {
    f32x4 a = {0.f, 0.f, 0.f, 0.f}, b = a;
#pragma unroll
    for (int q = 0; q < NSP_UP; ++q) { a = a + *(const f32x4*)(s + (size_t)q * NS * NAB); b = b + *(const f32x4*)(s + (size_t)q * NS * NAB + 4); }
    f[0] = a[0]; f[1] = a[1]; f[2] = a[2]; f[3] = a[3]; f[4] = b[0]; f[5] = b[1]; f[6] = b[2]; f[7] = b[3];
}
DI void ph_convact(const Params& p, const bf16_t* AB, bf16_t* G) {
    const float* cw = p.in[21]; const float* cb = p.in[22]; const float* sc = p.in[6];
    const float* ACC = (const float*)(p.ws + WS_ACC_UP);
    for (size_t idx = (size_t)blockIdx.x * 512 + threadIdx.x; idx < (size_t)(126 + NS) * 704; idx += (size_t)gridDim.x * 512) {
        const int ri = (int)(idx / 704), c = (int)(idx % 704) * 8;
        const int m = ri < 126 ? 256 * (1 + (ri >> 1)) + (ri & 1) : TP + (ri - 126);
        float a2[8], a1[8], a0[8], bl[8];
        if (m < TP) {
            unpack8(*(const u32x4*)(AB + (size_t)m * NAB + c), a2);
            unpack8(*(const u32x4*)(AB + (size_t)m * NAB + DFF + c), bl);
            if (m >= 1) unpack8(*(const u32x4*)(AB + (size_t)(m - 1) * NAB + c), a1); else { for (int j = 0; j < 8; ++j) a1[j] = 0.f; }
            if (m >= 2) unpack8(*(const u32x4*)(AB + (size_t)(m - 2) * NAB + c), a0); else { for (int j = 0; j < 8; ++j) a0[j] = 0.f; }
        } else {
            const int ms = m - TP, t = ms & 3, b = ms >> 2;
            ld8p(ACC + (size_t)ms * NAB + c, a2);
            ld8p(ACC + (size_t)ms * NAB + DFF + c, bl);
            if (t >= 1) ld8p(ACC + (size_t)(ms - 1) * NAB + c, a1); else ld8f(sc + (size_t)(b * 2 + 1) * DFF + c, a1);
            if (t >= 2) ld8p(ACC + (size_t)(ms - 2) * NAB + c, a0); else ld8f(sc + (size_t)(b * 2 + t) * DFF + c, a0);
            if (t >= 2) { float* d = p.out + OFF_CVS + (size_t)(b * 2 + t - 2) * DFF + c; *(f32x4*)d = (f32x4){a2[0], a2[1], a2[2], a2[3]}; *(f32x4*)(d + 4) = (f32x4){a2[4], a2[5], a2[6], a2[7]}; }
        }
        float w0[8], w1[8], w2[8], bb[8];
        ld8f(cw + c, w0); ld8f(cw + DFF + c, w1); ld8f(cw + 2 * DFF + c, w2); ld8f(cb + c, bb);
        float o[8];
#pragma unroll
        for (int j = 0; j < 8; ++j) { const float u = bb[j] + w0[j] * a0[j] + w1[j] * a1[j] + w2[j] * a2[j]; o[j] = silu(u) * bl[j]; }
        u32x4 w; w.x = pk2(o[0], o[1]); w.y = pk2(o[2], o[3]); w.z = pk2(o[4], o[5]); w.w = pk2(o[6], o[7]);
        *(u32x4*)(G + (size_t)m * DFF + c) = w;
    }
}

DI void ph_mixfix(const Params& p) {
    const bf16_t* Z = (const bf16_t*)(p.ws + WS_Z); const float* PA = (const float*)(p.ws + WS_ACC_PA); const float* PB = (const float*)(p.ws + WS_ACC_PB); bf16_t* Y = (bf16_t*)(p.ws + WS_YMIX);
    for (int idx = blockIdx.x * 512 + threadIdx.x; idx < NS * (D / 4); idx += gridDim.x * 512) {
        const int r = idx / (D / 4), c = (idx % (D / 4)) * 4;
        f32x4 a = {0.f, 0.f, 0.f, 0.f}, b = a;
#pragma unroll
        for (int q = 0; q < NSP_PA; ++q) a = a + *(const f32x4*)(PA + ((size_t)q * NS + r) * D + c);
#pragma unroll
        for (int q = 0; q < NSP_PB; ++q) b = b + *(const f32x4*)(PB + ((size_t)q * NS + r) * D + c);
        const u32x2 ga = *(const u32x2*)(Z + (size_t)(TP + r) * NZ + ZGA + c), gb = *(const u32x2*)(Z + (size_t)(TP + r) * NZ + ZGB + c);
        const float y0 = sigm(bflo(ga.x)) * a[0] + sigm(bflo(gb.x)) * b[0], y1 = sigm(bfhi(ga.x)) * a[1] + sigm(bfhi(gb.x)) * b[1];
        const float y2 = sigm(bflo(ga.y)) * a[2] + sigm(bflo(gb.y)) * b[2], y3 = sigm(bfhi(ga.y)) * a[3] + sigm(bfhi(gb.y)) * b[3];
        u32x2 w; w.x = pk2(y0, y1); w.y = pk2(y2, y3);
        *(u32x2*)(Y + (size_t)(TP + r) * D + c) = w;
    }
}
#define XB_TMO      128
#define XB_XCNT(j)  (256  + 64 * (j))
#define XB_XSUB(j)  (1280 + 64 * (j))
#define XB_XGEN(j)  (2304 + 64 * (j))
#define XB_TOP      3328
#define XB_TOPGEN   3392
#define XCD_BAR_WORDS 3456
#define XB_SPIN_CAP (1u << 18)

__device__ __forceinline__ unsigned xb_ld(unsigned* p)              { return __hip_atomic_load(p, __ATOMIC_RELAXED, __HIP_MEMORY_SCOPE_AGENT); }
__device__ __forceinline__ unsigned xb_add(unsigned* p, unsigned v) { return __hip_atomic_fetch_add(p, v, __ATOMIC_RELAXED, __HIP_MEMORY_SCOPE_AGENT); }
__device__ __forceinline__ unsigned xb_xcc_id() { return (unsigned)__builtin_amdgcn_s_getreg((3 << 11) | 20) & 0xFu; }
#define XB_SPIN(cond, bar) do { unsigned _sp = 0; while (cond) { __builtin_amdgcn_s_sleep(1); \
    if ((++_sp & 255u) == 0u) { if (xb_ld(&(bar)[XB_TMO])) break; if (_sp > XB_SPIN_CAP) { atomicAdd(&(bar)[XB_TMO], 1u); break; } } } } while (0)

struct XcdBarrier {
    unsigned* bar; unsigned x;
    volatile LAS unsigned* st;
};

__device__ __forceinline__ XcdBarrier xcd_barrier_post(unsigned* bar, volatile LAS unsigned* st) {
    XcdBarrier b; b.bar = bar; b.x = xb_xcc_id(); b.st = st;
    if (threadIdx.x == 0) (void)xb_add(&bar[XB_XCNT(b.x)], 1u);
    return b;
}
__device__ __forceinline__ void xcd_barrier_complete(unsigned* bar, unsigned x, unsigned& nloc, unsigned& nx) {
    const unsigned G = gridDim.x * gridDim.y * gridDim.z;
    unsigned sum, cnt, mine, sp = 0u;
    for (;;) {
        sum = 0u; cnt = 0u; mine = 0u;
#pragma unroll
        for (unsigned j = 0; j < 16; ++j) { const unsigned c = xb_ld(&bar[XB_XCNT(j)]); sum += c; cnt += (c > 0u) ? 1u : 0u; mine = (j == x) ? c : mine; }
        if (sum == G) break;
        __builtin_amdgcn_s_sleep(1);
        if ((++sp & 255u) == 0u) { if (xb_ld(&bar[XB_TMO])) break; if (sp > XB_SPIN_CAP) { atomicAdd(&bar[XB_TMO], 1u); break; } }
    }
    nloc = mine > 0u ? mine : 1u; nx = cnt > 0u ? cnt : 1u;
}

__device__ __forceinline__ void xcd_barrier(const XcdBarrier& b) {
    asm volatile("s_waitcnt vmcnt(0)" ::: "memory");
    __syncthreads();
    if (threadIdx.x == 0) {
        unsigned* bar = b.bar;
        __builtin_amdgcn_s_waitcnt(0);
        unsigned nloc = b.st[0], nx = b.st[1];
        if (nloc == 0u) { xcd_barrier_complete(bar, b.x, nloc, nx); b.st[0] = nloc; b.st[1] = nx; }
        const unsigned old = xb_add(&bar[XB_XSUB(b.x)], 1u);
        const unsigned gen = old / nloc;
        if (old + 1u == (gen + 1u) * nloc) {
            __builtin_amdgcn_fence(__ATOMIC_RELEASE, "agent");
            asm volatile("s_waitcnt vmcnt(0)" ::: "memory");
            const unsigned og = xb_add(&bar[XB_TOP], 1u);
            const unsigned tg = og / nx;
            if (og + 1u == (tg + 1u) * nx) xb_add(&bar[XB_TOPGEN], 1u);
            else XB_SPIN(xb_ld(&bar[XB_TOPGEN]) == tg, bar);
            __builtin_amdgcn_fence(__ATOMIC_ACQUIRE, "agent");
            xb_add(&bar[XB_XGEN(b.x)], 1u);
            asm volatile("s_waitcnt vmcnt(0)" ::: "memory");
        } else {
            XB_SPIN(xb_ld(&bar[XB_XGEN(b.x)]) == gen, bar);
            __builtin_amdgcn_fence(__ATOMIC_ACQUIRE, "agent");
            asm volatile("s_waitcnt vmcnt(0)" ::: "memory");
        }
    }
    __syncthreads();
}

template <class Epi> DI void run_gemm(LAS unsigned char* L, const bf16_t* A, const bf16_t* Bt, int N, int K, const Epi& E) {
    pg8::Gemm g{A, Bt, MP, N, K}; pg8::StaticOrder S; S.init(MP, N, K, (int)gridDim.x, (int)blockIdx.x);
    pg8::gemm_phase<Epi, pg8::StaticOrder, false>(L, g, S, E, nullptr);
}
template <class Epi> DI void run_gemm_split(LAS unsigned char* L, const bf16_t* A, const bf16_t* Bt, int N, int K, const Epi& E) {
    pg8::Gemm g{A, Bt, MP, N, K}; pg8::SplitOrder S; S.init(N, K, (int)gridDim.x, (int)blockIdx.x);
    pg8::gemm_phase<Epi, pg8::SplitOrder, false>(L, g, S, E, nullptr);
}

__global__ void __launch_bounds__(512, 2) mega(Params p) {
    extern __shared__ __attribute__((aligned(16))) unsigned char lds[];
    LAS unsigned char* L = (LAS unsigned char*)lds;
    cg::grid_group grid = cg::this_grid();
    unsigned char* ws = p.ws;
    const int lo = p.ph_lo, hi = p.ph_hi;
    const int tid = threadIdx.x, lane = tid & 63, wave = tid >> 6;
    bf16_t* Z = (bf16_t*)(ws + WS_Z);
    bf16_t* H = (bf16_t*)(ws + WS_H);
    float* MOD = (float*)(ws + WS_MOD);
#define IN(k) (lo <= (k) && (k) < hi)
    XcdBarrier xbar; xbar.bar = (unsigned*)ws; xbar.x = 0; xbar.st = (volatile LAS unsigned*)(L + 131072 + 4096);
    if (hi - lo > 1) {
        if (threadIdx.x < 2) xbar.st[threadIdx.x] = 0u;
        __syncthreads();
        xbar = xcd_barrier_post((unsigned*)ws, (volatile LAS unsigned*)(L + 131072 + 4096));
        grid.sync();
    }
#define SEAM(k) do { if (IN(k) && IN((k) + 1)) xcd_barrier(xbar); } while (0)
#define SOFT(k) do { if (IN(k) && IN((k) + 1)) __syncthreads(); } while (0)
    if (IN(0)) ph_prologue(p, L);
    SEAM(0);
    if (IN(1)) ph_hnorm(p, nullptr, false, p.in[11], 0, H);
    SEAM(1);
    if (IN(2)) { EpiZ E{Z, (const float*)(ws + WS_ROPE), p.out, p.in[2], p.in[3], p.in[4]}; run_gemm(L, H, (const bf16_t*)(ws + WS_WIN), NZ, D, E); }
    SEAM(2);
    if (IN(3)) {
        HgaRegs RA;
        int it = blockIdx.x;
        if (it < 2048) hg_passA_load(Z, it, RA);
        while (it < 2048) {
            const int itn = it + gridDim.x; HgaRegs RB;
            if (itn < 2048) hg_passA_load(Z, itn, RB);
            hg_passA_item(p, (float*)(ws + WS_HS), (float*)(ws + WS_HD), L, it, RA);
            RA = RB; it = itn;
        }
    }
    SOFT(3);
    if (IN(4)) {
        const int gw = blockIdx.x * 8 + wave, NGW = gridDim.x * 8;
        LAS bf16_t* Vl = (LAS bf16_t*)(L + wave * 8704);
        for (int base = 0; base < 6144; base += 3 * NGW)
            for (int j = 0; j < 3; ++j) { const int it = base + gw * 3 + j; if (it < 6144) attn_prompt_item(Z, (bf16_t*)(ws + WS_OG), (float*)(ws + WS_LSE), Vl, it, lane); }
    }
    SOFT(4);
    if (IN(5)) { const int gw = blockIdx.x * 8 + wave, NGW = gridDim.x * 8; for (int it = gw; it < 1536; it += NGW) attn_sample_item(p, Z, (bf16_t*)(ws + WS_OG), (float*)(ws + WS_LSE), it, lane); }
    SEAM(5);
    if (IN(6)) hg_scan(p, (const float*)(ws + WS_HS), (bf16_t*)(ws + WS_HS2), (const float*)(ws + WS_HD));
    SEAM(6);
    if (IN(7)) {
        HgcRegs RA;
        int it = blockIdx.x;
        if (it < 2048) hg_passC_load(Z, (const bf16_t*)(ws + WS_HS2), it, RA);
        while (it < 2048) {
            const int itn = it + gridDim.x; HgcRegs RB;
            if (itn < 2048) hg_passC_load(Z, (const bf16_t*)(ws + WS_HS2), itn, RB);
            hg_passC_item(p, Z, (bf16_t*)(ws + WS_OHG), L, it, RA);
            RA = RB; it = itn;
        }
    }
    SOFT(7);
    if (IN(8)) for (int it = blockIdx.x; it < 256; it += gridDim.x) hg_sample_item(p, Z, (bf16_t*)(ws + WS_OHG), L, it);
    SOFT(8);
    if (IN(9)) ph_merge((const bf16_t*)(ws + WS_OG), (const float*)(ws + WS_LSE), (bf16_t*)(ws + WS_OATT));
    SEAM(9);
    if (IN(10)) {
        { EpiMix1 E{Z, (float*)(ws + WS_TMP), (float*)(ws + WS_ACC_PA)}; run_gemm_split(L, (const bf16_t*)(ws + WS_OATT), (const bf16_t*)(ws + WS_WPA), D, 512, E); }
        { EpiMix2 E{Z, (const float*)(ws + WS_TMP), (bf16_t*)(ws + WS_YMIX), (float*)(ws + WS_ACC_PB)}; run_gemm_split(L, (const bf16_t*)(ws + WS_OHG), (const bf16_t*)(ws + WS_WPB), D, 1024, E); }
    }
    SEAM(10);
    if (IN(11)) ph_mixfix(p);
    SEAM(11);
    if (IN(12)) { EpiWO E{p.in[0], p.in[1], MOD, p.out, (float*)(ws + WS_ACC_WO)}; run_gemm_split(L, (const bf16_t*)(ws + WS_YMIX), (const bf16_t*)(ws + WS_WO), D, D, E); }
    SEAM(12);
    if (IN(13)) ph_hnorm(p, p.out, true, p.in[18], 3, H);
    SEAM(13);
    if (IN(14)) { EpiUp E{(bf16_t*)(ws + WS_AB), (bf16_t*)(ws + WS_G), p.out, (float*)(ws + WS_ACC_UP), p.in[21], p.in[22], (LAS float*)(L + 131072)}; run_gemm_split(L, H, (const bf16_t*)(ws + WS_WAB), NAB, D, E); }
    SEAM(14);
    if (IN(15)) ph_convact(p, (const bf16_t*)(ws + WS_AB), (bf16_t*)(ws + WS_G));
    SEAM(15);
    if (IN(16)) { EpiDown E{MOD, p.out, (float*)(ws + WS_ACC_DN)}; run_gemm_split(L, (const bf16_t*)(ws + WS_G), (const bf16_t*)(ws + WS_WDN), D, DFF, E); }
    SEAM(16);
    if (IN(17)) ph_final_norm(p);
#undef IN
#undef SEAM
#undef SOFT
}

#ifndef MK_MULTI
#define MK_MULTI 0
#endif
extern "C" void kernel_launch(void* const* d_in, const int* in_sizes, int n_in, void* d_out, int out_size, void* d_ws, size_t ws_size, hipStream_t stream) {
    static int grid = 0;
    if (grid == 0) {
        if (n_in != 25 || (size_t)out_size != OUT_TOTAL || ws_size < WS_END) { fprintf(stderr, "kernel_launch: unexpected shapes: n_in %d out %d ws %zu (need %zu)\n", n_in, out_size, ws_size, (size_t)WS_END); grid = -1; return; }
        int dev = 0, cus = 0, per_cu = 0;
        hipGetDevice(&dev);
        hipDeviceGetAttribute(&cus, hipDeviceAttributeMultiprocessorCount, dev);
        if (hipFuncSetAttribute((const void*)mega, hipFuncAttributeMaxDynamicSharedMemorySize, LDS_BYTES) != hipSuccess) { fprintf(stderr, "kernel_launch: hipFuncSetAttribute failed\n"); grid = -1; return; }
        if (hipOccupancyMaxActiveBlocksPerMultiprocessor(&per_cu, (const void*)mega, 512, LDS_BYTES) != hipSuccess || per_cu < 1) { fprintf(stderr, "kernel_launch: occupancy query failed (%d)\n", per_cu); (void)hipGetLastError(); per_cu = 1; }
        grid = cus * 1;
        if (grid < 1) grid = -1;
    }
    if (grid < 0) return;
    Params p{};
    for (int i = 0; i < 25; ++i) p.in[i] = (const float*)d_in[i];
    p.out = (float*)d_out; p.ws = (unsigned char*)d_ws;
#ifndef DUP_MASK
#define DUP_MASK 0
#endif
#if MK_MULTI
    for (int ph = 0; ph < NPH; ++ph) for (int rep = 0; rep < (((DUP_MASK >> ph) & 1) ? 2 : 1); ++rep) { p.ph_lo = ph; p.ph_hi = ph + 1; hipLaunchKernelGGL(mega, dim3(grid), dim3(512), LDS_BYTES, stream, p); }
#else
    p.ph_lo = 0; p.ph_hi = NPH;
    if (hipMemsetAsync(d_ws, 0, 16384, stream) != hipSuccess) { fprintf(stderr, "kernel_launch: memset of the barrier words failed\n"); return; }
    void* args[] = {&p};
    hipError_t e = hipLaunchCooperativeKernel((const void*)mega, dim3(grid), dim3(512), args, LDS_BYTES, stream);
    if (e != hipSuccess) fprintf(stderr, "cooperative launch failed: %s (grid %d)\n", hipGetErrorString(e), grid);
#endif
}
```
